# Optimizing an MI355X kernel written in HIP

```python
import jax
import jax.numpy as jnp
from jax import lax
import numpy as np

D_MODEL = 1024
BATCH = 8
SEQ = 4096
DEPTH = 4

HEAD_DIM = 64
CHUNK = 64
MIX_HALF = D_MODEL // 2
N_EVEN = (DEPTH + 1) // 2
N_ODD = DEPTH // 2
NORM_EPS = 1e-6

RWKV_HEADS = MIX_HALF // HEAD_DIM
RWKV_DECAY_RANK = 64
RWKV_ICLR_RANK = 64
RWKV_GATE_RANK = 128
RWKV_IN = 3 * MIX_HALF + RWKV_DECAY_RANK + RWKV_ICLR_RANK + RWKV_GATE_RANK
RWKV_GN_EPS = 64e-5
RWKV_DECAY_SCALE = float(np.exp(-0.5))

GLA_HEADS = 4
GLA_DV = MIX_HALF // GLA_HEADS
GLA_DK = GLA_DV // 2
GLA_KEY = GLA_HEADS * GLA_DK
GLA_GATE_RANK = 16
GLA_GATE_NORM = 16.0
GLA_IN = 2 * GLA_KEY + MIX_HALF + GLA_GATE_RANK + MIX_HALF

HGRN_HEADS = 4
HGRN_DV = MIX_HALF // HGRN_HEADS
HGRN_DK = HGRN_DV // 2
HGRN_KEY = HGRN_HEADS * HGRN_DK
HGRN_IN = 2 * HGRN_KEY + 2 * MIX_HALF

SSD_HEADS = MIX_HALF // HEAD_DIM
SSD_GROUPS = 2
SSD_STATE = 64
SSD_CONV = 4
SSD_XBC = MIX_HALF + 2 * SSD_GROUPS * SSD_STATE
SSD_IN = MIX_HALF + SSD_XBC + SSD_HEADS

EVEN_IN = RWKV_IN + GLA_IN
ODD_IN = HGRN_IN + SSD_IN

N_EXPERTS = 16
N_EXPERT_GROUPS = 4
EXPERTS_PER_GROUP = N_EXPERTS // N_EXPERT_GROUPS
TOP_K = 2
D_EXPERT = D_MODEL // 2
MOE_BLOCK = 128

kernel_name = 'hybrid_rwkv7_gla_hgrn2_ssd_grouped_moe_adaln'


def split_cols(u, sizes):
    idx = [int(s) for s in np.cumsum(sizes)[:-1]]
    return jnp.split(u, idx, axis=-1)


def rms_norm(x, gain):
    xf = x.astype(jnp.float32)
    y = xf * lax.rsqrt(jnp.mean(xf * xf, axis=-1, keepdims=True) + NORM_EPS)
    return y.astype(x.dtype) * gain


def token_shift(u):
    return jnp.pad(u[:, :-1], ((0, 0), (1, 0), (0, 0)))


def causal_depthwise_conv(x, w, b):
    y = lax.conv_general_dilated(x, w[:, None, :], window_strides=(1,), padding=[(SSD_CONV - 1, 0)],
                                 dimension_numbers=('NWC', 'WIO', 'NWC'), feature_group_count=x.shape[-1])
    return y + b


def to_chunks(t):
    bsz, s, h, d = t.shape
    return t.reshape(bsz, s // CHUNK, CHUNK, h, d).transpose(1, 0, 3, 2, 4)


def chunked_gated_linear_attention(q, k, v, log_decay):
    bsz, s, h, dk = q.shape
    dv = v.shape[-1]
    causal = jnp.tril(jnp.ones((CHUNK, CHUNK), dtype=bool))

    def step(state, inp):
        qc, kc, vc, gc = inp
        b = jnp.cumsum(gc, axis=2)
        o_inter = jnp.einsum('bhid,bhdv->bhiv', qc * jnp.exp(b), state)
        diff = jnp.where(causal[:, :, None], b[:, :, :, None, :] - b[:, :, None, :, :], -jnp.inf)
        scores = jnp.einsum('bhid,bhjd,bhijd->bhij', qc, kc, jnp.exp(diff))
        o_intra = jnp.einsum('bhij,bhjv->bhiv', scores, vc)
        b_last = b[:, :, -1:, :]
        state = (jnp.exp(b_last[:, :, 0, :])[..., None] * state
                 + jnp.einsum('bhjd,bhjv->bhdv', kc * jnp.exp(b_last - b), vc))
        return state, o_inter + o_intra

    state0 = jnp.zeros((bsz, h, dk, dv), jnp.float32)
    _, o = lax.scan(step, state0, (to_chunks(q), to_chunks(k), to_chunks(v), to_chunks(log_decay)))
    return o.transpose(1, 0, 3, 2, 4).reshape(bsz, s, h, dv)


def rwkv7_recurrence(r, w, kk, a, kt, v):
    bsz, s, h, n = r.shape

    def step(state, inp):
        r_t, w_t, kk_t, a_t, kt_t, v_t = inp
        removed = jnp.einsum('bhvk,bhk->bhv', state, kk_t)
        state = (state * w_t[:, :, None, :]
                 - removed[..., None] * (kk_t * a_t)[:, :, None, :]
                 + v_t[..., None] * kt_t[:, :, None, :])
        return state, jnp.einsum('bhvk,bhk->bhv', state, r_t)

    xs = tuple(t.transpose(1, 0, 2, 3) for t in (r, w, kk, a, kt, v))
    _, y = lax.scan(step, jnp.zeros((bsz, h, n, n), jnp.float32), xs)
    return y.transpose(1, 0, 2, 3)


def ssd_chunked(xh, dt, a_neg, bm, cm):
    bsz, s, h, p = xh.shape
    g, n = bm.shape[2], bm.shape[3]
    rep = h // g
    nc = s // CHUNK
    causal = jnp.tril(jnp.ones((CHUNK, CHUNK), dtype=bool))
    x = (xh * dt[..., None]).reshape(bsz, nc, CHUNK, g, rep, p)
    bc = bm.reshape(bsz, nc, CHUNK, g, n)
    cc = cm.reshape(bsz, nc, CHUNK, g, n)
    da = (dt * a_neg).reshape(bsz, nc, CHUNK, g, rep).transpose(0, 1, 3, 4, 2)
    cum = jnp.cumsum(da, axis=-1)
    seg = jnp.exp(jnp.where(causal, cum[..., :, None] - cum[..., None, :], -jnp.inf))
    cb = jnp.einsum('bclgn,bcsgn->bcgls', cc, bc)
    y_diag = jnp.einsum('bcgls,bcgrls,bcsgrp->bclgrp', cb, seg, x)
    decay_to_end = jnp.exp(cum[..., -1:] - cum)
    chunk_states = jnp.einsum('bcsgn,bcgrs,bcsgrp->bcgrpn', bc, decay_to_end, x)
    chunk_decay = jnp.exp(cum[..., -1])

    def step(hs, inp):
        st, dec = inp
        return dec[..., None, None] * hs + st, hs

    h0 = jnp.zeros((bsz, g, rep, p, n), jnp.float32)
    _, prev = lax.scan(step, h0, (chunk_states.transpose(1, 0, 2, 3, 4, 5), chunk_decay.transpose(1, 0, 2, 3)))
    prev = prev.transpose(1, 0, 2, 3, 4, 5)
    y_off = jnp.einsum('bclgn,bcgrpn,bcgrl->bclgrp', cc, prev, jnp.exp(cum))
    return (y_diag + y_off).reshape(bsz, s, h, p)


def rwkv7_group(ua, mu, w0, w_up, a0, a_up, g_up, k_k, k_a, r_k, ln_gain, ln_bias):
    bsz, s, _ = ua.shape
    f32 = jnp.float32
    ua = ua + mu * (token_shift(ua) - ua)
    r, k, v, wd, ad, gd = split_cols(ua, [MIX_HALF, MIX_HALF, MIX_HALF, RWKV_DECAY_RANK, RWKV_ICLR_RANK, RWKV_GATE_RANK])
    d = (w0 + jnp.tanh(wd) @ w_up).astype(f32)
    w = jnp.exp(-RWKV_DECAY_SCALE * jax.nn.sigmoid(d))
    a = jax.nn.sigmoid((a0 + ad @ a_up).astype(f32))
    gate = jax.nn.sigmoid(gd) @ g_up
    hd = lambda t: t.astype(f32).reshape(bsz, s, RWKV_HEADS, HEAD_DIM)
    r, k, v, w, a = hd(r), hd(k), hd(v), hd(w), hd(a)
    kk = k * k_k.astype(f32).reshape(RWKV_HEADS, HEAD_DIM)
    kk = kk * lax.rsqrt(jnp.sum(kk * kk, axis=-1, keepdims=True) + 1e-12)
    kt = k * (1.0 + (a - 1.0) * k_a.astype(f32).reshape(RWKV_HEADS, HEAD_DIM))
    y = rwkv7_recurrence(r, w, kk, a, kt, v)
    mean = jnp.mean(y, axis=-1, keepdims=True)
    var = jnp.mean((y - mean) ** 2, axis=-1, keepdims=True)
    y = ((y - mean) * lax.rsqrt(var + RWKV_GN_EPS) * ln_gain.astype(f32).reshape(RWKV_HEADS, HEAD_DIM)
         + ln_bias.astype(f32).reshape(RWKV_HEADS, HEAD_DIM))
    y = y + jnp.sum(r * kt * r_k.astype(f32), axis=-1, keepdims=True) * v
    return (y.reshape(bsz, s, MIX_HALF) * gate).astype(ua.dtype)


def gla_group(ub, alpha_up, alpha_bias, norm_gain):
    bsz, s, _ = ub.shape
    f32 = jnp.float32
    q, k, v, ad, g = split_cols(ub, [GLA_KEY, GLA_KEY, MIX_HALF, GLA_GATE_RANK, MIX_HALF])
    log_a = jax.nn.log_sigmoid((ad @ alpha_up + alpha_bias).astype(f32)) / GLA_GATE_NORM
    hd = lambda t: t.astype(f32).reshape(bsz, s, GLA_HEADS, -1)
    o = chunked_gated_linear_attention(hd(q) * GLA_DK ** -0.5, hd(k), hd(v), hd(log_a))
    o = rms_norm(o, norm_gain)
    return (o.reshape(bsz, s, MIX_HALF) * jax.nn.silu(g)).astype(ub.dtype)


def hgrn_lower_bounds(c_lb):
    p = jax.nn.softmax(c_lb.astype(jnp.float32), axis=0)
    cum = jnp.cumsum(p, axis=0)
    return cum - cum[0:1]


def hgrn2_group(uc, lb, norm_gain):
    bsz, s, _ = uc.shape
    f32 = jnp.float32
    q, fr, i, g = split_cols(uc, [HGRN_KEY, HGRN_KEY, MIX_HALF, MIX_HALF])
    f = lb + (1.0 - lb) * jax.nn.sigmoid(fr.astype(f32))
    hd = lambda t: t.astype(f32).reshape(bsz, s, HGRN_HEADS, -1)
    o = chunked_gated_linear_attention(hd(q), hd(1.0 - f), hd(i), hd(jnp.log(f)))
    o = rms_norm(o, norm_gain)
    return (o.reshape(bsz, s, MIX_HALF) * jax.nn.silu(g)).astype(uc.dtype)


def ssd_group(ud, conv_w, conv_b, dt_bias, a_log, skip, norm_gain):
    bsz, s, _ = ud.shape
    f32 = jnp.float32
    z, xbc, dt_raw = split_cols(ud, [MIX_HALF, SSD_XBC, SSD_HEADS])
    xbc = jax.nn.silu(causal_depthwise_conv(xbc, conv_w, conv_b))
    xs, bm, cm = split_cols(xbc, [MIX_HALF, SSD_GROUPS * SSD_STATE, SSD_GROUPS * SSD_STATE])
    dt = jax.nn.softplus((dt_raw + dt_bias).astype(f32))
    a_neg = -jnp.exp(a_log.astype(f32))
    xh = xs.astype(f32).reshape(bsz, s, SSD_HEADS, HEAD_DIM)
    y = ssd_chunked(xh, dt, a_neg,
                    bm.astype(f32).reshape(bsz, s, SSD_GROUPS, SSD_STATE),
                    cm.astype(f32).reshape(bsz, s, SSD_GROUPS, SSD_STATE))
    y = y + skip.astype(f32)[:, None] * xh
    y = y.reshape(bsz, s, MIX_HALF) * jax.nn.silu(z.astype(f32))
    y = rms_norm(y.reshape(bsz, s, SSD_GROUPS, -1), norm_gain.astype(f32).reshape(SSD_GROUPS, -1))
    return y.reshape(bsz, s, MIX_HALF).astype(ud.dtype)


def grouped_moe(h, w_router, router_bias, w_gate, w_up, w_down):
    bsz, s, d = h.shape
    t = bsz * s
    hf = h.reshape(t, d)
    scores = jax.nn.sigmoid((hf @ w_router).astype(jnp.float32))
    sel = (scores + router_bias.astype(jnp.float32)).reshape(t, N_EXPERT_GROUPS, EXPERTS_PER_GROUP)
    group_score = jnp.sum(lax.top_k(sel, TOP_K)[0], axis=-1)
    group = jnp.argmax(group_score, axis=-1)
    in_group = jnp.take_along_axis(sel, group[:, None, None], axis=1)[:, 0]
    _, local = lax.top_k(in_group, TOP_K)
    expert = group[:, None] * EXPERTS_PER_GROUP + local
    gate = jnp.take_along_axis(scores, expert, axis=1)
    gate = gate / jnp.sum(gate, axis=-1, keepdims=True)
    n_assign = t * TOP_K
    flat_e = expert.reshape(n_assign)
    order = jnp.argsort(flat_e)
    sorted_e = flat_e[order]
    tok = (order // TOP_K).astype(jnp.int32)
    counts = jnp.bincount(flat_e, length=N_EXPERTS)
    padded = (counts + MOE_BLOCK - 1) // MOE_BLOCK * MOE_BLOCK
    pad_end = jnp.cumsum(padded)
    pad_start = pad_end - padded
    start = jnp.cumsum(counts) - counts
    dest = pad_start[sorted_e] + (jnp.arange(n_assign) - start[sorted_e])
    n_blocks = -(-n_assign // MOE_BLOCK) + N_EXPERTS
    n_pad = n_blocks * MOE_BLOCK
    buf_tok = jnp.zeros((n_pad,), jnp.int32).at[dest].set(tok)
    buf_w = jnp.zeros((n_pad,), h.dtype).at[dest].set(gate.reshape(n_assign)[order].astype(h.dtype))
    block_expert = jnp.minimum(jnp.searchsorted(pad_end, jnp.arange(n_blocks) * MOE_BLOCK, side='right'), N_EXPERTS - 1)
    xb = hf[buf_tok].reshape(n_blocks, MOE_BLOCK, d)

    def expert_block(args):
        xblk, e = args
        return (jax.nn.silu(xblk @ w_gate[e]) * (xblk @ w_up[e])) @ w_down[e]

    yb = lax.map(expert_block, (xb, block_expert)).reshape(n_pad, d)
    out = jnp.zeros((t, d), h.dtype).at[buf_tok].add(yb * buf_w[:, None])
    return out.reshape(bsz, s, d)


def setup_inputs(seed: int = 0) -> dict:
    key = jax.random.key(seed)
    keys = jax.random.split(key, 36)
    ki = iter(range(36))

    def nrm(shape, scale):
        return scale * jax.random.normal(keys[next(ki)], shape, jnp.float32)

    def unif(shape, lo, hi):
        return jax.random.uniform(keys[next(ki)], shape, jnp.float32, lo, hi)

    dt0 = jnp.exp(unif((N_ODD, SSD_HEADS), float(np.log(1e-3)), float(np.log(1e-1))))
    return {
        'x': nrm((BATCH, SEQ, D_MODEL), 1.0),
        'c': nrm((BATCH, D_MODEL), 1.0),
        'norm_gain': 1.0 + nrm((DEPTH, 2, D_MODEL), 0.05),
        'w_ada': nrm((DEPTH, D_MODEL, 6 * D_MODEL), 0.5 * D_MODEL ** -0.5),
        'b_ada': nrm((DEPTH, 6 * D_MODEL), 0.05),
        'w_in_even': nrm((N_EVEN, D_MODEL, EVEN_IN), D_MODEL ** -0.5),
        'w_in_odd': nrm((N_ODD, D_MODEL, ODD_IN), D_MODEL ** -0.5),
        'w_out': nrm((DEPTH, D_MODEL, D_MODEL), D_MODEL ** -0.5),
        'a_mu': unif((N_EVEN, RWKV_IN), 0.0, 1.0),
        'a_w0': unif((N_EVEN, MIX_HALF), -2.0, 2.0),
        'a_w_up': nrm((N_EVEN, RWKV_DECAY_RANK, MIX_HALF), RWKV_DECAY_RANK ** -0.5),
        'a_a0': nrm((N_EVEN, MIX_HALF), 0.5),
        'a_a_up': nrm((N_EVEN, RWKV_ICLR_RANK, MIX_HALF), RWKV_ICLR_RANK ** -0.5),
        'a_g_up': nrm((N_EVEN, RWKV_GATE_RANK, MIX_HALF), RWKV_GATE_RANK ** -0.5),
        'a_k_k': 0.85 + nrm((N_EVEN, MIX_HALF), 0.05),
        'a_k_a': 1.0 + nrm((N_EVEN, MIX_HALF), 0.05),
        'a_r_k': nrm((N_EVEN, RWKV_HEADS, HEAD_DIM), 0.1),
        'a_ln_gain': 1.0 + nrm((N_EVEN, MIX_HALF), 0.05),
        'a_ln_bias': nrm((N_EVEN, MIX_HALF), 0.02),
        'b_alpha_up': nrm((N_EVEN, GLA_GATE_RANK, GLA_KEY), GLA_GATE_RANK ** -0.5),
        'b_alpha_bias': nrm((N_EVEN, GLA_KEY), 0.5),
        'b_norm_gain': 1.0 + nrm((N_EVEN, GLA_DV), 0.05),
        'c_lb': nrm((DEPTH, HGRN_KEY), 0.5),
        'c_norm_gain': 1.0 + nrm((N_ODD, HGRN_DV), 0.05),
        'd_conv_w': nrm((N_ODD, SSD_CONV, SSD_XBC), SSD_CONV ** -0.5),
        'd_conv_b': nrm((N_ODD, SSD_XBC), 0.02),
        'd_dt_bias': dt0 + jnp.log(-jnp.expm1(-dt0)),
        'd_a_log': jnp.log(unif((N_ODD, SSD_HEADS), 1.0, 16.0)),
        'd_skip': 1.0 + nrm((N_ODD, SSD_HEADS), 0.05),
        'd_norm_gain': 1.0 + nrm((N_ODD, MIX_HALF), 0.05),
        'w_router': nrm((D_MODEL, N_EXPERTS), D_MODEL ** -0.5),
        'router_bias': nrm((N_EXPERTS,), 0.01),
        'w_gate': nrm((DEPTH, N_EXPERTS, D_MODEL, D_EXPERT), D_MODEL ** -0.5),
        'w_up': nrm((DEPTH, N_EXPERTS, D_MODEL, D_EXPERT), D_MODEL ** -0.5),
        'w_down': nrm((DEPTH, N_EXPERTS, D_EXPERT, D_MODEL), D_EXPERT ** -0.5),
        'final_gain': 1.0 + nrm((D_MODEL,), 0.05),
    }


def reference(x, c, norm_gain, w_ada, b_ada, w_in_even, w_in_odd, w_out,
              a_mu, a_w0, a_w_up, a_a0, a_a_up, a_g_up, a_k_k, a_k_a, a_r_k, a_ln_gain, a_ln_bias,
              b_alpha_up, b_alpha_bias, b_norm_gain, c_lb, c_norm_gain,
              d_conv_w, d_conv_b, d_dt_bias, d_a_log, d_skip, d_norm_gain,
              w_router, router_bias, w_gate, w_up, w_down, final_gain):
    lower_bounds = hgrn_lower_bounds(c_lb)
    cond = jax.nn.silu(c)
    for l in range(DEPTH):
        j = l // 2
        mod = cond @ w_ada[l] + b_ada[l]
        sh_m, sc_m, g_m, sh_f, sc_f, g_f = [m[:, None, :] for m in jnp.split(mod, 6, axis=-1)]
        h = rms_norm(x, norm_gain[l, 0]) * (1.0 + sc_m) + sh_m
        if l % 2 == 0:
            ua, ub = split_cols(h @ w_in_even[j], [RWKV_IN, GLA_IN])
            y_first = rwkv7_group(ua, a_mu[j], a_w0[j], a_w_up[j], a_a0[j], a_a_up[j], a_g_up[j],
                                  a_k_k[j], a_k_a[j], a_r_k[j], a_ln_gain[j], a_ln_bias[j])
            y_second = gla_group(ub, b_alpha_up[j], b_alpha_bias[j], b_norm_gain[j])
        else:
            uc, ud = split_cols(h @ w_in_odd[j], [HGRN_IN, SSD_IN])
            y_first = hgrn2_group(uc, lower_bounds[l], c_norm_gain[j])
            y_second = ssd_group(ud, d_conv_w[j], d_conv_b[j], d_dt_bias[j], d_a_log[j], d_skip[j], d_norm_gain[j])
        x = x + g_m * (jnp.concatenate([y_first, y_second], axis=-1) @ w_out[l])
        h = rms_norm(x, norm_gain[l, 1]) * (1.0 + sc_f) + sh_f
        x = x + g_f * grouped_moe(h, w_router, router_bias, w_gate[l], w_up[l], w_down[l])
    return rms_norm(x, final_gain)
```

```cpp
#include <hip/hip_runtime.h>
#include <stdint.h>
#include <stdio.h>

#ifndef MK_LAUNCHES
#define MK_LAUNCHES 0
#endif

#define LAS __attribute__((address_space(3)))
#if defined(__HIP_DEVICE_COMPILE__)
#define GAS __attribute__((address_space(1)))
#else
#define GAS
#endif
typedef unsigned short bf16_t;
typedef short bf16x8 __attribute__((ext_vector_type(8)));
typedef unsigned short u16x4 __attribute__((ext_vector_type(4)));
typedef float f32x4 __attribute__((ext_vector_type(4)));
typedef float f32x2 __attribute__((ext_vector_type(2)));
typedef unsigned u32x4 __attribute__((ext_vector_type(4)));
typedef unsigned u32x2 __attribute__((ext_vector_type(2)));

constexpr int D = 1024, NB = 8, SEQ = 4096, T = NB * SEQ, DEPTH = 4, CH = 64, NCH = SEQ / CH;
constexpr int EVEN_IN = 3344, ODD_IN = 2824, NPE = 3584, NPO = 3072, UPITCH = 3584;
constexpr int RW_R = 0, RW_K = 512, RW_V = 1024, RW_WD = 1536, RW_AD = 1600, RW_GD = 1664, RWKV_IN = 1792;
constexpr int GL_Q = 1792, GL_K = 2048, GL_V = 2304, GL_AD = 2816, GL_G = 2832;
constexpr int HG_Q = 0, HG_F = 256, HG_I = 512, HG_G = 1024, HGRN_IN = 1536;
constexpr int SD_Z = 1536, SD_XBC = 2048, SD_XS = 2048, SD_BM = 2560, SD_CM = 2688, SD_DT = 2816;
constexpr int NEXP = 16, DEXP = 512;
constexpr float NORM_EPS = 1e-6f;

constexpr size_t al256(size_t x) { return (x + 255) & ~(size_t)255; }
constexpr size_t WS_CTL = 0;
constexpr size_t CTL_BYTES = 65536;
constexpr size_t WS_MOD = WS_CTL + CTL_BYTES;
constexpr size_t WS_LB = WS_MOD + al256((size_t)DEPTH * NB * 6 * D * 4);
constexpr size_t WS_WINE = WS_LB + al256((size_t)DEPTH * 256 * 4);
constexpr size_t WS_WINO = WS_WINE + (size_t)2 * NPE * D * 2;
constexpr size_t WS_WOUT = WS_WINO + (size_t)2 * NPO * D * 2;
constexpr size_t WS_WGU = WS_WOUT + (size_t)4 * D * D * 2;
constexpr size_t WS_WDN = WS_WGU + (size_t)NEXP * 1024 * D * 2;
constexpr size_t WS_WUPT = WS_WDN + (size_t)NEXP * D * DEXP * 2;
constexpr size_t WS_AUPT = WS_WUPT + (size_t)2 * 512 * 64 * 2;
constexpr size_t WS_GUPT = WS_AUPT + (size_t)2 * 512 * 64 * 2;
constexpr size_t WS_LISTA = WS_GUPT + (size_t)2 * 512 * 128 * 2;
constexpr size_t WS_LISTW = WS_LISTA + (size_t)NEXP * T * 4;
constexpr size_t WS_Y = WS_LISTW + (size_t)NEXP * T * 4;
constexpr size_t WS_U = WS_Y + (size_t)T * D * 2;
constexpr size_t WS_H = WS_U + (size_t)T * UPITCH * 2;
constexpr size_t WS_MIX = WS_H + (size_t)T * D * 2;
constexpr size_t MIX_BYTES = (size_t)200 * 1024 * 1024;
constexpr size_t WS_END = WS_MIX + MIX_BYTES;
constexpr size_t WS_ACT = WS_U;
constexpr size_t ACT_ROWS = (size_t)(2 * T / 256 + NEXP) * 256;
constexpr size_t WS_YB = WS_ACT + al256(ACT_ROWS * DEXP * 2);
static_assert(WS_YB + (size_t)2 * T * D * 2 <= WS_H, "MoE aliases overflow U");
static_assert(WS_END <= (size_t)706000000, "workspace larger than the guaranteed ws_size");
constexpr int CW_BAR = 0;
constexpr int CW_CNT = 4096;

typedef __bf16 bf16x2_t __attribute__((ext_vector_type(2)));
__device__ __forceinline__ unsigned pk2(float lo, float hi) { const f32x2 v = {lo, hi}; const bf16x2_t b = __builtin_convertvector(v, bf16x2_t); return __builtin_bit_cast(unsigned, b); }
__device__ __forceinline__ float bflo(unsigned u) { return __uint_as_float(u << 16); }
__device__ __forceinline__ float bfhi(unsigned u) { return __uint_as_float(u & 0xffff0000u); }
__device__ __forceinline__ float bf2f(bf16_t b) { return __uint_as_float(((unsigned)b) << 16); }
__device__ __forceinline__ float sigmoidf_(float x) { return 1.f / (1.f + __expf(-x)); }
__device__ __forceinline__ float siluf_(float x) { return x / (1.f + __expf(-x)); }
__device__ __forceinline__ float softplusf_(float x) { return x > 20.f ? x : __logf(1.f + __expf(x)); }
__device__ __forceinline__ float logsigmoidf_(float x) { return fminf(x, 0.f) - __logf(1.f + __expf(-fabsf(x))); }
__device__ __forceinline__ void unpack8(const u32x4 v, float (&f)[8]) {
    f[0] = bflo(v.x); f[1] = bfhi(v.x); f[2] = bflo(v.y); f[3] = bfhi(v.y); f[4] = bflo(v.z); f[5] = bfhi(v.z); f[6] = bflo(v.w); f[7] = bfhi(v.w);
}
__device__ __forceinline__ u32x4 pack8(const float (&f)[8]) { u32x4 o; o.x = pk2(f[0], f[1]); o.y = pk2(f[2], f[3]); o.z = pk2(f[4], f[5]); o.w = pk2(f[6], f[7]); return o; }
__device__ __forceinline__ float wave_sum(float v) {
#pragma unroll
    for (int o = 1; o < 64; o <<= 1) v += __shfl_xor(v, o);
    return v;
}
#define MFMA16(a, b, c) __builtin_amdgcn_mfma_f32_16x16x32_bf16((a), (b), (c), 0, 0, 0)
#define SETTLE(acc) asm volatile("s_nop 7\n\ts_nop 7\n\ts_nop 7" : "+v"(acc))

__device__ __forceinline__ bf16x8 rf_lds(const LAS unsigned char* tile, int strideB, int r0, int c0, int lane) {
    return *(const LAS bf16x8*)(tile + (r0 + (lane & 15)) * strideB + (c0 + 8 * (lane >> 4)) * 2);
}
__device__ __forceinline__ bf16x8 tf_lds(const LAS unsigned char* tile, int strideB, int r0, int c0, int lane) {
    const int g = lane >> 4, q = (lane & 15) >> 2, p = lane & 3;
    const unsigned a0 = (unsigned)(uintptr_t)tile + (unsigned)((r0 + 8 * g + q) * strideB + (c0 + 4 * p) * 2);
    const unsigned a1 = a0 + 4u * (unsigned)strideB;
    u16x4 lo, hi;
    asm volatile("ds_read_b64_tr_b16 %0, %2\n\tds_read_b64_tr_b16 %1, %3\n\ts_waitcnt lgkmcnt(0)" : "=&v"(lo), "=&v"(hi) : "v"(a0), "v"(a1) : "memory");
    bf16x8 r;
    r[0] = (short)lo[0]; r[1] = (short)lo[1]; r[2] = (short)lo[2]; r[3] = (short)lo[3]; r[4] = (short)hi[0]; r[5] = (short)hi[1]; r[6] = (short)hi[2]; r[7] = (short)hi[3];
    return r;
}
__device__ __forceinline__ bf16x8 rf_glb(const GAS bf16_t* base, int ld, int r0, int c0, int lane) {
    return *(const GAS bf16x8*)(base + (size_t)(r0 + (lane & 15)) * ld + c0 + 8 * (lane >> 4));
}
__device__ __forceinline__ void st4_lds(LAS unsigned char* tile, int strideB, int row, int col, f32x4 v) {
    u32x2 o; o.x = pk2(v[0], v[1]); o.y = pk2(v[2], v[3]);
    *(LAS u32x2*)(tile + row * strideB + col * 2) = o;
}
__device__ __forceinline__ f32x4 ld4_lds(const LAS unsigned char* tile, int strideB, int row, int col) {
    const u32x2 o = *(const LAS u32x2*)(tile + row * strideB + col * 2);
    return (f32x4){bflo(o.x), bfhi(o.x), bflo(o.y), bfhi(o.y)};
}
constexpr int TS = 144;
constexpr int TS2 = 272;
constexpr int TILE64 = 64 * TS;
constexpr int FS = 68;
constexpr int FTILE = 64 * FS * 4;

#define XB_TMO      128
#define XB_XCNT(j)  (256  + 64 * (j))
#define XB_XSUB(j)  (1280 + 64 * (j))
#define XB_XGEN(j)  (2304 + 64 * (j))
#define XB_TOP      3328
#define XB_TOPGEN   3392
#define XCD_BAR_WORDS 3456
#define XB_SPIN_CAP (1u << 18)
__device__ __forceinline__ unsigned xb_ld(GAS unsigned* p)              { return __hip_atomic_load(p, __ATOMIC_RELAXED, __HIP_MEMORY_SCOPE_AGENT); }
__device__ __forceinline__ unsigned xb_add(GAS unsigned* p, unsigned v) { return __hip_atomic_fetch_add(p, v, __ATOMIC_RELAXED, __HIP_MEMORY_SCOPE_AGENT); }
__device__ __forceinline__ unsigned xb_xcc_id() { return (unsigned)__builtin_amdgcn_s_getreg((3 << 11) | 20) & 0xFu; }
#define XB_SPIN(cond, bar) do { unsigned _sp = 0; while (cond) { __builtin_amdgcn_s_sleep(1); \
    if ((++_sp & 255u) == 0u) { if (xb_ld(&(bar)[XB_TMO])) break; if (_sp > XB_SPIN_CAP) { atomicAdd(&(bar)[XB_TMO], 1u); break; } } } } while (0)
struct XcdBarrier { GAS unsigned* bar; unsigned x; volatile LAS unsigned* st; };
__device__ __forceinline__ XcdBarrier xcd_barrier_post(GAS unsigned* bar, volatile LAS unsigned* st, int tid) {
    XcdBarrier b; b.bar = bar; b.x = xb_xcc_id(); b.st = st;
    if (tid == 0) (void)xb_add(&bar[XB_XCNT(b.x)], 1u);
    return b;
}
__device__ __forceinline__ void xcd_barrier_complete(GAS unsigned* bar, unsigned x, unsigned& nloc, unsigned& nx) {
    const unsigned G = gridDim.x * gridDim.y * gridDim.z;
    unsigned sum, cnt, mine, sp = 0u;
    for (;;) {
        sum = 0u; cnt = 0u; mine = 0u;
#pragma unroll
        for (unsigned j = 0; j < 16; ++j) { const unsigned c = xb_ld(&bar[XB_XCNT(j)]); sum += c; cnt += (c > 0u) ? 1u : 0u; mine = (j == x) ? c : mine; }
        if (sum == G) break;
        __builtin_amdgcn_s_sleep(1);
        if ((++sp & 255u) == 0u) { if (xb_ld(&bar[XB_TMO])) break; if (sp > XB_SPIN_CAP) { atomicAdd(&bar[XB_TMO], 1u); break; } }
    }
    nloc = mine > 0u ? mine : 1u; nx = cnt > 0u ? cnt : 1u;
}
__device__ __forceinline__ void xcd_barrier(const XcdBarrier& b, int tid) {
    asm volatile("s_waitcnt vmcnt(0)" ::: "memory");
    __syncthreads();
    if (tid == 0) {
        GAS unsigned* bar = b.bar;
        __builtin_amdgcn_s_waitcnt(0);
        unsigned nloc = b.st[0], nx = b.st[1];
        if (nloc == 0u) { xcd_barrier_complete(bar, b.x, nloc, nx); b.st[0] = nloc; b.st[1] = nx; }
        const unsigned old = xb_add(&bar[XB_XSUB(b.x)], 1u);
        const unsigned gen = old / nloc;
        if (old + 1u == (gen + 1u) * nloc) {
            __builtin_amdgcn_fence(__ATOMIC_RELEASE, "agent");
            asm volatile("s_waitcnt vmcnt(0)" ::: "memory");
            const unsigned og = xb_add(&bar[XB_TOP], 1u);
            const unsigned tg = og / nx;
            if (og + 1u == (tg + 1u) * nx) xb_add(&bar[XB_TOPGEN], 1u);
            else XB_SPIN(xb_ld(&bar[XB_TOPGEN]) == tg, bar);
            __builtin_amdgcn_fence(__ATOMIC_ACQUIRE, "agent");
            xb_add(&bar[XB_XGEN(b.x)], 1u);
            asm volatile("s_waitcnt vmcnt(0)" ::: "memory");
        } else {
            XB_SPIN(xb_ld(&bar[XB_XGEN(b.x)]) == gen, bar);
            __builtin_amdgcn_fence(__ATOMIC_ACQUIRE, "agent");
            asm volatile("s_waitcnt vmcnt(0)" ::: "memory");
        }
    }
    __syncthreads();
}
namespace pg8 {
constexpr int BM = 256, BK = 64, HALF = 128, HTB = HALF * BK * 2, STAGE_BYTES = 8 * HTB, NXCD = 8, WGM = 8;
__host__ __device__ __forceinline__ int lds_byte(int r, int c) { const int st = (r >> 4) * 2 + (c >> 5), rr = r & 15, cc = c & 31, ob = rr * 64 + cc * 2; return st * 1024 + (ob ^ (((ob >> 9) & 1) << 5)); }
__host__ __device__ __forceinline__ void stage_rc(int b, int& R, int& C) { const int st = b / 1024, sb = b % 1024, swz = sb ^ (((sb >> 9) & 1) << 5); R = (st >> 1) * 16 + swz / 64; C = (st & 1) * 32 + (swz % 64) / 2; }
__host__ __device__ __forceinline__ int perm32(int rho) { const int n = rho >> 4, i = rho & 15; return 8 * (i >> 2) + 4 * n + (i & 3); }

struct Unit { int pm, pn, e, ml; };

struct StaticOrder {
    const GAS char* A; const GAS char* Bt; int K;
    int nM, nN, nwg, G, c;
    __device__ void init(const GAS void* A_, const GAS void* Bt_, int M, int N, int K_, int G_, int c_) { A = (const GAS char*)A_; Bt = (const GAS char*)Bt_; K = K_; nM = M / BM; nN = N / BM; nwg = nM * nN; G = G_; c = c_; }
    __device__ bool next(int i, Unit& u) const {
        const long L = (long)i * G + c; if (L >= nwg) return false;
        int wgid = (int)L; { const int q = nwg / NXCD, r = nwg % NXCD, xcd = wgid % NXCD, off = wgid / NXCD; wgid = (xcd < r ? xcd * (q + 1) : r * (q + 1) + (xcd - r) * q) + off; }
        const int nig = WGM * nN, gid = wgid / nig, fm = gid * WGM, gsz = (nM - fm) < WGM ? (nM - fm) : WGM;
        u.pm = fm + ((wgid % nig) % gsz); u.pn = (wgid % nig) / gsz; u.e = 0; u.ml = 0; return true;
    }
    __device__ __forceinline__ const GAS char* a_base(const Unit& u) const { return A + (size_t)u.pm * BM * K * 2; }
    __device__ __forceinline__ const GAS char* b_base(const Unit& u) const { return Bt + (size_t)u.pn * BM * K * 2; }
    __device__ __forceinline__ void a_rows(const Unit&, const int (&)[2], unsigned (&)[2][2]) const {}
};

template <class Epi, class Sched, bool GATHER>
__device__ __forceinline__ void gemm_phase(LAS unsigned char* lds, const int tid_, const int K, const Sched& S, const Epi& E) {
    const int tid = tid_, wid = __builtin_amdgcn_readfirstlane(tid >> 6), lane = tid & 63, wr = wid >> 2, wc = wid & 3, fr = lane & 15, fq = lane >> 4;
    const int nt = K / BK;
    unsigned voffA[2], voffB[2]; int RA[2]; unsigned CA2[2];
#pragma unroll
    for (int i = 0; i < 2; ++i) { int R, C; stage_rc(tid * 16 + i * 8192, R, C); const int Rb = Epi::PERM ? ((R & ~31) + perm32(R & 31)) : R;
        voffA[i] = (unsigned)(R * K + C) * 2u; voffB[i] = (unsigned)(Rb * K + C) * 2u; RA[i] = R; CA2[i] = (unsigned)C * 2u; }
    const size_t kstep = (size_t)(BK * 2);
    const size_t hstep = (size_t)HALF * K * 2;
    const unsigned ldsw = (unsigned)wid * 1024u;
    const int aoff = lds_byte(wr * 64 + fr, fq * 8), boff = lds_byte(wc * 32 + fr, fq * 8);
    unsigned offC[2][2], offN[2][2];
#define PG8_SA(b, h) (((b) * 2 + (h)) * HTB)
#define PG8_SB(b, h) ((4 + (b) * 2 + (h)) * HTB)
#define PG8_STAGE(bufoff, gbase, voff) do { _Pragma("unroll") for (int _i = 0; _i < 2; ++_i) \
        __builtin_amdgcn_global_load_lds((const GAS unsigned*)((const GAS char*)(gbase) + (voff)[_i]), (LAS unsigned*)(lds + (bufoff) + ldsw + _i * 8192), 16, 0, 0); } while (0)
#define PG8_STAGE_A(bufoff, gb, h, offs) do { if constexpr (GATHER) { PG8_STAGE(bufoff, gb, (offs)[h]); } else { PG8_STAGE(bufoff, (gb) + (h) * hstep, voffA); } } while (0)
#define PG8_LDA(dst, b, h) do { _Pragma("unroll") for (int m = 0; m < 4; ++m) _Pragma("unroll") for (int k = 0; k < 2; ++k) dst[m][k] = *(const LAS bf16x8*)(lds + PG8_SA(b, h) + aoff + m * 2048 + k * 1024); } while (0)
#define PG8_LDB(dst, b, h) do { _Pragma("unroll") for (int n = 0; n < 2; ++n) _Pragma("unroll") for (int k = 0; k < 2; ++k) dst[n][k] = *(const LAS bf16x8*)(lds + PG8_SB(b, h) + boff + n * 2048 + k * 1024); } while (0)
#define PG8_MMA(ai, bj, At, Bt) do { __builtin_amdgcn_s_setprio(1); _Pragma("unroll") for (int m = 0; m < 4; ++m) _Pragma("unroll") for (int n = 0; n < 2; ++n) _Pragma("unroll") for (int k = 0; k < 2; ++k) \
        acc[ai][bj][m][n] = __builtin_amdgcn_mfma_f32_16x16x32_bf16(Bt[n][k], At[m][k], acc[ai][bj][m][n], 0, 0, 0); __builtin_amdgcn_s_setprio(0); } while (0)
#define PG8_WAIT_V(n) asm volatile("s_waitcnt vmcnt(" #n ")" ::: "memory")
#define PG8_WAIT_L(n) asm volatile("s_waitcnt lgkmcnt(" #n ")" ::: "memory")
#define PG8_BAR __builtin_amdgcn_s_barrier()
#define PG8_SCHED __builtin_amdgcn_sched_barrier(0)
    Unit cur, nxt; int ui = 0;
    if (!S.next(0, cur)) return;
    f32x4 acc[2][2][4][2];
#pragma unroll
    for (int a = 0; a < 2; ++a)
#pragma unroll
        for (int b = 0; b < 2; ++b)
#pragma unroll
            for (int m = 0; m < 4; ++m)
#pragma unroll
                for (int n = 0; n < 2; ++n) acc[a][b][m][n] = (f32x4){0.f, 0.f, 0.f, 0.f};
    bf16x8 At[4][2], B0[2][2], B1[2][2];
    const GAS char* cA = S.a_base(cur); const GAS char* cB = S.b_base(cur);
    if constexpr (GATHER) { S.a_rows(cur, RA, offC);
#pragma unroll
        for (int h = 0; h < 2; ++h)
#pragma unroll
            for (int i = 0; i < 2; ++i) { offC[h][i] += CA2[i]; offN[h][i] = offC[h][i]; } }
    PG8_STAGE(PG8_SB(0, 0), cB, voffB); PG8_STAGE(PG8_SB(0, 1), cB + hstep, voffB); PG8_STAGE_A(PG8_SA(0, 0), cA, 0, offC); PG8_STAGE_A(PG8_SA(0, 1), cA, 1, offC);
    if (wr == 1) PG8_BAR;
    PG8_WAIT_V(2); PG8_BAR;
    PG8_STAGE(PG8_SB(1, 0), cB + kstep, voffB); PG8_STAGE_A(PG8_SA(1, 0), cA + kstep, 0, offC); PG8_STAGE(PG8_SB(1, 1), cB + hstep + kstep, voffB);
    PG8_WAIT_V(6); PG8_BAR;
    for (;;) {
        const bool has_next = S.next(ui + 1, nxt);
        const GAS char* nA = has_next ? S.a_base(nxt) : cA; const GAS char* nB = has_next ? S.b_base(nxt) : cB;
        if constexpr (GATHER) { if (has_next) { S.a_rows(nxt, RA, offN);
#pragma unroll
            for (int h = 0; h < 2; ++h)
#pragma unroll
                for (int i = 0; i < 2; ++i) offN[h][i] += CA2[i]; } }
        for (int t = 0; t < nt; t += 2) {
            const bool last = (t == nt - 2);
            const GAS char* a1 = cA + (size_t)(t + 1) * kstep;
            const GAS char* a2 = last ? nA : cA + (size_t)(t + 2) * kstep; const GAS char* b2 = last ? nB : cB + (size_t)(t + 2) * kstep;
            const GAS char* a3 = a2 + kstep; const GAS char* b3 = b2 + kstep;
            unsigned o2[2][2];
            if constexpr (GATHER) {
#pragma unroll
                for (int h = 0; h < 2; ++h)
#pragma unroll
                    for (int i = 0; i < 2; ++i) o2[h][i] = last ? offN[h][i] : offC[h][i]; }
            PG8_LDB(B0, 0, 0); PG8_LDB(B1, 0, 1); PG8_SCHED; PG8_LDA(At, 0, 0); PG8_STAGE_A(PG8_SA(1, 1), a1, 1, offC);
            PG8_WAIT_V(8); PG8_WAIT_L(0); PG8_BAR; PG8_MMA(0, 0, At, B0); PG8_MMA(0, 1, At, B1); PG8_BAR; PG8_SCHED;
            PG8_LDA(At, 0, 1); PG8_STAGE(PG8_SB(0, 0), b2, voffB); PG8_STAGE(PG8_SB(0, 1), b2 + hstep, voffB); PG8_STAGE_A(PG8_SA(0, 0), a2, 0, o2);
            PG8_WAIT_V(8); PG8_WAIT_L(0); PG8_BAR; PG8_MMA(1, 0, At, B0); PG8_MMA(1, 1, At, B1); PG8_BAR; PG8_SCHED;
            PG8_LDB(B0, 1, 0); PG8_LDB(B1, 1, 1); PG8_SCHED; PG8_LDA(At, 1, 0); PG8_STAGE_A(PG8_SA(0, 1), a2, 1, o2);
            PG8_WAIT_V(8); PG8_WAIT_L(0); PG8_BAR; PG8_MMA(0, 0, At, B0); PG8_MMA(0, 1, At, B1); PG8_BAR; PG8_SCHED;
            PG8_LDA(At, 1, 1); PG8_STAGE(PG8_SB(1, 0), b3, voffB); PG8_STAGE(PG8_SB(1, 1), b3 + hstep, voffB); PG8_STAGE_A(PG8_SA(1, 0), a3, 0, o2);
            PG8_WAIT_V(8); PG8_WAIT_L(0); PG8_BAR; PG8_MMA(1, 0, At, B0); PG8_MMA(1, 1, At, B1); PG8_BAR; PG8_SCHED;
        }
        if (wr == 0) PG8_BAR;
        E(acc, cur, wr, wc, fr, fq);
        if (!has_next) break;
#pragma unroll
        for (int a = 0; a < 2; ++a)
#pragma unroll
            for (int b = 0; b < 2; ++b)
#pragma unroll
                for (int m = 0; m < 4; ++m)
#pragma unroll
                    for (int n = 0; n < 2; ++n) acc[a][b][m][n] = (f32x4){0.f, 0.f, 0.f, 0.f};
        cur = nxt; cA = nA; cB = nB; ++ui;
        if constexpr (GATHER) {
#pragma unroll
            for (int h = 0; h < 2; ++h)
#pragma unroll
                for (int i = 0; i < 2; ++i) offC[h][i] = offN[h][i]; }
        if (wr == 1) PG8_BAR;
    }
    PG8_WAIT_V(0);
    PG8_BAR;
#undef PG8_SA
#undef PG8_SB
#undef PG8_STAGE
#undef PG8_STAGE_A
#undef PG8_LDA
#undef PG8_LDB
#undef PG8_MMA
#undef PG8_WAIT_V
#undef PG8_WAIT_L
#undef PG8_BAR
#undef PG8_SCHED
}
}
struct Params {
    const GAS float* x; const GAS float* c; const GAS float* norm_gain; const GAS float* w_ada; const GAS float* b_ada; const GAS float* w_in_even; const GAS float* w_in_odd; const GAS float* w_out;
    const GAS float* a_mu; const GAS float* a_w0; const GAS float* a_w_up; const GAS float* a_a0; const GAS float* a_a_up; const GAS float* a_g_up; const GAS float* a_k_k; const GAS float* a_k_a; const GAS float* a_r_k;
    const GAS float* a_ln_gain; const GAS float* a_ln_bias; const GAS float* b_alpha_up; const GAS float* b_alpha_bias; const GAS float* b_norm_gain; const GAS float* c_lb; const GAS float* c_norm_gain;
    const GAS float* d_conv_w; const GAS float* d_conv_b; const GAS float* d_dt_bias; const GAS float* d_a_log; const GAS float* d_skip; const GAS float* d_norm_gain;
    const GAS float* w_router; const GAS float* router_bias; const GAS float* w_gate; const GAS float* w_up; const GAS float* w_down; const GAS float* final_gain;
    GAS float* out; GAS unsigned char* ws;
    long long ph_lo, ph_hi;
};

struct Ctx {
    LAS unsigned char* lds; int tid, lane, wave, G, bid;
};

__device__ __forceinline__ void cvt_item(const GAS float* W, int K, int N, int ldw, GAS bf16_t* WT, int mode, LAS float* scr, int kb, int nb, int lane) {
    const int k0 = 64 * kb, n0 = 32 * nb;
    const int nn = n0 + (lane & 31);
#pragma unroll 8
    for (int i = 0; i < 32; ++i) { const int kk = 2 * i + (lane >> 5); scr[kk * 33 + (lane & 31)] = (nn < N) ? W[(size_t)(k0 + kk) * ldw + nn] : 0.f; }
    asm volatile("s_waitcnt lgkmcnt(0)" ::: "memory");
    const int c = lane & 7;
#pragma unroll
    for (int j = 0; j < 4; ++j) { const int n = (lane >> 3) + 8 * j; const LAS float* s = scr + (8 * c) * 33 + n;
        u32x4 o; o.x = pk2(s[0 * 33], s[1 * 33]); o.y = pk2(s[2 * 33], s[3 * 33]); o.z = pk2(s[4 * 33], s[5 * 33]); o.w = pk2(s[6 * 33], s[7 * 33]);
        const int ng = n0 + n; const int row = mode == 0 ? ng : ((ng >> 7) * 256 + (mode == 2 ? 128 : 0) + (ng & 127));
        *(GAS u32x4*)(WT + (size_t)row * K + k0 + 8 * c) = o; }
    asm volatile("s_waitcnt lgkmcnt(0)" ::: "memory");
}
__device__ __forceinline__ void moe_convert(const Params& p, const Ctx& C, int layer, int w, int nw) {
    LAS float* scr = (LAS float*)(C.lds + C.wave * 16384);
    GAS bf16_t* WGU = (GAS bf16_t*)(p.ws + WS_WGU); GAS bf16_t* WDN = (GAS bf16_t*)(p.ws + WS_WDN);
    constexpr int PER_E = 768;
    for (int it = w; it < NEXP * PER_E; it += nw) {
        const int e = it / PER_E, r = it % PER_E;
        const size_t wofs = ((size_t)layer * NEXP + e) * (size_t)D * DEXP;
        if (r < 256)      cvt_item(p.w_gate + wofs, D, DEXP, DEXP, WGU + (size_t)e * 1024 * D, 1, scr, r >> 4, r & 15, C.lane);
        else if (r < 512) cvt_item(p.w_up + wofs, D, DEXP, DEXP, WGU + (size_t)e * 1024 * D, 2, scr, (r - 256) >> 4, (r - 256) & 15, C.lane);
        else              cvt_item(p.w_down + wofs, DEXP, D, D, WDN + (size_t)e * D * DEXP, 0, scr, (r - 512) >> 5, (r - 512) & 31, C.lane);
    }
}

__device__ __forceinline__ void p0_prologue(const Params& p, const Ctx& C) {
    {
        LAS float* cs = (LAS float*)C.lds;
        LAS float* red = (LAS float*)(C.lds + 32768);
        for (int i = C.tid; i < NB * D; i += 512) cs[i] = siluf_(p.c[i]);
        __syncthreads();
        GAS float* mod = (GAS float*)(p.ws + WS_MOD);
        for (int it = C.bid; it < DEPTH * 96; it += C.G) {
            const int l = it / 96, cg = it % 96;
            const GAS float* W = p.w_ada + (size_t)l * D * 6 * D + 64 * cg + C.lane;
            float acc[8];
#pragma unroll
            for (int b = 0; b < 8; ++b) acc[b] = 0.f;
            const int k0 = 128 * C.wave;
#pragma unroll 8
            for (int k = 0; k < 128; ++k) { const float wv = W[(size_t)(k0 + k) * 6 * D];
#pragma unroll
                for (int b = 0; b < 8; ++b) acc[b] += cs[b * D + k0 + k] * wv; }
#pragma unroll
            for (int b = 0; b < 8; ++b) red[(C.wave * 8 + b) * 64 + C.lane] = acc[b];
            __syncthreads();
            { const int b = C.tid >> 6, col = C.tid & 63; float s = p.b_ada[l * 6 * D + 64 * cg + col];
#pragma unroll
              for (int w = 0; w < 8; ++w) s += red[(w * 8 + b) * 64 + col];
              mod[((size_t)l * NB + b) * 6 * D + 64 * cg + col] = s; }
            __syncthreads();
        }
    }
    if (C.bid == 0 && C.tid < 256) {
        float v[4], m = -1e30f;
#pragma unroll
        for (int l = 0; l < 4; ++l) { v[l] = p.c_lb[l * 256 + C.tid]; m = fmaxf(m, v[l]); }
        float s = 0.f;
#pragma unroll
        for (int l = 0; l < 4; ++l) { v[l] = __expf(v[l] - m); s += v[l]; }
        GAS float* lb = (GAS float*)(p.ws + WS_LB); float cum = 0.f; const float c0 = v[0] / s;
#pragma unroll
        for (int l = 0; l < 4; ++l) { cum += v[l] / s; lb[l * 256 + C.tid] = cum - c0; }
    }
    __syncthreads();
    {
        LAS float* scr = (LAS float*)(C.lds + C.wave * 16384);
        const int gw = C.bid * 8 + C.wave, NGW = C.G * 8;
        constexpr int I_E = 16 * (NPE / 32), I_O = 16 * (NPO / 32), I_W = 16 * 32, I_S1 = 16, I_S2 = 32;
        constexpr int NIT = 2 * I_E + 2 * I_O + 4 * I_W + 2 * (2 * I_S1 + I_S2);
        for (int it = gw; it < NIT; it += NGW) {
            int r = it;
            if (r < 2 * I_E) { const int j = r / I_E; r %= I_E; cvt_item(p.w_in_even + (size_t)j * D * EVEN_IN, D, EVEN_IN, EVEN_IN, (GAS bf16_t*)(p.ws + WS_WINE) + (size_t)j * NPE * D, 0, scr, r / (NPE / 32), r % (NPE / 32), C.lane); continue; }
            r -= 2 * I_E;
            if (r < 2 * I_O) { const int j = r / I_O; r %= I_O; cvt_item(p.w_in_odd + (size_t)j * D * ODD_IN, D, ODD_IN, ODD_IN, (GAS bf16_t*)(p.ws + WS_WINO) + (size_t)j * NPO * D, 0, scr, r / (NPO / 32), r % (NPO / 32), C.lane); continue; }
            r -= 2 * I_O;
            if (r < 4 * I_W) { const int l = r / I_W; r %= I_W; cvt_item(p.w_out + (size_t)l * D * D, D, D, D, (GAS bf16_t*)(p.ws + WS_WOUT) + (size_t)l * D * D, 0, scr, r / 32, r % 32, C.lane); continue; }
            r -= 4 * I_W;
            { const int j = r / (2 * I_S1 + I_S2); r %= (2 * I_S1 + I_S2);
              if (r < I_S1) cvt_item(p.a_w_up + (size_t)j * 64 * 512, 64, 512, 512, (GAS bf16_t*)(p.ws + WS_WUPT) + (size_t)j * 512 * 64, 0, scr, 0, r, C.lane);
              else if (r < 2 * I_S1) cvt_item(p.a_a_up + (size_t)j * 64 * 512, 64, 512, 512, (GAS bf16_t*)(p.ws + WS_AUPT) + (size_t)j * 512 * 64, 0, scr, 0, r - I_S1, C.lane);
              else { r -= 2 * I_S1; cvt_item(p.a_g_up + (size_t)j * 128 * 512, 128, 512, 512, (GAS bf16_t*)(p.ws + WS_GUPT) + (size_t)j * 512 * 128, 0, scr, r >> 4, r & 15, C.lane); } }
        }
        moe_convert(p, C, 0, gw, NGW);
    }
}

template <bool FINAL>
__device__ __forceinline__ void norm_phase(const Params& p, const Ctx& C, int layer) {
    const int gw = C.bid * 8 + C.wave, NGW = C.G * 8;
    const GAS float* mod = (const GAS float*)(p.ws + WS_MOD);
    const GAS bf16_t* YB = (const GAS bf16_t*)(p.ws + WS_YB);
    GAS bf16_t* H = (GAS bf16_t*)(p.ws + WS_H);
    const bool first = (layer == 0) && !FINAL;
    const int lprev = FINAL ? DEPTH - 1 : layer - 1;
    for (int row = gw; row < T; row += NGW) {
        const int b = row >> 12;
        const GAS f32x4* xr = (const GAS f32x4*)((first ? p.x : p.out) + (size_t)row * D) + C.lane;
        f32x4 v[4];
#pragma unroll
        for (int j = 0; j < 4; ++j) v[j] = xr[64 * j];
        if (!first) {
            const GAS float* gf = mod + ((size_t)lprev * NB + b) * 6 * D + 5 * D;
            const GAS u32x2* y0 = (const GAS u32x2*)(YB + (size_t)(2 * row) * D) + C.lane; const GAS u32x2* y1 = (const GAS u32x2*)(YB + (size_t)(2 * row + 1) * D) + C.lane;
#pragma unroll
            for (int j = 0; j < 4; ++j) { const u32x2 a = y0[64 * j], c2 = y1[64 * j]; const f32x4 g = *((const GAS f32x4*)gf + C.lane + 64 * j);
                v[j][0] += g[0] * (bflo(a.x) + bflo(c2.x)); v[j][1] += g[1] * (bfhi(a.x) + bfhi(c2.x)); v[j][2] += g[2] * (bflo(a.y) + bflo(c2.y)); v[j][3] += g[3] * (bfhi(a.y) + bfhi(c2.y)); }
        }
        float s2 = 0.f;
#pragma unroll
        for (int j = 0; j < 4; ++j) s2 += (v[j][0] * v[j][0] + v[j][1] * v[j][1]) + (v[j][2] * v[j][2] + v[j][3] * v[j][3]);
        const float rstd = rsqrtf(wave_sum(s2) * (1.f / D) + NORM_EPS);
        if (FINAL) {
            GAS f32x4* o = (GAS f32x4*)(p.out + (size_t)row * D) + C.lane;
#pragma unroll
            for (int j = 0; j < 4; ++j) { const f32x4 g = *((const GAS f32x4*)p.final_gain + C.lane + 64 * j); o[64 * j] = v[j] * rstd * g; }
        } else {
            GAS f32x4* xo = (GAS f32x4*)(p.out + (size_t)row * D) + C.lane;
#pragma unroll
            for (int j = 0; j < 4; ++j) xo[64 * j] = v[j];
            const GAS float* m = mod + ((size_t)layer * NB + b) * 6 * D;
            GAS u32x2* ho = (GAS u32x2*)(H + (size_t)row * D) + C.lane;
#pragma unroll
            for (int j = 0; j < 4; ++j) { const f32x4 g = *((const GAS f32x4*)(p.norm_gain + (size_t)layer * 2 * D) + C.lane + 64 * j); const f32x4 sh = *((const GAS f32x4*)m + C.lane + 64 * j); const f32x4 sc = *((const GAS f32x4*)(m + D) + C.lane + 64 * j);
                const f32x4 h = v[j] * rstd * g * (1.f + sc) + sh; u32x2 o; o.x = pk2(h[0], h[1]); o.y = pk2(h[2], h[3]); ho[64 * j] = o; }
        }
    }
}

__device__ __forceinline__ void route_phase(const Params& p, const Ctx& C, int layer) {
    LAS float* wr_l = (LAS float*)C.lds;
    LAS int* lcnt = (LAS int*)(C.lds + 65536);
    LAS int* lbase = lcnt + 16;
    LAS int* rinfo = lcnt + 32;
    LAS float* rgate = (LAS float*)(rinfo + 256);
    const GAS float* mod = (const GAS float*)(p.ws + WS_MOD);
    GAS bf16_t* H = (GAS bf16_t*)(p.ws + WS_H);
    GAS unsigned* cnt = (GAS unsigned*)(p.ws + WS_CTL) + CW_CNT + layer * 16;
    GAS int* lista = (GAS int*)(p.ws + WS_LISTA); GAS float* listw = (GAS float*)(p.ws + WS_LISTW);
    for (int i = C.tid; i < D * 16; i += 512) wr_l[(i & 15) * D + (i >> 4)] = p.w_router[i];
    float rb[16];
#pragma unroll
    for (int e = 0; e < 16; ++e) rb[e] = p.router_bias[e];
    for (int blk = C.bid; blk < T / 128; blk += C.G) {
        if (C.tid < 16) lcnt[C.tid] = 0;
        __syncthreads();
        for (int rr = 0; rr < 16; ++rr) {
            const int rl = C.wave * 16 + rr, row = blk * 128 + rl, b = row >> 12;
            const GAS f32x4* xr = (const GAS f32x4*)(p.out + (size_t)row * D) + C.lane;
            f32x4 v[4]; float s2 = 0.f;
#pragma unroll
            for (int j = 0; j < 4; ++j) { v[j] = xr[64 * j]; s2 += (v[j][0] * v[j][0] + v[j][1] * v[j][1]) + (v[j][2] * v[j][2] + v[j][3] * v[j][3]); }
            const float rstd = rsqrtf(wave_sum(s2) * (1.f / D) + NORM_EPS);
            const GAS float* m = mod + ((size_t)layer * NB + b) * 6 * D;
            GAS u32x2* ho = (GAS u32x2*)(H + (size_t)row * D) + C.lane;
            float lg[16];
#pragma unroll
            for (int e = 0; e < 16; ++e) lg[e] = 0.f;
#pragma unroll
            for (int j = 0; j < 4; ++j) { const f32x4 g = *((const GAS f32x4*)(p.norm_gain + (size_t)layer * 2 * D + D) + C.lane + 64 * j); const f32x4 sh = *((const GAS f32x4*)(m + 3 * D) + C.lane + 64 * j); const f32x4 sc = *((const GAS f32x4*)(m + 4 * D) + C.lane + 64 * j);
                const f32x4 h = v[j] * rstd * g * (1.f + sc) + sh; u32x2 o; o.x = pk2(h[0], h[1]); o.y = pk2(h[2], h[3]); ho[64 * j] = o;
#pragma unroll
                for (int e = 0; e < 16; ++e) { const f32x4 w4 = *(const LAS f32x4*)(wr_l + e * D + 4 * (C.lane + 64 * j)); lg[e] += (h[0] * w4[0] + h[1] * w4[1]) + (h[2] * w4[2] + h[3] * w4[3]); } }
            float sc16[16];
#pragma unroll
            for (int e = 0; e < 16; ++e) sc16[e] = sigmoidf_(wave_sum(lg[e]));
            float sel[16];
#pragma unroll
            for (int e = 0; e < 16; ++e) sel[e] = sc16[e] + rb[e];
            int grp = 0; float best = -1e30f;
#pragma unroll
            for (int g = 0; g < 4; ++g) { float m1 = -1e30f, m2 = -1e30f;
#pragma unroll
                for (int q = 0; q < 4; ++q) { const float s = sel[4 * g + q]; if (s > m1) { m2 = m1; m1 = s; } else if (s > m2) m2 = s; }
                const float gs = m1 + m2; if (gs > best) { best = gs; grp = g; } }
            int i1 = 0, i2 = 0; float m1 = -1e30f, m2 = -1e30f; float s1 = 0.f, s2g = 0.f;
#pragma unroll
            for (int e = 0; e < 16; ++e) { if ((e >> 2) == grp) { const float s = sel[e]; if (s > m1) { m2 = m1; i2 = i1; s2g = s1; m1 = s; i1 = e; s1 = sc16[e]; } else if (s > m2) { m2 = s; i2 = e; s2g = sc16[e]; } } }
            const float inv = 1.f / (s1 + s2g);
            if (C.lane == 0) {
                const int sl1 = __hip_atomic_fetch_add(&lcnt[i1], 1, __ATOMIC_RELAXED, __HIP_MEMORY_SCOPE_WORKGROUP), sl2 = __hip_atomic_fetch_add(&lcnt[i2], 1, __ATOMIC_RELAXED, __HIP_MEMORY_SCOPE_WORKGROUP);
                rinfo[rl * 2 + 0] = i1 | (sl1 << 8); rinfo[rl * 2 + 1] = i2 | (sl2 << 8); rgate[rl * 2 + 0] = s1 * inv; rgate[rl * 2 + 1] = s2g * inv;
            }
        }
        __syncthreads();
        if (C.tid < 16) lbase[C.tid] = (int)__hip_atomic_fetch_add(&cnt[C.tid], (unsigned)lcnt[C.tid], __ATOMIC_RELAXED, __HIP_MEMORY_SCOPE_AGENT);
        __syncthreads();
        if (C.tid < 256) { const int rl = C.tid >> 1, k = C.tid & 1; const int inf = rinfo[C.tid]; const int e = inf & 255, sl = inf >> 8;
            const size_t idx = (size_t)e * T + lbase[e] + sl; lista[idx] = (blk * 128 + rl) * 2 + k; listw[idx] = rgate[C.tid]; }
        __syncthreads();
    }
}
struct EpiU {
    static constexpr bool PERM = true;
    GAS bf16_t* O;
    __device__ __forceinline__ void operator()(const f32x4 (&acc)[2][2][4][2], const pg8::Unit& u, int wr, int wc, int fr, int fq) const {
        const int row0 = u.pm * 256 + wr * 64 + fr, col0 = u.pn * 256 + wc * 32 + 8 * fq;
#pragma unroll
        for (int ai = 0; ai < 2; ++ai)
#pragma unroll
            for (int m = 0; m < 4; ++m) { GAS bf16_t* rowp = O + (size_t)(row0 + ai * 128 + m * 16) * UPITCH + col0;
#pragma unroll
                for (int bj = 0; bj < 2; ++bj) { const f32x4 v0 = acc[ai][bj][m][0], v1 = acc[ai][bj][m][1];
                    u32x4 o; o.x = pk2(v0[0], v0[1]); o.y = pk2(v0[2], v0[3]); o.z = pk2(v1[0], v1[1]); o.w = pk2(v1[2], v1[3]);
                    *(GAS u32x4*)(rowp + bj * 128) = o; } }
    }
};
struct EpiOut {
    static constexpr bool PERM = false;
    GAS float* X; const GAS float* gm;
    __device__ __forceinline__ void operator()(const f32x4 (&acc)[2][2][4][2], const pg8::Unit& u, int wr, int wc, int fr, int fq) const {
        const int row0 = u.pm * 256 + wr * 64 + fr, col0 = u.pn * 256 + wc * 32 + 4 * fq;
        const GAS float* g = gm + (size_t)(row0 >> 12) * 6 * D + col0;
        f32x4 gv[2][2];
#pragma unroll
        for (int bj = 0; bj < 2; ++bj)
#pragma unroll
            for (int n = 0; n < 2; ++n) gv[bj][n] = *(const GAS f32x4*)(g + bj * 128 + n * 16);
#pragma unroll
        for (int ai = 0; ai < 2; ++ai)
#pragma unroll
            for (int m = 0; m < 4; ++m) { GAS float* rowp = X + (size_t)(row0 + ai * 128 + m * 16) * D + col0;
#pragma unroll
                for (int bj = 0; bj < 2; ++bj)
#pragma unroll
                    for (int n = 0; n < 2; ++n) { GAS f32x4* q = (GAS f32x4*)(rowp + bj * 128 + n * 16); *q = *q + gv[bj][n] * acc[ai][bj][m][n]; } }
    }
};
struct EpiUp {
    static constexpr bool PERM = true;
    GAS bf16_t* ACT;
    __device__ __forceinline__ void operator()(const f32x4 (&acc)[2][2][4][2], const pg8::Unit& u, int wr, int wc, int fr, int fq) const {
        const int row0 = u.pm * 256 + wr * 64 + fr, col0 = u.pn * 128 + wc * 32 + 8 * fq;
#pragma unroll
        for (int ai = 0; ai < 2; ++ai)
#pragma unroll
            for (int m = 0; m < 4; ++m) { GAS bf16_t* rowp = ACT + (size_t)(row0 + ai * 128 + m * 16) * DEXP + col0;
                float r[8];
#pragma unroll
                for (int n = 0; n < 2; ++n)
#pragma unroll
                    for (int q = 0; q < 4; ++q) r[4 * n + q] = siluf_(acc[ai][0][m][n][q]) * acc[ai][1][m][n][q];
                *(GAS u32x4*)rowp = pack8(r); }
    }
};
struct EpiDown {
    static constexpr bool PERM = true;
    GAS bf16_t* YB; const GAS int* lista; const GAS float* listw;
    __device__ __forceinline__ void operator()(const f32x4 (&acc)[2][2][4][2], const pg8::Unit& u, int wr, int wc, int fr, int fq) const {
        const int rl0 = wr * 64 + fr, col0 = u.pn * 256 + wc * 32 + 8 * fq;
        const size_t lb = (size_t)u.e * T + (size_t)u.ml * 256;
        const int nrows = u.pm;
#pragma unroll
        for (int ai = 0; ai < 2; ++ai)
#pragma unroll
            for (int m = 0; m < 4; ++m) { const int rl = rl0 + ai * 128 + m * 16;
                if (rl < nrows) { const int a = lista[lb + rl]; const float w = listw[lb + rl]; GAS bf16_t* rowp = YB + (size_t)a * D + col0;
#pragma unroll
                    for (int bj = 0; bj < 2; ++bj) { const f32x4 v0 = acc[ai][bj][m][0] * w, v1 = acc[ai][bj][m][1] * w;
                        u32x4 o; o.x = pk2(v0[0], v0[1]); o.y = pk2(v0[2], v0[3]); o.z = pk2(v1[0], v1[1]); o.w = pk2(v1[2], v1[3]);
                        *(GAS u32x4*)(rowp + bj * 128) = o; } } }
    }
};
struct MoeOrder {
    const GAS char* A; const GAS char* Bt; int K; size_t estride; const LAS int* tab; const GAS int* lista; int G, c; bool down;
    __device__ bool next(int i, pg8::Unit& u) const {
        const int L = i * G + c; const int NT = __builtin_amdgcn_readfirstlane(tab[16]);
        if (L >= NT * 4) return false;
        const int mt = L >> 2; int e = 0;
#pragma unroll
        for (int q = 1; q < 16; ++q) e += (__builtin_amdgcn_readfirstlane(tab[q]) <= mt) ? 1 : 0;
        e = __builtin_amdgcn_readfirstlane(e);
        const int t0 = __builtin_amdgcn_readfirstlane(tab[e]), cn = __builtin_amdgcn_readfirstlane(tab[17 + e]);
        u.pn = L & 3; u.e = e; u.ml = mt - t0;
        const int left = cn - u.ml * 256;
        u.pm = down ? (left < 256 ? left : 256) : mt;
        return true;
    }
    __device__ __forceinline__ const GAS char* a_base(const pg8::Unit& u) const { return down ? A + (size_t)(__builtin_amdgcn_readfirstlane(tab[u.e]) + u.ml) * 256 * K * 2 : A; }
    __device__ __forceinline__ const GAS char* b_base(const pg8::Unit& u) const { return Bt + (size_t)u.e * estride + (size_t)u.pn * 256 * K * 2; }
    __device__ __forceinline__ void a_rows(const pg8::Unit& u, const int (&RA)[2], unsigned (&off)[2][2]) const {
        const int n = __builtin_amdgcn_readfirstlane(tab[17 + u.e]) - u.ml * 256; const size_t lb = (size_t)u.e * T + (size_t)u.ml * 256;
#pragma unroll
        for (int h = 0; h < 2; ++h)
#pragma unroll
            for (int i = 0; i < 2; ++i) { const int r = 128 * h + RA[i]; const int tok = (r < n) ? (lista[lb + r] >> 1) : 0; off[h][i] = (unsigned)tok * (unsigned)(K * 2); }
    }
};
__device__ __forceinline__ void moe_table(const Params& p, const Ctx& C, int layer, LAS int* tab) {
    if (C.tid == 0) { const GAS unsigned* cnt = (const GAS unsigned*)(p.ws + WS_CTL) + CW_CNT + layer * 16; int acc = 0;
        for (int e = 0; e < 16; ++e) { const int n = (int)__hip_atomic_load(cnt + e, __ATOMIC_RELAXED, __HIP_MEMORY_SCOPE_AGENT); tab[e] = acc; tab[17 + e] = n; acc += (n + 255) >> 8; }
        tab[16] = acc; }
    __syncthreads();
}
constexpr size_t MX_BASE = WS_H;
constexpr size_t MX_AVAIL = WS_END - WS_H;
constexpr size_t M64 = (size_t)64 * 64;
constexpr size_t RW_PT = 0, RW_QT = RW_PT + 4096 * M64 * 2, RW_RH = RW_QT + 4096 * M64 * 2, RW_MH = RW_RH + 4096 * M64 * 2, RW_S = RW_MH + 4096 * M64 * 2, RW_BON = RW_S + 4096 * M64 * 2;
constexpr size_t GX_D_E = RW_BON + 4096 * 64 * 4;
constexpr size_t GX_S_E = GX_D_E + (size_t)2048 * 128 * 64 * 4;
constexpr size_t GX_DEC_E = GX_S_E + (size_t)2048 * 128 * 64 * 2;
constexpr size_t MX_END_E = GX_DEC_E + (size_t)2048 * 64 * 4;
constexpr size_t GX_D_O = 0, GX_S_O = GX_D_O + (size_t)2048 * 128 * 64 * 4, GX_DEC_O = GX_S_O + (size_t)2048 * 128 * 64 * 2;
constexpr size_t SX_ST = GX_DEC_O + (size_t)2048 * 64 * 4;
constexpr size_t SX_S = SX_ST + 4096 * M64 * 4;
constexpr size_t SX_DEC = SX_S + 4096 * M64 * 2;
constexpr size_t MX_END_O = SX_DEC + 4096 * 4;
static_assert(MX_END_E <= MX_AVAIL && MX_END_O <= MX_AVAIL, "mixer scratch overflow");

template <int NC>
__device__ __forceinline__ void lds_cumsum64(LAS float* tile, int stride, LAS float* seg, int tid) {
    const int n = tid % NC, s = tid / NC; const bool act = tid < 8 * NC;
    float v[8];
    if (act) {
#pragma unroll
        for (int i = 0; i < 8; ++i) v[i] = tile[(8 * s + i) * stride + n];
#pragma unroll
        for (int i = 1; i < 8; ++i) v[i] += v[i - 1];
        seg[s * NC + n] = v[7];
    }
    __syncthreads();
    if (act) { float off = 0.f;
#pragma unroll
        for (int q = 0; q < 8; ++q) off += (q < s) ? seg[q * NC + n] : 0.f;
#pragma unroll
        for (int i = 0; i < 8; ++i) tile[(8 * s + i) * stride + n] = v[i] + off; }
    __syncthreads();
}

constexpr int GL_GT = 0, GL_SEG = 17408, GL_AUP = 19456, GL_KD = 24576, GL_KM = 24576, GL_QM = 33792, GL_Q2 = 43008, GL_VT = 52224, GL_ST = 69632, GL_PL = 88064, GL_RS = 97280;

template <bool HGRN>
__device__ __forceinline__ void gla_stage_g(const Params& p, const Ctx& C, int layer, int h, const GAS bf16_t* urow0, float (&kreg)[8]) {
    const int j = C.tid >> 3, cg = C.tid & 7, jl = layer >> 1;
    LAS float* Gt = (LAS float*)(C.lds + GL_GT);
    const GAS bf16_t* ur = urow0 + (size_t)j * UPITCH;
    float g[8];
    if constexpr (HGRN) {
        float fr[8]; unpack8(*(const GAS u32x4*)(ur + HG_F + 64 * h + 8 * cg), fr);
        const GAS float* lb = (const GAS float*)(p.ws + WS_LB) + layer * 256 + 64 * h + 8 * cg;
#pragma unroll
        for (int q = 0; q < 8; ++q) { const float l = lb[q]; const float f = l + (1.f - l) * sigmoidf_(fr[q]); g[q] = __logf(f); kreg[q] = 1.f - f; }
    } else {
        LAS float* AUP = (LAS float*)(C.lds + GL_AUP);
        float ad[16]; { float t0[8], t1[8]; unpack8(*(const GAS u32x4*)(ur + GL_AD), t0); unpack8(*(const GAS u32x4*)(ur + GL_AD + 8), t1);
#pragma unroll
            for (int q = 0; q < 8; ++q) { ad[q] = t0[q]; ad[8 + q] = t1[q]; } }
#pragma unroll
        for (int q = 0; q < 8; ++q) { float x = AUP[16 * 64 + 8 * cg + q];
#pragma unroll
            for (int r = 0; r < 16; ++r) x += ad[r] * AUP[r * 64 + 8 * cg + q];
            g[q] = logsigmoidf_(x) * (1.f / 16.f); }
        unpack8(*(const GAS u32x4*)(ur + GL_K + 64 * h + 8 * cg), kreg);
    }
    *(LAS f32x4*)(Gt + j * FS + 8 * cg) = (f32x4){g[0], g[1], g[2], g[3]};
    *(LAS f32x4*)(Gt + j * FS + 8 * cg + 4) = (f32x4){g[4], g[5], g[6], g[7]};
    (void)jl;
}
template <bool HGRN>
__device__ __forceinline__ void gla_stage_aup(const Params& p, const Ctx& C, int layer, int h) {
    if constexpr (!HGRN) { const int jl = layer >> 1; LAS float* AUP = (LAS float*)(C.lds + GL_AUP);
        for (int i = C.tid; i < 16 * 64; i += 512) AUP[i] = p.b_alpha_up[(size_t)jl * 16 * 256 + (i >> 6) * 256 + 64 * h + (i & 63)];
        if (C.tid < 64) AUP[16 * 64 + C.tid] = p.b_alpha_bias[jl * 256 + 64 * h + C.tid]; }
}
__device__ __forceinline__ void gla_stage_v(const Ctx& C, const GAS bf16_t* urow0, int vcol) {
    const int j = C.tid >> 3, cg = C.tid & 7;
    const GAS u32x4* src = (const GAS u32x4*)(urow0 + (size_t)j * UPITCH + vcol + 16 * cg);
    LAS u32x4* dst = (LAS u32x4*)(C.lds + GL_VT + j * TS2 + 32 * cg);
    dst[0] = src[0]; dst[1] = src[1];
}

template <bool HGRN>
__device__ __forceinline__ void gla_pass1_item(const Params& p, const Ctx& C0, int layer, int item) {
    Ctx C = C0; asm volatile("" : "+s"(C.wave)); asm volatile("" : "+v"(C.tid)); C.lane = C.tid & 63;
    const int h = item & 3, bc = item >> 2;
    const GAS bf16_t* urow0 = (const GAS bf16_t*)(p.ws + WS_U) + (size_t)bc * 64 * UPITCH;
    LAS float* Gt = (LAS float*)(C.lds + GL_GT);
    const int j = C.tid >> 3, cg = C.tid & 7;
    GAS unsigned char* mx = p.ws + MX_BASE;
    GAS float* Dg = (GAS float*)(mx + (HGRN ? GX_D_O : GX_D_E)) + (size_t)item * 128 * 64;
    GAS float* DECg = (GAS float*)(mx + (HGRN ? GX_DEC_O : GX_DEC_E)) + (size_t)item * 64;
    gla_stage_aup<HGRN>(p, C, layer, h);
    __syncthreads();
    float kreg[8];
    gla_stage_g<HGRN>(p, C, layer, h, urow0, kreg);
    gla_stage_v(C, urow0, (HGRN ? HG_I : GL_V) + 128 * h);
    __syncthreads();
    lds_cumsum64<64>(Gt, FS, (LAS float*)(C.lds + GL_SEG), C.tid);
    { float kd[8];
#pragma unroll
      for (int q = 0; q < 8; ++q) { const float bj = Gt[j * FS + 8 * cg + q], bl = Gt[63 * FS + 8 * cg + q]; kd[q] = kreg[q] * __expf(bl - bj); if (j == 63) DECg[8 * cg + q] = __expf(bl); }
      *(LAS u32x4*)(C.lds + GL_KD + j * TS + 16 * cg) = pack8(kd); }
    __syncthreads();
    { const int e0 = 16 * C.wave; const LAS unsigned char* Vt = C.lds + GL_VT; const LAS unsigned char* Kd = C.lds + GL_KD;
      bf16x8 bv[2]; bv[0] = tf_lds(Vt, TS2, 0, e0, C.lane); bv[1] = tf_lds(Vt, TS2, 32, e0, C.lane);
#pragma unroll
      for (int bt = 0; bt < 4; ++bt) { f32x4 acc = {0.f, 0.f, 0.f, 0.f};
#pragma unroll
          for (int ks = 0; ks < 2; ++ks) acc = MFMA16(tf_lds(Kd, TS, 32 * ks, 16 * bt, C.lane), bv[ks], acc);
          SETTLE(acc);
          *(GAS f32x4*)(Dg + (size_t)(e0 + (C.lane & 15)) * 64 + 16 * bt + 4 * (C.lane >> 4)) = acc; } }
    __syncthreads();
}

template <bool HGRN>
__device__ __forceinline__ void gla_pass2_job(const Params& p, int job, int lane) {
    GAS unsigned char* mx = p.ws + MX_BASE;
    const int bh = job >> 5, slab = job & 31, b = bh >> 2, h = bh & 3;
    const int el = slab * 256 + lane * 4;
    const int d0 = el & 63;
    f32x4 S = {0.f, 0.f, 0.f, 0.f};
    for (int c = 0; c < 64; ++c) {
        const size_t item = ((size_t)(b * 64 + c) * 4 + h);
        const f32x4 Dv = *(const GAS f32x4*)((const GAS float*)(mx + (HGRN ? GX_D_O : GX_D_E)) + item * 8192 + el);
        const f32x4 dc = *(const GAS f32x4*)((const GAS float*)(mx + (HGRN ? GX_DEC_O : GX_DEC_E)) + item * 64 + d0);
        u32x2 o; o.x = pk2(S[0], S[1]); o.y = pk2(S[2], S[3]);
        *(GAS u32x2*)((GAS bf16_t*)(mx + (HGRN ? GX_S_O : GX_S_E)) + item * 8192 + el) = o;
        S = S * dc + Dv;
    }
}

template <bool HGRN>
__device__ __forceinline__ void gla_pass3_item(const Params& p, const Ctx& C0, int layer, int item) {
    Ctx C = C0; asm volatile("" : "+s"(C.wave)); asm volatile("" : "+v"(C.tid)); C.lane = C.tid & 63;
    const int h = item & 3, bc = item >> 2, jl = layer >> 1;
    const GAS bf16_t* urow0 = (const GAS bf16_t*)(p.ws + WS_U) + (size_t)bc * 64 * UPITCH;
    GAS bf16_t* Y = (GAS bf16_t*)(p.ws + WS_Y);
    LAS float* Gt = (LAS float*)(C.lds + GL_GT);
    const int j = C.tid >> 3, cg = C.tid & 7;
    GAS unsigned char* mx = p.ws + MX_BASE;
    const GAS bf16_t* Sg = (const GAS bf16_t*)(mx + (HGRN ? GX_S_O : GX_S_E)) + (size_t)item * 8192;
    gla_stage_aup<HGRN>(p, C, layer, h);
    __syncthreads();
    float kreg[8];
    gla_stage_g<HGRN>(p, C, layer, h, urow0, kreg);
    gla_stage_v(C, urow0, (HGRN ? HG_I : GL_V) + 128 * h);
    {
#pragma unroll
      for (int q = 0; q < 2; ++q) { const int idx = C.tid + 512 * q, e = idx >> 3, ch = idx & 7;
          *(LAS u32x4*)(C.lds + GL_ST + e * TS + 16 * ch) = *(const GAS u32x4*)(Sg + (size_t)e * 64 + 8 * ch); } }
    __syncthreads();
    lds_cumsum64<64>(Gt, FS, (LAS float*)(C.lds + GL_SEG), C.tid);
    { float qv[8]; unpack8(*(const GAS u32x4*)(urow0 + (size_t)j * UPITCH + (HGRN ? HG_Q : GL_Q) + 64 * h + 8 * cg), qv);
      const float qs = HGRN ? 1.f : 0.125f;
      float qm[8], q2[8], km[8];
#pragma unroll
      for (int q = 0; q < 8; ++q) { const float bj = Gt[j * FS + 8 * cg + q], br = Gt[31 * FS + 8 * cg + q]; const float qq = qv[q] * qs;
          qm[q] = qq * __expf(bj - br); q2[q] = qq * __expf(bj); km[q] = kreg[q] * __expf(br - bj); }
      *(LAS u32x4*)(C.lds + GL_QM + j * TS + 16 * cg) = pack8(qm);
      *(LAS u32x4*)(C.lds + GL_Q2 + j * TS + 16 * cg) = pack8(q2);
      *(LAS u32x4*)(C.lds + GL_KM + j * TS + 16 * cg) = pack8(km); }
    __syncthreads();
    {
      const LAS unsigned char* Qm = C.lds + GL_QM; const LAS unsigned char* Km = C.lds + GL_KM; LAS unsigned char* Pl = C.lds + GL_PL;
#pragma unroll
      for (int q = 0; q < 2; ++q) { const int id = 2 * C.wave + q, at = id >> 2, bt = id & 3; f32x4 acc = {0.f, 0.f, 0.f, 0.f};
          if (bt <= at) {
#pragma unroll
              for (int ks = 0; ks < 2; ++ks) acc = MFMA16(rf_lds(Km, TS, 16 * bt, 32 * ks, C.lane), rf_lds(Qm, TS, 16 * at, 32 * ks, C.lane), acc);
          SETTLE(acc);
              const int i = 16 * at + (C.lane & 15), j0 = 16 * bt + 4 * (C.lane >> 4);
#pragma unroll
              for (int r = 0; r < 4; ++r) acc[r] = (j0 + r <= i) ? acc[r] : 0.f; }
          st4_lds(Pl, TS, 16 * at + (C.lane & 15), 16 * bt + 4 * (C.lane >> 4), acc); } }
    __syncthreads();
    { const int at = C.wave & 3, eh = C.wave >> 2, i = 16 * at + (C.lane & 15), g4 = 4 * (C.lane >> 4);
      const LAS unsigned char* Vt = C.lds + GL_VT; const LAS unsigned char* St = C.lds + GL_ST; const LAS unsigned char* Pl = C.lds + GL_PL; const LAS unsigned char* Q2 = C.lds + GL_Q2;
      LAS float* RS = (LAS float*)(C.lds + GL_RS);
      bf16x8 bp[2], bq[2];
#pragma unroll
      for (int ks = 0; ks < 2; ++ks) { bp[ks] = rf_lds(Pl, TS, 16 * at, 32 * ks, C.lane); bq[ks] = rf_lds(Q2, TS, 16 * at, 32 * ks, C.lane); }
      f32x4 acc[4]; float ss = 0.f;
#pragma unroll
      for (int et = 0; et < 4; ++et) { const int e0 = 64 * eh + 16 * et; f32x4 a = {0.f, 0.f, 0.f, 0.f};
#pragma unroll
          for (int ks = 0; ks < 2; ++ks) { a = MFMA16(tf_lds(Vt, TS2, 32 * ks, e0, C.lane), bp[ks], a); a = MFMA16(rf_lds(St, TS, e0, 32 * ks, C.lane), bq[ks], a); }
          SETTLE(a);
          acc[et] = a; ss += (a[0] * a[0] + a[1] * a[1]) + (a[2] * a[2] + a[3] * a[3]); }
      ss += __shfl_xor(ss, 16); ss += __shfl_xor(ss, 32);
      if (C.lane < 16) RS[eh * 64 + i] = ss;
      __syncthreads();
      const float rstd = rsqrtf((RS[i] + RS[64 + i]) * (1.f / 128.f) + NORM_EPS);
      const GAS float* gain = (HGRN ? p.c_norm_gain : p.b_norm_gain) + jl * 128;
      const size_t tk = (size_t)bc * 64 + i;
      const GAS bf16_t* gp = (const GAS bf16_t*)(p.ws + WS_U) + tk * UPITCH + (HGRN ? HG_G : GL_G) + 128 * h;
      GAS bf16_t* yp = Y + tk * D + (HGRN ? 0 : 512) + 128 * h;
#pragma unroll
      for (int et = 0; et < 4; ++et) { const int e = 64 * eh + 16 * et + g4; const u32x2 gv = *(const GAS u32x2*)(gp + e); const f32x4 gn = *(const GAS f32x4*)(gain + e);
          const float g0 = siluf_(bflo(gv.x)), g1 = siluf_(bfhi(gv.x)), g2 = siluf_(bflo(gv.y)), g3 = siluf_(bfhi(gv.y));
          u32x2 o; o.x = pk2(acc[et][0] * rstd * gn[0] * g0, acc[et][1] * rstd * gn[1] * g1); o.y = pk2(acc[et][2] * rstd * gn[2] * g2, acc[et][3] * rstd * gn[3] * g3);
          *(GAS u32x2*)(yp + e) = o; } }
    __syncthreads();
}
constexpr int SD_BMT = 0, SD_CMT = 9216, SD_X = 18432  , SD_HS = 55296  , SD_PL = 92160  , SD_DTL = 129024  , SD_CUM = 130048  , SD_SEG = 131072  , SD_RS = 131328  ;

__device__ __forceinline__ void ssd_stage_dt(const Params& p, const Ctx& C, int layer, int grp, const GAS bf16_t* urow0) {
    const int jl = layer >> 1;
    LAS float* DTL = (LAS float*)(C.lds + SD_DTL); LAS float* CUM = (LAS float*)(C.lds + SD_CUM);
    if (C.tid < 256) { const int j = C.tid >> 2, hh = C.tid & 3, head = 4 * grp + hh;
        const float raw = bf2f(urow0[(size_t)j * UPITCH + SD_DT + head]) + p.d_dt_bias[jl * 8 + head];
        const float dt = softplusf_(raw); DTL[j * 4 + hh] = dt; CUM[j * 4 + hh] = -dt * __expf(p.d_a_log[jl * 8 + head]); }
    __syncthreads();
    lds_cumsum64<4>(CUM, 4, (LAS float*)(C.lds + SD_SEG), C.tid);
}
__device__ __forceinline__ void ssd_conv8(const Params& p, int jl, const GAS bf16_t* useq, int pos, int ch, float (&o)[8]) {
    const GAS float* cw = p.d_conv_w + (size_t)jl * 4 * 768 + ch; const GAS float* cb = p.d_conv_b + jl * 768 + ch;
#pragma unroll
    for (int q = 0; q < 8; ++q) o[q] = cb[q];
#pragma unroll
    for (int i = 0; i < 4; ++i) { const int pp = pos - 3 + i;
        if (pp >= 0) { float xv[8]; unpack8(*(const GAS u32x4*)(useq + (size_t)pp * UPITCH + SD_XBC + ch), xv);
            const f32x4 w0 = *(const GAS f32x4*)(cw + i * 768), w1 = *(const GAS f32x4*)(cw + i * 768 + 4);
            o[0] += w0[0] * xv[0]; o[1] += w0[1] * xv[1]; o[2] += w0[2] * xv[2]; o[3] += w0[3] * xv[3]; o[4] += w1[0] * xv[4]; o[5] += w1[1] * xv[5]; o[6] += w1[2] * xv[6]; o[7] += w1[3] * xv[7]; } }
#pragma unroll
    for (int q = 0; q < 8; ++q) o[q] = siluf_(o[q]);
}

__device__ __forceinline__ void ssd_pass1_item(const Params& p, const Ctx& C0, int layer, int item) {
    Ctx C = C0; asm volatile("" : "+s"(C.wave)); asm volatile("" : "+v"(C.tid)); C.lane = C.tid & 63;
    const int grp = item & 1, bc = item >> 1, c = bc & 63, jl = layer >> 1;
    const GAS bf16_t* U = (const GAS bf16_t*)(p.ws + WS_U);
    const GAS bf16_t* urow0 = U + (size_t)bc * 64 * UPITCH; const GAS bf16_t* useq = U + (size_t)(bc >> 6) * SEQ * UPITCH;
    LAS float* DTL = (LAS float*)(C.lds + SD_DTL); LAS float* CUM = (LAS float*)(C.lds + SD_CUM);
    GAS unsigned char* mx = p.ws + MX_BASE;
    ssd_stage_dt(p, C, layer, grp, urow0);
    for (int t = C.tid; t < 40 * 64; t += 512) { const int j = t & 63, cgx = t >> 6; float o[8];
        if (cgx < 32) { const int hh = cgx >> 3; ssd_conv8(p, jl, useq, c * 64 + j, 256 * grp + 8 * cgx, o);
            const float s = DTL[j * 4 + hh] * __expf(CUM[63 * 4 + hh] - CUM[j * 4 + hh]);
#pragma unroll
            for (int q = 0; q < 8; ++q) o[q] *= s;
            *(LAS u32x4*)(C.lds + SD_X + hh * TILE64 + j * TS + 16 * (cgx & 7)) = pack8(o);
        } else { ssd_conv8(p, jl, useq, c * 64 + j, 512 + 64 * grp + 8 * (cgx - 32), o); *(LAS u32x4*)(C.lds + SD_BMT + j * TS + 16 * (cgx - 32)) = pack8(o); } }
    __syncthreads();
    { const int hh = C.wave >> 1; const LAS unsigned char* Xt = C.lds + SD_X + hh * TILE64; const LAS unsigned char* Bt = C.lds + SD_BMT;
      const size_t ih = (size_t)bc * 8 + 4 * grp + hh;
      GAS float* STg = (GAS float*)(mx + SX_ST) + ih * 4096;
      if ((C.wave & 1) == 0 && C.lane == 0) ((GAS float*)(mx + SX_DEC))[ih] = __expf(CUM[63 * 4 + hh]);
#pragma unroll
      for (int q = 0; q < 2; ++q) { const int at = 2 * (C.wave & 1) + q;
          bf16x8 bx[2]; bx[0] = tf_lds(Xt, TS, 0, 16 * at, C.lane); bx[1] = tf_lds(Xt, TS, 32, 16 * at, C.lane);
#pragma unroll
          for (int bt = 0; bt < 4; ++bt) { f32x4 acc = {0.f, 0.f, 0.f, 0.f};
#pragma unroll
              for (int ks = 0; ks < 2; ++ks) acc = MFMA16(tf_lds(Bt, TS, 32 * ks, 16 * bt, C.lane), bx[ks], acc);
          SETTLE(acc);
              *(GAS f32x4*)(STg + (size_t)(16 * at + (C.lane & 15)) * 64 + 16 * bt + 4 * (C.lane >> 4)) = acc; } } }
    __syncthreads();
}
__device__ __forceinline__ void ssd_pass2_job(const Params& p, int job, int lane) {
    GAS unsigned char* mx = p.ws + MX_BASE;
    const int bh = job >> 4, slab = job & 15, b = bh >> 3, head = bh & 7;
    const int el = slab * 256 + lane * 4;
    f32x4 S = {0.f, 0.f, 0.f, 0.f};
    for (int c = 0; c < 64; ++c) {
        const size_t ih = (size_t)(b * 64 + c) * 8 + head;
        const f32x4 Dv = *(const GAS f32x4*)((const GAS float*)(mx + SX_ST) + ih * 4096 + el);
        const float dc = ((const GAS float*)(mx + SX_DEC))[ih];
        u32x2 o; o.x = pk2(S[0], S[1]); o.y = pk2(S[2], S[3]);
        *(GAS u32x2*)((GAS bf16_t*)(mx + SX_S) + ih * 4096 + el) = o;
        S = S * dc + Dv;
    }
}
__device__ __forceinline__ void ssd_pass3_item(const Params& p, const Ctx& C0, int layer, int item) {
    Ctx C = C0; asm volatile("" : "+s"(C.wave)); asm volatile("" : "+v"(C.tid)); C.lane = C.tid & 63;
    const int grp = item & 1, bc = item >> 1, c = bc & 63, jl = layer >> 1;
    const GAS bf16_t* U = (const GAS bf16_t*)(p.ws + WS_U);
    const GAS bf16_t* urow0 = U + (size_t)bc * 64 * UPITCH; const GAS bf16_t* useq = U + (size_t)(bc >> 6) * SEQ * UPITCH;
    LAS float* DTL = (LAS float*)(C.lds + SD_DTL); LAS float* CUM = (LAS float*)(C.lds + SD_CUM); LAS float* RS = (LAS float*)(C.lds + SD_RS);
    GAS unsigned char* mx = p.ws + MX_BASE;
    GAS bf16_t* Y = (GAS bf16_t*)(p.ws + WS_Y);
    ssd_stage_dt(p, C, layer, grp, urow0);
    for (int t = C.tid; t < 48 * 64; t += 512) { const int j = t & 63, cgx = t >> 6; float o[8];
        if (cgx < 32) { const int hh = cgx >> 3; ssd_conv8(p, jl, useq, c * 64 + j, 256 * grp + 8 * cgx, o);
            const float s = DTL[j * 4 + hh];
#pragma unroll
            for (int q = 0; q < 8; ++q) o[q] *= s;
            *(LAS u32x4*)(C.lds + SD_X + hh * TILE64 + j * TS + 16 * (cgx & 7)) = pack8(o);
        } else if (cgx < 40) { ssd_conv8(p, jl, useq, c * 64 + j, 512 + 64 * grp + 8 * (cgx - 32), o); *(LAS u32x4*)(C.lds + SD_BMT + j * TS + 16 * (cgx - 32)) = pack8(o);
        } else { ssd_conv8(p, jl, useq, c * 64 + j, 640 + 64 * grp + 8 * (cgx - 40), o); *(LAS u32x4*)(C.lds + SD_CMT + j * TS + 16 * (cgx - 40)) = pack8(o); } }
    for (int t = C.tid; t < 4 * 512; t += 512) { const int hh = t >> 9, idx = t & 511, pr = idx >> 3, ch = idx & 7;
        const GAS bf16_t* Sg = (const GAS bf16_t*)(mx + SX_S) + ((size_t)bc * 8 + 4 * grp + hh) * 4096;
        *(LAS u32x4*)(C.lds + SD_HS + hh * TILE64 + pr * TS + 16 * ch) = *(const GAS u32x4*)(Sg + (size_t)pr * 64 + 8 * ch); }
    __syncthreads();
    {
      const LAS unsigned char* Cm = C.lds + SD_CMT; const LAS unsigned char* Bm = C.lds + SD_BMT;
#pragma unroll
      for (int q = 0; q < 2; ++q) { const int id = 2 * C.wave + q, at = id >> 2, bt = id & 3; f32x4 acc = {0.f, 0.f, 0.f, 0.f};
          const int tt = 16 * at + (C.lane & 15), s0 = 16 * bt + 4 * (C.lane >> 4);
          if (bt <= at) {
#pragma unroll
              for (int ks = 0; ks < 2; ++ks) acc = MFMA16(rf_lds(Bm, TS, 16 * bt, 32 * ks, C.lane), rf_lds(Cm, TS, 16 * at, 32 * ks, C.lane), acc); }
          SETTLE(acc);
#pragma unroll
          for (int hh = 0; hh < 4; ++hh) { f32x4 v; const float ct = CUM[tt * 4 + hh];
#pragma unroll
              for (int r = 0; r < 4; ++r) { const float e = __expf(ct - CUM[(s0 + r) * 4 + hh]); v[r] = (bt <= at && s0 + r <= tt) ? acc[r] * e : 0.f; }
              st4_lds(C.lds + SD_PL + hh * TILE64, TS, tt, s0, v); } } }
    __syncthreads();
    { const int at = C.wave & 3, hp = C.wave >> 2, tt = 16 * at + (C.lane & 15), g4 = 4 * (C.lane >> 4);
      const LAS unsigned char* Cm = C.lds + SD_CMT;
      bf16x8 bc_[2]; bc_[0] = rf_lds(Cm, TS, 16 * at, 0, C.lane); bc_[1] = rf_lds(Cm, TS, 16 * at, 32, C.lane);
      const size_t tk = (size_t)bc * 64 + tt;
      f32x4 yv[2][4]; float ss = 0.f;
#pragma unroll
      for (int q = 0; q < 2; ++q) { const int hh = 2 * hp + q, head = 4 * grp + hh;
          const LAS unsigned char* Hs = C.lds + SD_HS + hh * TILE64; const LAS unsigned char* Xt = C.lds + SD_X + hh * TILE64; const LAS unsigned char* Pl = C.lds + SD_PL + hh * TILE64;
          bf16x8 bp[2]; bp[0] = rf_lds(Pl, TS, 16 * at, 0, C.lane); bp[1] = rf_lds(Pl, TS, 16 * at, 32, C.lane);
          const float ec = __expf(CUM[tt * 4 + hh]), rdt = 1.f / DTL[tt * 4 + hh], skip = p.d_skip[jl * 8 + head];
          const GAS bf16_t* zp = U + tk * UPITCH + SD_Z + 64 * head;
#pragma unroll
          for (int pt = 0; pt < 4; ++pt) { f32x4 a = {0.f, 0.f, 0.f, 0.f};
#pragma unroll
              for (int ks = 0; ks < 2; ++ks) a = MFMA16(rf_lds(Hs, TS, 16 * pt, 32 * ks, C.lane), bc_[ks], a);
          SETTLE(a);
              a = a * ec;
#pragma unroll
              for (int ks = 0; ks < 2; ++ks) a = MFMA16(tf_lds(Xt, TS, 32 * ks, 16 * pt, C.lane), bp[ks], a);
          SETTLE(a);
              const f32x4 xh = ld4_lds(Xt, TS, tt, 16 * pt + g4) * rdt;
              const u32x2 zv = *(const GAS u32x2*)(zp + 16 * pt + g4);
              a[0] = (a[0] + skip * xh[0]) * siluf_(bflo(zv.x)); a[1] = (a[1] + skip * xh[1]) * siluf_(bfhi(zv.x)); a[2] = (a[2] + skip * xh[2]) * siluf_(bflo(zv.y)); a[3] = (a[3] + skip * xh[3]) * siluf_(bfhi(zv.y));
              yv[q][pt] = a; ss += (a[0] * a[0] + a[1] * a[1]) + (a[2] * a[2] + a[3] * a[3]); } }
      ss += __shfl_xor(ss, 16); ss += __shfl_xor(ss, 32);
      if (C.lane < 16) RS[hp * 64 + tt] = ss;
      __syncthreads();
      const float rstd = rsqrtf((RS[tt] + RS[64 + tt]) * (1.f / 256.f) + NORM_EPS);
#pragma unroll
      for (int q = 0; q < 2; ++q) { const int hh = 2 * hp + q, head = 4 * grp + hh;
          const GAS float* gn = p.d_norm_gain + jl * 512 + 64 * head; GAS bf16_t* yp = Y + tk * D + 512 + 64 * head;
#pragma unroll
          for (int pt = 0; pt < 4; ++pt) { const f32x4 g = *(const GAS f32x4*)(gn + 16 * pt + g4); const f32x4 a = yv[q][pt] * rstd * g;
              u32x2 o; o.x = pk2(a[0], a[1]); o.y = pk2(a[2], a[3]); *(GAS u32x2*)(yp + 16 * pt + g4) = o; } } }
    __syncthreads();
}
constexpr int RK_LW = 0, RK_AA = 17408, RK_NA = 0, RK_NB = 9216, RK_TA = 18432, RK_TB = 27648, RK_SEG = 40960, RK_ECL = 43008, RK_TW = 43520, RK_AD = 52736, RK_WZ = 43520,
              RK_KKG = 61952, RK_BI = 71168, RK_KTI = 80384, RK_RG = 89600, RK_V = 98816, RK_MBR = 108032, RK_MKR = 117248, RK_N0 = 126464, RK_AK = 135680, RK_KH = RK_BI, RK_END = 144896;

__device__ __forceinline__ void rk_shift8(const GAS bf16_t* cur, const GAS bf16_t* prv, bool has_prev, const GAS float* mu, float (&o)[8]) {
    float c[8], q[8]; unpack8(*(const GAS u32x4*)cur, c);
    if (has_prev) unpack8(*(const GAS u32x4*)prv, q); else {
#pragma unroll
        for (int i = 0; i < 8; ++i) q[i] = 0.f; }
    const f32x4 m0 = *(const GAS f32x4*)mu, m1 = *(const GAS f32x4*)(mu + 4);
#pragma unroll
    for (int i = 0; i < 8; ++i) { const float m = i < 4 ? m0[i & 3] : m1[i & 3]; o[i] = c[i] + m * (q[i] - c[i]); }
}
__device__ __forceinline__ float tanhf_(float x) { const float e = __expf(-2.f * fabsf(x)); const float t = (1.f - e) / (1.f + e); return x < 0.f ? -t : t; }

#ifdef DBG_RW
#define RWCHK(cond, bit) do { if (layer == 0 && __any((int)(cond))) { GAS unsigned* f_ = (GAS unsigned*)(p.ws + WS_CTL) + 8192; if (C.lane == 0 && !(__hip_atomic_load(f_, __ATOMIC_RELAXED, __HIP_MEMORY_SCOPE_AGENT) & (bit))) atomicOr(f_, (bit)); } } while (0)
#else
#define RWCHK(cond, bit) do { } while (0)
#endif
#ifdef DBG_DUMP
#define RWDUMP(ldsoff, nbytes, gofs) do { if (layer == 0 && item < 1024) { const int rs_ = ((nbytes) == 64 * TS2) ? TS2 : TS; const int vb_ = rs_ - 16; for (int i_ = C.tid * 16; i_ < 64 * vb_; i_ += 512 * 16) { const int r_ = i_ / vb_, c_ = i_ % vb_; *(GAS u32x4*)(p.ws + WS_Y + (gofs) + (size_t)item * (nbytes) + r_ * rs_ + c_) = *(const LAS u32x4*)(L + (ldsoff) + r_ * rs_ + c_); } } } while (0)
#else
#define RWDUMP(ldsoff, nbytes, gofs) do { } while (0)
#endif
__device__ __forceinline__ void rwkv_pass1_item(const Params& p, const Ctx& C0, int layer, int item) {
    Ctx C = C0; asm volatile("" : "+s"(C.wave)); asm volatile("" : "+v"(C.tid)); C.lane = C.tid & 63;
    const int h = item & 7, bc = item >> 3, c = bc & 63, jl = layer >> 1;
    const GAS bf16_t* urow0 = (const GAS bf16_t*)(p.ws + WS_U) + (size_t)bc * 64 * UPITCH;
    GAS unsigned char* mx = p.ws + MX_BASE;
    LAS unsigned char* L = C.lds;
    LAS float* LW = (LAS float*)(L + RK_LW); LAS float* AA = (LAS float*)(L + RK_AA); LAS float* ECL = (LAS float*)(L + RK_ECL);
    const int j = C.tid >> 3, cg = C.tid & 7, lane = C.lane, w = C.wave;
    const int g4 = 4 * (lane >> 4), l15 = lane & 15;
    float rr[8], kk[8], vv[8];
    { const GAS bf16_t* cur = urow0 + (size_t)j * UPITCH; const GAS bf16_t* prv = cur - UPITCH; const bool hp = (c * 64 + j) != 0;
      const GAS float* mu = p.a_mu + (size_t)jl * RWKV_IN;
      rk_shift8(cur + RW_R + 64 * h + 8 * cg, prv + RW_R + 64 * h + 8 * cg, hp, mu + RW_R + 64 * h + 8 * cg, rr);
      rk_shift8(cur + RW_K + 64 * h + 8 * cg, prv + RW_K + 64 * h + 8 * cg, hp, mu + RW_K + 64 * h + 8 * cg, kk);
      rk_shift8(cur + RW_V + 64 * h + 8 * cg, prv + RW_V + 64 * h + 8 * cg, hp, mu + RW_V + 64 * h + 8 * cg, vv);
      float t[8];
      rk_shift8(cur + RW_WD + 8 * cg, prv + RW_WD + 8 * cg, hp, mu + RW_WD + 8 * cg, t);
#pragma unroll
      for (int q = 0; q < 8; ++q) t[q] = tanhf_(t[q]);
      *(LAS u32x4*)(L + RK_TW + j * TS + 16 * cg) = pack8(t);
      rk_shift8(cur + RW_AD + 8 * cg, prv + RW_AD + 8 * cg, hp, mu + RW_AD + 8 * cg, t);
      *(LAS u32x4*)(L + RK_AD + j * TS + 16 * cg) = pack8(t); }
    __syncthreads();
    { const int prod = w >> 2, at = w & 3;
      const LAS unsigned char* src = L + (prod ? RK_AD : RK_TW);
      const GAS bf16_t* Wt = (const GAS bf16_t*)(p.ws + (prod ? WS_AUPT : WS_WUPT)) + ((size_t)jl * 512 + 64 * h) * 64;
      const GAS float* bias = (prod ? p.a_a0 : p.a_w0) + jl * 512 + 64 * h;
      LAS float* dst = prod ? AA : LW;
      bf16x8 bj[2]; bj[0] = rf_lds(src, TS, 16 * at, 0, lane); bj[1] = rf_lds(src, TS, 16 * at, 32, lane);
#pragma unroll
      for (int bt = 0; bt < 4; ++bt) { f32x4 acc = *(const GAS f32x4*)(bias + 16 * bt + g4);
#pragma unroll
          for (int ks = 0; ks < 2; ++ks) acc = MFMA16(rf_glb(Wt, 64, 16 * bt, 32 * ks, lane), bj[ks], acc);
          SETTLE(acc);
#pragma unroll
          for (int r = 0; r < 4; ++r) acc[r] = prod ? sigmoidf_(acc[r]) : -0.6065306597f * sigmoidf_(acc[r]);
          *(LAS f32x4*)(dst + (16 * at + l15) * FS + 16 * bt + g4) = acc; } }
    __syncthreads();
    float lw[8];
#pragma unroll
    for (int q = 0; q < 8; ++q) lw[q] = LW[j * FS + 8 * cg + q];
    __syncthreads();
    lds_cumsum64<64>(LW, FS, (LAS float*)(L + RK_SEG), C.tid);
    { const GAS float* k_k = p.a_k_k + jl * 512 + 64 * h + 8 * cg; const GAS float* k_a = p.a_k_a + jl * 512 + 64 * h + 8 * cg; const GAS float* r_k = p.a_r_k + jl * 512 + 64 * h + 8 * cg;
      float kn[8], ss = 0.f, bon = 0.f, kt[8], bb[8], cs[8];
#pragma unroll
      for (int q = 0; q < 8; ++q) { kn[q] = kk[q] * k_k[q]; ss += kn[q] * kn[q]; }
      ss += __shfl_xor(ss, 1); ss += __shfl_xor(ss, 2); ss += __shfl_xor(ss, 4);
      const float rn = rsqrtf(ss + 1e-12f);
#pragma unroll
      for (int q = 0; q < 8; ++q) { const float a = AA[j * FS + 8 * cg + q]; kn[q] *= rn; kt[q] = kk[q] * (1.f + (a - 1.f) * k_a[q]); bb[q] = a * kn[q]; bon += rr[q] * kt[q] * r_k[q]; cs[q] = LW[j * FS + 8 * cg + q]; }
#pragma unroll
      for (int q = 0; q < 1; ++q) { }
      bon += __shfl_xor(bon, 1); bon += __shfl_xor(bon, 2); bon += __shfl_xor(bon, 4);
      if (cg == 0) ((GAS float*)(mx + RW_BON))[(size_t)item * 64 + j] = bon;
      float o[8];
#pragma unroll
      for (int q = 0; q < 8; ++q) o[q] = kn[q] * __expf(cs[q] - lw[q]);
      *(LAS u32x4*)(L + RK_KKG + j * TS + 16 * cg) = pack8(o);
#pragma unroll
      for (int q = 0; q < 8; ++q) o[q] = bb[q] * __expf(-cs[q]);
      *(LAS u32x4*)(L + RK_BI + j * TS + 16 * cg) = pack8(o);
#pragma unroll
      for (int q = 0; q < 8; ++q) o[q] = kt[q] * __expf(-cs[q]);
      *(LAS u32x4*)(L + RK_KTI + j * TS + 16 * cg) = pack8(o);
#pragma unroll
      for (int q = 0; q < 8; ++q) o[q] = rr[q] * __expf(cs[q]);
      *(LAS u32x4*)(L + RK_RG + j * TS + 16 * cg) = pack8(o);
      *(LAS u32x4*)(L + RK_V + j * TS + 16 * cg) = pack8(vv);
      if (j == 63) {
#pragma unroll
          for (int q = 0; q < 8; ++q) ECL[8 * cg + q] = __expf(cs[q]); } }
    __syncthreads();
    { const int prod = w >> 1;
      const LAS unsigned char* bsrc = L + (prod <= 1 ? RK_KKG : (prod == 2 ? RK_BI : RK_RG));
      const LAS unsigned char* asrc = L + (prod == 0 ? RK_BI : (prod == 1 ? RK_KTI : (prod == 2 ? RK_RG : RK_KTI)));
      LAS unsigned char* dst = L + (prod == 0 ? RK_N0 : (prod == 1 ? RK_AK : (prod == 2 ? RK_MBR : RK_MKR)));
#pragma unroll
      for (int q = 0; q < 2; ++q) { const int at = 2 * (w & 1) + q;
          bf16x8 bj[2]; bj[0] = rf_lds(bsrc, TS, 16 * at, 0, lane); bj[1] = rf_lds(bsrc, TS, 16 * at, 32, lane);
#pragma unroll
          for (int bt = 0; bt < 4; ++bt) { f32x4 acc = {0.f, 0.f, 0.f, 0.f};
#pragma unroll
              for (int ks = 0; ks < 2; ++ks) acc = MFMA16(rf_lds(asrc, TS, 16 * bt, 32 * ks, lane), bj[ks], acc);
          SETTLE(acc);
              const int a = 16 * at + l15, b0 = 16 * bt + g4;
#pragma unroll
              for (int r = 0; r < 4; ++r) { const int b = b0 + r; const bool keep = prod <= 1 ? (b < a) : (prod == 2 ? (a <= b) : (b <= a)); acc[r] = keep ? acc[r] : 0.f; }
#pragma unroll
              for (int r = 0; r < 4; ++r) RWCHK(!(fabsf(acc[r]) < (prod == 0 ? 1.5f : 1e3f)), prod == 0 ? 1u : 2u);
              st4_lds(dst, TS, a, b0, acc);
              if (prod == 0) { f32x4 t0;
#pragma unroll
                  for (int r = 0; r < 4; ++r) t0[r] = ((b0 + r) == a ? 1.f : 0.f) - acc[r];
                  st4_lds(L + RK_TA, TS, a, b0, t0); } } } }
    __syncthreads();
    {
        int nsrc = RK_N0, ndst = RK_NA, tsrc = RK_TA, tdst = RK_TB;
        for (int st = 0; st < 6; ++st) {
            const int at = w & 3, prod = w >> 2;
            const bool doN = (st < 5), doT = (st > 0);
            if ((prod == 0 && doN) || (prod == 1 && doT)) {
                const LAS unsigned char* bs = L + (prod == 0 ? nsrc : tsrc); const LAS unsigned char* as = L + nsrc; LAS unsigned char* dst = L + (prod == 0 ? ndst : tdst);
                bf16x8 bj[2]; bj[0] = rf_lds(bs, TS, 16 * at, 0, lane); bj[1] = rf_lds(bs, TS, 16 * at, 32, lane);
#pragma unroll
                for (int bt = 0; bt < 4; ++bt) { f32x4 acc = {0.f, 0.f, 0.f, 0.f};
                    if (prod == 1) acc = ld4_lds(bs, TS, 16 * at + l15, 16 * bt + g4);
#pragma unroll
                    for (int ks = 0; ks < 2; ++ks) acc = MFMA16(tf_lds(as, TS, 32 * ks, 16 * bt, lane), bj[ks], acc);
          SETTLE(acc);
#pragma unroll
                    for (int r = 0; r < 4; ++r) RWCHK(!(fabsf(acc[r]) < 1e3f), 4u);
                    st4_lds(dst, TS, 16 * at + l15, 16 * bt + g4, acc); }
            }
            __syncthreads();
            if (doT) { const int t = tsrc; tsrc = tdst; tdst = t; }
            if (doN) { nsrc = ndst; ndst = (ndst == RK_NA) ? RK_NB : RK_NA; }
        }
        { const int at = w & 3, half = w >> 2; const LAS unsigned char* Tt = L + tsrc;
          bf16x8 bj[2]; bj[0] = tf_lds(Tt, TS, 0, 16 * at, lane); bj[1] = tf_lds(Tt, TS, 32, 16 * at, lane);
          const LAS unsigned char* as = L + (half ? RK_MBR : RK_BI);
#pragma unroll
          for (int bt = 0; bt < 4; ++bt) { f32x4 acc = {0.f, 0.f, 0.f, 0.f};
#pragma unroll
              for (int ks = 0; ks < 2; ++ks) acc = MFMA16(tf_lds(as, TS, 32 * ks, 16 * bt, lane), bj[ks], acc);
          SETTLE(acc);
              if (!half) { const f32x4 e = *(const LAS f32x4*)(ECL + 16 * bt + g4); acc = acc * e; }
#pragma unroll
              for (int r = 0; r < 4; ++r) RWCHK(!(fabsf(acc[r]) < 1e4f), 8u);
              st4_lds(L + RK_WZ, TS2, 16 * at + l15, 64 * half + 16 * bt + g4, acc); } }
    }
    __syncthreads();
    { const int prod = w >> 1; const size_t io = (size_t)item * 4096;
      GAS bf16_t* Pt = (GAS bf16_t*)(mx + RW_PT) + io; GAS bf16_t* Rh = (GAS bf16_t*)(mx + RW_RH) + io; GAS bf16_t* Mh = (GAS bf16_t*)(mx + RW_MH) + io;
#pragma unroll
      for (int q = 0; q < 2; ++q) { const int at = 2 * (w & 1) + q; const int a = 16 * at + l15;
          bf16x8 bj[2];
          if (prod == 0) { bj[0] = tf_lds(L + RK_WZ, TS2, 0, 16 * at, lane); bj[1] = tf_lds(L + RK_WZ, TS2, 32, 16 * at, lane); }
          else if (prod == 2) { bj[0] = tf_lds(L + RK_AK, TS, 0, 16 * at, lane); bj[1] = tf_lds(L + RK_AK, TS, 32, 16 * at, lane); }
          else { bj[0] = tf_lds(L + RK_WZ, TS2, 0, 64 + 16 * at, lane); bj[1] = tf_lds(L + RK_WZ, TS2, 32, 64 + 16 * at, lane); }
#pragma unroll
          for (int bt = 0; bt < 4; ++bt) { f32x4 acc = {0.f, 0.f, 0.f, 0.f}; const int b0 = 16 * bt + g4;
#pragma unroll
              for (int ks = 0; ks < 2; ++ks) { bf16x8 af;
                  if (prod == 0 || prod == 1) af = tf_lds(L + RK_KKG, TS, 32 * ks, 16 * bt, lane);
                  else if (prod == 2) af = tf_lds(L + RK_WZ, TS2, 32 * ks, 16 * bt, lane);
                  else af = tf_lds(L + RK_AK, TS, 32 * ks, 16 * bt, lane);
                  acc = MFMA16(af, bj[ks], acc); }
              SETTLE(acc);
              f32x4 o;
#pragma unroll
              for (int r = 0; r < 4; ++r) RWCHK(!(fabsf(acc[r]) < 1e4f), 16u);
              if (prod == 0) { const float e = ECL[a];
#pragma unroll
                  for (int r = 0; r < 4; ++r) o[r] = ((b0 + r) == a ? e : 0.f) - acc[r];
                  RWCHK(!(fabsf(o[0]) < 1e4f) || !(fabsf(o[1]) < 1e4f) || !(fabsf(o[2]) < 1e4f) || !(fabsf(o[3]) < 1e4f), 1u);
                  u32x2 pk; pk.x = pk2(o[0], o[1]); pk.y = pk2(o[2], o[3]); *(GAS u32x2*)(Pt + (size_t)a * 64 + b0) = pk;
              } else if (prod == 1) { o = ld4_lds(L + RK_RG, TS, a, b0) - acc;
                  RWCHK(!(fabsf(o[0]) < 1e4f) || !(fabsf(o[1]) < 1e4f) || !(fabsf(o[2]) < 1e4f) || !(fabsf(o[3]) < 1e4f), 2u);
                  u32x2 pk; pk.x = pk2(o[0], o[1]); pk.y = pk2(o[2], o[3]); *(GAS u32x2*)(Rh + (size_t)a * 64 + b0) = pk;
              } else if (prod == 2) { const f32x4 e = *(const LAS f32x4*)(ECL + b0); o = ld4_lds(L + RK_KTI, TS, a, b0) * e - acc;
                  st4_lds(L + RK_KH, TS, a, b0, o);
              } else { o = ld4_lds(L + RK_MKR, TS, a, b0) - acc;
                  u32x2 pk; pk.x = pk2(o[0], o[1]); pk.y = pk2(o[2], o[3]); *(GAS u32x2*)(Mh + (size_t)a * 64 + b0) = pk; } } } }
    __syncthreads();
    { GAS bf16_t* Qt = (GAS bf16_t*)(mx + RW_QT) + (size_t)item * 4096;
#pragma unroll
      for (int q = 0; q < 2; ++q) { const int id = 2 * w + q, at = id >> 2, bt = id & 3; f32x4 acc = {0.f, 0.f, 0.f, 0.f};
#pragma unroll
          for (int ks = 0; ks < 2; ++ks) acc = MFMA16(tf_lds(L + RK_V, TS, 32 * ks, 16 * bt, lane), tf_lds(L + RK_KH, TS, 32 * ks, 16 * at, lane), acc);
          SETTLE(acc);
#pragma unroll
          for (int r = 0; r < 4; ++r) RWCHK(true, 32u);
          u32x2 pk; pk.x = pk2(acc[0], acc[1]); pk.y = pk2(acc[2], acc[3]); *(GAS u32x2*)(Qt + (size_t)(16 * at + l15) * 64 + 16 * bt + g4) = pk; } }
    __syncthreads();
    RWDUMP(RK_MBR, TILE64, 0); RWDUMP(RK_MKR, TILE64, (size_t)10 << 20); RWDUMP(RK_WZ, 64 * TS2, (size_t)20 << 20); RWDUMP(RK_RG, TILE64, (size_t)40 << 20); RWDUMP(RK_AK, TILE64, (size_t)50 << 20);
    __syncthreads();
}

__device__ __forceinline__ void rwkv_pass2_job(const Params& p, LAS unsigned char* scr  , int job, int lane) {
    GAS unsigned char* mx = p.ws + MX_BASE;
    const int bh = job >> 2, vq = job & 3, b = bh >> 3, h = bh & 7, g4 = 4 * (lane >> 4), l15 = lane & 15;
    f32x4 S[4];
#pragma unroll
    for (int nt = 0; nt < 4; ++nt) S[nt] = (f32x4){0.f, 0.f, 0.f, 0.f};
    for (int c = 0; c < 64; ++c) {
        const size_t io = ((size_t)(b * 64 + c) * 8 + h) * 4096;
        const GAS bf16_t* Pt = (const GAS bf16_t*)(mx + RW_PT) + io; const GAS bf16_t* Qt = (const GAS bf16_t*)(mx + RW_QT) + io; GAS bf16_t* Sg = (GAS bf16_t*)(mx + RW_S) + io;
        bf16x8 bp[4][2]; u32x2 qv[4];
#pragma unroll
        for (int nt = 0; nt < 4; ++nt) { bp[nt][0] = rf_glb(Pt, 64, 16 * nt, 0, lane); bp[nt][1] = rf_glb(Pt, 64, 16 * nt, 32, lane); qv[nt] = *(const GAS u32x2*)(Qt + (size_t)(16 * nt + l15) * 64 + 16 * vq + g4); }
#pragma unroll
        for (int nt = 0; nt < 4; ++nt)
#pragma unroll
            for (int r = 0; r < 4; ++r) *(LAS bf16_t*)(scr + (g4 + r) * TS + (16 * nt + l15) * 2) = (bf16_t)(pk2(S[nt][r], 0.f) & 0xffffu);
        asm volatile("s_waitcnt lgkmcnt(0)" ::: "memory");
        bf16x8 af[2]; af[0] = rf_lds(scr, TS, 0, 0, lane); af[1] = rf_lds(scr, TS, 0, 32, lane);
        asm volatile("s_waitcnt lgkmcnt(0)" ::: "memory");
        *(GAS bf16x8*)(Sg + (size_t)(16 * vq + l15) * 64 + 8 * (lane >> 4)) = af[0];
        *(GAS bf16x8*)(Sg + (size_t)(16 * vq + l15) * 64 + 32 + 8 * (lane >> 4)) = af[1];
#pragma unroll
        for (int nt = 0; nt < 4; ++nt) { f32x4 acc = {bflo(qv[nt].x), bfhi(qv[nt].x), bflo(qv[nt].y), bfhi(qv[nt].y)};
            acc = MFMA16(af[0], bp[nt][0], acc); acc = MFMA16(af[1], bp[nt][1], acc); S[nt] = acc; }
        SETTLE(S[0]); SETTLE(S[1]); SETTLE(S[2]); SETTLE(S[3]);
    }
}

constexpr int R3_S0 = 0, R3_RH = 9216, R3_MH = 18432, R3_V = 27648, R3_SG = 36864, R3_HALF = 54272;
__device__ __forceinline__ void rwkv_pass3_pair(const Params& p, const Ctx& C0, int layer, int pair) {
    Ctx C = C0; asm volatile("" : "+s"(C.wave)); asm volatile("" : "+v"(C.tid)); C.lane = C.tid & 63;
    const int half = C.wave >> 2, item = 2 * pair + half, h = item & 7, bc = item >> 3, c = bc & 63, jl = layer >> 1;
    const GAS bf16_t* urow0 = (const GAS bf16_t*)(p.ws + WS_U) + (size_t)bc * 64 * UPITCH;
    GAS unsigned char* mx = p.ws + MX_BASE;
    LAS unsigned char* L = C.lds + half * R3_HALF;
    GAS bf16_t* Y = (GAS bf16_t*)(p.ws + WS_Y);
    const int th = C.tid & 255, lane = C.lane, g4 = 4 * (lane >> 4), l15 = lane & 15;
    { const int j = th >> 2, cq = th & 3; const GAS bf16_t* cur = urow0 + (size_t)j * UPITCH; const GAS bf16_t* prv = cur - UPITCH; const bool hp = (c * 64 + j) != 0;
      const GAS float* mu = p.a_mu + (size_t)jl * RWKV_IN; float t[8];
#pragma unroll
      for (int q = 0; q < 2; ++q) { const int col = RW_V + 64 * h + 16 * cq + 8 * q; rk_shift8(cur + col, prv + col, hp, mu + col, t); *(LAS u32x4*)(L + R3_V + j * TS + 32 * cq + 16 * q) = pack8(t); }
#pragma unroll
      for (int q = 0; q < 4; ++q) { const int col = RW_GD + 32 * cq + 8 * q; rk_shift8(cur + col, prv + col, hp, mu + col, t);
#pragma unroll
          for (int i = 0; i < 8; ++i) t[i] = sigmoidf_(t[i]);
          *(LAS u32x4*)(L + R3_SG + j * TS2 + 64 * cq + 16 * q) = pack8(t); }
      const size_t io = (size_t)item * 4096;
      const GAS bf16_t* Sg = (const GAS bf16_t*)(mx + RW_S) + io; const GAS bf16_t* Rh = (const GAS bf16_t*)(mx + RW_RH) + io; const GAS bf16_t* Mh = (const GAS bf16_t*)(mx + RW_MH) + io;
#pragma unroll
      for (int q = 0; q < 2; ++q) { const int idx = th + 256 * q, r = idx >> 3, ch = idx & 7;
          *(LAS u32x4*)(L + R3_S0 + r * TS + 16 * ch) = *(const GAS u32x4*)(Sg + (size_t)r * 64 + 8 * ch);
          *(LAS u32x4*)(L + R3_RH + r * TS + 16 * ch) = *(const GAS u32x4*)(Rh + (size_t)r * 64 + 8 * ch);
          *(LAS u32x4*)(L + R3_MH + r * TS + 16 * ch) = *(const GAS u32x4*)(Mh + (size_t)r * 64 + 8 * ch); } }
    __syncthreads();
    { const int tb = C.wave & 3, t = 16 * tb + l15; const size_t tk = (size_t)bc * 64 + t;
      bf16x8 br[2], bm[2], bg[4];
#pragma unroll
      for (int ks = 0; ks < 2; ++ks) { br[ks] = rf_lds(L + R3_RH, TS, 16 * tb, 32 * ks, lane); bm[ks] = rf_lds(L + R3_MH, TS, 16 * tb, 32 * ks, lane); }
#pragma unroll
      for (int ks = 0; ks < 4; ++ks) bg[ks] = rf_lds(L + R3_SG, TS2, 16 * tb, 32 * ks, lane);
      const GAS bf16_t* Gt = (const GAS bf16_t*)(p.ws + WS_GUPT) + ((size_t)jl * 512 + 64 * h) * 128;
      f32x4 y[4], gt[4]; float s = 0.f;
#pragma unroll
      for (int mt = 0; mt < 4; ++mt) { f32x4 a = {0.f, 0.f, 0.f, 0.f}, g = {0.f, 0.f, 0.f, 0.f};
#pragma unroll
          for (int ks = 0; ks < 2; ++ks) { a = MFMA16(rf_lds(L + R3_S0, TS, 16 * mt, 32 * ks, lane), br[ks], a); a = MFMA16(tf_lds(L + R3_V, TS, 32 * ks, 16 * mt, lane), bm[ks], a); }
          SETTLE(a);
#pragma unroll
          for (int ks = 0; ks < 4; ++ks) g = MFMA16(rf_glb(Gt, 128, 16 * mt, 32 * ks, lane), bg[ks], g);
          SETTLE(g);
          y[mt] = a; gt[mt] = g; s += (a[0] + a[1]) + (a[2] + a[3]); }
      s += __shfl_xor(s, 16); s += __shfl_xor(s, 32);
      const float mean = s * (1.f / 64.f); float s2 = 0.f;
#pragma unroll
      for (int mt = 0; mt < 4; ++mt)
#pragma unroll
          for (int r = 0; r < 4; ++r) { const float d = y[mt][r] - mean; s2 += d * d; }
      s2 += __shfl_xor(s2, 16); s2 += __shfl_xor(s2, 32);
      const float rstd = rsqrtf(s2 * (1.f / 64.f) + 64e-5f);
      const float bon = ((const GAS float*)(mx + RW_BON))[(size_t)item * 64 + t];
      const GAS float* lg = p.a_ln_gain + jl * 512 + 64 * h; const GAS float* lb = p.a_ln_bias + jl * 512 + 64 * h;
      GAS bf16_t* yp = Y + tk * D + 64 * h;
#pragma unroll
      for (int mt = 0; mt < 4; ++mt) { const int v0 = 16 * mt + g4; const f32x4 G = *(const GAS f32x4*)(lg + v0), Bv = *(const GAS f32x4*)(lb + v0); const f32x4 vv = ld4_lds(L + R3_V, TS, t, v0);
          f32x4 o;
#pragma unroll
          for (int r = 0; r < 4; ++r) o[r] = ((y[mt][r] - mean) * rstd * G[r] + Bv[r] + bon * vv[r]) * gt[mt][r];
          u32x2 pk; pk.x = pk2(o[0], o[1]); pk.y = pk2(o[2], o[3]); *(GAS u32x2*)(yp + v0) = pk; } }
    __syncthreads();
}
constexpr int LDS_BYTES = 147456;
constexpr int LDS_TAB = 131072;
constexpr int LDS_P2SCR = 135168;
constexpr int LDS_BARW = LDS_BYTES - 16;
constexpr int N_PHASES = 2 + 9 * DEPTH;
static_assert(RK_END <= LDS_BARW && SD_RS + 512 <= LDS_BARW && 2 * R3_HALF <= LDS_BARW, "LDS map");

typedef const __attribute__((address_space(4))) Params* KParams;
__global__ void __launch_bounds__(512, 2) mk_fwd(Params p_arg) {
    extern __shared__ __attribute__((aligned(16))) unsigned char lds_raw[];
    KParams kp0 = (KParams)__builtin_amdgcn_kernarg_segment_ptr();
    Params p;
    Ctx C; C.lds = (LAS unsigned char*)lds_raw; C.G = gridDim.x; C.bid = blockIdx.x;
    const int wave0 = __builtin_amdgcn_readfirstlane(threadIdx.x >> 6);
    C.wave = wave0; C.lane = __builtin_amdgcn_mbcnt_hi(~0u, __builtin_amdgcn_mbcnt_lo(~0u, 0u)); C.tid = wave0 * 64 + C.lane;
    const int lo = (int)kp0->ph_lo, hi = (int)kp0->ph_hi;
    GAS unsigned char* const ws0 = kp0->ws;
    if (C.tid == 0) *(LAS u32x4*)(C.lds + LDS_BARW) = (u32x4){0u, 0u, 0u, 0u};
    __syncthreads();
    XcdBarrier bar; bar.bar = (GAS unsigned*)(ws0 + WS_CTL) + CW_BAR; bar.x = 0; bar.st = (volatile LAS unsigned*)(C.lds + LDS_BARW);
    if (hi - lo > 1) bar = xcd_barrier_post((GAS unsigned*)(ws0 + WS_CTL) + CW_BAR, (volatile LAS unsigned*)(C.lds + LDS_BARW), C.tid);
#define FRESH() do { KParams kq_ = kp0; asm volatile("" : "+s"(kq_)); { const __attribute__((address_space(4))) unsigned long long* kw_ = (const __attribute__((address_space(4))) unsigned long long*)kq_; unsigned long long* pw_ = (unsigned long long*)&p; _Pragma("unroll") for (int i_ = 0; i_ < (int)(sizeof(Params) / 8); ++i_) pw_[i_] = kw_[i_]; } int wv_ = wave0; asm volatile("" : "+s"(wv_)); \
        int ln_ = __builtin_amdgcn_mbcnt_hi(~0u, __builtin_amdgcn_mbcnt_lo(~0u, 0u)); asm volatile("" : "+v"(ln_)); C.wave = wv_; C.lane = ln_; C.tid = wv_ * 64 + ln_; } while (0)
#ifndef PH_MASK
#define PH_MASK 0xFFFF
#endif
#define PM(b) ((PH_MASK >> (b)) & 1)
#define IN(k) (lo <= (k) && (k) < hi)
#define SEAM(k) do { if (IN(k) && IN((k) + 1)) { FRESH(); xcd_barrier(bar, C.tid); } } while (0)
    if (PM(0) && IN(0)) { FRESH(); p0_prologue(p, C); }
    SEAM(0);
#pragma nounroll
    for (int l = 0; l < DEPTH; ++l) {
        const int P = 1 + 9 * l; const bool odd = (l & 1) != 0;
        if (PM(1) && IN(P)) { FRESH(); norm_phase<false>(p, C, l); }
        SEAM(P);
        if (PM(2) && IN(P + 1)) { FRESH();
            const GAS bf16_t* W = odd ? (const GAS bf16_t*)(p.ws + WS_WINO) + (size_t)(l >> 1) * NPO * D : (const GAS bf16_t*)(p.ws + WS_WINE) + (size_t)(l >> 1) * NPE * D;
            pg8::StaticOrder S; S.init(p.ws + WS_H, W, T, odd ? NPO : NPE, D, C.G, C.bid);
            EpiU E{(GAS bf16_t*)(p.ws + WS_U)};
            pg8::gemm_phase<EpiU, pg8::StaticOrder, false>(C.lds, C.tid, D, S, E);
        }
        SEAM(P + 1);
        if (IN(P + 2)) { FRESH();
            if (!odd) { if (PM(3)) for (int it = C.bid; it < 4096; it += C.G) rwkv_pass1_item(p, C, l, it);
                        if (PM(4)) for (int it = C.bid; it < 2048; it += C.G) gla_pass1_item<false>(p, C, l, it); }
            else      { if (PM(4)) for (int it = C.bid; it < 2048; it += C.G) gla_pass1_item<true>(p, C, l, it);
                        if (PM(5)) for (int it = C.bid; it < 1024; it += C.G) ssd_pass1_item(p, C, l, it); }
        }
        SEAM(P + 2);
        if (PM(6) && IN(P + 3)) { FRESH();
            if (!odd) { if (C.wave == 0) { for (int job = C.bid; job < 256; job += C.G) rwkv_pass2_job(p, C.lds + LDS_P2SCR, job, C.lane); }
                        else if (C.wave <= 4) { for (int job = C.bid * 4 + C.wave - 1; job < 1024; job += C.G * 4) gla_pass2_job<false>(p, job, C.lane); } }
            else      { if (C.wave < 4) { for (int job = C.bid * 4 + C.wave; job < 1024; job += C.G * 4) gla_pass2_job<true>(p, job, C.lane); }
                        else { for (int job = C.bid * 4 + C.wave - 4; job < 1024; job += C.G * 4) ssd_pass2_job(p, job, C.lane); } }
            if (l > 0) moe_convert(p, C, l, C.bid * 8 + C.wave, C.G * 8);
        }
        SEAM(P + 3);
        if (IN(P + 4)) { FRESH();
            if (!odd) { if (PM(7)) for (int it = C.bid; it < 2048; it += C.G) rwkv_pass3_pair(p, C, l, it);
                        if (PM(8)) for (int it = C.bid; it < 2048; it += C.G) gla_pass3_item<false>(p, C, l, it); }
            else      { if (PM(8)) for (int it = C.bid; it < 2048; it += C.G) gla_pass3_item<true>(p, C, l, it);
                        if (PM(9)) for (int it = C.bid; it < 1024; it += C.G) ssd_pass3_item(p, C, l, it); }
        }
        SEAM(P + 4);
        if (PM(10) && IN(P + 5)) { FRESH();
            pg8::StaticOrder S; S.init(p.ws + WS_Y, (const GAS bf16_t*)(p.ws + WS_WOUT) + (size_t)l * D * D, T, D, D, C.G, C.bid);
            EpiOut E{p.out, (const GAS float*)(p.ws + WS_MOD) + (size_t)l * NB * 6 * D + 2 * D};
            pg8::gemm_phase<EpiOut, pg8::StaticOrder, false>(C.lds, C.tid, D, S, E);
        }
        SEAM(P + 5);
        if (PM(11) && IN(P + 6)) { FRESH(); route_phase(p, C, l); }
        SEAM(P + 6);
        if (PM(12) && IN(P + 7)) { FRESH();
            LAS int* tab = (LAS int*)(C.lds + LDS_TAB); moe_table(p, C, l, tab);
            MoeOrder S{(const GAS char*)(p.ws + WS_H), (const GAS char*)(p.ws + WS_WGU), D, (size_t)1024 * D * 2, tab, (const GAS int*)(p.ws + WS_LISTA), C.G, C.bid, false};
            EpiUp E{(GAS bf16_t*)(p.ws + WS_ACT)};
            pg8::gemm_phase<EpiUp, MoeOrder, true>(C.lds, C.tid, D, S, E);
        }
        SEAM(P + 7);
        if (PM(13) && IN(P + 8)) { FRESH();
            LAS int* tab = (LAS int*)(C.lds + LDS_TAB); moe_table(p, C, l, tab);
            MoeOrder S{(const GAS char*)(p.ws + WS_ACT), (const GAS char*)(p.ws + WS_WDN), DEXP, (size_t)D * DEXP * 2, tab, (const GAS int*)(p.ws + WS_LISTA), C.G, C.bid, true};
            EpiDown E{(GAS bf16_t*)(p.ws + WS_YB), (const GAS int*)(p.ws + WS_LISTA), (const GAS float*)(p.ws + WS_LISTW)};
            pg8::gemm_phase<EpiDown, MoeOrder, false>(C.lds, C.tid, DEXP, S, E);
        }
        SEAM(P + 8);
    }
    if (PM(14) && IN(N_PHASES - 1)) { FRESH(); norm_phase<true>(p, C, DEPTH - 1); }
#undef IN
#undef PM
#undef SEAM
}


#ifdef DBG
constexpr int CW_DBG = 8192;
__global__ void dbg_scan(const void* base, int rows, int cols, int pitch, int is_f32, unsigned* flags, unsigned bit, float thr = 1e30f) {
    bool bad = false;
    for (size_t i = (size_t)blockIdx.x * blockDim.x + threadIdx.x; i < (size_t)rows * cols; i += (size_t)gridDim.x * blockDim.x) {
        const size_t r = i / cols, c = i % cols;
        float v = is_f32 ? ((const float*)base)[r * pitch + c] : bf2f(((const bf16_t*)base)[r * pitch + c]);
        if (!(fabsf(v) < thr)) bad = true;
    }
    if (bad) atomicOr(flags, bit);
}

__global__ void dbg_count(const void* base, size_t n, int is_f32, unsigned long long* cnt) {
    unsigned long long c = 0;
    for (size_t i = (size_t)blockIdx.x * blockDim.x + threadIdx.x; i < n; i += (size_t)gridDim.x * blockDim.x) {
        float v = is_f32 ? ((const float*)base)[i] : bf2f(((const bf16_t*)base)[i]);
        if (!(fabsf(v) < 1e30f)) ++c;
    }
    if (c) atomicAdd(cnt, c);
}
__global__ void dbg_log2(const unsigned long long* cnt, unsigned* flags) { unsigned long long c = *cnt; unsigned k = 0; while (c) { ++k; c >>= 1; } *flags = k; }

__global__ void dbg_sum(const void* base, int rows, int cols, int pitch, int esz, unsigned long long* slot) {
    unsigned long long c = 0;
    for (size_t i = (size_t)blockIdx.x * blockDim.x + threadIdx.x; i < (size_t)rows * cols; i += (size_t)gridDim.x * blockDim.x) {
        const size_t r = i / cols, cc = i % cols;
        const unsigned v = esz == 4 ? ((const unsigned*)base)[r * pitch + cc] : (unsigned)((const unsigned short*)base)[r * pitch + cc];
        c += (unsigned long long)v * (unsigned long long)(1 + (i & 1023));
    }
    atomicAdd(slot, c);
}
__global__ void dbg_cmpmask(const unsigned long long* s1, const unsigned long long* s2, int n, unsigned* flags) { unsigned f = 0; for (int i = 0; i < n; ++i) if (s1[i] != s2[i]) f |= 1u << i; *flags = f; }
__global__ void dbg_cmp(const unsigned long long* s1, const unsigned long long* s2, int n, unsigned* flags) { unsigned f = 0; for (int i = n - 1; i >= 0; --i) if (s1[i] != s2[i]) f = (unsigned)i; *flags = f; }
__global__ void dbg_emit(float* out, const unsigned* flags) {
    const size_t i = (size_t)blockIdx.x * blockDim.x + threadIdx.x;
    if (i < (size_t)T * D) out[i] = (i == 0) ? sqrtf((float)(flags[0] + flags[1]) * (float)T * (float)D) : 0.f;
}
#endif
extern "C" void kernel_launch(void* const* d_in, const int* in_sizes, int n_in, void* d_out, int out_size, void* d_ws, size_t ws_size, hipStream_t stream) {
    static int grid = 0;
    if (grid == 0) {
        if (n_in != 36 || out_size != T * D || ws_size < WS_END) { fprintf(stderr, "kernel_launch: unexpected shapes (n_in %d out %d ws %zu need %zu)\n", n_in, out_size, ws_size, (size_t)WS_END); grid = -1; return; }
        int dev = 0, cus = 0, per_cu = 0;
        if (hipGetDevice(&dev) != hipSuccess || hipDeviceGetAttribute(&cus, hipDeviceAttributeMultiprocessorCount, dev) != hipSuccess) { grid = -1; return; }
        if (hipFuncSetAttribute((const void*)mk_fwd, hipFuncAttributeMaxDynamicSharedMemorySize, LDS_BYTES) != hipSuccess) { fprintf(stderr, "kernel_launch: hipFuncSetAttribute failed\n"); grid = -1; return; }
        if (hipOccupancyMaxActiveBlocksPerMultiprocessor(&per_cu, (const void*)mk_fwd, 512, LDS_BYTES) != hipSuccess || per_cu < 1) { fprintf(stderr, "kernel_launch: occupancy query says %d\n", per_cu); (void)hipGetLastError(); grid = -1; return; }
        grid = cus;
    }
    if (grid < 0) return;
#ifdef DBG_MEMSET_ALL
    (void)hipMemsetAsync((char*)d_ws, 0, WS_END, stream);
#else
    (void)hipMemsetAsync((char*)d_ws + WS_CTL, 0, CTL_BYTES, stream);
#endif
    Params p{};
    const float** pp = (const float**)&p;
    for (int i = 0; i < 36; ++i) pp[i] = (const float*)d_in[i];
    p.out = (GAS float*)d_out; p.ws = (GAS unsigned char*)d_ws;
#if MK_LAUNCHES == 1
    p.ph_lo = 0; p.ph_hi = N_PHASES;
    hipLaunchKernelGGL(mk_fwd, dim3(grid), dim3(512), LDS_BYTES, stream, p);
#else
#ifdef DBG_TWICE
    (void)hipMemsetAsync((char*)d_ws + WS_END - 65536, 0, 65536, stream);
    for (int rep = 0; rep < 2; ++rep) { if (rep) (void)hipMemsetAsync((char*)d_ws + WS_CTL, 0, CTL_BYTES, stream);
#else
    { const int rep = 0; (void)rep;
#endif
    for (int ph = 0; ph < N_PHASES; ++ph) { p.ph_lo = ph; p.ph_hi = ph + 1; hipLaunchKernelGGL(mk_fwd, dim3(grid), dim3(512), LDS_BYTES, stream, p);
#ifdef DBG
        unsigned char* ws = (unsigned char*)d_ws; unsigned* fl = (unsigned*)(ws + WS_CTL) + CW_DBG;
        DBG_HOOKS
#endif
    }
    }
#ifdef DBG
    { unsigned* fl = (unsigned*)((unsigned char*)d_ws + WS_CTL) + CW_DBG;
      hipLaunchKernelGGL(dbg_scan, dim3(1024), dim3(256), 0, stream, (const void*)d_out, T, D, D, 1, fl, DBG_FINAL_BIT);
      hipLaunchKernelGGL(dbg_emit, dim3(T * D / 256), dim3(256), 0, stream, (float*)d_out, (const unsigned*)fl); }
#endif
#endif
}
```

```cpp
#include <hip/hip_runtime.h>
#include <stdint.h>
#include <stdio.h>

#ifndef MK_LAUNCHES
#define MK_LAUNCHES 1
#endif

#define LAS __attribute__((address_space(3)))
#if defined(__HIP_DEVICE_COMPILE__)
#define GAS __attribute__((address_space(1)))
#else
#define GAS
#endif
typedef unsigned short bf16_t;
typedef short bf16x8 __attribute__((ext_vector_type(8)));
typedef unsigned short u16x4 __attribute__((ext_vector_type(4)));
typedef float f32x4 __attribute__((ext_vector_type(4)));
typedef float f32x2 __attribute__((ext_vector_type(2)));
typedef unsigned u32x4 __attribute__((ext_vector_type(4)));
typedef unsigned u32x2 __attribute__((ext_vector_type(2)));

constexpr int D = 1024, NB = 8, SEQ = 4096, T = NB * SEQ, DEPTH = 4, CH = 64, NCH = SEQ / CH;
constexpr int EVEN_IN = 3344, ODD_IN = 2824, NPE = 3584, NPO = 3072, UPITCH = 3584;
constexpr int RW_R = 0, RW_K = 512, RW_V = 1024, RW_WD = 1536, RW_AD = 1600, RW_GD = 1664, RWKV_IN = 1792;
constexpr int GL_Q = 1792, GL_K = 2048, GL_V = 2304, GL_AD = 2816, GL_G = 2832;
constexpr int HG_Q = 0, HG_F = 256, HG_I = 512, HG_G = 1024, HGRN_IN = 1536;
constexpr int SD_Z = 1536, SD_XBC = 2048, SD_XS = 2048, SD_BM = 2560, SD_CM = 2688, SD_DT = 2816;
constexpr int NEXP = 16, DEXP = 512;
constexpr float NORM_EPS = 1e-6f;

constexpr size_t al256(size_t x) { return (x + 255) & ~(size_t)255; }
constexpr size_t WS_CTL = 0;
constexpr size_t CTL_BYTES = 65536;
constexpr size_t WS_MOD = WS_CTL + CTL_BYTES;
constexpr size_t WS_LB = WS_MOD + al256((size_t)DEPTH * NB * 6 * D * 4);
constexpr size_t WS_WINE = WS_LB + al256((size_t)DEPTH * 256 * 4);
constexpr size_t WS_WINO = WS_WINE + (size_t)2 * NPE * D * 2;
constexpr size_t WS_WOUT = WS_WINO + (size_t)2 * NPO * D * 2;
constexpr size_t WS_WGU = WS_WOUT + (size_t)4 * D * D * 2;
constexpr size_t WS_WDN = WS_WGU + (size_t)NEXP * 1024 * D * 2;
constexpr size_t WS_WUPT = WS_WDN + (size_t)NEXP * D * DEXP * 2;
constexpr size_t WS_AUPT = WS_WUPT + (size_t)2 * 512 * 64 * 2;
constexpr size_t WS_GUPT = WS_AUPT + (size_t)2 * 512 * 64 * 2;
constexpr size_t WS_LISTA = WS_GUPT + (size_t)2 * 512 * 128 * 2;
constexpr size_t WS_LISTW = WS_LISTA + (size_t)NEXP * T * 4;
constexpr size_t WS_Y = WS_LISTW + (size_t)NEXP * T * 4;
constexpr size_t WS_U = WS_Y + (size_t)T * D * 2;
constexpr size_t WS_H = WS_U + (size_t)T * UPITCH * 2;
constexpr size_t WS_MIX = WS_H + (size_t)T * D * 2;
constexpr size_t MIX_BYTES = (size_t)200 * 1024 * 1024;
constexpr size_t WS_END = WS_MIX + MIX_BYTES;
constexpr size_t WS_ACT = WS_U;
constexpr size_t ACT_ROWS = (size_t)(2 * T / 256 + NEXP) * 256;
constexpr size_t WS_YB = WS_ACT + al256(ACT_ROWS * DEXP * 2);
static_assert(WS_YB + (size_t)2 * T * D * 2 <= WS_H, "MoE aliases overflow U");
static_assert(WS_END <= (size_t)706000000, "workspace larger than the guaranteed ws_size");
constexpr int CW_BAR = 0;
constexpr int CW_CNT = 4096;

typedef __bf16 bf16x2_t __attribute__((ext_vector_type(2)));
__device__ __forceinline__ unsigned pk2(float lo, float hi) { const f32x2 v = {lo, hi}; const bf16x2_t b = __builtin_convertvector(v, bf16x2_t); return __builtin_bit_cast(unsigned, b); }
__device__ __forceinline__ float bflo(unsigned u) { return __uint_as_float(u << 16); }
__device__ __forceinline__ float bfhi(unsigned u) { return __uint_as_float(u & 0xffff0000u); }
__device__ __forceinline__ float bf2f(bf16_t b) { return __uint_as_float(((unsigned)b) << 16); }
__device__ __forceinline__ float sigmoidf_(float x) { return 1.f / (1.f + __expf(-x)); }
__device__ __forceinline__ float siluf_(float x) { return x / (1.f + __expf(-x)); }
__device__ __forceinline__ float softplusf_(float x) { return x > 20.f ? x : __logf(1.f + __expf(x)); }
__device__ __forceinline__ float logsigmoidf_(float x) { return fminf(x, 0.f) - __logf(1.f + __expf(-fabsf(x))); }
__device__ __forceinline__ void unpack8(const u32x4 v, float (&f)[8]) {
    f[0] = bflo(v.x); f[1] = bfhi(v.x); f[2] = bflo(v.y); f[3] = bfhi(v.y); f[4] = bflo(v.z); f[5] = bfhi(v.z); f[6] = bflo(v.w); f[7] = bfhi(v.w);
}
__device__ __forceinline__ u32x4 pack8(const float (&f)[8]) { u32x4 o; o.x = pk2(f[0], f[1]); o.y = pk2(f[2], f[3]); o.z = pk2(f[4], f[5]); o.w = pk2(f[6], f[7]); return o; }
__device__ __forceinline__ float wave_sum(float v) {
#pragma unroll
    for (int o = 1; o < 64; o <<= 1) v += __shfl_xor(v, o);
    return v;
}
#define MFMA16(a, b, c) __builtin_amdgcn_mfma_f32_16x16x32_bf16((a), (b), (c), 0, 0, 0)
#define SETTLE(acc) asm volatile("s_nop 7\n\ts_nop 7\n\ts_nop 7" : "+v"(acc))

__device__ __forceinline__ bf16x8 rf_lds(const LAS unsigned char* tile, int strideB, int r0, int c0, int lane) {
    return *(const LAS bf16x8*)(tile + (r0 + (lane & 15)) * strideB + (c0 + 8 * (lane >> 4)) * 2);
}
__device__ __forceinline__ bf16x8 tf_lds(const LAS unsigned char* tile, int strideB, int r0, int c0, int lane) {
    const int g = lane >> 4, q = (lane & 15) >> 2, p = lane & 3;
    const unsigned a0 = (unsigned)(uintptr_t)tile + (unsigned)((r0 + 8 * g + q) * strideB + (c0 + 4 * p) * 2);
    const unsigned a1 = a0 + 4u * (unsigned)strideB;
    u16x4 lo, hi;
    asm volatile("ds_read_b64_tr_b16 %0, %2\n\tds_read_b64_tr_b16 %1, %3\n\ts_waitcnt lgkmcnt(0)" : "=&v"(lo), "=&v"(hi) : "v"(a0), "v"(a1) : "memory");
    bf16x8 r;
    r[0] = (short)lo[0]; r[1] = (short)lo[1]; r[2] = (short)lo[2]; r[3] = (short)lo[3]; r[4] = (short)hi[0]; r[5] = (short)hi[1]; r[6] = (short)hi[2]; r[7] = (short)hi[3];
    return r;
}
__device__ __forceinline__ bf16x8 rf_glb(const GAS bf16_t* base, int ld, int r0, int c0, int lane) {
    return *(const GAS bf16x8*)(base + (size_t)(r0 + (lane & 15)) * ld + c0 + 8 * (lane >> 4));
}
__device__ __forceinline__ void st4_lds(LAS unsigned char* tile, int strideB, int row, int col, f32x4 v) {
    u32x2 o; o.x = pk2(v[0], v[1]); o.y = pk2(v[2], v[3]);
    *(LAS u32x2*)(tile + row * strideB + col * 2) = o;
}
__device__ __forceinline__ f32x4 ld4_lds(const LAS unsigned char* tile, int strideB, int row, int col) {
    const u32x2 o = *(const LAS u32x2*)(tile + row * strideB + col * 2);
    return (f32x4){bflo(o.x), bfhi(o.x), bflo(o.y), bfhi(o.y)};
}
constexpr int TS = 144;
constexpr int TS2 = 272;
constexpr int TILE64 = 64 * TS;
constexpr int FS = 68;
constexpr int FTILE = 64 * FS * 4;

#define XB_TMO      128
#define XB_XCNT(j)  (256  + 64 * (j))
#define XB_XSUB(j)  (1280 + 64 * (j))
#define XB_XGEN(j)  (2304 + 64 * (j))
#define XB_TOP      3328
#define XB_TOPGEN   3392
#define XCD_BAR_WORDS 3456
#define XB_SPIN_CAP (1u << 18)
__device__ __forceinline__ unsigned xb_ld(GAS unsigned* p)              { return __hip_atomic_load(p, __ATOMIC_RELAXED, __HIP_MEMORY_SCOPE_AGENT); }
__device__ __forceinline__ unsigned xb_add(GAS unsigned* p, unsigned v) { return __hip_atomic_fetch_add(p, v, __ATOMIC_RELAXED, __HIP_MEMORY_SCOPE_AGENT); }
__device__ __forceinline__ unsigned xb_xcc_id() { return (unsigned)__builtin_amdgcn_s_getreg((3 << 11) | 20) & 0xFu; }
#define XB_SPIN(cond, bar) do { unsigned _sp = 0; while (cond) { __builtin_amdgcn_s_sleep(1); \
    if ((++_sp & 255u) == 0u) { if (xb_ld(&(bar)[XB_TMO])) break; if (_sp > XB_SPIN_CAP) { atomicAdd(&(bar)[XB_TMO], 1u); break; } } } } while (0)
struct XcdBarrier { GAS unsigned* bar; unsigned x; volatile LAS unsigned* st; };
__device__ __forceinline__ XcdBarrier xcd_barrier_post(GAS unsigned* bar, volatile LAS unsigned* st, int tid) {
    XcdBarrier b; b.bar = bar; b.x = xb_xcc_id(); b.st = st;
    if (tid == 0) (void)xb_add(&bar[XB_XCNT(b.x)], 1u);
    return b;
}
__device__ __forceinline__ void xcd_barrier_complete(GAS unsigned* bar, unsigned x, unsigned& nloc, unsigned& nx) {
    const unsigned G = gridDim.x * gridDim.y * gridDim.z;
    unsigned sum, cnt, mine, sp = 0u;
    for (;;) {
        sum = 0u; cnt = 0u; mine = 0u;
#pragma unroll
        for (unsigned j = 0; j < 16; ++j) { const unsigned c = xb_ld(&bar[XB_XCNT(j)]); sum += c; cnt += (c > 0u) ? 1u : 0u; mine = (j == x) ? c : mine; }
        if (sum == G) break;
        __builtin_amdgcn_s_sleep(1);
        if ((++sp & 255u) == 0u) { if (xb_ld(&bar[XB_TMO])) break; if (sp > XB_SPIN_CAP) { atomicAdd(&bar[XB_TMO], 1u); break; } }
    }
    nloc = mine > 0u ? mine : 1u; nx = cnt > 0u ? cnt : 1u;
}
__device__ __forceinline__ void xcd_barrier(const XcdBarrier& b, int tid) {
    asm volatile("s_waitcnt vmcnt(0)" ::: "memory");
    __syncthreads();
    if (tid == 0) {
        GAS unsigned* bar = b.bar;
        __builtin_amdgcn_s_waitcnt(0);
        unsigned nloc = b.st[0], nx = b.st[1];
        if (nloc == 0u) { xcd_barrier_complete(bar, b.x, nloc, nx); b.st[0] = nloc; b.st[1] = nx; }
        const unsigned old = xb_add(&bar[XB_XSUB(b.x)], 1u);
        const unsigned gen = old / nloc;
        if (old + 1u == (gen + 1u) * nloc) {
            __builtin_amdgcn_fence(__ATOMIC_RELEASE, "agent");
            asm volatile("s_waitcnt vmcnt(0)" ::: "memory");
            const unsigned og = xb_add(&bar[XB_TOP], 1u);
            const unsigned tg = og / nx;
            if (og + 1u == (tg + 1u) * nx) xb_add(&bar[XB_TOPGEN], 1u);
            else XB_SPIN(xb_ld(&bar[XB_TOPGEN]) == tg, bar);
            __builtin_amdgcn_fence(__ATOMIC_ACQUIRE, "agent");
            xb_add(&bar[XB_XGEN(b.x)], 1u);
            asm volatile("s_waitcnt vmcnt(0)" ::: "memory");
        } else {
            XB_SPIN(xb_ld(&bar[XB_XGEN(b.x)]) == gen, bar);
            __builtin_amdgcn_fence(__ATOMIC_ACQUIRE, "agent");
            asm volatile("s_waitcnt vmcnt(0)" ::: "memory");
        }
    }
    __syncthreads();
}
namespace pg8 {
constexpr int BM = 256, BK = 64, HALF = 128, HTB = HALF * BK * 2, STAGE_BYTES = 8 * HTB, NXCD = 8, WGM = 8;
__host__ __device__ __forceinline__ int lds_byte(int r, int c) { const int st = (r >> 4) * 2 + (c >> 5), rr = r & 15, cc = c & 31, ob = rr * 64 + cc * 2; return st * 1024 + (ob ^ (((ob >> 9) & 1) << 5)); }
__host__ __device__ __forceinline__ void stage_rc(int b, int& R, int& C) { const int st = b / 1024, sb = b % 1024, swz = sb ^ (((sb >> 9) & 1) << 5); R = (st >> 1) * 16 + swz / 64; C = (st & 1) * 32 + (swz % 64) / 2; }
__host__ __device__ __forceinline__ int perm32(int rho) { const int n = rho >> 4, i = rho & 15; return 8 * (i >> 2) + 4 * n + (i & 3); }

struct Unit { int pm, pn, e, ml; };

struct StaticOrder {
    const GAS char* A; const GAS char* Bt; int K;
    int nM, nN, nwg, G, c;
    __device__ void init(const GAS void* A_, const GAS void* Bt_, int M, int N, int K_, int G_, int c_) { A = (const GAS char*)A_; Bt = (const GAS char*)Bt_; K = K_; nM = M / BM; nN = N / BM; nwg = nM * nN; G = G_; c = c_; }
    __device__ bool next(int i, Unit& u) const {
        const long L = (long)i * G + c; if (L >= nwg) return false;
        int wgid = (int)L; { const int q = nwg / NXCD, r = nwg % NXCD, xcd = wgid % NXCD, off = wgid / NXCD; wgid = (xcd < r ? xcd * (q + 1) : r * (q + 1) + (xcd - r) * q) + off; }
        const int nig = WGM * nN, gid = wgid / nig, fm = gid * WGM, gsz = (nM - fm) < WGM ? (nM - fm) : WGM;
        u.pm = fm + ((wgid % nig) % gsz); u.pn = (wgid % nig) / gsz; u.e = 0; u.ml = 0; return true;
    }
    __device__ __forceinline__ const GAS char* a_base(const Unit& u) const { return A + (size_t)u.pm * BM * K * 2; }
    __device__ __forceinline__ const GAS char* b_base(const Unit& u) const { return Bt + (size_t)u.pn * BM * K * 2; }
    __device__ __forceinline__ void a_rows(const Unit&, const int (&)[2], unsigned (&)[2][2]) const {}
};

template <class Epi, class Sched, bool GATHER>
__device__ __forceinline__ void gemm_phase(LAS unsigned char* lds, const int tid_, const int K, const Sched& S, const Epi& E) {
    const int tid = tid_, wid = __builtin_amdgcn_readfirstlane(tid >> 6), lane = tid & 63, wr = wid >> 2, wc = wid & 3, fr = lane & 15, fq = lane >> 4;
    const int nt = K / BK;
    unsigned voffA[2], voffB[2]; int RA[2]; unsigned CA2[2];
#pragma unroll
    for (int i = 0; i < 2; ++i) { int R, C; stage_rc(tid * 16 + i * 8192, R, C); const int Rb = Epi::PERM ? ((R & ~31) + perm32(R & 31)) : R;
        voffA[i] = (unsigned)(R * K + C) * 2u; voffB[i] = (unsigned)(Rb * K + C) * 2u; RA[i] = R; CA2[i] = (unsigned)C * 2u; }
    const size_t kstep = (size_t)(BK * 2);
    const size_t hstep = (size_t)HALF * K * 2;
    const unsigned ldsw = (unsigned)wid * 1024u;
    const int aoff = lds_byte(wr * 64 + fr, fq * 8), boff = lds_byte(wc * 32 + fr, fq * 8);
    unsigned offC[2][2], offN[2][2];
#define PG8_SA(b, h) (((b) * 2 + (h)) * HTB)
#define PG8_SB(b, h) ((4 + (b) * 2 + (h)) * HTB)
#define PG8_STAGE(bufoff, gbase, voff) do { _Pragma("unroll") for (int _i = 0; _i < 2; ++_i) \
        __builtin_amdgcn_global_load_lds((const GAS unsigned*)((const GAS char*)(gbase) + (voff)[_i]), (LAS unsigned*)(lds + (bufoff) + ldsw + _i * 8192), 16, 0, 0); } while (0)
#define PG8_STAGE_A(bufoff, gb, h, offs) do { if constexpr (GATHER) { PG8_STAGE(bufoff, gb, (offs)[h]); } else { PG8_STAGE(bufoff, (gb) + (h) * hstep, voffA); } } while (0)
#define PG8_LDA(dst, b, h) do { _Pragma("unroll") for (int m = 0; m < 4; ++m) _Pragma("unroll") for (int k = 0; k < 2; ++k) dst[m][k] = *(const LAS bf16x8*)(lds + PG8_SA(b, h) + aoff + m * 2048 + k * 1024); } while (0)
#define PG8_LDB(dst, b, h) do { _Pragma("unroll") for (int n = 0; n < 2; ++n) _Pragma("unroll") for (int k = 0; k < 2; ++k) dst[n][k] = *(const LAS bf16x8*)(lds + PG8_SB(b, h) + boff + n * 2048 + k * 1024); } while (0)
#define PG8_MMA(ai, bj, At, Bt) do { __builtin_amdgcn_s_setprio(1); _Pragma("unroll") for (int m = 0; m < 4; ++m) _Pragma("unroll") for (int n = 0; n < 2; ++n) _Pragma("unroll") for (int k = 0; k < 2; ++k) \
        acc[ai][bj][m][n] = __builtin_amdgcn_mfma_f32_16x16x32_bf16(Bt[n][k], At[m][k], acc[ai][bj][m][n], 0, 0, 0); __builtin_amdgcn_s_setprio(0); } while (0)
#define PG8_WAIT_V(n) asm volatile("s_waitcnt vmcnt(" #n ")" ::: "memory")
#define PG8_WAIT_L(n) asm volatile("s_waitcnt lgkmcnt(" #n ")" ::: "memory")
#define PG8_BAR __builtin_amdgcn_s_barrier()
#define PG8_SCHED __builtin_amdgcn_sched_barrier(0)
    Unit cur, nxt; int ui = 0;
    if (!S.next(0, cur)) return;
    f32x4 acc[2][2][4][2];
#pragma unroll
    for (int a = 0; a < 2; ++a)
#pragma unroll
        for (int b = 0; b < 2; ++b)
#pragma unroll
            for (int m = 0; m < 4; ++m)
#pragma unroll
                for (int n = 0; n < 2; ++n) acc[a][b][m][n] = (f32x4){0.f, 0.f, 0.f, 0.f};
    bf16x8 At[4][2], B0[2][2], B1[2][2];
    const GAS char* cA = S.a_base(cur); const GAS char* cB = S.b_base(cur);
    if constexpr (GATHER) { S.a_rows(cur, RA, offC);
#pragma unroll
        for (int h = 0; h < 2; ++h)
#pragma unroll
            for (int i = 0; i < 2; ++i) { offC[h][i] += CA2[i]; offN[h][i] = offC[h][i]; } }
    PG8_STAGE(PG8_SB(0, 0), cB, voffB); PG8_STAGE(PG8_SB(0, 1), cB + hstep, voffB); PG8_STAGE_A(PG8_SA(0, 0), cA, 0, offC); PG8_STAGE_A(PG8_SA(0, 1), cA, 1, offC);
    if (wr == 1) PG8_BAR;
    PG8_WAIT_V(2); PG8_BAR;
    PG8_STAGE(PG8_SB(1, 0), cB + kstep, voffB); PG8_STAGE_A(PG8_SA(1, 0), cA + kstep, 0, offC); PG8_STAGE(PG8_SB(1, 1), cB + hstep + kstep, voffB);
    PG8_WAIT_V(6); PG8_BAR;
    for (;;) {
        const bool has_next = S.next(ui + 1, nxt);
        const GAS char* nA = has_next ? S.a_base(nxt) : cA; const GAS char* nB = has_next ? S.b_base(nxt) : cB;
        if constexpr (GATHER) { if (has_next) { S.a_rows(nxt, RA, offN);
#pragma unroll
            for (int h = 0; h < 2; ++h)
#pragma unroll
                for (int i = 0; i < 2; ++i) offN[h][i] += CA2[i]; } }
        for (int t = 0; t < nt; t += 2) {
            const bool last = (t == nt - 2);
            const GAS char* a1 = cA + (size_t)(t + 1) * kstep;
            const GAS char* a2 = last ? nA : cA + (size_t)(t + 2) * kstep; const GAS char* b2 = last ? nB : cB + (size_t)(t + 2) * kstep;
            const GAS char* a3 = a2 + kstep; const GAS char* b3 = b2 + kstep;
            unsigned o2[2][2];
            if constexpr (GATHER) {
#pragma unroll
                for (int h = 0; h < 2; ++h)
#pragma unroll
                    for (int i = 0; i < 2; ++i) o2[h][i] = last ? offN[h][i] : offC[h][i]; }
            PG8_LDB(B0, 0, 0); PG8_LDB(B1, 0, 1); PG8_SCHED; PG8_LDA(At, 0, 0); PG8_STAGE_A(PG8_SA(1, 1), a1, 1, offC);
            PG8_WAIT_V(8); PG8_WAIT_L(0); PG8_BAR; PG8_MMA(0, 0, At, B0); PG8_MMA(0, 1, At, B1); PG8_BAR; PG8_SCHED;
            PG8_LDA(At, 0, 1); PG8_STAGE(PG8_SB(0, 0), b2, voffB); PG8_STAGE(PG8_SB(0, 1), b2 + hstep, voffB); PG8_STAGE_A(PG8_SA(0, 0), a2, 0, o2);
            PG8_WAIT_V(8); PG8_WAIT_L(0); PG8_BAR; PG8_MMA(1, 0, At, B0); PG8_MMA(1, 1, At, B1); PG8_BAR; PG8_SCHED;
            PG8_LDB(B0, 1, 0); PG8_LDB(B1, 1, 1); PG8_SCHED; PG8_LDA(At, 1, 0); PG8_STAGE_A(PG8_SA(0, 1), a2, 1, o2);
            PG8_WAIT_V(8); PG8_WAIT_L(0); PG8_BAR; PG8_MMA(0, 0, At, B0); PG8_MMA(0, 1, At, B1); PG8_BAR; PG8_SCHED;
            PG8_LDA(At, 1, 1); PG8_STAGE(PG8_SB(1, 0), b3, voffB); PG8_STAGE(PG8_SB(1, 1), b3 + hstep, voffB); PG8_STAGE_A(PG8_SA(1, 0), a3, 0, o2);
            PG8_WAIT_V(8); PG8_WAIT_L(0); PG8_BAR; PG8_MMA(1, 0, At, B0); PG8_MMA(1, 1, At, B1); PG8_BAR; PG8_SCHED;
        }
        if (wr == 0) PG8_BAR;
        E(acc, cur, wr, wc, fr, fq);
        if (!has_next) break;
#pragma unroll
        for (int a = 0; a < 2; ++a)
#pragma unroll
            for (int b = 0; b < 2; ++b)
#pragma unroll
                for (int m = 0; m < 4; ++m)
#pragma unroll
                    for (int n = 0; n < 2; ++n) acc[a][b][m][n] = (f32x4){0.f, 0.f, 0.f, 0.f};
        cur = nxt; cA = nA; cB = nB; ++ui;
        if constexpr (GATHER) {
#pragma unroll
            for (int h = 0; h < 2; ++h)
#pragma unroll
                for (int i = 0; i < 2; ++i) offC[h][i] = offN[h][i]; }
        if (wr == 1) PG8_BAR;
    }
    PG8_WAIT_V(0);
    PG8_BAR;
#undef PG8_SA
#undef PG8_SB
#undef PG8_STAGE
#undef PG8_STAGE_A
#undef PG8_LDA
#undef PG8_LDB
#undef PG8_MMA
#undef PG8_WAIT_V
#undef PG8_WAIT_L
#undef PG8_BAR
#undef PG8_SCHED
}
}
struct Params {
    const GAS float* x; const GAS float* c; const GAS float* norm_gain; const GAS float* w_ada; const GAS float* b_ada; const GAS float* w_in_even; const GAS float* w_in_odd; const GAS float* w_out;
    const GAS float* a_mu; const GAS float* a_w0; const GAS float* a_w_up; const GAS float* a_a0; const GAS float* a_a_up; const GAS float* a_g_up; const GAS float* a_k_k; const GAS float* a_k_a; const GAS float* a_r_k;
    const GAS float* a_ln_gain; const GAS float* a_ln_bias; const GAS float* b_alpha_up; const GAS float* b_alpha_bias; const GAS float* b_norm_gain; const GAS float* c_lb; const GAS float* c_norm_gain;
    const GAS float* d_conv_w; const GAS float* d_conv_b; const GAS float* d_dt_bias; const GAS float* d_a_log; const GAS float* d_skip; const GAS float* d_norm_gain;
    const GAS float* w_router; const GAS float* router_bias; const GAS float* w_gate; const GAS float* w_up; const GAS float* w_down; const GAS float* final_gain;
    GAS float* out; GAS unsigned char* ws;
    long long ph_lo, ph_hi;
};

struct Ctx {
    LAS unsigned char* lds; int tid, lane, wave, G, bid;
};

__device__ __forceinline__ void cvt_item(const GAS float* W, int K, int N, int ldw, GAS bf16_t* WT, int mode, LAS float* scr, int kb, int nb, int lane) {
    const int k0 = 64 * kb, n0 = 32 * nb;
    const int nn = n0 + (lane & 31);
#pragma unroll 8
    for (int i = 0; i < 32; ++i) { const int kk = 2 * i + (lane >> 5); scr[kk * 33 + (lane & 31)] = (nn < N) ? W[(size_t)(k0 + kk) * ldw + nn] : 0.f; }
    asm volatile("s_waitcnt lgkmcnt(0)" ::: "memory");
    const int c = lane & 7;
#pragma unroll
    for (int j = 0; j < 4; ++j) { const int n = (lane >> 3) + 8 * j; const LAS float* s = scr + (8 * c) * 33 + n;
        u32x4 o; o.x = pk2(s[0 * 33], s[1 * 33]); o.y = pk2(s[2 * 33], s[3 * 33]); o.z = pk2(s[4 * 33], s[5 * 33]); o.w = pk2(s[6 * 33], s[7 * 33]);
        const int ng = n0 + n; const int row = mode == 0 ? ng : ((ng >> 7) * 256 + (mode == 2 ? 128 : 0) + (ng & 127));
        *(GAS u32x4*)(WT + (size_t)row * K + k0 + 8 * c) = o; }
    asm volatile("s_waitcnt lgkmcnt(0)" ::: "memory");
}
__device__ __forceinline__ void moe_convert(const Params& p, const Ctx& C, int layer, int w, int nw) {
    LAS float* scr = (LAS float*)(C.lds + C.wave * 16384);
    GAS bf16_t* WGU = (GAS bf16_t*)(p.ws + WS_WGU); GAS bf16_t* WDN = (GAS bf16_t*)(p.ws + WS_WDN);
    constexpr int PER_E = 768;
    for (int it = w; it < NEXP * PER_E; it += nw) {
        const int e = it / PER_E, r = it % PER_E;
        const size_t wofs = ((size_t)layer * NEXP + e) * (size_t)D * DEXP;
        if (r < 256)      cvt_item(p.w_gate + wofs, D, DEXP, DEXP, WGU + (size_t)e * 1024 * D, 1, scr, r >> 4, r & 15, C.lane);
        else if (r < 512) cvt_item(p.w_up + wofs, D, DEXP, DEXP, WGU + (size_t)e * 1024 * D, 2, scr, (r - 256) >> 4, (r - 256) & 15, C.lane);
        else              cvt_item(p.w_down + wofs, DEXP, D, D, WDN + (size_t)e * D * DEXP, 0, scr, (r - 512) >> 5, (r - 512) & 31, C.lane);
    }
}

__device__ __forceinline__ void p0_prologue(const Params& p, const Ctx& C) {
    {
        LAS float* cs = (LAS float*)C.lds;
        LAS float* red = (LAS float*)(C.lds + 32768);
        for (int i = C.tid; i < NB * D; i += 512) cs[i] = siluf_(p.c[i]);
        __syncthreads();
        GAS float* mod = (GAS float*)(p.ws + WS_MOD);
        for (int it = C.bid; it < DEPTH * 96; it += C.G) {
            const int l = it / 96, cg = it % 96;
            const GAS float* W = p.w_ada + (size_t)l * D * 6 * D + 64 * cg + C.lane;
            float acc[8];
#pragma unroll
            for (int b = 0; b < 8; ++b) acc[b] = 0.f;
            const int k0 = 128 * C.wave;
#pragma unroll 8
            for (int k = 0; k < 128; ++k) { const float wv = W[(size_t)(k0 + k) * 6 * D];
#pragma unroll
                for (int b = 0; b < 8; ++b) acc[b] += cs[b * D + k0 + k] * wv; }
#pragma unroll
            for (int b = 0; b < 8; ++b) red[(C.wave * 8 + b) * 64 + C.lane] = acc[b];
            __syncthreads();
            { const int b = C.tid >> 6, col = C.tid & 63; float s = p.b_ada[l * 6 * D + 64 * cg + col];
#pragma unroll
              for (int w = 0; w < 8; ++w) s += red[(w * 8 + b) * 64 + col];
              mod[((size_t)l * NB + b) * 6 * D + 64 * cg + col] = s; }
            __syncthreads();
        }
    }
    if (C.bid == 0 && C.tid < 256) {
        float v[4], m = -1e30f;
#pragma unroll
        for (int l = 0; l < 4; ++l) { v[l] = p.c_lb[l * 256 + C.tid]; m = fmaxf(m, v[l]); }
        float s = 0.f;
#pragma unroll
        for (int l = 0; l < 4; ++l) { v[l] = __expf(v[l] - m); s += v[l]; }
        GAS float* lb = (GAS float*)(p.ws + WS_LB); float cum = 0.f; const float c0 = v[0] / s;
#pragma unroll
        for (int l = 0; l < 4; ++l) { cum += v[l] / s; lb[l * 256 + C.tid] = cum - c0; }
    }
    __syncthreads();
    {
        LAS float* scr = (LAS float*)(C.lds + C.wave * 16384);
        const int gw = C.bid * 8 + C.wave, NGW = C.G * 8;
        constexpr int I_E = 16 * (NPE / 32), I_O = 16 * (NPO / 32), I_W = 16 * 32, I_S1 = 16, I_S2 = 32;
        constexpr int NIT = 2 * I_E + 2 * I_O + 4 * I_W + 2 * (2 * I_S1 + I_S2);
        for (int it = gw; it < NIT; it += NGW) {
            int r = it;
            if (r < 2 * I_E) { const int j = r / I_E; r %= I_E; cvt_item(p.w_in_even + (size_t)j * D * EVEN_IN, D, EVEN_IN, EVEN_IN, (GAS bf16_t*)(p.ws + WS_WINE) + (size_t)j * NPE * D, 0, scr, r / (NPE / 32), r % (NPE / 32), C.lane); continue; }
            r -= 2 * I_E;
            if (r < 2 * I_O) { const int j = r / I_O; r %= I_O; cvt_item(p.w_in_odd + (size_t)j * D * ODD_IN, D, ODD_IN, ODD_IN, (GAS bf16_t*)(p.ws + WS_WINO) + (size_t)j * NPO * D, 0, scr, r / (NPO / 32), r % (NPO / 32), C.lane); continue; }
            r -= 2 * I_O;
            if (r < 4 * I_W) { const int l = r / I_W; r %= I_W; cvt_item(p.w_out + (size_t)l * D * D, D, D, D, (GAS bf16_t*)(p.ws + WS_WOUT) + (size_t)l * D * D, 0, scr, r / 32, r % 32, C.lane); continue; }
            r -= 4 * I_W;
            { const int j = r / (2 * I_S1 + I_S2); r %= (2 * I_S1 + I_S2);
              if (r < I_S1) cvt_item(p.a_w_up + (size_t)j * 64 * 512, 64, 512, 512, (GAS bf16_t*)(p.ws + WS_WUPT) + (size_t)j * 512 * 64, 0, scr, 0, r, C.lane);
              else if (r < 2 * I_S1) cvt_item(p.a_a_up + (size_t)j * 64 * 512, 64, 512, 512, (GAS bf16_t*)(p.ws + WS_AUPT) + (size_t)j * 512 * 64, 0, scr, 0, r - I_S1, C.lane);
              else { r -= 2 * I_S1; cvt_item(p.a_g_up + (size_t)j * 128 * 512, 128, 512, 512, (GAS bf16_t*)(p.ws + WS_GUPT) + (size_t)j * 512 * 128, 0, scr, r >> 4, r & 15, C.lane); } }
        }
        moe_convert(p, C, 0, gw, NGW);
    }
}

template <bool FINAL>
__device__ __forceinline__ void norm_phase(const Params& p, const Ctx& C, int layer) {
    const int gw = C.bid * 8 + C.wave, NGW = C.G * 8;
    const GAS float* mod = (const GAS float*)(p.ws + WS_MOD);
    const GAS bf16_t* YB = (const GAS bf16_t*)(p.ws + WS_YB);
    GAS bf16_t* H = (GAS bf16_t*)(p.ws + WS_H);
    const bool first = (layer == 0) && !FINAL;
    const int lprev = FINAL ? DEPTH - 1 : layer - 1;
    for (int row = gw; row < T; row += NGW) {
        const int b = row >> 12;
        const GAS f32x4* xr = (const GAS f32x4*)((first ? p.x : p.out) + (size_t)row * D) + C.lane;
        f32x4 v[4];
#pragma unroll
        for (int j = 0; j < 4; ++j) v[j] = xr[64 * j];
        if (!first) {
            const GAS float* gf = mod + ((size_t)lprev * NB + b) * 6 * D + 5 * D;
            const GAS u32x2* y0 = (const GAS u32x2*)(YB + (size_t)(2 * row) * D) + C.lane; const GAS u32x2* y1 = (const GAS u32x2*)(YB + (size_t)(2 * row + 1) * D) + C.lane;
#pragma unroll
            for (int j = 0; j < 4; ++j) { const u32x2 a = y0[64 * j], c2 = y1[64 * j]; const f32x4 g = *((const GAS f32x4*)gf + C.lane + 64 * j);
                v[j][0] += g[0] * (bflo(a.x) + bflo(c2.x)); v[j][1] += g[1] * (bfhi(a.x) + bfhi(c2.x)); v[j][2] += g[2] * (bflo(a.y) + bflo(c2.y)); v[j][3] += g[3] * (bfhi(a.y) + bfhi(c2.y)); }
        }
        float s2 = 0.f;
#pragma unroll
        for (int j = 0; j < 4; ++j) s2 += (v[j][0] * v[j][0] + v[j][1] * v[j][1]) + (v[j][2] * v[j][2] + v[j][3] * v[j][3]);
        const float rstd = rsqrtf(wave_sum(s2) * (1.f / D) + NORM_EPS);
        if (FINAL) {
            GAS f32x4* o = (GAS f32x4*)(p.out + (size_t)row * D) + C.lane;
#pragma unroll
            for (int j = 0; j < 4; ++j) { const f32x4 g = *((const GAS f32x4*)p.final_gain + C.lane + 64 * j); o[64 * j] = v[j] * rstd * g; }
        } else {
            GAS f32x4* xo = (GAS f32x4*)(p.out + (size_t)row * D) + C.lane;
#pragma unroll
            for (int j = 0; j < 4; ++j) xo[64 * j] = v[j];
            const GAS float* m = mod + ((size_t)layer * NB + b) * 6 * D;
            GAS u32x2* ho = (GAS u32x2*)(H + (size_t)row * D) + C.lane;
#pragma unroll
            for (int j = 0; j < 4; ++j) { const f32x4 g = *((const GAS f32x4*)(p.norm_gain + (size_t)layer * 2 * D) + C.lane + 64 * j); const f32x4 sh = *((const GAS f32x4*)m + C.lane + 64 * j); const f32x4 sc = *((const GAS f32x4*)(m + D) + C.lane + 64 * j);
                const f32x4 h = v[j] * rstd * g * (1.f + sc) + sh; u32x2 o; o.x = pk2(h[0], h[1]); o.y = pk2(h[2], h[3]); ho[64 * j] = o; }
        }
    }
}

__device__ __forceinline__ void route_phase(const Params& p, const Ctx& C, int layer) {
    LAS float* wr_l = (LAS float*)C.lds;
    LAS int* lcnt = (LAS int*)(C.lds + 65536);
    LAS int* lbase = lcnt + 16;
    LAS int* rinfo = lcnt + 32;
    LAS float* rgate = (LAS float*)(rinfo + 256);
    const GAS float* mod = (const GAS float*)(p.ws + WS_MOD);
    GAS bf16_t* H = (GAS bf16_t*)(p.ws + WS_H);
    GAS unsigned* cnt = (GAS unsigned*)(p.ws + WS_CTL) + CW_CNT + layer * 16;
    GAS int* lista = (GAS int*)(p.ws + WS_LISTA); GAS float* listw = (GAS float*)(p.ws + WS_LISTW);
    for (int i = C.tid; i < D * 16; i += 512) wr_l[(i & 15) * D + (i >> 4)] = p.w_router[i];
    float rb[16];
#pragma unroll
    for (int e = 0; e < 16; ++e) rb[e] = p.router_bias[e];
    for (int blk = C.bid; blk < T / 128; blk += C.G) {
        if (C.tid < 16) lcnt[C.tid] = 0;
        __syncthreads();
        for (int rr = 0; rr < 16; ++rr) {
            const int rl = C.wave * 16 + rr, row = blk * 128 + rl, b = row >> 12;
            const GAS f32x4* xr = (const GAS f32x4*)(p.out + (size_t)row * D) + C.lane;
            f32x4 v[4]; float s2 = 0.f;
#pragma unroll
            for (int j = 0; j < 4; ++j) { v[j] = xr[64 * j]; s2 += (v[j][0] * v[j][0] + v[j][1] * v[j][1]) + (v[j][2] * v[j][2] + v[j][3] * v[j][3]); }
            const float rstd = rsqrtf(wave_sum(s2) * (1.f / D) + NORM_EPS);
            const GAS float* m = mod + ((size_t)layer * NB + b) * 6 * D;
            GAS u32x2* ho = (GAS u32x2*)(H + (size_t)row * D) + C.lane;
            float lg[16];
#pragma unroll
            for (int e = 0; e < 16; ++e) lg[e] = 0.f;
#pragma unroll
            for (int j = 0; j < 4; ++j) { const f32x4 g = *((const GAS f32x4*)(p.norm_gain + (size_t)layer * 2 * D + D) + C.lane + 64 * j); const f32x4 sh = *((const GAS f32x4*)(m + 3 * D) + C.lane + 64 * j); const f32x4 sc = *((const GAS f32x4*)(m + 4 * D) + C.lane + 64 * j);
                const f32x4 h = v[j] * rstd * g * (1.f + sc) + sh; u32x2 o; o.x = pk2(h[0], h[1]); o.y = pk2(h[2], h[3]); ho[64 * j] = o;
#pragma unroll
                for (int e = 0; e < 16; ++e) { const f32x4 w4 = *(const LAS f32x4*)(wr_l + e * D + 4 * (C.lane + 64 * j)); lg[e] += (h[0] * w4[0] + h[1] * w4[1]) + (h[2] * w4[2] + h[3] * w4[3]); } }
            float sc16[16];
#pragma unroll
            for (int e = 0; e < 16; ++e) sc16[e] = sigmoidf_(wave_sum(lg[e]));
            float sel[16];
#pragma unroll
            for (int e = 0; e < 16; ++e) sel[e] = sc16[e] + rb[e];
            int grp = 0; float best = -1e30f;
#pragma unroll
            for (int g = 0; g < 4; ++g) { float m1 = -1e30f, m2 = -1e30f;
#pragma unroll
                for (int q = 0; q < 4; ++q) { const float s = sel[4 * g + q]; if (s > m1) { m2 = m1; m1 = s; } else if (s > m2) m2 = s; }
                const float gs = m1 + m2; if (gs > best) { best = gs; grp = g; } }
            int i1 = 0, i2 = 0; float m1 = -1e30f, m2 = -1e30f; float s1 = 0.f, s2g = 0.f;
#pragma unroll
            for (int e = 0; e < 16; ++e) { if ((e >> 2) == grp) { const float s = sel[e]; if (s > m1) { m2 = m1; i2 = i1; s2g = s1; m1 = s; i1 = e; s1 = sc16[e]; } else if (s > m2) { m2 = s; i2 = e; s2g = sc16[e]; } } }
            const float inv = 1.f / (s1 + s2g);
            if (C.lane == 0) {
                const int sl1 = __hip_atomic_fetch_add(&lcnt[i1], 1, __ATOMIC_RELAXED, __HIP_MEMORY_SCOPE_WORKGROUP), sl2 = __hip_atomic_fetch_add(&lcnt[i2], 1, __ATOMIC_RELAXED, __HIP_MEMORY_SCOPE_WORKGROUP);
                rinfo[rl * 2 + 0] = i1 | (sl1 << 8); rinfo[rl * 2 + 1] = i2 | (sl2 << 8); rgate[rl * 2 + 0] = s1 * inv; rgate[rl * 2 + 1] = s2g * inv;
            }
        }
        __syncthreads();
        if (C.tid < 16) lbase[C.tid] = (int)__hip_atomic_fetch_add(&cnt[C.tid], (unsigned)lcnt[C.tid], __ATOMIC_RELAXED, __HIP_MEMORY_SCOPE_AGENT);
        __syncthreads();
        if (C.tid < 256) { const int rl = C.tid >> 1, k = C.tid & 1; const int inf = rinfo[C.tid]; const int e = inf & 255, sl = inf >> 8;
            const size_t idx = (size_t)e * T + lbase[e] + sl; lista[idx] = (blk * 128 + rl) * 2 + k; listw[idx] = rgate[C.tid]; }
        __syncthreads();
    }
}
struct EpiU {
    static constexpr bool PERM = true;
    GAS bf16_t* O;
    __device__ __forceinline__ void operator()(const f32x4 (&acc)[2][2][4][2], const pg8::Unit& u, int wr, int wc, int fr, int fq) const {
        const int row0 = u.pm * 256 + wr * 64 + fr, col0 = u.pn * 256 + wc * 32 + 8 * fq;
#pragma unroll
        for (int ai = 0; ai < 2; ++ai)
#pragma unroll
            for (int m = 0; m < 4; ++m) { GAS bf16_t* rowp = O + (size_t)(row0 + ai * 128 + m * 16) * UPITCH + col0;
#pragma unroll
                for (int bj = 0; bj < 2; ++bj) { const f32x4 v0 = acc[ai][bj][m][0], v1 = acc[ai][bj][m][1];
                    u32x4 o; o.x = pk2(v0[0], v0[1]); o.y = pk2(v0[2], v0[3]); o.z = pk2(v1[0], v1[1]); o.w = pk2(v1[2], v1[3]);
                    *(GAS u32x4*)(rowp + bj * 128) = o; } }
    }
};
struct EpiOut {
    static constexpr bool PERM = false;
    GAS float* X; const GAS float* gm;
    __device__ __forceinline__ void operator()(const f32x4 (&acc)[2][2][4][2], const pg8::Unit& u, int wr, int wc, int fr, int fq) const {
        const int row0 = u.pm * 256 + wr * 64 + fr, col0 = u.pn * 256 + wc * 32 + 4 * fq;
        const GAS float* g = gm + (size_t)(row0 >> 12) * 6 * D + col0;
        f32x4 gv[2][2];
#pragma unroll
        for (int bj = 0; bj < 2; ++bj)
#pragma unroll
            for (int n = 0; n < 2; ++n) gv[bj][n] = *(const GAS f32x4*)(g + bj * 128 + n * 16);
#pragma unroll
        for (int ai = 0; ai < 2; ++ai)
#pragma unroll
            for (int m = 0; m < 4; ++m) { GAS float* rowp = X + (size_t)(row0 + ai * 128 + m * 16) * D + col0;
#pragma unroll
                for (int bj = 0; bj < 2; ++bj)
#pragma unroll
                    for (int n = 0; n < 2; ++n) { GAS f32x4* q = (GAS f32x4*)(rowp + bj * 128 + n * 16); *q = *q + gv[bj][n] * acc[ai][bj][m][n]; } }
    }
};
struct EpiUp {
    static constexpr bool PERM = true;
    GAS bf16_t* ACT;
    __device__ __forceinline__ void operator()(const f32x4 (&acc)[2][2][4][2], const pg8::Unit& u, int wr, int wc, int fr, int fq) const {
        const int row0 = u.pm * 256 + wr * 64 + fr, col0 = u.pn * 128 + wc * 32 + 8 * fq;
#pragma unroll
        for (int ai = 0; ai < 2; ++ai)
#pragma unroll
            for (int m = 0; m < 4; ++m) { GAS bf16_t* rowp = ACT + (size_t)(row0 + ai * 128 + m * 16) * DEXP + col0;
                float r[8];
#pragma unroll
                for (int n = 0; n < 2; ++n)
#pragma unroll
                    for (int q = 0; q < 4; ++q) r[4 * n + q] = siluf_(acc[ai][0][m][n][q]) * acc[ai][1][m][n][q];
                *(GAS u32x4*)rowp = pack8(r); }
    }
};
struct EpiDown {
    static constexpr bool PERM = true;
    GAS bf16_t* YB; const GAS int* lista; const GAS float* listw;
    __device__ __forceinline__ void operator()(const f32x4 (&acc)[2][2][4][2], const pg8::Unit& u, int wr, int wc, int fr, int fq) const {
        const int rl0 = wr * 64 + fr, col0 = u.pn * 256 + wc * 32 + 8 * fq;
        const size_t lb = (size_t)u.e * T + (size_t)u.ml * 256;
        const int nrows = u.pm;
#pragma unroll
        for (int ai = 0; ai < 2; ++ai)
#pragma unroll
            for (int m = 0; m < 4; ++m) { const int rl = rl0 + ai * 128 + m * 16;
                if (rl < nrows) { const int a = lista[lb + rl]; const float w = listw[lb + rl]; GAS bf16_t* rowp = YB + (size_t)a * D + col0;
#pragma unroll
                    for (int bj = 0; bj < 2; ++bj) { const f32x4 v0 = acc[ai][bj][m][0] * w, v1 = acc[ai][bj][m][1] * w;
                        u32x4 o; o.x = pk2(v0[0], v0[1]); o.y = pk2(v0[2], v0[3]); o.z = pk2(v1[0], v1[1]); o.w = pk2(v1[2], v1[3]);
                        *(GAS u32x4*)(rowp + bj * 128) = o; } } }
    }
};
struct MoeOrder {
    const GAS char* A; const GAS char* Bt; int K; size_t estride; const LAS int* tab; const GAS int* lista; int G, c; bool down;
    __device__ bool next(int i, pg8::Unit& u) const {
        const int L = i * G + c; const int NT = __builtin_amdgcn_readfirstlane(tab[16]);
        if (L >= NT * 4) return false;
        const int mt = L >> 2; int e = 0;
#pragma unroll
        for (int q = 1; q < 16; ++q) e += (__builtin_amdgcn_readfirstlane(tab[q]) <= mt) ? 1 : 0;
        e = __builtin_amdgcn_readfirstlane(e);
        const int t0 = __builtin_amdgcn_readfirstlane(tab[e]), cn = __builtin_amdgcn_readfirstlane(tab[17 + e]);
        u.pn = L & 3; u.e = e; u.ml = mt - t0;
        const int left = cn - u.ml * 256;
        u.pm = down ? (left < 256 ? left : 256) : mt;
        return true;
    }
    __device__ __forceinline__ const GAS char* a_base(const pg8::Unit& u) const { return down ? A + (size_t)(__builtin_amdgcn_readfirstlane(tab[u.e]) + u.ml) * 256 * K * 2 : A; }
    __device__ __forceinline__ const GAS char* b_base(const pg8::Unit& u) const { return Bt + (size_t)u.e * estride + (size_t)u.pn * 256 * K * 2; }
    __device__ __forceinline__ void a_rows(const pg8::Unit& u, const int (&RA)[2], unsigned (&off)[2][2]) const {
        const int n = __builtin_amdgcn_readfirstlane(tab[17 + u.e]) - u.ml * 256; const size_t lb = (size_t)u.e * T + (size_t)u.ml * 256;
#pragma unroll
        for (int h = 0; h < 2; ++h)
#pragma unroll
            for (int i = 0; i < 2; ++i) { const int r = 128 * h + RA[i]; const int tok = (r < n) ? (lista[lb + r] >> 1) : 0; off[h][i] = (unsigned)tok * (unsigned)(K * 2); }
    }
};
__device__ __forceinline__ void moe_table(const Params& p, const Ctx& C, int layer, LAS int* tab) {
    if (C.tid == 0) { const GAS unsigned* cnt = (const GAS unsigned*)(p.ws + WS_CTL) + CW_CNT + layer * 16; int acc = 0;
        for (int e = 0; e < 16; ++e) { const int n = (int)__hip_atomic_load(cnt + e, __ATOMIC_RELAXED, __HIP_MEMORY_SCOPE_AGENT); tab[e] = acc; tab[17 + e] = n; acc += (n + 255) >> 8; }
        tab[16] = acc; }
    __syncthreads();
}
constexpr size_t MX_BASE = WS_H;
constexpr size_t MX_AVAIL = WS_END - WS_H;
constexpr size_t M64 = (size_t)64 * 64;
constexpr size_t RW_PT = 0, RW_QT = RW_PT + 4096 * M64 * 2, RW_RH = RW_QT + 4096 * M64 * 2, RW_MH = RW_RH + 4096 * M64 * 2, RW_S = RW_MH + 4096 * M64 * 2, RW_BON = RW_S + 4096 * M64 * 2;
constexpr size_t GX_D_E = RW_BON + 4096 * 64 * 4;
constexpr size_t GX_S_E = GX_D_E + (size_t)2048 * 128 * 64 * 4;
constexpr size_t GX_DEC_E = GX_S_E + (size_t)2048 * 128 * 64 * 2;
constexpr size_t MX_END_E = GX_DEC_E + (size_t)2048 * 64 * 4;
constexpr size_t GX_D_O = 0, GX_S_O = GX_D_O + (size_t)2048 * 128 * 64 * 4, GX_DEC_O = GX_S_O + (size_t)2048 * 128 * 64 * 2;
constexpr size_t SX_ST = GX_DEC_O + (size_t)2048 * 64 * 4;
constexpr size_t SX_S = SX_ST + 4096 * M64 * 4;
constexpr size_t SX_DEC = SX_S + 4096 * M64 * 2;
constexpr size_t MX_END_O = SX_DEC + 4096 * 4;
static_assert(MX_END_E <= MX_AVAIL && MX_END_O <= MX_AVAIL, "mixer scratch overflow");

template <int NC>
__device__ __forceinline__ void lds_cumsum64(LAS float* tile, int stride, LAS float* seg, int tid) {
    const int n = tid % NC, s = tid / NC; const bool act = tid < 8 * NC;
    float v[8];
    if (act) {
#pragma unroll
        for (int i = 0; i < 8; ++i) v[i] = tile[(8 * s + i) * stride + n];
#pragma unroll
        for (int i = 1; i < 8; ++i) v[i] += v[i - 1];
        seg[s * NC + n] = v[7];
    }
    __syncthreads();
    if (act) { float off = 0.f;
#pragma unroll
        for (int q = 0; q < 8; ++q) off += (q < s) ? seg[q * NC + n] : 0.f;
#pragma unroll
        for (int i = 0; i < 8; ++i) tile[(8 * s + i) * stride + n] = v[i] + off; }
    __syncthreads();
}

constexpr int GL_GT = 0, GL_SEG = 17408, GL_AUP = 19456, GL_KD = 24576, GL_KM = 24576, GL_QM = 33792, GL_Q2 = 43008, GL_VT = 52224, GL_ST = 69632, GL_PL = 88064, GL_RS = 97280;

template <bool HGRN>
__device__ __forceinline__ void gla_stage_g(const Params& p, const Ctx& C, int layer, int h, const GAS bf16_t* urow0, float (&kreg)[8]) {
    const int j = C.tid >> 3, cg = C.tid & 7, jl = layer >> 1;
    LAS float* Gt = (LAS float*)(C.lds + GL_GT);
    const GAS bf16_t* ur = urow0 + (size_t)j * UPITCH;
    float g[8];
    if constexpr (HGRN) {
        float fr[8]; unpack8(*(const GAS u32x4*)(ur + HG_F + 64 * h + 8 * cg), fr);
        const GAS float* lb = (const GAS float*)(p.ws + WS_LB) + layer * 256 + 64 * h + 8 * cg;
#pragma unroll
        for (int q = 0; q < 8; ++q) { const float l = lb[q]; const float f = l + (1.f - l) * sigmoidf_(fr[q]); g[q] = __logf(f); kreg[q] = 1.f - f; }
    } else {
        LAS float* AUP = (LAS float*)(C.lds + GL_AUP);
        float ad[16]; { float t0[8], t1[8]; unpack8(*(const GAS u32x4*)(ur + GL_AD), t0); unpack8(*(const GAS u32x4*)(ur + GL_AD + 8), t1);
#pragma unroll
            for (int q = 0; q < 8; ++q) { ad[q] = t0[q]; ad[8 + q] = t1[q]; } }
#pragma unroll
        for (int q = 0; q < 8; ++q) { float x = AUP[16 * 64 + 8 * cg + q];
#pragma unroll
            for (int r = 0; r < 16; ++r) x += ad[r] * AUP[r * 64 + 8 * cg + q];
            g[q] = logsigmoidf_(x) * (1.f / 16.f); }
        unpack8(*(const GAS u32x4*)(ur + GL_K + 64 * h + 8 * cg), kreg);
    }
    *(LAS f32x4*)(Gt + j * FS + 8 * cg) = (f32x4){g[0], g[1], g[2], g[3]};
    *(LAS f32x4*)(Gt + j * FS + 8 * cg + 4) = (f32x4){g[4], g[5], g[6], g[7]};
    (void)jl;
}
template <bool HGRN>
__device__ __forceinline__ void gla_stage_aup(const Params& p, const Ctx& C, int layer, int h) {
    if constexpr (!HGRN) { const int jl = layer >> 1; LAS float* AUP = (LAS float*)(C.lds + GL_AUP);
        for (int i = C.tid; i < 16 * 64; i += 512) AUP[i] = p.b_alpha_up[(size_t)jl * 16 * 256 + (i >> 6) * 256 + 64 * h + (i & 63)];
        if (C.tid < 64) AUP[16 * 64 + C.tid] = p.b_alpha_bias[jl * 256 + 64 * h + C.tid]; }
}
__device__ __forceinline__ void gla_stage_v(const Ctx& C, const GAS bf16_t* urow0, int vcol) {
    const int j = C.tid >> 3, cg = C.tid & 7;
    const GAS u32x4* src = (const GAS u32x4*)(urow0 + (size_t)j * UPITCH + vcol + 16 * cg);
    LAS u32x4* dst = (LAS u32x4*)(C.lds + GL_VT + j * TS2 + 32 * cg);
    dst[0] = src[0]; dst[1] = src[1];
}

template <bool HGRN>
__device__ __forceinline__ void gla_pass1_item(const Params& p, const Ctx& C0, int layer, int item) {
    Ctx C = C0; asm volatile("" : "+s"(C.wave)); asm volatile("" : "+v"(C.tid)); C.lane = C.tid & 63;
    const int h = item & 3, bc = item >> 2;
    const GAS bf16_t* urow0 = (const GAS bf16_t*)(p.ws + WS_U) + (size_t)bc * 64 * UPITCH;
    LAS float* Gt = (LAS float*)(C.lds + GL_GT);
    const int j = C.tid >> 3, cg = C.tid & 7;
    GAS unsigned char* mx = p.ws + MX_BASE;
    GAS float* Dg = (GAS float*)(mx + (HGRN ? GX_D_O : GX_D_E)) + (size_t)item * 128 * 64;
    GAS float* DECg = (GAS float*)(mx + (HGRN ? GX_DEC_O : GX_DEC_E)) + (size_t)item * 64;
    gla_stage_aup<HGRN>(p, C, layer, h);
    __syncthreads();
    float kreg[8];
    gla_stage_g<HGRN>(p, C, layer, h, urow0, kreg);
    gla_stage_v(C, urow0, (HGRN ? HG_I : GL_V) + 128 * h);
    __syncthreads();
    lds_cumsum64<64>(Gt, FS, (LAS float*)(C.lds + GL_SEG), C.tid);
    { float kd[8];
#pragma unroll
      for (int q = 0; q < 8; ++q) { const float bj = Gt[j * FS + 8 * cg + q], bl = Gt[63 * FS + 8 * cg + q]; kd[q] = kreg[q] * __expf(bl - bj); if (j == 63) DECg[8 * cg + q] = __expf(bl); }
      *(LAS u32x4*)(C.lds + GL_KD + j * TS + 16 * cg) = pack8(kd); }
    __syncthreads();
    { const int e0 = 16 * C.wave; const LAS unsigned char* Vt = C.lds + GL_VT; const LAS unsigned char* Kd = C.lds + GL_KD;
      bf16x8 bv[2]; bv[0] = tf_lds(Vt, TS2, 0, e0, C.lane); bv[1] = tf_lds(Vt, TS2, 32, e0, C.lane);
#pragma unroll
      for (int bt = 0; bt < 4; ++bt) { f32x4 acc = {0.f, 0.f, 0.f, 0.f};
#pragma unroll
          for (int ks = 0; ks < 2; ++ks) acc = MFMA16(tf_lds(Kd, TS, 32 * ks, 16 * bt, C.lane), bv[ks], acc);
          SETTLE(acc);
          *(GAS f32x4*)(Dg + (size_t)(e0 + (C.lane & 15)) * 64 + 16 * bt + 4 * (C.lane >> 4)) = acc; } }
    __syncthreads();
}

template <bool HGRN>
__device__ __forceinline__ void gla_pass2_job(const Params& p, int job, int lane) {
    GAS unsigned char* mx = p.ws + MX_BASE;
    const int bh = job >> 5, slab = job & 31, b = bh >> 2, h = bh & 3;
    const int el = slab * 256 + lane * 4;
    const int d0 = el & 63;
    f32x4 S = {0.f, 0.f, 0.f, 0.f};
    for (int c = 0; c < 64; ++c) {
        const size_t item = ((size_t)(b * 64 + c) * 4 + h);
        const f32x4 Dv = *(const GAS f32x4*)((const GAS float*)(mx + (HGRN ? GX_D_O : GX_D_E)) + item * 8192 + el);
        const f32x4 dc = *(const GAS f32x4*)((const GAS float*)(mx + (HGRN ? GX_DEC_O : GX_DEC_E)) + item * 64 + d0);
        u32x2 o; o.x = pk2(S[0], S[1]); o.y = pk2(S[2], S[3]);
        *(GAS u32x2*)((GAS bf16_t*)(mx + (HGRN ? GX_S_O : GX_S_E)) + item * 8192 + el) = o;
        S = S * dc + Dv;
    }
}

template <bool HGRN>
__device__ __forceinline__ void gla_pass3_item(const Params& p, const Ctx& C0, int layer, int item) {
    Ctx C = C0; asm volatile("" : "+s"(C.wave)); asm volatile("" : "+v"(C.tid)); C.lane = C.tid & 63;
    const int h = item & 3, bc = item >> 2, jl = layer >> 1;
    const GAS bf16_t* urow0 = (const GAS bf16_t*)(p.ws + WS_U) + (size_t)bc * 64 * UPITCH;
    GAS bf16_t* Y = (GAS bf16_t*)(p.ws + WS_Y);
    LAS float* Gt = (LAS float*)(C.lds + GL_GT);
    const int j = C.tid >> 3, cg = C.tid & 7;
    GAS unsigned char* mx = p.ws + MX_BASE;
    const GAS bf16_t* Sg = (const GAS bf16_t*)(mx + (HGRN ? GX_S_O : GX_S_E)) + (size_t)item * 8192;
    gla_stage_aup<HGRN>(p, C, layer, h);
    __syncthreads();
    float kreg[8];
    gla_stage_g<HGRN>(p, C, layer, h, urow0, kreg);
    gla_stage_v(C, urow0, (HGRN ? HG_I : GL_V) + 128 * h);
    {
#pragma unroll
      for (int q = 0; q < 2; ++q) { const int idx = C.tid + 512 * q, e = idx >> 3, ch = idx & 7;
          *(LAS u32x4*)(C.lds + GL_ST + e * TS + 16 * ch) = *(const GAS u32x4*)(Sg + (size_t)e * 64 + 8 * ch); } }
    __syncthreads();
    lds_cumsum64<64>(Gt, FS, (LAS float*)(C.lds + GL_SEG), C.tid);
    { float qv[8]; unpack8(*(const GAS u32x4*)(urow0 + (size_t)j * UPITCH + (HGRN ? HG_Q : GL_Q) + 64 * h + 8 * cg), qv);
      const float qs = HGRN ? 1.f : 0.125f;
      float qm[8], q2[8], km[8];
#pragma unroll
      for (int q = 0; q < 8; ++q) { const float bj = Gt[j * FS + 8 * cg + q], br = Gt[31 * FS + 8 * cg + q]; const float qq = qv[q] * qs;
          qm[q] = qq * __expf(bj - br); q2[q] = qq * __expf(bj); km[q] = kreg[q] * __expf(br - bj); }
      *(LAS u32x4*)(C.lds + GL_QM + j * TS + 16 * cg) = pack8(qm);
      *(LAS u32x4*)(C.lds + GL_Q2 + j * TS + 16 * cg) = pack8(q2);
      *(LAS u32x4*)(C.lds + GL_KM + j * TS + 16 * cg) = pack8(km); }
    __syncthreads();
    {
      const LAS unsigned char* Qm = C.lds + GL_QM; const LAS unsigned char* Km = C.lds + GL_KM; LAS unsigned char* Pl = C.lds + GL_PL;
#pragma unroll
      for (int q = 0; q < 2; ++q) { const int id = 2 * C.wave + q, at = id >> 2, bt = id & 3; f32x4 acc = {0.f, 0.f, 0.f, 0.f};
          if (bt <= at) {
#pragma unroll
              for (int ks = 0; ks < 2; ++ks) acc = MFMA16(rf_lds(Km, TS, 16 * bt, 32 * ks, C.lane), rf_lds(Qm, TS, 16 * at, 32 * ks, C.lane), acc);
          SETTLE(acc);
              const int i = 16 * at + (C.lane & 15), j0 = 16 * bt + 4 * (C.lane >> 4);
#pragma unroll
              for (int r = 0; r < 4; ++r) acc[r] = (j0 + r <= i) ? acc[r] : 0.f; }
          st4_lds(Pl, TS, 16 * at + (C.lane & 15), 16 * bt + 4 * (C.lane >> 4), acc); } }
    __syncthreads();
    { const int at = C.wave & 3, eh = C.wave >> 2, i = 16 * at + (C.lane & 15), g4 = 4 * (C.lane >> 4);
      const LAS unsigned char* Vt = C.lds + GL_VT; const LAS unsigned char* St = C.lds + GL_ST; const LAS unsigned char* Pl = C.lds + GL_PL; const LAS unsigned char* Q2 = C.lds + GL_Q2;
      LAS float* RS = (LAS float*)(C.lds + GL_RS);
      bf16x8 bp[2], bq[2];
#pragma unroll
      for (int ks = 0; ks < 2; ++ks) { bp[ks] = rf_lds(Pl, TS, 16 * at, 32 * ks, C.lane); bq[ks] = rf_lds(Q2, TS, 16 * at, 32 * ks, C.lane); }
      f32x4 acc[4]; float ss = 0.f;
#pragma unroll
      for (int et = 0; et < 4; ++et) { const int e0 = 64 * eh + 16 * et; f32x4 a = {0.f, 0.f, 0.f, 0.f};
#pragma unroll
          for (int ks = 0; ks < 2; ++ks) { a = MFMA16(tf_lds(Vt, TS2, 32 * ks, e0, C.lane), bp[ks], a); a = MFMA16(rf_lds(St, TS, e0, 32 * ks, C.lane), bq[ks], a); }
          SETTLE(a);
          acc[et] = a; ss += (a[0] * a[0] + a[1] * a[1]) + (a[2] * a[2] + a[3] * a[3]); }
      ss += __shfl_xor(ss, 16); ss += __shfl_xor(ss, 32);
      if (C.lane < 16) RS[eh * 64 + i] = ss;
      __syncthreads();
      const float rstd = rsqrtf((RS[i] + RS[64 + i]) * (1.f / 128.f) + NORM_EPS);
      const GAS float* gain = (HGRN ? p.c_norm_gain : p.b_norm_gain) + jl * 128;
      const size_t tk = (size_t)bc * 64 + i;
      const GAS bf16_t* gp = (const GAS bf16_t*)(p.ws + WS_U) + tk * UPITCH + (HGRN ? HG_G : GL_G) + 128 * h;
      GAS bf16_t* yp = Y + tk * D + (HGRN ? 0 : 512) + 128 * h;
#pragma unroll
      for (int et = 0; et < 4; ++et) { const int e = 64 * eh + 16 * et + g4; const u32x2 gv = *(const GAS u32x2*)(gp + e); const f32x4 gn = *(const GAS f32x4*)(gain + e);
          const float g0 = siluf_(bflo(gv.x)), g1 = siluf_(bfhi(gv.x)), g2 = siluf_(bflo(gv.y)), g3 = siluf_(bfhi(gv.y));
          u32x2 o; o.x = pk2(acc[et][0] * rstd * gn[0] * g0, acc[et][1] * rstd * gn[1] * g1); o.y = pk2(acc[et][2] * rstd * gn[2] * g2, acc[et][3] * rstd * gn[3] * g3);
          *(GAS u32x2*)(yp + e) = o; } }
    __syncthreads();
}
constexpr int SD_BMT = 0, SD_CMT = 9216, SD_X = 18432  , SD_HS = 55296  , SD_PL = 92160  , SD_DTL = 129024  , SD_CUM = 130048  , SD_SEG = 131072  , SD_RS = 131328  ;

__device__ __forceinline__ void ssd_stage_dt(const Params& p, const Ctx& C, int layer, int grp, const GAS bf16_t* urow0) {
    const int jl = layer >> 1;
    LAS float* DTL = (LAS float*)(C.lds + SD_DTL); LAS float* CUM = (LAS float*)(C.lds + SD_CUM);
    if (C.tid < 256) { const int j = C.tid >> 2, hh = C.tid & 3, head = 4 * grp + hh;
        const float raw = bf2f(urow0[(size_t)j * UPITCH + SD_DT + head]) + p.d_dt_bias[jl * 8 + head];
        const float dt = softplusf_(raw); DTL[j * 4 + hh] = dt; CUM[j * 4 + hh] = -dt * __expf(p.d_a_log[jl * 8 + head]); }
    __syncthreads();
    lds_cumsum64<4>(CUM, 4, (LAS float*)(C.lds + SD_SEG), C.tid);
}
__device__ __forceinline__ void ssd_conv8(const Params& p, int jl, const GAS bf16_t* useq, int pos, int ch, float (&o)[8]) {
    const GAS float* cw = p.d_conv_w + (size_t)jl * 4 * 768 + ch; const GAS float* cb = p.d_conv_b + jl * 768 + ch;
#pragma unroll
    for (int q = 0; q < 8; ++q) o[q] = cb[q];
#pragma unroll
    for (int i = 0; i < 4; ++i) { const int pp = pos - 3 + i;
        if (pp >= 0) { float xv[8]; unpack8(*(const GAS u32x4*)(useq + (size_t)pp * UPITCH + SD_XBC + ch), xv);
            const f32x4 w0 = *(const GAS f32x4*)(cw + i * 768), w1 = *(const GAS f32x4*)(cw + i * 768 + 4);
            o[0] += w0[0] * xv[0]; o[1] += w0[1] * xv[1]; o[2] += w0[2] * xv[2]; o[3] += w0[3] * xv[3]; o[4] += w1[0] * xv[4]; o[5] += w1[1] * xv[5]; o[6] += w1[2] * xv[6]; o[7] += w1[3] * xv[7]; } }
#pragma unroll
    for (int q = 0; q < 8; ++q) o[q] = siluf_(o[q]);
}

__device__ __forceinline__ void ssd_pass1_item(const Params& p, const Ctx& C0, int layer, int item) {
    Ctx C = C0; asm volatile("" : "+s"(C.wave)); asm volatile("" : "+v"(C.tid)); C.lane = C.tid & 63;
    const int grp = item & 1, bc = item >> 1, c = bc & 63, jl = layer >> 1;
    const GAS bf16_t* U = (const GAS bf16_t*)(p.ws + WS_U);
    const GAS bf16_t* urow0 = U + (size_t)bc * 64 * UPITCH; const GAS bf16_t* useq = U + (size_t)(bc >> 6) * SEQ * UPITCH;
    LAS float* DTL = (LAS float*)(C.lds + SD_DTL); LAS float* CUM = (LAS float*)(C.lds + SD_CUM);
    GAS unsigned char* mx = p.ws + MX_BASE;
    ssd_stage_dt(p, C, layer, grp, urow0);
    for (int t = C.tid; t < 40 * 64; t += 512) { const int j = t & 63, cgx = t >> 6; float o[8];
        if (cgx < 32) { const int hh = cgx >> 3; ssd_conv8(p, jl, useq, c * 64 + j, 256 * grp + 8 * cgx, o);
            const float s = DTL[j * 4 + hh] * __expf(CUM[63 * 4 + hh] - CUM[j * 4 + hh]);
#pragma unroll
            for (int q = 0; q < 8; ++q) o[q] *= s;
            *(LAS u32x4*)(C.lds + SD_X + hh * TILE64 + j * TS + 16 * (cgx & 7)) = pack8(o);
        } else { ssd_conv8(p, jl, useq, c * 64 + j, 512 + 64 * grp + 8 * (cgx - 32), o); *(LAS u32x4*)(C.lds + SD_BMT + j * TS + 16 * (cgx - 32)) = pack8(o); } }
    __syncthreads();
    { const int hh = C.wave >> 1; const LAS unsigned char* Xt = C.lds + SD_X + hh * TILE64; const LAS unsigned char* Bt = C.lds + SD_BMT;
      const size_t ih = (size_t)bc * 8 + 4 * grp + hh;
      GAS float* STg = (GAS float*)(mx + SX_ST) + ih * 4096;
      if ((C.wave & 1) == 0 && C.lane == 0) ((GAS float*)(mx + SX_DEC))[ih] = __expf(CUM[63 * 4 + hh]);
#pragma unroll
      for (int q = 0; q < 2; ++q) { const int at = 2 * (C.wave & 1) + q;
          bf16x8 bx[2]; bx[0] = tf_lds(Xt, TS, 0, 16 * at, C.lane); bx[1] = tf_lds(Xt, TS, 32, 16 * at, C.lane);
#pragma unroll
          for (int bt = 0; bt < 4; ++bt) { f32x4 acc = {0.f, 0.f, 0.f, 0.f};
#pragma unroll
              for (int ks = 0; ks < 2; ++ks) acc = MFMA16(tf_lds(Bt, TS, 32 * ks, 16 * bt, C.lane), bx[ks], acc);
          SETTLE(acc);
              *(GAS f32x4*)(STg + (size_t)(16 * at + (C.lane & 15)) * 64 + 16 * bt + 4 * (C.lane >> 4)) = acc; } } }
    __syncthreads();
}
__device__ __forceinline__ void ssd_pass2_job(const Params& p, int job, int lane) {
    GAS unsigned char* mx = p.ws + MX_BASE;
    const int bh = job >> 4, slab = job & 15, b = bh >> 3, head = bh & 7;
    const int el = slab * 256 + lane * 4;
    f32x4 S = {0.f, 0.f, 0.f, 0.f};
    for (int c = 0; c < 64; ++c) {
        const size_t ih = (size_t)(b * 64 + c) * 8 + head;
        const f32x4 Dv = *(const GAS f32x4*)((const GAS float*)(mx + SX_ST) + ih * 4096 + el);
        const float dc = ((const GAS float*)(mx + SX_DEC))[ih];
        u32x2 o; o.x = pk2(S[0], S[1]); o.y = pk2(S[2], S[3]);
        *(GAS u32x2*)((GAS bf16_t*)(mx + SX_S) + ih * 4096 + el) = o;
        S = S * dc + Dv;
    }
}
__device__ __forceinline__ void ssd_pass3_item(const Params& p, const Ctx& C0, int layer, int item) {
    Ctx C = C0; asm volatile("" : "+s"(C.wave)); asm volatile("" : "+v"(C.tid)); C.lane = C.tid & 63;
    const int grp = item & 1, bc = item >> 1, c = bc & 63, jl = layer >> 1;
    const GAS bf16_t* U = (const GAS bf16_t*)(p.ws + WS_U);
    const GAS bf16_t* urow0 = U + (size_t)bc * 64 * UPITCH; const GAS bf16_t* useq = U + (size_t)(bc >> 6) * SEQ * UPITCH;
    LAS float* DTL = (LAS float*)(C.lds + SD_DTL); LAS float* CUM = (LAS float*)(C.lds + SD_CUM); LAS float* RS = (LAS float*)(C.lds + SD_RS);
    GAS unsigned char* mx = p.ws + MX_BASE;
    GAS bf16_t* Y = (GAS bf16_t*)(p.ws + WS_Y);
    ssd_stage_dt(p, C, layer, grp, urow0);
    for (int t = C.tid; t < 48 * 64; t += 512) { const int j = t & 63, cgx = t >> 6; float o[8];
        if (cgx < 32) { const int hh = cgx >> 3; ssd_conv8(p, jl, useq, c * 64 + j, 256 * grp + 8 * cgx, o);
            const float s = DTL[j * 4 + hh];
#pragma unroll
            for (int q = 0; q < 8; ++q) o[q] *= s;
            *(LAS u32x4*)(C.lds + SD_X + hh * TILE64 + j * TS + 16 * (cgx & 7)) = pack8(o);
        } else if (cgx < 40) { ssd_conv8(p, jl, useq, c * 64 + j, 512 + 64 * grp + 8 * (cgx - 32), o); *(LAS u32x4*)(C.lds + SD_BMT + j * TS + 16 * (cgx - 32)) = pack8(o);
        } else { ssd_conv8(p, jl, useq, c * 64 + j, 640 + 64 * grp + 8 * (cgx - 40), o); *(LAS u32x4*)(C.lds + SD_CMT + j * TS + 16 * (cgx - 40)) = pack8(o); } }
    for (int t = C.tid; t < 4 * 512; t += 512) { const int hh = t >> 9, idx = t & 511, pr = idx >> 3, ch = idx & 7;
        const GAS bf16_t* Sg = (const GAS bf16_t*)(mx + SX_S) + ((size_t)bc * 8 + 4 * grp + hh) * 4096;
        *(LAS u32x4*)(C.lds + SD_HS + hh * TILE64 + pr * TS + 16 * ch) = *(const GAS u32x4*)(Sg + (size_t)pr * 64 + 8 * ch); }
    __syncthreads();
    {
      const LAS unsigned char* Cm = C.lds + SD_CMT; const LAS unsigned char* Bm = C.lds + SD_BMT;
#pragma unroll
      for (int q = 0; q < 2; ++q) { const int id = 2 * C.wave + q, at = id >> 2, bt = id & 3; f32x4 acc = {0.f, 0.f, 0.f, 0.f};
          const int tt = 16 * at + (C.lane & 15), s0 = 16 * bt + 4 * (C.lane >> 4);
          if (bt <= at) {
#pragma unroll
              for (int ks = 0; ks < 2; ++ks) acc = MFMA16(rf_lds(Bm, TS, 16 * bt, 32 * ks, C.lane), rf_lds(Cm, TS, 16 * at, 32 * ks, C.lane), acc); }
          SETTLE(acc);
#pragma unroll
          for (int hh = 0; hh < 4; ++hh) { f32x4 v; const float ct = CUM[tt * 4 + hh];
#pragma unroll
              for (int r = 0; r < 4; ++r) { const float e = __expf(ct - CUM[(s0 + r) * 4 + hh]); v[r] = (bt <= at && s0 + r <= tt) ? acc[r] * e : 0.f; }
              st4_lds(C.lds + SD_PL + hh * TILE64, TS, tt, s0, v); } } }
    __syncthreads();
    { const int at = C.wave & 3, hp = C.wave >> 2, tt = 16 * at + (C.lane & 15), g4 = 4 * (C.lane >> 4);
      const LAS unsigned char* Cm = C.lds + SD_CMT;
      bf16x8 bc_[2]; bc_[0] = rf_lds(Cm, TS, 16 * at, 0, C.lane); bc_[1] = rf_lds(Cm, TS, 16 * at, 32, C.lane);
      const size_t tk = (size_t)bc * 64 + tt;
      f32x4 yv[2][4]; float ss = 0.f;
#pragma unroll
      for (int q = 0; q < 2; ++q) { const int hh = 2 * hp + q, head = 4 * grp + hh;
          const LAS unsigned char* Hs = C.lds + SD_HS + hh * TILE64; const LAS unsigned char* Xt = C.lds + SD_X + hh * TILE64; const LAS unsigned char* Pl = C.lds + SD_PL + hh * TILE64;
          bf16x8 bp[2]; bp[0] = rf_lds(Pl, TS, 16 * at, 0, C.lane); bp[1] = rf_lds(Pl, TS, 16 * at, 32, C.lane);
          const float ec = __expf(CUM[tt * 4 + hh]), rdt = 1.f / DTL[tt * 4 + hh], skip = p.d_skip[jl * 8 + head];
          const GAS bf16_t* zp = U + tk * UPITCH + SD_Z + 64 * head;
#pragma unroll
          for (int pt = 0; pt < 4; ++pt) { f32x4 a = {0.f, 0.f, 0.f, 0.f};
#pragma unroll
              for (int ks = 0; ks < 2; ++ks) a = MFMA16(rf_lds(Hs, TS, 16 * pt, 32 * ks, C.lane), bc_[ks], a);
          SETTLE(a);
              a = a * ec;
#pragma unroll
              for (int ks = 0; ks < 2; ++ks) a = MFMA16(tf_lds(Xt, TS, 32 * ks, 16 * pt, C.lane), bp[ks], a);
          SETTLE(a);
              const f32x4 xh = ld4_lds(Xt, TS, tt, 16 * pt + g4) * rdt;
              const u32x2 zv = *(const GAS u32x2*)(zp + 16 * pt + g4);
              a[0] = (a[0] + skip * xh[0]) * siluf_(bflo(zv.x)); a[1] = (a[1] + skip * xh[1]) * siluf_(bfhi(zv.x)); a[2] = (a[2] + skip * xh[2]) * siluf_(bflo(zv.y)); a[3] = (a[3] + skip * xh[3]) * siluf_(bfhi(zv.y));
              yv[q][pt] = a; ss += (a[0] * a[0] + a[1] * a[1]) + (a[2] * a[2] + a[3] * a[3]); } }
      ss += __shfl_xor(ss, 16); ss += __shfl_xor(ss, 32);
      if (C.lane < 16) RS[hp * 64 + tt] = ss;
      __syncthreads();
      const float rstd = rsqrtf((RS[tt] + RS[64 + tt]) * (1.f / 256.f) + NORM_EPS);
#pragma unroll
      for (int q = 0; q < 2; ++q) { const int hh = 2 * hp + q, head = 4 * grp + hh;
          const GAS float* gn = p.d_norm_gain + jl * 512 + 64 * head; GAS bf16_t* yp = Y + tk * D + 512 + 64 * head;
#pragma unroll
          for (int pt = 0; pt < 4; ++pt) { const f32x4 g = *(const GAS f32x4*)(gn + 16 * pt + g4); const f32x4 a = yv[q][pt] * rstd * g;
              u32x2 o; o.x = pk2(a[0], a[1]); o.y = pk2(a[2], a[3]); *(GAS u32x2*)(yp + 16 * pt + g4) = o; } } }
    __syncthreads();
}
constexpr int RK_LW = 0, RK_AA = 17408, RK_NA = 0, RK_NB = 9216, RK_TA = 18432, RK_TB = 27648, RK_SEG = 40960, RK_ECL = 43008, RK_TW = 43520, RK_AD = 52736, RK_WZ = 43520,
              RK_KKG = 61952, RK_BI = 71168, RK_KTI = 80384, RK_RG = 89600, RK_V = 98816, RK_MBR = 108032, RK_MKR = 117248, RK_N0 = 126464, RK_AK = 135680, RK_KH = RK_BI, RK_END = 144896;

__device__ __forceinline__ void rk_shift8(const GAS bf16_t* cur, const GAS bf16_t* prv, bool has_prev, const GAS float* mu, float (&o)[8]) {
    float c[8], q[8]; unpack8(*(const GAS u32x4*)cur, c);
    if (has_prev) unpack8(*(const GAS u32x4*)prv, q); else {
#pragma unroll
        for (int i = 0; i < 8; ++i) q[i] = 0.f; }
    const f32x4 m0 = *(const GAS f32x4*)mu, m1 = *(const GAS f32x4*)(mu + 4);
#pragma unroll
    for (int i = 0; i < 8; ++i) { const float m = i < 4 ? m0[i & 3] : m1[i & 3]; o[i] = c[i] + m * (q[i] - c[i]); }
}
__device__ __forceinline__ float tanhf_(float x) { const float e = __expf(-2.f * fabsf(x)); const float t = (1.f - e) / (1.f + e); return x < 0.f ? -t : t; }

#ifdef DBG_RW
#define RWCHK(cond, bit) do { if (layer == 0 && __any((int)(cond))) { GAS unsigned* f_ = (GAS unsigned*)(p.ws + WS_CTL) + 8192; if (C.lane == 0 && !(__hip_atomic_load(f_, __ATOMIC_RELAXED, __HIP_MEMORY_SCOPE_AGENT) & (bit))) atomicOr(f_, (bit)); } } while (0)
#else
#define RWCHK(cond, bit) do { } while (0)
#endif
#ifdef DBG_DUMP
#define RWDUMP(ldsoff, nbytes, gofs) do { if (layer == 0 && item < 1024) { const int rs_ = ((nbytes) == 64 * TS2) ? TS2 : TS; const int vb_ = rs_ - 16; for (int i_ = C.tid * 16; i_ < 64 * vb_; i_ += 512 * 16) { const int r_ = i_ / vb_, c_ = i_ % vb_; *(GAS u32x4*)(p.ws + WS_Y + (gofs) + (size_t)item * (nbytes) + r_ * rs_ + c_) = *(const LAS u32x4*)(L + (ldsoff) + r_ * rs_ + c_); } } } while (0)
#else
#define RWDUMP(ldsoff, nbytes, gofs) do { } while (0)
#endif
__device__ __forceinline__ void rwkv_pass1_item(const Params& p, const Ctx& C0, int layer, int item) {
    Ctx C = C0; asm volatile("" : "+s"(C.wave)); asm volatile("" : "+v"(C.tid)); C.lane = C.tid & 63;
    const int h = item & 7, bc = item >> 3, c = bc & 63, jl = layer >> 1;
    const GAS bf16_t* urow0 = (const GAS bf16_t*)(p.ws + WS_U) + (size_t)bc * 64 * UPITCH;
    GAS unsigned char* mx = p.ws + MX_BASE;
    LAS unsigned char* L = C.lds;
    LAS float* LW = (LAS float*)(L + RK_LW); LAS float* AA = (LAS float*)(L + RK_AA); LAS float* ECL = (LAS float*)(L + RK_ECL);
    const int j = C.tid >> 3, cg = C.tid & 7, lane = C.lane, w = C.wave;
    const int g4 = 4 * (lane >> 4), l15 = lane & 15;
    float rr[8], kk[8], vv[8];
    { const GAS bf16_t* cur = urow0 + (size_t)j * UPITCH; const GAS bf16_t* prv = cur - UPITCH; const bool hp = (c * 64 + j) != 0;
      const GAS float* mu = p.a_mu + (size_t)jl * RWKV_IN;
      rk_shift8(cur + RW_R + 64 * h + 8 * cg, prv + RW_R + 64 * h + 8 * cg, hp, mu + RW_R + 64 * h + 8 * cg, rr);
      rk_shift8(cur + RW_K + 64 * h + 8 * cg, prv + RW_K + 64 * h + 8 * cg, hp, mu + RW_K + 64 * h + 8 * cg, kk);
      rk_shift8(cur + RW_V + 64 * h + 8 * cg, prv + RW_V + 64 * h + 8 * cg, hp, mu + RW_V + 64 * h + 8 * cg, vv);
      float t[8];
      rk_shift8(cur + RW_WD + 8 * cg, prv + RW_WD + 8 * cg, hp, mu + RW_WD + 8 * cg, t);
#pragma unroll
      for (int q = 0; q < 8; ++q) t[q] = tanhf_(t[q]);
      *(LAS u32x4*)(L + RK_TW + j * TS + 16 * cg) = pack8(t);
      rk_shift8(cur + RW_AD + 8 * cg, prv + RW_AD + 8 * cg, hp, mu + RW_AD + 8 * cg, t);
      *(LAS u32x4*)(L + RK_AD + j * TS + 16 * cg) = pack8(t); }
    __syncthreads();
    { const int prod = w >> 2, at = w & 3;
      const LAS unsigned char* src = L + (prod ? RK_AD : RK_TW);
      const GAS bf16_t* Wt = (const GAS bf16_t*)(p.ws + (prod ? WS_AUPT : WS_WUPT)) + ((size_t)jl * 512 + 64 * h) * 64;
      const GAS float* bias = (prod ? p.a_a0 : p.a_w0) + jl * 512 + 64 * h;
      LAS float* dst = prod ? AA : LW;
      bf16x8 bj[2]; bj[0] = rf_lds(src, TS, 16 * at, 0, lane); bj[1] = rf_lds(src, TS, 16 * at, 32, lane);
#pragma unroll
      for (int bt = 0; bt < 4; ++bt) { f32x4 acc = *(const GAS f32x4*)(bias + 16 * bt + g4);
#pragma unroll
          for (int ks = 0; ks < 2; ++ks) acc = MFMA16(rf_glb(Wt, 64, 16 * bt, 32 * ks, lane), bj[ks], acc);
          SETTLE(acc);
#pragma unroll
          for (int r = 0; r < 4; ++r) acc[r] = prod ? sigmoidf_(acc[r]) : -0.6065306597f * sigmoidf_(acc[r]);
          *(LAS f32x4*)(dst + (16 * at + l15) * FS + 16 * bt + g4) = acc; } }
    __syncthreads();
    float lw[8];
#pragma unroll
    for (int q = 0; q < 8; ++q) lw[q] = LW[j * FS + 8 * cg + q];
    __syncthreads();
    lds_cumsum64<64>(LW, FS, (LAS float*)(L + RK_SEG), C.tid);
    { const GAS float* k_k = p.a_k_k + jl * 512 + 64 * h + 8 * cg; const GAS float* k_a = p.a_k_a + jl * 512 + 64 * h + 8 * cg; const GAS float* r_k = p.a_r_k + jl * 512 + 64 * h + 8 * cg;
      float kn[8], ss = 0.f, bon = 0.f, kt[8], bb[8], cs[8];
#pragma unroll
      for (int q = 0; q < 8; ++q) { kn[q] = kk[q] * k_k[q]; ss += kn[q] * kn[q]; }
      ss += __shfl_xor(ss, 1); ss += __shfl_xor(ss, 2); ss += __shfl_xor(ss, 4);
      const float rn = rsqrtf(ss + 1e-12f);
#pragma unroll
      for (int q = 0; q < 8; ++q) { const float a = AA[j * FS + 8 * cg + q]; kn[q] *= rn; kt[q] = kk[q] * (1.f + (a - 1.f) * k_a[q]); bb[q] = a * kn[q]; bon += rr[q] * kt[q] * r_k[q]; cs[q] = LW[j * FS + 8 * cg + q]; }
#pragma unroll
      for (int q = 0; q < 1; ++q) { }
      bon += __shfl_xor(bon, 1); bon += __shfl_xor(bon, 2); bon += __shfl_xor(bon, 4);
      if (cg == 0) ((GAS float*)(mx + RW_BON))[(size_t)item * 64 + j] = bon;
      float o[8];
#pragma unroll
      for (int q = 0; q < 8; ++q) o[q] = kn[q] * __expf(cs[q] - lw[q]);
      *(LAS u32x4*)(L + RK_KKG + j * TS + 16 * cg) = pack8(o);
#pragma unroll
      for (int q = 0; q < 8; ++q) o[q] = bb[q] * __expf(-cs[q]);
      *(LAS u32x4*)(L + RK_BI + j * TS + 16 * cg) = pack8(o);
#pragma unroll
      for (int q = 0; q < 8; ++q) o[q] = kt[q] * __expf(-cs[q]);
      *(LAS u32x4*)(L + RK_KTI + j * TS + 16 * cg) = pack8(o);
#pragma unroll
      for (int q = 0; q < 8; ++q) o[q] = rr[q] * __expf(cs[q]);
      *(LAS u32x4*)(L + RK_RG + j * TS + 16 * cg) = pack8(o);
      *(LAS u32x4*)(L + RK_V + j * TS + 16 * cg) = pack8(vv);
      if (j == 63) {
#pragma unroll
          for (int q = 0; q < 8; ++q) ECL[8 * cg + q] = __expf(cs[q]); } }
    __syncthreads();
    { const int prod = w >> 1;
      const LAS unsigned char* bsrc = L + (prod <= 1 ? RK_KKG : (prod == 2 ? RK_BI : RK_RG));
      const LAS unsigned char* asrc = L + (prod == 0 ? RK_BI : (prod == 1 ? RK_KTI : (prod == 2 ? RK_RG : RK_KTI)));
      LAS unsigned char* dst = L + (prod == 0 ? RK_N0 : (prod == 1 ? RK_AK : (prod == 2 ? RK_MBR : RK_MKR)));
#pragma unroll
      for (int q = 0; q < 2; ++q) { const int at = 2 * (w & 1) + q;
          bf16x8 bj[2]; bj[0] = rf_lds(bsrc, TS, 16 * at, 0, lane); bj[1] = rf_lds(bsrc, TS, 16 * at, 32, lane);
#pragma unroll
          for (int bt = 0; bt < 4; ++bt) { f32x4 acc = {0.f, 0.f, 0.f, 0.f};
#pragma unroll
              for (int ks = 0; ks < 2; ++ks) acc = MFMA16(rf_lds(asrc, TS, 16 * bt, 32 * ks, lane), bj[ks], acc);
          SETTLE(acc);
              const int a = 16 * at + l15, b0 = 16 * bt + g4;
#pragma unroll
              for (int r = 0; r < 4; ++r) { const int b = b0 + r; const bool keep = prod <= 1 ? (b < a) : (prod == 2 ? (a <= b) : (b <= a)); acc[r] = keep ? acc[r] : 0.f; }
#pragma unroll
              for (int r = 0; r < 4; ++r) RWCHK(!(fabsf(acc[r]) < (prod == 0 ? 1.5f : 1e3f)), prod == 0 ? 1u : 2u);
              st4_lds(dst, TS, a, b0, acc);
              if (prod == 0) { f32x4 t0;
#pragma unroll
                  for (int r = 0; r < 4; ++r) t0[r] = ((b0 + r) == a ? 1.f : 0.f) - acc[r];
                  st4_lds(L + RK_TA, TS, a, b0, t0); } } } }
    __syncthreads();
    {
        int nsrc = RK_N0, ndst = RK_NA, tsrc = RK_TA, tdst = RK_TB;
        for (int st = 0; st < 6; ++st) {
            const int at = w & 3, prod = w >> 2;
            const bool doN = (st < 5), doT = (st > 0);
            if ((prod == 0 && doN) || (prod == 1 && doT)) {
                const LAS unsigned char* bs = L + (prod == 0 ? nsrc : tsrc); const LAS unsigned char* as = L + nsrc; LAS unsigned char* dst = L + (prod == 0 ? ndst : tdst);
                bf16x8 bj[2]; bj[0] = rf_lds(bs, TS, 16 * at, 0, lane); bj[1] = rf_lds(bs, TS, 16 * at, 32, lane);
#pragma unroll
                for (int bt = 0; bt < 4; ++bt) { f32x4 acc = {0.f, 0.f, 0.f, 0.f};
                    if (prod == 1) acc = ld4_lds(bs, TS, 16 * at + l15, 16 * bt + g4);
#pragma unroll
                    for (int ks = 0; ks < 2; ++ks) acc = MFMA16(tf_lds(as, TS, 32 * ks, 16 * bt, lane), bj[ks], acc);
          SETTLE(acc);
#pragma unroll
                    for (int r = 0; r < 4; ++r) RWCHK(!(fabsf(acc[r]) < 1e3f), 4u);
                    st4_lds(dst, TS, 16 * at + l15, 16 * bt + g4, acc); }
            }
            __syncthreads();
            if (doT) { const int t = tsrc; tsrc = tdst; tdst = t; }
            if (doN) { nsrc = ndst; ndst = (ndst == RK_NA) ? RK_NB : RK_NA; }
        }
        { const int at = w & 3, half = w >> 2; const LAS unsigned char* Tt = L + tsrc;
          bf16x8 bj[2]; bj[0] = tf_lds(Tt, TS, 0, 16 * at, lane); bj[1] = tf_lds(Tt, TS, 32, 16 * at, lane);
          const LAS unsigned char* as = L + (half ? RK_MBR : RK_BI);
#pragma unroll
          for (int bt = 0; bt < 4; ++bt) { f32x4 acc = {0.f, 0.f, 0.f, 0.f};
#pragma unroll
              for (int ks = 0; ks < 2; ++ks) acc = MFMA16(tf_lds(as, TS, 32 * ks, 16 * bt, lane), bj[ks], acc);
          SETTLE(acc);
              if (!half) { const f32x4 e = *(const LAS f32x4*)(ECL + 16 * bt + g4); acc = acc * e; }
#pragma unroll
              for (int r = 0; r < 4; ++r) RWCHK(!(fabsf(acc[r]) < 1e4f), 8u);
              st4_lds(L + RK_WZ, TS2, 16 * at + l15, 64 * half + 16 * bt + g4, acc); } }
    }
    __syncthreads();
    { const int prod = w >> 1; const size_t io = (size_t)item * 4096;
      GAS bf16_t* Pt = (GAS bf16_t*)(mx + RW_PT) + io; GAS bf16_t* Rh = (GAS bf16_t*)(mx + RW_RH) + io; GAS bf16_t* Mh = (GAS bf16_t*)(mx + RW_MH) + io;
#pragma unroll
      for (int q = 0; q < 2; ++q) { const int at = 2 * (w & 1) + q; const int a = 16 * at + l15;
          bf16x8 bj[2];
          if (prod == 0) { bj[0] = tf_lds(L + RK_WZ, TS2, 0, 16 * at, lane); bj[1] = tf_lds(L + RK_WZ, TS2, 32, 16 * at, lane); }
          else if (prod == 2) { bj[0] = tf_lds(L + RK_AK, TS, 0, 16 * at, lane); bj[1] = tf_lds(L + RK_AK, TS, 32, 16 * at, lane); }
          else { bj[0] = tf_lds(L + RK_WZ, TS2, 0, 64 + 16 * at, lane); bj[1] = tf_lds(L + RK_WZ, TS2, 32, 64 + 16 * at, lane); }
#pragma unroll
          for (int bt = 0; bt < 4; ++bt) { f32x4 acc = {0.f, 0.f, 0.f, 0.f}; const int b0 = 16 * bt + g4;
#pragma unroll
              for (int ks = 0; ks < 2; ++ks) { bf16x8 af;
                  if (prod == 0 || prod == 1) af = tf_lds(L + RK_KKG, TS, 32 * ks, 16 * bt, lane);
                  else if (prod == 2) af = tf_lds(L + RK_WZ, TS2, 32 * ks, 16 * bt, lane);
                  else af = tf_lds(L + RK_AK, TS, 32 * ks, 16 * bt, lane);
                  acc = MFMA16(af, bj[ks], acc); }
              SETTLE(acc);
              f32x4 o;
#pragma unroll
              for (int r = 0; r < 4; ++r) RWCHK(!(fabsf(acc[r]) < 1e4f), 16u);
              if (prod == 0) { const float e = ECL[a];
#pragma unroll
                  for (int r = 0; r < 4; ++r) o[r] = ((b0 + r) == a ? e : 0.f) - acc[r];
                  RWCHK(!(fabsf(o[0]) < 1e4f) || !(fabsf(o[1]) < 1e4f) || !(fabsf(o[2]) < 1e4f) || !(fabsf(o[3]) < 1e4f), 1u);
                  u32x2 pk; pk.x = pk2(o[0], o[1]); pk.y = pk2(o[2], o[3]); *(GAS u32x2*)(Pt + (size_t)a * 64 + b0) = pk;
              } else if (prod == 1) { o = ld4_lds(L + RK_RG, TS, a, b0) - acc;
                  RWCHK(!(fabsf(o[0]) < 1e4f) || !(fabsf(o[1]) < 1e4f) || !(fabsf(o[2]) < 1e4f) || !(fabsf(o[3]) < 1e4f), 2u);
                  u32x2 pk; pk.x = pk2(o[0], o[1]); pk.y = pk2(o[2], o[3]); *(GAS u32x2*)(Rh + (size_t)a * 64 + b0) = pk;
              } else if (prod == 2) { const f32x4 e = *(const LAS f32x4*)(ECL + b0); o = ld4_lds(L + RK_KTI, TS, a, b0) * e - acc;
                  st4_lds(L + RK_KH, TS, a, b0, o);
              } else { o = ld4_lds(L + RK_MKR, TS, a, b0) - acc;
                  u32x2 pk; pk.x = pk2(o[0], o[1]); pk.y = pk2(o[2], o[3]); *(GAS u32x2*)(Mh + (size_t)a * 64 + b0) = pk; } } } }
    __syncthreads();
    { GAS bf16_t* Qt = (GAS bf16_t*)(mx + RW_QT) + (size_t)item * 4096;
#pragma unroll
      for (int q = 0; q < 2; ++q) { const int id = 2 * w + q, at = id >> 2, bt = id & 3; f32x4 acc = {0.f, 0.f, 0.f, 0.f};
#pragma unroll
          for (int ks = 0; ks < 2; ++ks) acc = MFMA16(tf_lds(L + RK_V, TS, 32 * ks, 16 * bt, lane), tf_lds(L + RK_KH, TS, 32 * ks, 16 * at, lane), acc);
          SETTLE(acc);
#pragma unroll
          for (int r = 0; r < 4; ++r) RWCHK(true, 32u);
          u32x2 pk; pk.x = pk2(acc[0], acc[1]); pk.y = pk2(acc[2], acc[3]); *(GAS u32x2*)(Qt + (size_t)(16 * at + l15) * 64 + 16 * bt + g4) = pk; } }
    __syncthreads();
    RWDUMP(RK_MBR, TILE64, 0); RWDUMP(RK_MKR, TILE64, (size_t)10 << 20); RWDUMP(RK_WZ, 64 * TS2, (size_t)20 << 20); RWDUMP(RK_RG, TILE64, (size_t)40 << 20); RWDUMP(RK_AK, TILE64, (size_t)50 << 20);
    __syncthreads();
}

__device__ __forceinline__ void rwkv_pass2_job(const Params& p, LAS unsigned char* scr  , int job, int lane) {
    GAS unsigned char* mx = p.ws + MX_BASE;
    const int bh = job >> 2, vq = job & 3, b = bh >> 3, h = bh & 7, g4 = 4 * (lane >> 4), l15 = lane & 15;
    f32x4 S[4];
#pragma unroll
    for (int nt = 0; nt < 4; ++nt) S[nt] = (f32x4){0.f, 0.f, 0.f, 0.f};
    for (int c = 0; c < 64; ++c) {
        const size_t io = ((size_t)(b * 64 + c) * 8 + h) * 4096;
        const GAS bf16_t* Pt = (const GAS bf16_t*)(mx + RW_PT) + io; const GAS bf16_t* Qt = (const GAS bf16_t*)(mx + RW_QT) + io; GAS bf16_t* Sg = (GAS bf16_t*)(mx + RW_S) + io;
        bf16x8 bp[4][2]; u32x2 qv[4];
#pragma unroll
        for (int nt = 0; nt < 4; ++nt) { bp[nt][0] = rf_glb(Pt, 64, 16 * nt, 0, lane); bp[nt][1] = rf_glb(Pt, 64, 16 * nt, 32, lane); qv[nt] = *(const GAS u32x2*)(Qt + (size_t)(16 * nt + l15) * 64 + 16 * vq + g4); }
#pragma unroll
        for (int nt = 0; nt < 4; ++nt)
#pragma unroll
            for (int r = 0; r < 4; ++r) *(LAS bf16_t*)(scr + (g4 + r) * TS + (16 * nt + l15) * 2) = (bf16_t)(pk2(S[nt][r], 0.f) & 0xffffu);
        asm volatile("s_waitcnt lgkmcnt(0)" ::: "memory");
        bf16x8 af[2]; af[0] = rf_lds(scr, TS, 0, 0, lane); af[1] = rf_lds(scr, TS, 0, 32, lane);
        asm volatile("s_waitcnt lgkmcnt(0)" ::: "memory");
        *(GAS bf16x8*)(Sg + (size_t)(16 * vq + l15) * 64 + 8 * (lane >> 4)) = af[0];
        *(GAS bf16x8*)(Sg + (size_t)(16 * vq + l15) * 64 + 32 + 8 * (lane >> 4)) = af[1];
#pragma unroll
        for (int nt = 0; nt < 4; ++nt) { f32x4 acc = {bflo(qv[nt].x), bfhi(qv[nt].x), bflo(qv[nt].y), bfhi(qv[nt].y)};
            acc = MFMA16(af[0], bp[nt][0], acc); acc = MFMA16(af[1], bp[nt][1], acc); S[nt] = acc; }
        SETTLE(S[0]); SETTLE(S[1]); SETTLE(S[2]); SETTLE(S[3]);
    }
}

constexpr int R3_S0 = 0, R3_RH = 9216, R3_MH = 18432, R3_V = 27648, R3_SG = 36864, R3_HALF = 54272;
__device__ __forceinline__ void rwkv_pass3_pair(const Params& p, const Ctx& C0, int layer, int pair) {
    Ctx C = C0; asm volatile("" : "+s"(C.wave)); asm volatile("" : "+v"(C.tid)); C.lane = C.tid & 63;
    const int half = C.wave >> 2, item = 2 * pair + half, h = item & 7, bc = item >> 3, c = bc & 63, jl = layer >> 1;
    const GAS bf16_t* urow0 = (const GAS bf16_t*)(p.ws + WS_U) + (size_t)bc * 64 * UPITCH;
    GAS unsigned char* mx = p.ws + MX_BASE;
    LAS unsigned char* L = C.lds + half * R3_HALF;
    GAS bf16_t* Y = (GAS bf16_t*)(p.ws + WS_Y);
    const int th = C.tid & 255, lane = C.lane, g4 = 4 * (lane >> 4), l15 = lane & 15;
    { const int j = th >> 2, cq = th & 3; const GAS bf16_t* cur = urow0 + (size_t)j * UPITCH; const GAS bf16_t* prv = cur - UPITCH; const bool hp = (c * 64 + j) != 0;
      const GAS float* mu = p.a_mu + (size_t)jl * RWKV_IN; float t[8];
#pragma unroll
      for (int q = 0; q < 2; ++q) { const int col = RW_V + 64 * h + 16 * cq + 8 * q; rk_shift8(cur + col, prv + col, hp, mu + col, t); *(LAS u32x4*)(L + R3_V + j * TS + 32 * cq + 16 * q) = pack8(t); }
#pragma unroll
      for (int q = 0; q < 4; ++q) { const int col = RW_GD + 32 * cq + 8 * q; rk_shift8(cur + col, prv + col, hp, mu + col, t);
#pragma unroll
          for (int i = 0; i < 8; ++i) t[i] = sigmoidf_(t[i]);
          *(LAS u32x4*)(L + R3_SG + j * TS2 + 64 * cq + 16 * q) = pack8(t); }
      const size_t io = (size_t)item * 4096;
      const GAS bf16_t* Sg = (const GAS bf16_t*)(mx + RW_S) + io; const GAS bf16_t* Rh = (const GAS bf16_t*)(mx + RW_RH) + io; const GAS bf16_t* Mh = (const GAS bf16_t*)(mx + RW_MH) + io;
#pragma unroll
      for (int q = 0; q < 2; ++q) { const int idx = th + 256 * q, r = idx >> 3, ch = idx & 7;
          *(LAS u32x4*)(L + R3_S0 + r * TS + 16 * ch) = *(const GAS u32x4*)(Sg + (size_t)r * 64 + 8 * ch);
          *(LAS u32x4*)(L + R3_RH + r * TS + 16 * ch) = *(const GAS u32x4*)(Rh + (size_t)r * 64 + 8 * ch);
          *(LAS u32x4*)(L + R3_MH + r * TS + 16 * ch) = *(const GAS u32x4*)(Mh + (size_t)r * 64 + 8 * ch); } }
    __syncthreads();
    { const int tb = C.wave & 3, t = 16 * tb + l15; const size_t tk = (size_t)bc * 64 + t;
      bf16x8 br[2], bm[2], bg[4];
#pragma unroll
      for (int ks = 0; ks < 2; ++ks) { br[ks] = rf_lds(L + R3_RH, TS, 16 * tb, 32 * ks, lane); bm[ks] = rf_lds(L + R3_MH, TS, 16 * tb, 32 * ks, lane); }
#pragma unroll
      for (int ks = 0; ks < 4; ++ks) bg[ks] = rf_lds(L + R3_SG, TS2, 16 * tb, 32 * ks, lane);
      const GAS bf16_t* Gt = (const GAS bf16_t*)(p.ws + WS_GUPT) + ((size_t)jl * 512 + 64 * h) * 128;
      f32x4 y[4], gt[4]; float s = 0.f;
#pragma unroll
      for (int mt = 0; mt < 4; ++mt) { f32x4 a = {0.f, 0.f, 0.f, 0.f}, g = {0.f, 0.f, 0.f, 0.f};
#pragma unroll
          for (int ks = 0; ks < 2; ++ks) { a = MFMA16(rf_lds(L + R3_S0, TS, 16 * mt, 32 * ks, lane), br[ks], a); a = MFMA16(tf_lds(L + R3_V, TS, 32 * ks, 16 * mt, lane), bm[ks], a); }
          SETTLE(a);
#pragma unroll
          for (int ks = 0; ks < 4; ++ks) g = MFMA16(rf_glb(Gt, 128, 16 * mt, 32 * ks, lane), bg[ks], g);
          SETTLE(g);
          y[mt] = a; gt[mt] = g; s += (a[0] + a[1]) + (a[2] + a[3]); }
      s += __shfl_xor(s, 16); s += __shfl_xor(s, 32);
      const float mean = s * (1.f / 64.f); float s2 = 0.f;
#pragma unroll
      for (int mt = 0; mt < 4; ++mt)
#pragma unroll
          for (int r = 0; r < 4; ++r) { const float d = y[mt][r] - mean; s2 += d * d; }
      s2 += __shfl_xor(s2, 16); s2 += __shfl_xor(s2, 32);
      const float rstd = rsqrtf(s2 * (1.f / 64.f) + 64e-5f);
      const float bon = ((const GAS float*)(mx + RW_BON))[(size_t)item * 64 + t];
      const GAS float* lg = p.a_ln_gain + jl * 512 + 64 * h; const GAS float* lb = p.a_ln_bias + jl * 512 + 64 * h;
      GAS bf16_t* yp = Y + tk * D + 64 * h;
#pragma unroll
      for (int mt = 0; mt < 4; ++mt) { const int v0 = 16 * mt + g4; const f32x4 G = *(const GAS f32x4*)(lg + v0), Bv = *(const GAS f32x4*)(lb + v0); const f32x4 vv = ld4_lds(L + R3_V, TS, t, v0);
          f32x4 o;
#pragma unroll
          for (int r = 0; r < 4; ++r) o[r] = ((y[mt][r] - mean) * rstd * G[r] + Bv[r] + bon * vv[r]) * gt[mt][r];
          u32x2 pk; pk.x = pk2(o[0], o[1]); pk.y = pk2(o[2], o[3]); *(GAS u32x2*)(yp + v0) = pk; } }
    __syncthreads();
}
constexpr int LDS_BYTES = 147456;
constexpr int LDS_TAB = 131072;
constexpr int LDS_P2SCR = 135168;
constexpr int LDS_BARW = LDS_BYTES - 16;
constexpr int N_PHASES = 2 + 9 * DEPTH;
static_assert(RK_END <= LDS_BARW && SD_RS + 512 <= LDS_BARW && 2 * R3_HALF <= LDS_BARW, "LDS map");

typedef const __attribute__((address_space(4))) Params* KParams;
__global__ void __launch_bounds__(512, 2) mk_fwd(Params p_arg) {
    extern __shared__ __attribute__((aligned(16))) unsigned char lds_raw[];
    KParams kp0 = (KParams)__builtin_amdgcn_kernarg_segment_ptr();
    Params p;
    Ctx C; C.lds = (LAS unsigned char*)lds_raw; C.G = gridDim.x; C.bid = blockIdx.x;
    const int wave0 = __builtin_amdgcn_readfirstlane(threadIdx.x >> 6);
    C.wave = wave0; C.lane = __builtin_amdgcn_mbcnt_hi(~0u, __builtin_amdgcn_mbcnt_lo(~0u, 0u)); C.tid = wave0 * 64 + C.lane;
    const int lo = (int)kp0->ph_lo, hi = (int)kp0->ph_hi;
    GAS unsigned char* const ws0 = kp0->ws;
    if (C.tid == 0) *(LAS u32x4*)(C.lds + LDS_BARW) = (u32x4){0u, 0u, 0u, 0u};
    __syncthreads();
    XcdBarrier bar; bar.bar = (GAS unsigned*)(ws0 + WS_CTL) + CW_BAR; bar.x = 0; bar.st = (volatile LAS unsigned*)(C.lds + LDS_BARW);
    if (hi - lo > 1) bar = xcd_barrier_post((GAS unsigned*)(ws0 + WS_CTL) + CW_BAR, (volatile LAS unsigned*)(C.lds + LDS_BARW), C.tid);
#define FRESH() do { KParams kq_ = kp0; asm volatile("" : "+s"(kq_)); { const __attribute__((address_space(4))) unsigned long long* kw_ = (const __attribute__((address_space(4))) unsigned long long*)kq_; unsigned long long* pw_ = (unsigned long long*)&p; _Pragma("unroll") for (int i_ = 0; i_ < (int)(sizeof(Params) / 8); ++i_) pw_[i_] = kw_[i_]; } int wv_ = wave0; asm volatile("" : "+s"(wv_)); \
        int ln_ = __builtin_amdgcn_mbcnt_hi(~0u, __builtin_amdgcn_mbcnt_lo(~0u, 0u)); asm volatile("" : "+v"(ln_)); C.wave = wv_; C.lane = ln_; C.tid = wv_ * 64 + ln_; } while (0)
#ifndef PH_MASK
#define PH_MASK 0xFFFF
#endif
#define PM(b) ((PH_MASK >> (b)) & 1)
#define IN(k) (lo <= (k) && (k) < hi)
#define SEAM(k) do { if (IN(k) && IN((k) + 1)) { FRESH(); xcd_barrier(bar, C.tid); } } while (0)
    if (PM(0) && IN(0)) { FRESH(); p0_prologue(p, C); }
    SEAM(0);
#pragma nounroll
    for (int l = 0; l < DEPTH; ++l) {
        const int P = 1 + 9 * l; const bool odd = (l & 1) != 0;
        if (PM(1) && IN(P)) { FRESH(); norm_phase<false>(p, C, l); }
        SEAM(P);
        if (PM(2) && IN(P + 1)) { FRESH();
            const GAS bf16_t* W = odd ? (const GAS bf16_t*)(p.ws + WS_WINO) + (size_t)(l >> 1) * NPO * D : (const GAS bf16_t*)(p.ws + WS_WINE) + (size_t)(l >> 1) * NPE * D;
            pg8::StaticOrder S; S.init(p.ws + WS_H, W, T, odd ? NPO : NPE, D, C.G, C.bid);
            EpiU E{(GAS bf16_t*)(p.ws + WS_U)};
            pg8::gemm_phase<EpiU, pg8::StaticOrder, false>(C.lds, C.tid, D, S, E);
        }
        SEAM(P + 1);
        if (IN(P + 2)) { FRESH();
            if (!odd) { if (PM(3)) for (int it = C.bid; it < 4096; it += C.G) rwkv_pass1_item(p, C, l, it);
                        if (PM(4)) for (int it = C.bid; it < 2048; it += C.G) gla_pass1_item<false>(p, C, l, it); }
            else      { if (PM(4)) for (int it = C.bid; it < 2048; it += C.G) gla_pass1_item<true>(p, C, l, it);
                        if (PM(5)) for (int it = C.bid; it < 1024; it += C.G) ssd_pass1_item(p, C, l, it); }
        }
        SEAM(P + 2);
        if (PM(6) && IN(P + 3)) { FRESH();
            if (!odd) { if (C.wave == 0) { for (int job = C.bid; job < 256; job += C.G) rwkv_pass2_job(p, C.lds + LDS_P2SCR, job, C.lane); }
                        else if (C.wave <= 4) { for (int job = C.bid * 4 + C.wave - 1; job < 1024; job += C.G * 4) gla_pass2_job<false>(p, job, C.lane); } }
            else      { if (C.wave < 4) { for (int job = C.bid * 4 + C.wave; job < 1024; job += C.G * 4) gla_pass2_job<true>(p, job, C.lane); }
                        else { for (int job = C.bid * 4 + C.wave - 4; job < 1024; job += C.G * 4) ssd_pass2_job(p, job, C.lane); } }
            if (l > 0) moe_convert(p, C, l, C.bid * 8 + C.wave, C.G * 8);
        }
        SEAM(P + 3);
        if (IN(P + 4)) { FRESH();
            if (!odd) { if (PM(7)) for (int it = C.bid; it < 2048; it += C.G) rwkv_pass3_pair(p, C, l, it);
                        if (PM(8)) for (int it = C.bid; it < 2048; it += C.G) gla_pass3_item<false>(p, C, l, it); }
            else      { if (PM(8)) for (int it = C.bid; it < 2048; it += C.G) gla_pass3_item<true>(p, C, l, it);
                        if (PM(9)) for (int it = C.bid; it < 1024; it += C.G) ssd_pass3_item(p, C, l, it); }
        }
        SEAM(P + 4);
        if (PM(10) && IN(P + 5)) { FRESH();
            pg8::StaticOrder S; S.init(p.ws + WS_Y, (const GAS bf16_t*)(p.ws + WS_WOUT) + (size_t)l * D * D, T, D, D, C.G, C.bid);
            EpiOut E{p.out, (const GAS float*)(p.ws + WS_MOD) + (size_t)l * NB * 6 * D + 2 * D};
            pg8::gemm_phase<EpiOut, pg8::StaticOrder, false>(C.lds, C.tid, D, S, E);
        }
        SEAM(P + 5);
        if (PM(11) && IN(P + 6)) { FRESH(); route_phase(p, C, l); }
        SEAM(P + 6);
        if (PM(12) && IN(P + 7)) { FRESH();
            LAS int* tab = (LAS int*)(C.lds + LDS_TAB); moe_table(p, C, l, tab);
            MoeOrder S{(const GAS char*)(p.ws + WS_H), (const GAS char*)(p.ws + WS_WGU), D, (size_t)1024 * D * 2, tab, (const GAS int*)(p.ws + WS_LISTA), C.G, C.bid, false};
            EpiUp E{(GAS bf16_t*)(p.ws + WS_ACT)};
            pg8::gemm_phase<EpiUp, MoeOrder, true>(C.lds, C.tid, D, S, E);
        }
        SEAM(P + 7);
        if (PM(13) && IN(P + 8)) { FRESH();
            LAS int* tab = (LAS int*)(C.lds + LDS_TAB); moe_table(p, C, l, tab);
            MoeOrder S{(const GAS char*)(p.ws + WS_ACT), (const GAS char*)(p.ws + WS_WDN), DEXP, (size_t)D * DEXP * 2, tab, (const GAS int*)(p.ws + WS_LISTA), C.G, C.bid, true};
            EpiDown E{(GAS bf16_t*)(p.ws + WS_YB), (const GAS int*)(p.ws + WS_LISTA), (const GAS float*)(p.ws + WS_LISTW)};
            pg8::gemm_phase<EpiDown, MoeOrder, false>(C.lds, C.tid, DEXP, S, E);
        }
        SEAM(P + 8);
    }
    if (PM(14) && IN(N_PHASES - 1)) { FRESH(); norm_phase<true>(p, C, DEPTH - 1); }
#undef IN
#undef PM
#undef SEAM
}


#ifdef DBG
constexpr int CW_DBG = 8192;
__global__ void dbg_scan(const void* base, int rows, int cols, int pitch, int is_f32, unsigned* flags, unsigned bit, float thr = 1e30f) {
    bool bad = false;
    for (size_t i = (size_t)blockIdx.x * blockDim.x + threadIdx.x; i < (size_t)rows * cols; i += (size_t)gridDim.x * blockDim.x) {
        const size_t r = i / cols, c = i % cols;
        float v = is_f32 ? ((const float*)base)[r * pitch + c] : bf2f(((const bf16_t*)base)[r * pitch + c]);
        if (!(fabsf(v) < thr)) bad = true;
    }
    if (bad) atomicOr(flags, bit);
}

__global__ void dbg_count(const void* base, size_t n, int is_f32, unsigned long long* cnt) {
    unsigned long long c = 0;
    for (size_t i = (size_t)blockIdx.x * blockDim.x + threadIdx.x; i < n; i += (size_t)gridDim.x * blockDim.x) {
        float v = is_f32 ? ((const float*)base)[i] : bf2f(((const bf16_t*)base)[i]);
        if (!(fabsf(v) < 1e30f)) ++c;
    }
    if (c) atomicAdd(cnt, c);
}
__global__ void dbg_log2(const unsigned long long* cnt, unsigned* flags) { unsigned long long c = *cnt; unsigned k = 0; while (c) { ++k; c >>= 1; } *flags = k; }

__global__ void dbg_sum(const void* base, int rows, int cols, int pitch, int esz, unsigned long long* slot) {
    unsigned long long c = 0;
    for (size_t i = (size_t)blockIdx.x * blockDim.x + threadIdx.x; i < (size_t)rows * cols; i += (size_t)gridDim.x * blockDim.x) {
        const size_t r = i / cols, cc = i % cols;
        const unsigned v = esz == 4 ? ((const unsigned*)base)[r * pitch + cc] : (unsigned)((const unsigned short*)base)[r * pitch + cc];
        c += (unsigned long long)v * (unsigned long long)(1 + (i & 1023));
    }
    atomicAdd(slot, c);
}
__global__ void dbg_cmpmask(const unsigned long long* s1, const unsigned long long* s2, int n, unsigned* flags) { unsigned f = 0; for (int i = 0; i < n; ++i) if (s1[i] != s2[i]) f |= 1u << i; *flags = f; }
__global__ void dbg_cmp(const unsigned long long* s1, const unsigned long long* s2, int n, unsigned* flags) { unsigned f = 0; for (int i = n - 1; i >= 0; --i) if (s1[i] != s2[i]) f = (unsigned)i; *flags = f; }
__global__ void dbg_emit(float* out, const unsigned* flags) {
    const size_t i = (size_t)blockIdx.x * blockDim.x + threadIdx.x;
    if (i < (size_t)T * D) out[i] = (i == 0) ? sqrtf((float)(flags[0] + flags[1]) * (float)T * (float)D) : 0.f;
}
#endif
extern "C" void kernel_launch(void* const* d_in, const int* in_sizes, int n_in, void* d_out, int out_size, void* d_ws, size_t ws_size, hipStream_t stream) {
    static int grid = 0;
    if (grid == 0) {
        if (n_in != 36 || out_size != T * D || ws_size < WS_END) { fprintf(stderr, "kernel_launch: unexpected shapes (n_in %d out %d ws %zu need %zu)\n", n_in, out_size, ws_size, (size_t)WS_END); grid = -1; return; }
        int dev = 0, cus = 0, per_cu = 0;
        if (hipGetDevice(&dev) != hipSuccess || hipDeviceGetAttribute(&cus, hipDeviceAttributeMultiprocessorCount, dev) != hipSuccess) { grid = -1; return; }
        if (hipFuncSetAttribute((const void*)mk_fwd, hipFuncAttributeMaxDynamicSharedMemorySize, LDS_BYTES) != hipSuccess) { fprintf(stderr, "kernel_launch: hipFuncSetAttribute failed\n"); grid = -1; return; }
        if (hipOccupancyMaxActiveBlocksPerMultiprocessor(&per_cu, (const void*)mk_fwd, 512, LDS_BYTES) != hipSuccess || per_cu < 1) { fprintf(stderr, "kernel_launch: occupancy query says %d\n", per_cu); (void)hipGetLastError(); grid = -1; return; }
        grid = cus;
    }
    if (grid < 0) return;
#ifdef DBG_MEMSET_ALL
    (void)hipMemsetAsync((char*)d_ws, 0, WS_END, stream);
#else
    (void)hipMemsetAsync((char*)d_ws + WS_CTL, 0, CTL_BYTES, stream);
#endif
    Params p{};
    const float** pp = (const float**)&p;
    for (int i = 0; i < 36; ++i) pp[i] = (const float*)d_in[i];
    p.out = (GAS float*)d_out; p.ws = (GAS unsigned char*)d_ws;
#if MK_LAUNCHES == 1
    p.ph_lo = 0; p.ph_hi = N_PHASES;
    hipLaunchKernelGGL(mk_fwd, dim3(grid), dim3(512), LDS_BYTES, stream, p);
#else
#ifdef DBG_TWICE
    (void)hipMemsetAsync((char*)d_ws + WS_END - 65536, 0, 65536, stream);
    for (int rep = 0; rep < 2; ++rep) { if (rep) (void)hipMemsetAsync((char*)d_ws + WS_CTL, 0, CTL_BYTES, stream);
#else
    { const int rep = 0; (void)rep;
#endif
    for (int ph = 0; ph < N_PHASES; ++ph) { p.ph_lo = ph; p.ph_hi = ph + 1; hipLaunchKernelGGL(mk_fwd, dim3(grid), dim3(512), LDS_BYTES, stream, p);
#ifdef DBG
        unsigned char* ws = (unsigned char*)d_ws; unsigned* fl = (unsigned*)(ws + WS_CTL) + CW_DBG;
        DBG_HOOKS
#endif
    }
    }
#ifdef DBG
    { unsigned* fl = (unsigned*)((unsigned char*)d_ws + WS_CTL) + CW_DBG;
      hipLaunchKernelGGL(dbg_scan, dim3(1024), dim3(256), 0, stream, (const void*)d_out, T, D, D, 1, fl, DBG_FINAL_BIT);
      hipLaunchKernelGGL(dbg_emit, dim3(T * D / 256), dim3(256), 0, stream, (float*)d_out, (const unsigned*)fl); }
#endif
#endif
}
```

```cpp
#include <hip/hip_runtime.h>
#include <stdint.h>
#include <stdio.h>

#ifndef MK_LAUNCHES
#define MK_LAUNCHES 1
#endif

#define LAS __attribute__((address_space(3)))
#if defined(__HIP_DEVICE_COMPILE__)
#define GAS __attribute__((address_space(1)))
#else
#define GAS
#endif
typedef unsigned short bf16_t;
typedef short bf16x8 __attribute__((ext_vector_type(8)));
typedef unsigned short u16x4 __attribute__((ext_vector_type(4)));
typedef float f32x4 __attribute__((ext_vector_type(4)));
typedef float f32x2 __attribute__((ext_vector_type(2)));
typedef unsigned u32x4 __attribute__((ext_vector_type(4)));
typedef unsigned u32x2 __attribute__((ext_vector_type(2)));

constexpr int D = 1024, NB = 8, SEQ = 4096, T = NB * SEQ, DEPTH = 4, CH = 64, NCH = SEQ / CH;
constexpr int EVEN_IN = 3344, ODD_IN = 2824, NPE = 3584, NPO = 3072, UPITCH = 3584;
constexpr int RW_R = 0, RW_K = 512, RW_V = 1024, RW_WD = 1536, RW_AD = 1600, RW_GD = 1664, RWKV_IN = 1792;
constexpr int GL_Q = 1792, GL_K = 2048, GL_V = 2304, GL_AD = 2816, GL_G = 2832;
constexpr int HG_Q = 0, HG_F = 256, HG_I = 512, HG_G = 1024, HGRN_IN = 1536;
constexpr int SD_Z = 1536, SD_XBC = 2048, SD_XS = 2048, SD_BM = 2560, SD_CM = 2688, SD_DT = 2816;
constexpr int NEXP = 16, DEXP = 512;
constexpr float NORM_EPS = 1e-6f;

constexpr size_t al256(size_t x) { return (x + 255) & ~(size_t)255; }
constexpr size_t WS_CTL = 0;
constexpr size_t CTL_BYTES = 65536;
constexpr size_t WS_MOD = WS_CTL + CTL_BYTES;
constexpr size_t WS_LB = WS_MOD + al256((size_t)DEPTH * NB * 6 * D * 4);
constexpr size_t WS_WINE = WS_LB + al256((size_t)DEPTH * 256 * 4);
constexpr size_t WS_WINO = WS_WINE + (size_t)2 * NPE * D * 2;
constexpr size_t WS_WOUT = WS_WINO + (size_t)2 * NPO * D * 2;
constexpr size_t WS_WGU = WS_WOUT + (size_t)4 * D * D * 2;
constexpr size_t WS_WDN = WS_WGU + (size_t)NEXP * 1024 * D * 2;
constexpr size_t WS_WUPT = WS_WDN + (size_t)NEXP * D * DEXP * 2;
constexpr size_t WS_AUPT = WS_WUPT + (size_t)2 * 512 * 64 * 2;
constexpr size_t WS_GUPT = WS_AUPT + (size_t)2 * 512 * 64 * 2;
constexpr size_t WS_LISTA = WS_GUPT + (size_t)2 * 512 * 128 * 2;
constexpr size_t WS_LISTW = WS_LISTA + (size_t)NEXP * T * 4;
constexpr size_t WS_Y = WS_LISTW + (size_t)NEXP * T * 4;
constexpr size_t WS_U = WS_Y + (size_t)T * D * 2;
constexpr size_t WS_H = WS_U + (size_t)T * UPITCH * 2;
constexpr size_t WS_MIX = WS_H + (size_t)T * D * 2;
constexpr size_t MIX_BYTES = (size_t)162 * 1024 * 1024;
constexpr size_t WS_XB = WS_MIX + MIX_BYTES;
constexpr size_t WS_END = WS_XB + (size_t)T * D * 2;
constexpr size_t WS_PGU = WS_XB - (size_t)NEXP * 1024 * D * 2 - (size_t)NEXP * D * DEXP * 2;
constexpr size_t WS_PDN = WS_PGU + (size_t)NEXP * 1024 * D * 2;
__host__ __device__ constexpr size_t moe_wgu(int layer) { return (layer & 1) ? WS_PGU : WS_WGU; }
__host__ __device__ constexpr size_t moe_wdn(int layer) { return (layer & 1) ? WS_PDN : WS_WDN; }
constexpr size_t WS_ACT = WS_U;
constexpr size_t ACT_ROWS = (size_t)(2 * T / 256 + NEXP) * 256;
constexpr size_t WS_YB = WS_ACT + al256(ACT_ROWS * DEXP * 2);
static_assert(WS_YB + (size_t)2 * T * D * 2 <= WS_H, "MoE aliases overflow U");
static_assert(WS_END <= (size_t)706000000, "workspace larger than the guaranteed ws_size");
constexpr int CW_BAR = 0;
constexpr int CW_CNT = 4096;

typedef __bf16 bf16x2_t __attribute__((ext_vector_type(2)));
__device__ __forceinline__ unsigned pk2(float lo, float hi) { const f32x2 v = {lo, hi}; const bf16x2_t b = __builtin_convertvector(v, bf16x2_t); return __builtin_bit_cast(unsigned, b); }
__device__ __forceinline__ float bflo(unsigned u) { return __uint_as_float(u << 16); }
__device__ __forceinline__ float bfhi(unsigned u) { return __uint_as_float(u & 0xffff0000u); }
__device__ __forceinline__ float bf2f(bf16_t b) { return __uint_as_float(((unsigned)b) << 16); }
__device__ __forceinline__ float rcpf_(float x) { return __builtin_amdgcn_rcpf(x); }
__device__ __forceinline__ float sigmoidf_(float x) { return rcpf_(1.f + __expf(-x)); }
__device__ __forceinline__ float siluf_(float x) { return x * rcpf_(1.f + __expf(-x)); }
__device__ __forceinline__ float softplusf_(float x) { return x > 20.f ? x : (x < -15.f ? __expf(x) : __logf(1.f + __expf(x))); }
__device__ __forceinline__ float logsigmoidf_(float x) { return fminf(x, 0.f) - __logf(1.f + __expf(-fabsf(x))); }
__device__ __forceinline__ void unpack8(const u32x4 v, float (&f)[8]) {
    f[0] = bflo(v.x); f[1] = bfhi(v.x); f[2] = bflo(v.y); f[3] = bfhi(v.y); f[4] = bflo(v.z); f[5] = bfhi(v.z); f[6] = bflo(v.w); f[7] = bfhi(v.w);
}
__device__ __forceinline__ u32x4 pack8(const float (&f)[8]) { u32x4 o; o.x = pk2(f[0], f[1]); o.y = pk2(f[2], f[3]); o.z = pk2(f[4], f[5]); o.w = pk2(f[6], f[7]); return o; }
__device__ __forceinline__ float wave_sum(float v) {
#pragma unroll
    for (int o = 1; o < 64; o <<= 1) v += __shfl_xor(v, o);
    return v;
}
#define MFMA16(a, b, c) __builtin_amdgcn_mfma_f32_16x16x32_bf16((a), (b), (c), 0, 0, 0)
#define SETTLE(acc) asm volatile("s_nop 7\n\ts_nop 7\n\ts_nop 7" : "+v"(acc))
#define LDS_BARRIER() asm volatile("s_waitcnt lgkmcnt(0)\n\ts_barrier" ::: "memory")
#define SETTLE4(a0, a1, a2, a3) asm volatile("s_nop 7\n\ts_nop 7\n\ts_nop 7" : "+v"(a0), "+v"(a1), "+v"(a2), "+v"(a3))

__device__ __forceinline__ bf16x8 rf_lds(const LAS unsigned char* tile, int strideB, int r0, int c0, int lane) {
    return *(const LAS bf16x8*)(tile + (r0 + (lane & 15)) * strideB + (c0 + 8 * (lane >> 4)) * 2);
}
__device__ __forceinline__ bf16x8 tf_lds(const LAS unsigned char* tile, int strideB, int r0, int c0, int lane) {
    const int g = lane >> 4, q = (lane & 15) >> 2, p = lane & 3;
    const unsigned a0 = (unsigned)(uintptr_t)tile + (unsigned)((r0 + 8 * g + q) * strideB + (c0 + 4 * p) * 2);
    const unsigned a1 = a0 + 4u * (unsigned)strideB;
    u16x4 lo, hi;
    asm volatile("ds_read_b64_tr_b16 %0, %2\n\tds_read_b64_tr_b16 %1, %3\n\ts_waitcnt lgkmcnt(0)" : "=&v"(lo), "=&v"(hi) : "v"(a0), "v"(a1) : "memory");
    bf16x8 r;
    r[0] = (short)lo[0]; r[1] = (short)lo[1]; r[2] = (short)lo[2]; r[3] = (short)lo[3]; r[4] = (short)hi[0]; r[5] = (short)hi[1]; r[6] = (short)hi[2]; r[7] = (short)hi[3];
    return r;
}

template <int STRIDE, int O0, int O1, int O2, int O3>
__device__ __forceinline__ void tf4_issue(unsigned a, u16x4& l0, u16x4& h0, u16x4& l1, u16x4& h1, u16x4& l2, u16x4& h2, u16x4& l3, u16x4& h3) {
    asm volatile("ds_read_b64_tr_b16 %0, %8 offset:%9\n\tds_read_b64_tr_b16 %1, %8 offset:%10\n\tds_read_b64_tr_b16 %2, %8 offset:%11\n\tds_read_b64_tr_b16 %3, %8 offset:%12\n\t"
                 "ds_read_b64_tr_b16 %4, %8 offset:%13\n\tds_read_b64_tr_b16 %5, %8 offset:%14\n\tds_read_b64_tr_b16 %6, %8 offset:%15\n\tds_read_b64_tr_b16 %7, %8 offset:%16"
                 : "=&v"(l0), "=&v"(h0), "=&v"(l1), "=&v"(h1), "=&v"(l2), "=&v"(h2), "=&v"(l3), "=&v"(h3)
                 : "v"(a), "n"(O0), "n"(O0 + 4 * STRIDE), "n"(O1), "n"(O1 + 4 * STRIDE), "n"(O2), "n"(O2 + 4 * STRIDE), "n"(O3), "n"(O3 + 4 * STRIDE) : "memory");
}
__device__ __forceinline__ bf16x8 tf_join(const u16x4 lo, const u16x4 hi) {
    bf16x8 r; r[0] = (short)lo[0]; r[1] = (short)lo[1]; r[2] = (short)lo[2]; r[3] = (short)lo[3]; r[4] = (short)hi[0]; r[5] = (short)hi[1]; r[6] = (short)hi[2]; r[7] = (short)hi[3]; return r;
}
__device__ __forceinline__ unsigned tf_base(const LAS unsigned char* tile, int strideB, int r0, int c0, int lane) {
    const int g = lane >> 4, q = (lane & 15) >> 2, p = lane & 3;
    return (unsigned)(uintptr_t)tile + (unsigned)((r0 + 8 * g + q) * strideB + (c0 + 4 * p) * 2);
}
template <int STRIDE>
__device__ __forceinline__ void tf_2x4(const LAS unsigned char* tile, int r0, int c0, int lane, bf16x8 (&f)[2][4]) {
    const unsigned a = tf_base(tile, STRIDE, r0, c0, lane);
    u16x4 l[8], h[8];
    tf4_issue<STRIDE, 0, 32, 64, 96>(a, l[0], h[0], l[1], h[1], l[2], h[2], l[3], h[3]);
    tf4_issue<STRIDE, 32 * STRIDE, 32 * STRIDE + 32, 32 * STRIDE + 64, 32 * STRIDE + 96>(a, l[4], h[4], l[5], h[5], l[6], h[6], l[7], h[7]);
    asm volatile("s_waitcnt lgkmcnt(0)" : "+v"(l[0]), "+v"(h[0]), "+v"(l[1]), "+v"(h[1]), "+v"(l[2]), "+v"(h[2]), "+v"(l[3]), "+v"(h[3]), "+v"(l[4]), "+v"(h[4]), "+v"(l[5]), "+v"(h[5]), "+v"(l[6]), "+v"(h[6]), "+v"(l[7]), "+v"(h[7]) :: "memory");
#pragma unroll
    for (int ks = 0; ks < 2; ++ks)
#pragma unroll
        for (int bt = 0; bt < 4; ++bt) f[ks][bt] = tf_join(l[4 * ks + bt], h[4 * ks + bt]);
}
template <int STRIDE>
__device__ __forceinline__ void tf_2x1(const LAS unsigned char* tile, int r0, int c0, int lane, bf16x8 (&f)[2]) {
    const unsigned a = tf_base(tile, STRIDE, r0, c0, lane);
    u16x4 l0, h0, l1, h1;
    asm volatile("ds_read_b64_tr_b16 %0, %4\n\tds_read_b64_tr_b16 %1, %4 offset:%5\n\tds_read_b64_tr_b16 %2, %4 offset:%6\n\tds_read_b64_tr_b16 %3, %4 offset:%7\n\ts_waitcnt lgkmcnt(0)"
                 : "=&v"(l0), "=&v"(h0), "=&v"(l1), "=&v"(h1) : "v"(a), "n"(4 * STRIDE), "n"(32 * STRIDE), "n"(36 * STRIDE) : "memory");
    f[0] = tf_join(l0, h0); f[1] = tf_join(l1, h1);
}
template <int STRIDE>
__device__ __forceinline__ void tf_1x2(const LAS unsigned char* tile, int r0, int c0, int lane, bf16x8 (&f)[2]) {
    const unsigned a = tf_base(tile, STRIDE, r0, c0, lane);
    u16x4 l0, h0, l1, h1;
    asm volatile("ds_read_b64_tr_b16 %0, %4\n\tds_read_b64_tr_b16 %1, %4 offset:%5\n\tds_read_b64_tr_b16 %2, %4 offset:%6\n\tds_read_b64_tr_b16 %3, %4 offset:%7\n\ts_waitcnt lgkmcnt(0)"
                 : "=&v"(l0), "=&v"(h0), "=&v"(l1), "=&v"(h1) : "v"(a), "n"(4 * STRIDE), "n"(32), "n"(32 + 4 * STRIDE) : "memory");
    f[0] = tf_join(l0, h0); f[1] = tf_join(l1, h1);
}
__device__ __forceinline__ bf16x8 rf_glb(const GAS bf16_t* base, int ld, int r0, int c0, int lane) {
    return *(const GAS bf16x8*)(base + (size_t)(r0 + (lane & 15)) * ld + c0 + 8 * (lane >> 4));
}
__device__ __forceinline__ void st4_lds(LAS unsigned char* tile, int strideB, int row, int col, f32x4 v) {
    u32x2 o; o.x = pk2(v[0], v[1]); o.y = pk2(v[2], v[3]);
    *(LAS u32x2*)(tile + row * strideB + col * 2) = o;
}
__device__ __forceinline__ f32x4 ld4_lds(const LAS unsigned char* tile, int strideB, int row, int col) {
    const u32x2 o = *(const LAS u32x2*)(tile + row * strideB + col * 2);
    return (f32x4){bflo(o.x), bfhi(o.x), bflo(o.y), bfhi(o.y)};
}
constexpr int TS = 144;
constexpr int TS2 = 272;
constexpr int TILE64 = 64 * TS;
constexpr int FS = 68;
constexpr int FTILE = 64 * FS * 4;

#define XB_TMO      128
#define XB_XCNT(j)  (256  + 64 * (j))
#define XB_XSUB(j)  (1280 + 64 * (j))
#define XB_XGEN(j)  (2304 + 64 * (j))
#define XB_TOP      3328
#define XB_TOPGEN   3392
#define XCD_BAR_WORDS 3456
#define XB_SPIN_CAP (1u << 18)
__device__ __forceinline__ unsigned xb_ld(GAS unsigned* p)              { return __hip_atomic_load(p, __ATOMIC_RELAXED, __HIP_MEMORY_SCOPE_AGENT); }
__device__ __forceinline__ unsigned xb_add(GAS unsigned* p, unsigned v) { return __hip_atomic_fetch_add(p, v, __ATOMIC_RELAXED, __HIP_MEMORY_SCOPE_AGENT); }
__device__ __forceinline__ unsigned xb_xcc_id() { return (unsigned)__builtin_amdgcn_s_getreg((3 << 11) | 20) & 0xFu; }
#define XB_SPIN(cond, bar) do { unsigned _sp = 0; while (cond) { __builtin_amdgcn_s_sleep(1); \
    if ((++_sp & 255u) == 0u) { if (xb_ld(&(bar)[XB_TMO])) break; if (_sp > XB_SPIN_CAP) { atomicAdd(&(bar)[XB_TMO], 1u); break; } } } } while (0)
struct XcdBarrier { GAS unsigned* bar; unsigned x; volatile LAS unsigned* st; };
__device__ __forceinline__ XcdBarrier xcd_barrier_post(GAS unsigned* bar, volatile LAS unsigned* st, int tid) {
    XcdBarrier b; b.bar = bar; b.x = xb_xcc_id(); b.st = st;
    if (tid == 0) (void)xb_add(&bar[XB_XCNT(b.x)], 1u);
    return b;
}
__device__ __forceinline__ void xcd_barrier_complete(GAS unsigned* bar, unsigned x, unsigned& nloc, unsigned& nx) {
    const unsigned G = gridDim.x * gridDim.y * gridDim.z;
    unsigned sum, cnt, mine, sp = 0u;
    for (;;) {
        sum = 0u; cnt = 0u; mine = 0u;
#pragma unroll
        for (unsigned j = 0; j < 16; ++j) { const unsigned c = xb_ld(&bar[XB_XCNT(j)]); sum += c; cnt += (c > 0u) ? 1u : 0u; mine = (j == x) ? c : mine; }
        if (sum == G) break;
        __builtin_amdgcn_s_sleep(1);
        if ((++sp & 255u) == 0u) { if (xb_ld(&bar[XB_TMO])) break; if (sp > XB_SPIN_CAP) { atomicAdd(&bar[XB_TMO], 1u); break; } }
    }
    nloc = mine > 0u ? mine : 1u; nx = cnt > 0u ? cnt : 1u;
}
__device__ __forceinline__ void xcd_barrier(const XcdBarrier& b, int tid) {
    asm volatile("s_waitcnt vmcnt(0)" ::: "memory");
    __syncthreads();
    if (tid == 0) {
        GAS unsigned* bar = b.bar;
        __builtin_amdgcn_s_waitcnt(0);
        unsigned nloc = b.st[0], nx = b.st[1];
        if (nloc == 0u) { xcd_barrier_complete(bar, b.x, nloc, nx); b.st[0] = nloc; b.st[1] = nx; }
        const unsigned old = xb_add(&bar[XB_XSUB(b.x)], 1u);
        const unsigned gen = old / nloc;
        if (old + 1u == (gen + 1u) * nloc) {
            __builtin_amdgcn_fence(__ATOMIC_RELEASE, "agent");
            asm volatile("s_waitcnt vmcnt(0)" ::: "memory");
            const unsigned og = xb_add(&bar[XB_TOP], 1u);
            const unsigned tg = og / nx;
            if (og + 1u == (tg + 1u) * nx) xb_add(&bar[XB_TOPGEN], 1u);
            else XB_SPIN(xb_ld(&bar[XB_TOPGEN]) == tg, bar);
            __builtin_amdgcn_fence(__ATOMIC_ACQUIRE, "agent");
            xb_add(&bar[XB_XGEN(b.x)], 1u);
            asm volatile("s_waitcnt vmcnt(0)" ::: "memory");
        } else {
            XB_SPIN(xb_ld(&bar[XB_XGEN(b.x)]) == gen, bar);
            __builtin_amdgcn_fence(__ATOMIC_ACQUIRE, "agent");
            asm volatile("s_waitcnt vmcnt(0)" ::: "memory");
        }
    }
    __syncthreads();
}
namespace pg8 {
constexpr int BM = 256, BK = 64, HALF = 128, HTB = HALF * BK * 2, STAGE_BYTES = 8 * HTB, NXCD = 8, WGM = 8;
__host__ __device__ __forceinline__ int lds_byte(int r, int c) { const int st = (r >> 4) * 2 + (c >> 5), rr = r & 15, cc = c & 31, ob = rr * 64 + cc * 2; return st * 1024 + (ob ^ (((ob >> 9) & 1) << 5)); }
__host__ __device__ __forceinline__ void stage_rc(int b, int& R, int& C) { const int st = b / 1024, sb = b % 1024, swz = sb ^ (((sb >> 9) & 1) << 5); R = (st >> 1) * 16 + swz / 64; C = (st & 1) * 32 + (swz % 64) / 2; }
__host__ __device__ __forceinline__ int perm32(int rho) { const int n = rho >> 4, i = rho & 15; return 8 * (i >> 2) + 4 * n + (i & 3); }

struct Unit { int pm, pn, e, ml; };

struct StaticOrder {
    const GAS char* A; const GAS char* Bt; int K;
    int nM, nN, nwg, G, c;
    __device__ void init(const GAS void* A_, const GAS void* Bt_, int M, int N, int K_, int G_, int c_) { A = (const GAS char*)A_; Bt = (const GAS char*)Bt_; K = K_; nM = M / BM; nN = N / BM; nwg = nM * nN; G = G_; c = c_; }
    __device__ bool next(int i, Unit& u) const {
        const long L = (long)i * G + c; if (L >= nwg) return false;
        int wgid = (int)L; { const int q = nwg / NXCD, r = nwg % NXCD, xcd = wgid % NXCD, off = wgid / NXCD; wgid = (xcd < r ? xcd * (q + 1) : r * (q + 1) + (xcd - r) * q) + off; }
        const int nig = WGM * nN, gid = wgid / nig, fm = gid * WGM, gsz = (nM - fm) < WGM ? (nM - fm) : WGM;
        u.pm = fm + ((wgid % nig) % gsz); u.pn = (wgid % nig) / gsz; u.e = 0; u.ml = 0; return true;
    }
    __device__ __forceinline__ const GAS char* a_base(const Unit& u) const { return A + (size_t)u.pm * BM * K * 2; }
    __device__ __forceinline__ const GAS char* b_base(const Unit& u) const { return Bt + (size_t)u.pn * BM * K * 2; }
    __device__ __forceinline__ void a_rows(const Unit&, int, unsigned (&)[2][2]) const {}
};

template <class Epi, class Sched, bool GATHER>
__device__ __forceinline__ void gemm_phase(LAS unsigned char* lds, const int tid_, const int K, const Sched& S, const Epi& E) {
    const int tid = tid_, wid = __builtin_amdgcn_readfirstlane(tid >> 6), lane = tid & 63, wr = wid >> 2, wc = wid & 3, fr = lane & 15, fq = lane >> 4;
    const int nt = K / BK;
    unsigned voffA[2], voffB[2];
#pragma unroll
    for (int i = 0; i < 2; ++i) { int R, C; stage_rc(tid * 16 + i * 8192, R, C); const int Rb = Epi::PERM ? ((R & ~31) + perm32(R & 31)) : R;
        voffA[i] = (unsigned)(R * K + C) * 2u; voffB[i] = (unsigned)(Rb * K + C) * 2u; }
    const size_t kstep = (size_t)(BK * 2);
    const size_t hstep = (size_t)HALF * K * 2;
    const unsigned ldsw = (unsigned)wid * 1024u;
    const int aoff = lds_byte(wr * 64 + fr, fq * 8), boff = lds_byte(wc * 32 + fr, fq * 8);
    unsigned offC[2][2], offN[2][2];
#define PG8_SA(b, h) (((b) * 2 + (h)) * HTB)
#define PG8_SB(b, h) ((4 + (b) * 2 + (h)) * HTB)
#define PG8_STAGE(bufoff, gbase, voff) do { _Pragma("unroll") for (int _i = 0; _i < 2; ++_i) \
        __builtin_amdgcn_global_load_lds((const GAS unsigned*)((const GAS char*)(gbase) + (voff)[_i]), (LAS unsigned*)(lds + (bufoff) + ldsw + _i * 8192), 16, 0, 0); } while (0)
#define PG8_STAGE_A(bufoff, gb, h, offs) do { if constexpr (GATHER) { PG8_STAGE(bufoff, gb, (offs)[h]); } else { PG8_STAGE(bufoff, (gb) + (h) * hstep, voffA); } } while (0)
#define PG8_LDA(dst, b, h) do { _Pragma("unroll") for (int m = 0; m < 4; ++m) _Pragma("unroll") for (int k = 0; k < 2; ++k) dst[m][k] = *(const LAS bf16x8*)(lds + PG8_SA(b, h) + aoff + m * 2048 + k * 1024); } while (0)
#define PG8_LDB(dst, b, h) do { _Pragma("unroll") for (int n = 0; n < 2; ++n) _Pragma("unroll") for (int k = 0; k < 2; ++k) dst[n][k] = *(const LAS bf16x8*)(lds + PG8_SB(b, h) + boff + n * 2048 + k * 1024); } while (0)
#define PG8_MMA(ai, bj, At, Bt) do { __builtin_amdgcn_s_setprio(1); _Pragma("unroll") for (int m = 0; m < 4; ++m) _Pragma("unroll") for (int n = 0; n < 2; ++n) _Pragma("unroll") for (int k = 0; k < 2; ++k) \
        acc[ai][bj][m][n] = __builtin_amdgcn_mfma_f32_16x16x32_bf16(Bt[n][k], At[m][k], acc[ai][bj][m][n], 0, 0, 0); __builtin_amdgcn_s_setprio(0); } while (0)
#define PG8_WAIT_V(n) asm volatile("s_waitcnt vmcnt(" #n ")" ::: "memory")
#define PG8_WAIT_L(n) asm volatile("s_waitcnt lgkmcnt(" #n ")" ::: "memory")
#define PG8_BAR __builtin_amdgcn_s_barrier()
#define PG8_SCHED __builtin_amdgcn_sched_barrier(0)
    Unit cur, nxt; int ui = 0;
    if (!S.next(0, cur)) return;
    f32x4 acc[2][2][4][2];
#pragma unroll
    for (int a = 0; a < 2; ++a)
#pragma unroll
        for (int b = 0; b < 2; ++b)
#pragma unroll
            for (int m = 0; m < 4; ++m)
#pragma unroll
                for (int n = 0; n < 2; ++n) acc[a][b][m][n] = (f32x4){0.f, 0.f, 0.f, 0.f};
    bf16x8 At[4][2], B0[2][2], B1[2][2];
    const GAS char* cA = S.a_base(cur); const GAS char* cB = S.b_base(cur);
    if constexpr (GATHER) { int tz = tid; asm volatile("" : "+v"(tz)); S.a_rows(cur, tz, offC);
#pragma unroll
        for (int h = 0; h < 2; ++h)
#pragma unroll
            for (int i = 0; i < 2; ++i) offN[h][i] = offC[h][i]; }
    PG8_STAGE(PG8_SB(0, 0), cB, voffB); PG8_STAGE(PG8_SB(0, 1), cB + hstep, voffB); PG8_STAGE_A(PG8_SA(0, 0), cA, 0, offC); PG8_STAGE_A(PG8_SA(0, 1), cA, 1, offC);
    if (wr == 1) PG8_BAR;
    PG8_WAIT_V(2); PG8_BAR;
    PG8_STAGE(PG8_SB(1, 0), cB + kstep, voffB); PG8_STAGE_A(PG8_SA(1, 0), cA + kstep, 0, offC); PG8_STAGE(PG8_SB(1, 1), cB + hstep + kstep, voffB);
    PG8_WAIT_V(6); PG8_BAR;
    for (;;) {
        const bool has_next = S.next(ui + 1, nxt);
        const GAS char* nA = has_next ? S.a_base(nxt) : cA; const GAS char* nB = has_next ? S.b_base(nxt) : cB;
        if constexpr (GATHER) { if (has_next) { int tz = tid; asm volatile("" : "+v"(tz)); S.a_rows(nxt, tz, offN); } }
        for (int t = 0; t < nt; t += 2) {
            const bool last = (t == nt - 2);
            const GAS char* a1 = cA + (size_t)(t + 1) * kstep;
            const GAS char* a2 = last ? nA : cA + (size_t)(t + 2) * kstep; const GAS char* b2 = last ? nB : cB + (size_t)(t + 2) * kstep;
            const GAS char* a3 = a2 + kstep; const GAS char* b3 = b2 + kstep;
            unsigned o2[2][2];
            if constexpr (GATHER) {
#pragma unroll
                for (int h = 0; h < 2; ++h)
#pragma unroll
                    for (int i = 0; i < 2; ++i) o2[h][i] = last ? offN[h][i] : offC[h][i]; }
            PG8_LDB(B0, 0, 0); PG8_LDB(B1, 0, 1); PG8_SCHED; PG8_LDA(At, 0, 0); PG8_STAGE_A(PG8_SA(1, 1), a1, 1, offC);
            PG8_WAIT_V(8); PG8_WAIT_L(0); PG8_BAR; PG8_MMA(0, 0, At, B0); PG8_MMA(0, 1, At, B1); PG8_BAR; PG8_SCHED;
            PG8_LDA(At, 0, 1); PG8_STAGE(PG8_SB(0, 0), b2, voffB); PG8_STAGE(PG8_SB(0, 1), b2 + hstep, voffB); PG8_STAGE_A(PG8_SA(0, 0), a2, 0, o2);
            PG8_WAIT_V(8); PG8_WAIT_L(0); PG8_BAR; PG8_MMA(1, 0, At, B0); PG8_MMA(1, 1, At, B1); PG8_BAR; PG8_SCHED;
            PG8_LDB(B0, 1, 0); PG8_LDB(B1, 1, 1); PG8_SCHED; PG8_LDA(At, 1, 0); PG8_STAGE_A(PG8_SA(0, 1), a2, 1, o2);
            PG8_WAIT_V(8); PG8_WAIT_L(0); PG8_BAR; PG8_MMA(0, 0, At, B0); PG8_MMA(0, 1, At, B1); PG8_BAR; PG8_SCHED;
            PG8_LDA(At, 1, 1); PG8_STAGE(PG8_SB(1, 0), b3, voffB); PG8_STAGE(PG8_SB(1, 1), b3 + hstep, voffB); PG8_STAGE_A(PG8_SA(1, 0), a3, 0, o2);
            PG8_WAIT_V(8); PG8_WAIT_L(0); PG8_BAR; PG8_MMA(1, 0, At, B0); PG8_MMA(1, 1, At, B1); PG8_BAR; PG8_SCHED;
        }
        if (wr == 0) PG8_BAR;
        asm volatile("s_nop 7\n\ts_nop 7\n\ts_nop 7" ::: "memory");
        { int tz = tid; asm volatile("" : "+v"(tz)); int wz = wid; asm volatile("" : "+s"(wz)); const int l2 = tz & 63;
          E(acc, cur, wz >> 2, wz & 3, l2 & 15, l2 >> 4); }
        if (!has_next) break;
#pragma unroll
        for (int a = 0; a < 2; ++a)
#pragma unroll
            for (int b = 0; b < 2; ++b)
#pragma unroll
                for (int m = 0; m < 4; ++m)
#pragma unroll
                    for (int n = 0; n < 2; ++n) acc[a][b][m][n] = (f32x4){0.f, 0.f, 0.f, 0.f};
        cur = nxt; cA = nA; cB = nB; ++ui;
        if constexpr (GATHER) {
#pragma unroll
            for (int h = 0; h < 2; ++h)
#pragma unroll
                for (int i = 0; i < 2; ++i) offC[h][i] = offN[h][i]; }
        if (wr == 1) PG8_BAR;
    }
    PG8_WAIT_V(0);
    PG8_BAR;
#undef PG8_SA
#undef PG8_SB
#undef PG8_STAGE
#undef PG8_STAGE_A
#undef PG8_LDA
#undef PG8_LDB
#undef PG8_MMA
#undef PG8_WAIT_V
#undef PG8_WAIT_L
#undef PG8_BAR
#undef PG8_SCHED
}
}
struct Params {
    const GAS float* x; const GAS float* c; const GAS float* norm_gain; const GAS float* w_ada; const GAS float* b_ada; const GAS float* w_in_even; const GAS float* w_in_odd; const GAS float* w_out;
    const GAS float* a_mu; const GAS float* a_w0; const GAS float* a_w_up; const GAS float* a_a0; const GAS float* a_a_up; const GAS float* a_g_up; const GAS float* a_k_k; const GAS float* a_k_a; const GAS float* a_r_k;
    const GAS float* a_ln_gain; const GAS float* a_ln_bias; const GAS float* b_alpha_up; const GAS float* b_alpha_bias; const GAS float* b_norm_gain; const GAS float* c_lb; const GAS float* c_norm_gain;
    const GAS float* d_conv_w; const GAS float* d_conv_b; const GAS float* d_dt_bias; const GAS float* d_a_log; const GAS float* d_skip; const GAS float* d_norm_gain;
    const GAS float* w_router; const GAS float* router_bias; const GAS float* w_gate; const GAS float* w_up; const GAS float* w_down; const GAS float* final_gain;
    GAS float* out; GAS unsigned char* ws;
    long long ph_lo, ph_hi;
};

struct Ctx {
    LAS unsigned char* lds; int tid, lane, wave, G, bid;
};

__device__ __forceinline__ void cvt_item(const GAS float* W, int K, int N, int ldw, GAS bf16_t* WT, int mode, LAS float* scr, int kb, int nb, int lane) {
    const int k0 = 64 * kb, n0 = 32 * nb;
    const int c4 = lane & 7, kr = lane >> 3; const int nn = n0 + 4 * c4;
    f32x4 v[8];
    if (nn + 3 < N && (ldw & 3) == 0) {
#pragma unroll
        for (int i = 0; i < 8; ++i) v[i] = __builtin_nontemporal_load((const GAS f32x4*)(W + (size_t)(k0 + 8 * i + kr) * ldw + nn));
    } else {
#pragma unroll
        for (int i = 0; i < 8; ++i) { const GAS float* r = W + (size_t)(k0 + 8 * i + kr) * ldw;
            v[i][0] = (nn + 0 < N) ? r[nn + 0] : 0.f; v[i][1] = (nn + 1 < N) ? r[nn + 1] : 0.f; v[i][2] = (nn + 2 < N) ? r[nn + 2] : 0.f; v[i][3] = (nn + 3 < N) ? r[nn + 3] : 0.f; }
    }
#pragma unroll
    for (int i = 0; i < 8; ++i) *(LAS f32x4*)(scr + (8 * i + kr) * 36 + 4 * c4) = v[i];
    asm volatile("s_waitcnt lgkmcnt(0)" ::: "memory");
    const int c = lane & 7;
#pragma unroll
    for (int j = 0; j < 4; ++j) { const int n = (lane >> 3) + 8 * j; const LAS float* s = scr + (8 * c) * 36 + n;
        u32x4 o; o.x = pk2(s[0 * 36], s[1 * 36]); o.y = pk2(s[2 * 36], s[3 * 36]); o.z = pk2(s[4 * 36], s[5 * 36]); o.w = pk2(s[6 * 36], s[7 * 36]);
        const int ng = n0 + n; const int row = mode == 0 ? ng : ((ng >> 7) * 256 + (mode == 2 ? 128 : 0) + (ng & 127));
        *(GAS u32x4*)(WT + (size_t)row * K + k0 + 8 * c) = o; }
    asm volatile("s_waitcnt lgkmcnt(0)" ::: "memory");
}
__device__ __forceinline__ void moe_convert(const Params& p, const Ctx& C, int layer, int w, int nw, int part  ) {
    LAS float* scr = (LAS float*)(C.lds + C.wave * 16384);
    GAS bf16_t* WGU = (GAS bf16_t*)(p.ws + moe_wgu(layer)); GAS bf16_t* WDN = (GAS bf16_t*)(p.ws + moe_wdn(layer));
    if (part != 1)
        for (int it = w; it < NEXP * 512; it += nw) { const int e = it >> 9, r = it & 511; const size_t wofs = ((size_t)layer * NEXP + e) * (size_t)D * DEXP;
            if (r < 256) cvt_item(p.w_gate + wofs, D, DEXP, DEXP, WGU + (size_t)e * 1024 * D, 1, scr, r >> 4, r & 15, C.lane);
            else         cvt_item(p.w_up + wofs, D, DEXP, DEXP, WGU + (size_t)e * 1024 * D, 2, scr, (r - 256) >> 4, (r - 256) & 15, C.lane); }
    if (part != 0)
        for (int it = w; it < NEXP * 256; it += nw) { const int e = it >> 8, r = it & 255; const size_t wofs = ((size_t)layer * NEXP + e) * (size_t)D * DEXP;
            cvt_item(p.w_down + wofs, DEXP, D, D, WDN + (size_t)e * D * DEXP, 0, scr, r >> 5, r & 31, C.lane); }
}
__device__ __forceinline__ void moe_convert_tail(const Params& p, const Ctx& C, int layer, const LAS int* tab, int part) {
    if (layer + 1 >= DEPTH) return;
    const int U = __builtin_amdgcn_readfirstlane(tab[16]) * 4, lo = U % C.G;
    if (lo != 0 && C.bid < lo) return;
    const int j = lo == 0 ? C.bid : C.bid - lo, nidle = lo == 0 ? C.G : C.G - lo;
    moe_convert(p, C, layer + 1, j * 8 + C.wave, nidle * 8, part);
}

__device__ __forceinline__ void p0_prologue(const Params& p, const Ctx& C) {
    {
        LAS float* cs = (LAS float*)C.lds;
        LAS float* red = (LAS float*)(C.lds + 32768);
        for (int i = C.tid; i < NB * D; i += 512) cs[i] = siluf_(p.c[i]);
        __syncthreads();
        GAS float* mod = (GAS float*)(p.ws + WS_MOD);
        for (int it = C.bid; it < DEPTH * 96; it += C.G) {
            const int l = it / 96, cg = it % 96;
            const GAS float* W = p.w_ada + (size_t)l * D * 6 * D + 64 * cg + C.lane;
            float acc[8];
#pragma unroll
            for (int b = 0; b < 8; ++b) acc[b] = 0.f;
            const int k0 = 128 * C.wave;
#pragma unroll 8
            for (int k = 0; k < 128; ++k) { const float wv = W[(size_t)(k0 + k) * 6 * D];
#pragma unroll
                for (int b = 0; b < 8; ++b) acc[b] += cs[b * D + k0 + k] * wv; }
#pragma unroll
            for (int b = 0; b < 8; ++b) red[(C.wave * 8 + b) * 64 + C.lane] = acc[b];
            __syncthreads();
            { const int b = C.tid >> 6, col = C.tid & 63; float s = p.b_ada[l * 6 * D + 64 * cg + col];
#pragma unroll
              for (int w = 0; w < 8; ++w) s += red[(w * 8 + b) * 64 + col];
              mod[((size_t)l * NB + b) * 6 * D + 64 * cg + col] = s; }
            __syncthreads();
        }
    }
    if (C.bid == 0 && C.tid < 256) {
        float v[4], m = -1e30f;
#pragma unroll
        for (int l = 0; l < 4; ++l) { v[l] = p.c_lb[l * 256 + C.tid]; m = fmaxf(m, v[l]); }
        float s = 0.f;
#pragma unroll
        for (int l = 0; l < 4; ++l) { v[l] = __expf(v[l] - m); s += v[l]; }
        GAS float* lb = (GAS float*)(p.ws + WS_LB); float cum = 0.f; const float c0 = v[0] / s;
#pragma unroll
        for (int l = 0; l < 4; ++l) { cum += v[l] / s; lb[l * 256 + C.tid] = cum - c0; }
    }
    __syncthreads();
    {
        LAS float* scr = (LAS float*)(C.lds + C.wave * 16384);
        const int gw = C.bid * 8 + C.wave, NGW = C.G * 8;
        constexpr int I_E = 16 * (NPE / 32), I_O = 16 * (NPO / 32), I_W = 16 * 32, I_S1 = 16, I_S2 = 32;
        constexpr int NIT = 2 * I_E + 2 * I_O + 4 * I_W + 2 * (2 * I_S1 + I_S2);
        for (int it = gw; it < NIT; it += NGW) {
            int r = it;
            if (r < 2 * I_E) { const int j = r / I_E; r %= I_E; cvt_item(p.w_in_even + (size_t)j * D * EVEN_IN, D, EVEN_IN, EVEN_IN, (GAS bf16_t*)(p.ws + WS_WINE) + (size_t)j * NPE * D, 0, scr, r / (NPE / 32), r % (NPE / 32), C.lane); continue; }
            r -= 2 * I_E;
            if (r < 2 * I_O) { const int j = r / I_O; r %= I_O; cvt_item(p.w_in_odd + (size_t)j * D * ODD_IN, D, ODD_IN, ODD_IN, (GAS bf16_t*)(p.ws + WS_WINO) + (size_t)j * NPO * D, 0, scr, r / (NPO / 32), r % (NPO / 32), C.lane); continue; }
            r -= 2 * I_O;
            if (r < 4 * I_W) { const int l = r / I_W; r %= I_W; cvt_item(p.w_out + (size_t)l * D * D, D, D, D, (GAS bf16_t*)(p.ws + WS_WOUT) + (size_t)l * D * D, 0, scr, r / 32, r % 32, C.lane); continue; }
            r -= 4 * I_W;
            { const int j = r / (2 * I_S1 + I_S2); r %= (2 * I_S1 + I_S2);
              if (r < I_S1) cvt_item(p.a_w_up + (size_t)j * 64 * 512, 64, 512, 512, (GAS bf16_t*)(p.ws + WS_WUPT) + (size_t)j * 512 * 64, 0, scr, 0, r, C.lane);
              else if (r < 2 * I_S1) cvt_item(p.a_a_up + (size_t)j * 64 * 512, 64, 512, 512, (GAS bf16_t*)(p.ws + WS_AUPT) + (size_t)j * 512 * 64, 0, scr, 0, r - I_S1, C.lane);
              else { r -= 2 * I_S1; cvt_item(p.a_g_up + (size_t)j * 128 * 512, 128, 512, 512, (GAS bf16_t*)(p.ws + WS_GUPT) + (size_t)j * 512 * 128, 0, scr, r >> 4, r & 15, C.lane); } }
        }
        moe_convert(p, C, 0, gw, NGW, -1);
    }
}

template <bool FINAL, bool DRY = false>
__device__ __forceinline__ void norm_phase(const Params& p, const Ctx& C, int layer) {
    const int gw = C.bid * 8 + C.wave, NGW = C.G * 8;
    const GAS float* mod = (const GAS float*)(p.ws + WS_MOD);
    const GAS bf16_t* YB = (const GAS bf16_t*)(p.ws + WS_YB);
    GAS bf16_t* H = (GAS bf16_t*)(p.ws + WS_H); GAS bf16_t* XB = (GAS bf16_t*)(p.ws + WS_XB);
    const bool first = (layer == 0) && !FINAL;
    const int lprev = FINAL ? DEPTH - 1 : layer - 1;
    for (int blk = gw; blk < T / 16; blk += NGW) {
        const int row0 = blk * 16, b = row0 >> 12;
        f32x4 gf[4], ca[4], cb[4];
#pragma unroll
        for (int j = 0; j < 4; ++j) {
            gf[j] = first ? (f32x4){0.f, 0.f, 0.f, 0.f} : *((const GAS f32x4*)(mod + ((size_t)lprev * NB + b) * 6 * D + 5 * D) + C.lane + 64 * j);
            if (FINAL) { ca[j] = *((const GAS f32x4*)p.final_gain + C.lane + 64 * j); cb[j] = (f32x4){0.f, 0.f, 0.f, 0.f}; }
            else { const GAS float* m = mod + ((size_t)layer * NB + b) * 6 * D;
                const f32x4 g = *((const GAS f32x4*)(p.norm_gain + (size_t)layer * 2 * D) + C.lane + 64 * j); const f32x4 sc = *((const GAS f32x4*)(m + D) + C.lane + 64 * j);
                ca[j] = g * (1.f + sc); cb[j] = *((const GAS f32x4*)m + C.lane + 64 * j); } }
#pragma unroll 1
        for (int r4 = 0; r4 < 16; r4 += 4) {
            f32x4 v[4][4]; u32x2 ya[4][4], yc[4][4];
#pragma unroll
            for (int q = 0; q < 4; ++q) { const int row = row0 + r4 + q;
                if (first) { const GAS f32x4* xr = (const GAS f32x4*)(p.x + (size_t)row * D) + C.lane;
#pragma unroll
                    for (int j = 0; j < 4; ++j) v[q][j] = __builtin_nontemporal_load(xr + 64 * j);
                } else { const GAS u32x2* xr = (const GAS u32x2*)(XB + (size_t)row * D) + C.lane;
#pragma unroll
                    for (int j = 0; j < 4; ++j) { const u32x2 t = xr[64 * j]; v[q][j] = (f32x4){bflo(t.x), bfhi(t.x), bflo(t.y), bfhi(t.y)}; }
                    const GAS u32x2* y0 = (const GAS u32x2*)(YB + (size_t)(2 * row) * D) + C.lane; const GAS u32x2* y1 = (const GAS u32x2*)(YB + (size_t)(2 * row + 1) * D) + C.lane;
#pragma unroll
                    for (int j = 0; j < 4; ++j) { ya[q][j] = __builtin_nontemporal_load(y0 + 64 * j); yc[q][j] = __builtin_nontemporal_load(y1 + 64 * j); } } }
#pragma unroll
            for (int q = 0; q < 4; ++q) { const int row = row0 + r4 + q;
                if (!first) {
#pragma unroll
                    for (int j = 0; j < 4; ++j) { const u32x2 a = ya[q][j], c2 = yc[q][j];
                        v[q][j][0] += gf[j][0] * (bflo(a.x) + bflo(c2.x)); v[q][j][1] += gf[j][1] * (bfhi(a.x) + bfhi(c2.x)); v[q][j][2] += gf[j][2] * (bflo(a.y) + bflo(c2.y)); v[q][j][3] += gf[j][3] * (bfhi(a.y) + bfhi(c2.y)); } }
                float s2 = 0.f;
#pragma unroll
                for (int j = 0; j < 4; ++j) s2 += (v[q][j][0] * v[q][j][0] + v[q][j][1] * v[q][j][1]) + (v[q][j][2] * v[q][j][2] + v[q][j][3] * v[q][j][3]);
                const float rstd = rsqrtf(wave_sum(s2) * (1.f / D) + NORM_EPS);
                if (FINAL) { GAS f32x4* o = (GAS f32x4*)(p.out + (size_t)row * D) + C.lane;
#pragma unroll
                    for (int j = 0; j < 4; ++j) o[64 * j] = v[q][j] * rstd * ca[j];
                } else {
                    GAS u32x2* xo = (GAS u32x2*)(XB + (size_t)row * D) + C.lane; GAS u32x2* ho = (GAS u32x2*)(H + (size_t)row * D) + C.lane;
#pragma unroll
                    for (int j = 0; j < 4; ++j) { if (!DRY) { u32x2 xs; xs.x = pk2(v[q][j][0], v[q][j][1]); xs.y = pk2(v[q][j][2], v[q][j][3]); xo[64 * j] = xs; }
                        const f32x4 h = v[q][j] * rstd * ca[j] + cb[j]; u32x2 o; o.x = pk2(h[0], h[1]); o.y = pk2(h[2], h[3]); ho[64 * j] = o; } } }
        }
    }
}

template <bool DRY = false>
__device__ __forceinline__ void route_phase(const Params& p, const Ctx& C, int layer) {
    LAS float* wr_l = (LAS float*)C.lds;
    LAS int* lcnt = (LAS int*)(C.lds + 65536);
    LAS int* lbase = lcnt + 16;
    LAS int* rinfo = lcnt + 32;
    LAS float* rgate = (LAS float*)(rinfo + 256);
    const GAS float* mod = (const GAS float*)(p.ws + WS_MOD);
    GAS bf16_t* H = (GAS bf16_t*)(p.ws + WS_H);
    GAS unsigned* cnt = (GAS unsigned*)(p.ws + WS_CTL) + CW_CNT + layer * 16;
    GAS int* lista = (GAS int*)(p.ws + WS_LISTA); GAS float* listw = (GAS float*)(p.ws + WS_LISTW);
    { f32x4 wv[8];
#pragma unroll
      for (int k = 0; k < 8; ++k) wv[k] = *((const GAS f32x4*)p.w_router + C.tid + 512 * k);
#pragma unroll
      for (int k = 0; k < 8; ++k) { const int i = 4 * (C.tid + 512 * k);
#pragma unroll
          for (int q = 0; q < 4; ++q) wr_l[((i & 15) + q) * D + (i >> 4)] = wv[k][q]; } }
    float rb[16];
#pragma unroll
    for (int e = 0; e < 16; ++e) rb[e] = p.router_bias[e];
    for (int blk = C.bid; blk < T / 128; blk += C.G) {
        if (C.tid < 16) lcnt[C.tid] = 0;
        __syncthreads();
        const int b = (blk * 128) >> 12;
        f32x4 ca[4], cb[4];
        { const GAS float* m = mod + ((size_t)layer * NB + b) * 6 * D;
#pragma unroll
          for (int j = 0; j < 4; ++j) { const f32x4 g = *((const GAS f32x4*)(p.norm_gain + (size_t)layer * 2 * D + D) + C.lane + 64 * j); const f32x4 sc = *((const GAS f32x4*)(m + 4 * D) + C.lane + 64 * j);
              ca[j] = g * (1.f + sc); cb[j] = *((const GAS f32x4*)(m + 3 * D) + C.lane + 64 * j); } }
#pragma unroll 1
        for (int rr = 0; rr < 16; rr += 2) {
            f32x4 v[2][4];
#pragma unroll
            for (int q = 0; q < 2; ++q) { const GAS u32x2* xr = (const GAS u32x2*)((const GAS bf16_t*)(p.ws + WS_XB) + (size_t)(blk * 128 + C.wave * 16 + rr + q) * D) + C.lane;
#pragma unroll
                for (int j = 0; j < 4; ++j) { const u32x2 t = xr[64 * j]; v[q][j] = (f32x4){bflo(t.x), bfhi(t.x), bflo(t.y), bfhi(t.y)}; } }
#pragma unroll
            for (int q = 0; q < 2; ++q) {
                const int rl = C.wave * 16 + rr + q, row = blk * 128 + rl;
                float s2 = 0.f;
#pragma unroll
                for (int j = 0; j < 4; ++j) s2 += (v[q][j][0] * v[q][j][0] + v[q][j][1] * v[q][j][1]) + (v[q][j][2] * v[q][j][2] + v[q][j][3] * v[q][j][3]);
                const float rstd = rsqrtf(wave_sum(s2) * (1.f / D) + NORM_EPS);
                GAS u32x2* ho = (GAS u32x2*)(H + (size_t)row * D) + C.lane;
                float lg[16];
#pragma unroll
                for (int e = 0; e < 16; ++e) lg[e] = 0.f;
#pragma unroll
                for (int j = 0; j < 4; ++j) { const f32x4 h = v[q][j] * rstd * ca[j] + cb[j]; u32x2 o; o.x = pk2(h[0], h[1]); o.y = pk2(h[2], h[3]); ho[64 * j] = o;
#pragma unroll
                    for (int e = 0; e < 16; ++e) { const f32x4 w4 = *(const LAS f32x4*)(wr_l + e * D + 4 * (C.lane + 64 * j)); lg[e] += (h[0] * w4[0] + h[1] * w4[1]) + (h[2] * w4[2] + h[3] * w4[3]); } }
                float r8[8], r4[4], r2[2], r1;
                { const bool hi = (C.lane & 32) != 0;
#pragma unroll
                  for (int k = 0; k < 8; ++k) { const float keep = hi ? lg[k + 8] : lg[k], send = hi ? lg[k] : lg[k + 8]; r8[k] = keep + __shfl_xor(send, 32); } }
                { const bool hi = (C.lane & 16) != 0;
#pragma unroll
                  for (int k = 0; k < 4; ++k) { const float keep = hi ? r8[k + 4] : r8[k], send = hi ? r8[k] : r8[k + 4]; r4[k] = keep + __shfl_xor(send, 16); } }
                { const bool hi = (C.lane & 8) != 0;
#pragma unroll
                  for (int k = 0; k < 2; ++k) { const float keep = hi ? r4[k + 2] : r4[k], send = hi ? r4[k] : r4[k + 2]; r2[k] = keep + __shfl_xor(send, 8); } }
                { const bool hi = (C.lane & 4) != 0; const float keep = hi ? r2[1] : r2[0], send = hi ? r2[0] : r2[1]; r1 = keep + __shfl_xor(send, 4); }
                r1 += __shfl_xor(r1, 2); r1 += __shfl_xor(r1, 1);
                const float myscore = sigmoidf_(r1);
                float sc16[16];
#pragma unroll
                for (int e = 0; e < 16; ++e) sc16[e] = __shfl(myscore, 4 * e);
                float sel[16];
#pragma unroll
                for (int e = 0; e < 16; ++e) sel[e] = sc16[e] + rb[e];
                int grp = 0; float best = -1e30f;
#pragma unroll
                for (int g = 0; g < 4; ++g) { float m1 = -1e30f, m2 = -1e30f;
#pragma unroll
                    for (int t = 0; t < 4; ++t) { const float s = sel[4 * g + t]; if (s > m1) { m2 = m1; m1 = s; } else if (s > m2) m2 = s; }
                    const float gs = m1 + m2; if (gs > best) { best = gs; grp = g; } }
                int i1 = 0, i2 = 0; float m1 = -1e30f, m2 = -1e30f; float s1 = 0.f, s2g = 0.f;
#pragma unroll
                for (int e = 0; e < 16; ++e) { if ((e >> 2) == grp) { const float s = sel[e]; if (s > m1) { m2 = m1; i2 = i1; s2g = s1; m1 = s; i1 = e; s1 = sc16[e]; } else if (s > m2) { m2 = s; i2 = e; s2g = sc16[e]; } } }
                const float inv = 1.f / (s1 + s2g);
                if (C.lane == 0 && !DRY) {
                    const int sl1 = __hip_atomic_fetch_add(&lcnt[i1], 1, __ATOMIC_RELAXED, __HIP_MEMORY_SCOPE_WORKGROUP), sl2 = __hip_atomic_fetch_add(&lcnt[i2], 1, __ATOMIC_RELAXED, __HIP_MEMORY_SCOPE_WORKGROUP);
                    rinfo[rl * 2 + 0] = i1 | (sl1 << 8); rinfo[rl * 2 + 1] = i2 | (sl2 << 8); rgate[rl * 2 + 0] = s1 * inv; rgate[rl * 2 + 1] = s2g * inv;
                }
            }
        }
        __syncthreads();
        if (C.tid < 16 && !DRY) lbase[C.tid] = (int)__hip_atomic_fetch_add(&cnt[C.tid], (unsigned)lcnt[C.tid], __ATOMIC_RELAXED, __HIP_MEMORY_SCOPE_AGENT);
        __syncthreads();
        if (C.tid < 256 && !DRY) { const int rl = C.tid >> 1, k = C.tid & 1; const int inf = rinfo[C.tid]; const int e = inf & 255, sl = inf >> 8;
            const size_t idx = (size_t)e * T + lbase[e] + sl; lista[idx] = (blk * 128 + rl) * 2 + k; listw[idx] = rgate[C.tid]; }
        __syncthreads();
    }
}
struct EpiU {
    static constexpr bool PERM = true;
    GAS bf16_t* O;
    __device__ __forceinline__ void operator()(const f32x4 (&acc)[2][2][4][2], const pg8::Unit& u, int wr, int wc, int fr, int fq) const {
        const int row0 = u.pm * 256 + wr * 64 + fr, col0 = u.pn * 256 + wc * 32 + 8 * fq;
#pragma unroll
        for (int ai = 0; ai < 2; ++ai)
#pragma unroll
            for (int m = 0; m < 4; ++m) { GAS bf16_t* rowp = O + (size_t)(row0 + ai * 128 + m * 16) * UPITCH + col0;
#pragma unroll
                for (int bj = 0; bj < 2; ++bj) { const f32x4 v0 = acc[ai][bj][m][0], v1 = acc[ai][bj][m][1];
                    u32x4 o; o.x = pk2(v0[0], v0[1]); o.y = pk2(v0[2], v0[3]); o.z = pk2(v1[0], v1[1]); o.w = pk2(v1[2], v1[3]);
                    *(GAS u32x4*)(rowp + bj * 128) = o; } }
    }
};
struct EpiOut {
    static constexpr bool PERM = true;
    GAS bf16_t* X; const GAS float* gm;
    __device__ __forceinline__ void operator()(const f32x4 (&acc)[2][2][4][2], const pg8::Unit& u, int wr, int wc, int fr, int fq) const {
        const int row0 = u.pm * 256 + wr * 64 + fr, col0 = u.pn * 256 + wc * 32 + 8 * fq;
        const GAS float* g = gm + (size_t)(row0 >> 12) * 6 * D + col0;
        f32x4 gv[2][2];
#pragma unroll
        for (int bj = 0; bj < 2; ++bj)
#pragma unroll
            for (int n = 0; n < 2; ++n) gv[bj][n] = *(const GAS f32x4*)(g + bj * 128 + n * 4);
        u32x4 xr[2][4][2];
#pragma unroll
        for (int ai = 0; ai < 2; ++ai)
#pragma unroll
            for (int m = 0; m < 4; ++m) { const GAS bf16_t* rowp = X + (size_t)(row0 + ai * 128 + m * 16) * D + col0;
#pragma unroll
                for (int bj = 0; bj < 2; ++bj) xr[ai][m][bj] = *(const GAS u32x4*)(rowp + bj * 128); }
        asm volatile("" ::: "memory");
#pragma unroll
        for (int ai = 0; ai < 2; ++ai)
#pragma unroll
            for (int m = 0; m < 4; ++m) { GAS bf16_t* rowp = X + (size_t)(row0 + ai * 128 + m * 16) * D + col0;
#pragma unroll
                for (int bj = 0; bj < 2; ++bj) { GAS u32x4* q = (GAS u32x4*)(rowp + bj * 128); float xv[8]; unpack8(xr[ai][m][bj], xv);
                    const f32x4 a0 = acc[ai][bj][m][0] * gv[bj][0], a1 = acc[ai][bj][m][1] * gv[bj][1];
                    xv[0] += a0[0]; xv[1] += a0[1]; xv[2] += a0[2]; xv[3] += a0[3]; xv[4] += a1[0]; xv[5] += a1[1]; xv[6] += a1[2]; xv[7] += a1[3];
                    *q = pack8(xv); } }
    }
};
struct EpiUp {
    static constexpr bool PERM = true;
    GAS bf16_t* ACT;
    __device__ __forceinline__ void operator()(const f32x4 (&acc)[2][2][4][2], const pg8::Unit& u, int wr, int wc, int fr, int fq) const {
        const int row0 = u.pm * 256 + wr * 64 + fr, col0 = u.pn * 128 + wc * 32 + 8 * fq;
#pragma unroll
        for (int ai = 0; ai < 2; ++ai)
#pragma unroll
            for (int m = 0; m < 4; ++m) { GAS bf16_t* rowp = ACT + (size_t)(row0 + ai * 128 + m * 16) * DEXP + col0;
                float r[8];
#pragma unroll
                for (int n = 0; n < 2; ++n)
#pragma unroll
                    for (int q = 0; q < 4; ++q) r[4 * n + q] = siluf_(acc[ai][0][m][n][q]) * acc[ai][1][m][n][q];
                *(GAS u32x4*)rowp = pack8(r); }
    }
};
struct EpiDown {
    static constexpr bool PERM = true;
    GAS bf16_t* YB; const GAS int* lista; const GAS float* listw;
    __device__ __forceinline__ void operator()(const f32x4 (&acc)[2][2][4][2], const pg8::Unit& u, int wr, int wc, int fr, int fq) const {
        const int rl0 = wr * 64 + fr, col0 = u.pn * 256 + wc * 32 + 8 * fq;
        const GAS int* la = lista + ((size_t)u.e * T + (size_t)u.ml * 256); const GAS float* lw = listw + ((size_t)u.e * T + (size_t)u.ml * 256);
        const int nrows = u.pm;
        int a8[8]; float w8[8];
#pragma unroll
        for (int k = 0; k < 8; ++k) { const int rl = rl0 + (k >> 2) * 128 + (k & 3) * 16; a8[k] = la[rl]; w8[k] = lw[rl]; }
#pragma unroll
        for (int k = 0; k < 8; ++k) asm volatile("" :: "v"(a8[k]), "v"(w8[k]));
#pragma unroll
        for (int ai = 0; ai < 2; ++ai)
#pragma unroll
            for (int m = 0; m < 4; ++m) { const int rl = rl0 + ai * 128 + m * 16;
                if (rl < nrows) { const int a = a8[ai * 4 + m]; const float w = w8[ai * 4 + m]; GAS bf16_t* rowp = YB + (size_t)a * D + col0;
#pragma unroll
                    for (int bj = 0; bj < 2; ++bj) { const f32x4 v0 = acc[ai][bj][m][0] * w, v1 = acc[ai][bj][m][1] * w;
                        u32x4 o; o.x = pk2(v0[0], v0[1]); o.y = pk2(v0[2], v0[3]); o.z = pk2(v1[0], v1[1]); o.w = pk2(v1[2], v1[3]);
                        *(GAS u32x4*)(rowp + bj * 128) = o; } } }
    }
};
struct MoeOrder {
    const GAS char* A; const GAS char* Bt; int K; size_t estride; const LAS int* tab; const GAS int* lista; int G, c; bool down;
    __device__ bool next(int i, pg8::Unit& u) const {
        const int L = i * G + c; const int NT = __builtin_amdgcn_readfirstlane(tab[16]);
        if (L >= NT * 4) return false;
        const int mt = L >> 2; const int e = __builtin_amdgcn_readfirstlane(tab[34 + mt]);
        const int t0 = __builtin_amdgcn_readfirstlane(tab[e]), cn = __builtin_amdgcn_readfirstlane(tab[17 + e]);
        u.pn = L & 3; u.e = e; u.ml = mt - t0;
        const int left = cn - u.ml * 256;
        u.pm = down ? (left < 256 ? left : 256) : mt;
        return true;
    }
    __device__ __forceinline__ const GAS char* a_base(const pg8::Unit& u) const { return down ? A + (size_t)(__builtin_amdgcn_readfirstlane(tab[u.e]) + u.ml) * 256 * K * 2 : A; }
    __device__ __forceinline__ const GAS char* b_base(const pg8::Unit& u) const { return Bt + (size_t)u.e * estride + (size_t)u.pn * 256 * K * 2; }
    __device__ __forceinline__ void a_rows(const pg8::Unit& u, int tz, unsigned (&off)[2][2]) const {
        const int n = __builtin_amdgcn_readfirstlane(tab[17 + u.e]) - u.ml * 256; const GAS int* lp = lista + ((size_t)u.e * T + (size_t)u.ml * 256);
#pragma unroll
        for (int i = 0; i < 2; ++i) { int R, Cc; pg8::stage_rc(tz * 16 + i * 8192, R, Cc);
#pragma unroll
            for (int h = 0; h < 2; ++h) { const unsigned r = (unsigned)(128 * h + R); const int tok = lp[((int)r < n) ? r : 0u] >> 1; off[h][i] = (unsigned)tok * (unsigned)(K * 2) + (unsigned)Cc * 2u; } }
    }
    static constexpr int GROWS = 133120;
    __device__ __forceinline__ void a_rows_issue(LAS unsigned char* lds, const pg8::Unit& u, int tz) const {
        const int n = __builtin_amdgcn_readfirstlane(tab[17 + u.e]) - u.ml * 256; const GAS int* lp = lista + ((size_t)u.e * T + (size_t)u.ml * 256);
        const int wv = __builtin_amdgcn_readfirstlane(tz >> 6);
#pragma unroll
        for (int i = 0; i < 2; ++i) { int R, Cc; pg8::stage_rc(tz * 16 + i * 8192, R, Cc);
#pragma unroll
            for (int h = 0; h < 2; ++h) { const unsigned r = (unsigned)(128 * h + R);
                __builtin_amdgcn_global_load_lds((const GAS unsigned*)(lp + (((int)r < n) ? r : 0u)), (LAS unsigned*)(lds + GROWS + (2 * h + i) * 2048 + wv * 256), 4, 0, 0); } }
    }
    __device__ __forceinline__ void a_rows_finish(const LAS unsigned char* lds, int tz, unsigned (&off)[2][2]) const {
#pragma unroll
        for (int i = 0; i < 2; ++i) { int R, Cc; pg8::stage_rc(tz * 16 + i * 8192, R, Cc);
#pragma unroll
            for (int h = 0; h < 2; ++h) { const int raw = *(const LAS int*)(lds + GROWS + (2 * h + i) * 2048 + tz * 4); off[h][i] = (unsigned)(raw >> 1) * (unsigned)(K * 2) + (unsigned)Cc * 2u; } }
    }
};
__device__ __forceinline__ void moe_table(const Params& p, const Ctx& C, int layer, LAS int* tab) {
    if (C.tid < 16) { const GAS unsigned* cnt = (const GAS unsigned*)(p.ws + WS_CTL) + CW_CNT + layer * 16;
        tab[17 + C.tid] = (int)__hip_atomic_load(cnt + C.tid, __ATOMIC_RELAXED, __HIP_MEMORY_SCOPE_AGENT); }
    __syncthreads();
    if (C.tid == 0) { int acc = 0;
        for (int e = 0; e < 16; ++e) { const int n = tab[17 + e]; tab[e] = acc; acc += (n + 255) >> 8; }
        tab[16] = acc; }
    __syncthreads();
    for (int t = C.tid; t < tab[16]; t += 512) { int e = 0;
#pragma unroll
        for (int q = 1; q < 16; ++q) e += (tab[q] <= t) ? 1 : 0;
        tab[34 + t] = e; }
    __syncthreads();
}
constexpr size_t MX_BASE = WS_H;
constexpr size_t MX_AVAIL = WS_END - WS_H;
constexpr size_t M64 = (size_t)64 * 64;
constexpr size_t RW_PT = 0, RW_QT = RW_PT + 4096 * M64 * 2, RW_RH = RW_QT + 4096 * M64 * 2, RW_MH = RW_RH + 4096 * M64 * 2, RW_S = RW_MH + 4096 * M64 * 2, RW_BON = RW_S + 4096 * M64 * 2;
constexpr size_t GX_D_E = RW_BON + 4096 * 64 * 4;
constexpr size_t GX_S_E = GX_D_E + (size_t)2048 * 128 * 64 * 2;
constexpr size_t GX_DEC_E = GX_S_E + (size_t)2048 * 128 * 64 * 2;
constexpr size_t MX_END_E = GX_DEC_E + (size_t)2048 * 64 * 4;
constexpr size_t GX_D_O = 0, GX_S_O = GX_D_O + (size_t)2048 * 128 * 64 * 2, GX_DEC_O = GX_S_O + (size_t)2048 * 128 * 64 * 2;
constexpr size_t SX_ST = GX_DEC_O + (size_t)2048 * 64 * 4;
constexpr size_t SX_S = SX_ST + 4096 * M64 * 2;
constexpr size_t SX_DEC = SX_S + 4096 * M64 * 2;
constexpr size_t SX_BM = SX_DEC + 4096 * 4;
constexpr size_t MX_END_O = SX_BM + (size_t)1024 * M64 * 2;
static_assert(MX_END_E <= WS_XB - WS_H && MX_END_O <= WS_PGU - WS_H, "mixer scratch overflow");

template <int NC, bool LDSB = false>
__device__ __forceinline__ void lds_cumsum64(LAS float* tile, int stride, LAS float* seg, int tid) {
    const int n = tid % NC, s = tid / NC; const bool act = tid < 8 * NC;
    float v[8];
    if (act) {
#pragma unroll
        for (int i = 0; i < 8; ++i) v[i] = tile[(8 * s + i) * stride + n];
#pragma unroll
        for (int i = 1; i < 8; ++i) v[i] += v[i - 1];
        seg[s * NC + n] = v[7];
    }
    if constexpr (LDSB) LDS_BARRIER(); else __syncthreads();
    if (act) { float off = 0.f;
#pragma unroll
        for (int q = 0; q < 8; ++q) off += (q < s) ? seg[q * NC + n] : 0.f;
#pragma unroll
        for (int i = 0; i < 8; ++i) tile[(8 * s + i) * stride + n] = v[i] + off; }
    if constexpr (LDSB) LDS_BARRIER(); else __syncthreads();
}

constexpr int GL_GT = 0, GL_SEG = 17408, GL_AUP = 19456, GL_KD = 24576, GL_KM = 24576, GL_QM = 33792, GL_Q2 = 43008, GL_VT = 52224, GL_ST = 69632, GL_PL = 88064, GL_RS = 97280;

template <bool HGRN>
__device__ __forceinline__ void gla_stage_g(const Params& p, const Ctx& C, int layer, int h, const u32x4 a0, const u32x4 a1, const u32x4 kk, float (&kreg)[8]) {
    const int j = C.tid >> 3, cg = C.tid & 7, jl = layer >> 1;
    LAS float* Gt = (LAS float*)(C.lds + GL_GT);
    float g[8];
    if constexpr (HGRN) {
        float fr[8]; unpack8(a0, fr);
        const GAS float* lb = (const GAS float*)(p.ws + WS_LB) + layer * 256 + 64 * h + 8 * cg;
#pragma unroll
        for (int q = 0; q < 8; ++q) { const float l = lb[q]; const float f = l + (1.f - l) * sigmoidf_(fr[q]); g[q] = __logf(f); kreg[q] = 1.f - f; }
    } else {
        LAS float* AUP = (LAS float*)(C.lds + GL_AUP);
        float ad[16]; { float t0[8], t1[8]; unpack8(a0, t0); unpack8(a1, t1);
#pragma unroll
            for (int q = 0; q < 8; ++q) { ad[q] = t0[q]; ad[8 + q] = t1[q]; } }
#pragma unroll
        for (int q = 0; q < 8; ++q) { float x = AUP[16 * 64 + 8 * cg + q];
#pragma unroll
            for (int r = 0; r < 16; ++r) x += ad[r] * AUP[r * 64 + 8 * cg + q];
            g[q] = logsigmoidf_(x) * (1.f / 16.f); }
        unpack8(kk, kreg);
    }
    *(LAS f32x4*)(Gt + j * FS + 8 * cg) = (f32x4){g[0], g[1], g[2], g[3]};
    *(LAS f32x4*)(Gt + j * FS + 8 * cg + 4) = (f32x4){g[4], g[5], g[6], g[7]};
    (void)jl;
}
template <bool HGRN>
__device__ __forceinline__ void gla_stage_aup(const Params& p, const Ctx& C, int layer, int h) {
    if constexpr (!HGRN) { const int jl = layer >> 1; LAS float* AUP = (LAS float*)(C.lds + GL_AUP);
        for (int i = C.tid; i < 16 * 64; i += 512) AUP[i] = p.b_alpha_up[(size_t)jl * 16 * 256 + (i >> 6) * 256 + 64 * h + (i & 63)];
        if (C.tid < 64) AUP[16 * 64 + C.tid] = p.b_alpha_bias[jl * 256 + 64 * h + C.tid]; }
}
__device__ __forceinline__ void gla_stage_v(const Ctx& C, const GAS bf16_t* urow0, int vcol) {
    const int j = C.tid >> 3, cg = C.tid & 7;
    const GAS u32x4* src = (const GAS u32x4*)(urow0 + (size_t)j * UPITCH + vcol + 16 * cg);
    LAS u32x4* dst = (LAS u32x4*)(C.lds + GL_VT + j * TS2 + 32 * cg);
    dst[0] = src[0]; dst[1] = src[1];
}

struct GlPre { u32x4 a0, a1, k, v0, v1; };
template <bool HGRN>
__device__ __forceinline__ void gla_prefetch1(const Params& p, int tid, int item, GlPre& pre) {
    const int h = item & 3, bc = item >> 2, j = tid >> 3, cg = tid & 7;
    const GAS bf16_t* ur = (const GAS bf16_t*)(p.ws + WS_U) + ((size_t)bc * 64 + j) * UPITCH;
    if constexpr (HGRN) { pre.a0 = *(const GAS u32x4*)(ur + HG_F + 64 * h + 8 * cg); pre.a1 = pre.a0; pre.k = pre.a0; }
    else { pre.a0 = *(const GAS u32x4*)(ur + GL_AD); pre.a1 = *(const GAS u32x4*)(ur + GL_AD + 8); pre.k = *(const GAS u32x4*)(ur + GL_K + 64 * h + 8 * cg); }
    const GAS u32x4* vs = (const GAS u32x4*)(ur + (HGRN ? HG_I : GL_V) + 128 * h + 16 * cg); pre.v0 = vs[0]; pre.v1 = vs[1];
}
template <bool HGRN>
__device__ __forceinline__ void gla_pass1_item(const Params& p, const Ctx& C0, int layer, int item, int next_item, GlPre& pre) {
    Ctx C = C0; asm volatile("" : "+s"(C.wave)); asm volatile("" : "+v"(C.tid)); C.lane = C.tid & 63;
    const int h = item & 3, bc = item >> 2;
    const GAS bf16_t* urow0 = (const GAS bf16_t*)(p.ws + WS_U) + (size_t)bc * 64 * UPITCH;
    LAS float* Gt = (LAS float*)(C.lds + GL_GT);
    const int j = C.tid >> 3, cg = C.tid & 7;
    GAS unsigned char* mx = p.ws + MX_BASE;
    GAS bf16_t* Dg = (GAS bf16_t*)(mx + (HGRN ? GX_D_O : GX_D_E)) + (size_t)item * 128 * 64;
    GAS float* DECg = (GAS float*)(mx + (HGRN ? GX_DEC_O : GX_DEC_E)) + (size_t)item * 64;
    float kreg[8];
    gla_stage_g<HGRN>(p, C, layer, h, pre.a0, pre.a1, pre.k, kreg);
    { LAS u32x4* dst = (LAS u32x4*)(C.lds + GL_VT + j * TS2 + 32 * cg); dst[0] = pre.v0; dst[1] = pre.v1; }
    gla_prefetch1<HGRN>(p, C.tid, next_item, pre);
    LDS_BARRIER();
    lds_cumsum64<64, true>(Gt, FS, (LAS float*)(C.lds + GL_SEG), C.tid);
    { float kd[8]; float bjv[8];
#pragma unroll
      for (int q = 0; q < 8; ++q) { const float bj = Gt[j * FS + 8 * cg + q], bl = Gt[63 * FS + 8 * cg + q]; bjv[q] = bj; kd[q] = kreg[q] * __expf(bl - bj); if (j == 63) DECg[8 * cg + q] = __expf(bl); }
      *(LAS u32x4*)(C.lds + GL_KD + j * TS + 16 * cg) = pack8(kd);
      GAS float* Gg = (GAS float*)((GAS bf16_t*)(p.ws + WS_Y) + ((size_t)bc * 64 + j) * D + (HGRN ? 0 : 512) + 128 * h) + 8 * cg;
      *(GAS f32x4*)Gg = (f32x4){bjv[0], bjv[1], bjv[2], bjv[3]}; *(GAS f32x4*)(Gg + 4) = (f32x4){bjv[4], bjv[5], bjv[6], bjv[7]}; }
    LDS_BARRIER();
    { const int e0 = 16 * C.wave; const LAS unsigned char* Vt = C.lds + GL_VT; const LAS unsigned char* Kd = C.lds + GL_KD;
      bf16x8 bv[2], ak[2][4]; tf_2x1<TS2>(Vt, 0, e0, C.lane, bv); tf_2x4<TS>(Kd, 0, 0, C.lane, ak);
      f32x4 acc4[4];
#pragma unroll
      for (int bt = 0; bt < 4; ++bt) acc4[bt] = (f32x4){0.f, 0.f, 0.f, 0.f};
#pragma unroll
      for (int ks = 0; ks < 2; ++ks)
#pragma unroll
          for (int bt = 0; bt < 4; ++bt) acc4[bt] = MFMA16(ak[ks][bt], bv[ks], acc4[bt]);
      SETTLE4(acc4[0], acc4[1], acc4[2], acc4[3]);
#pragma unroll
      for (int bt = 0; bt < 4; ++bt) { const f32x4 acc = acc4[bt];
          { u32x2 o; o.x = pk2(acc[0], acc[1]); o.y = pk2(acc[2], acc[3]); *(GAS u32x2*)(Dg + (size_t)(e0 + (C.lane & 15)) * 64 + 16 * bt + 4 * (C.lane >> 4)) = o; } } }
    LDS_BARRIER();
}

template <bool HGRN>
__device__ __forceinline__ void gla_pass2_job(const Params& p, int job, int lane) {
    GAS unsigned char* mx = p.ws + MX_BASE;
    const int bh = job >> 5, slab = job & 31, b = bh >> 2, h = bh & 3;
    const int el = slab * 256 + lane * 4;
    const int d0 = el & 63;
    f32x4 S = {0.f, 0.f, 0.f, 0.f};
    const GAS bf16_t* Dp = (const GAS bf16_t*)(mx + (HGRN ? GX_D_O : GX_D_E)); const GAS float* Cp = (const GAS float*)(mx + (HGRN ? GX_DEC_O : GX_DEC_E)); GAS bf16_t* Sp = (GAS bf16_t*)(mx + (HGRN ? GX_S_O : GX_S_E));
#pragma unroll 1
    for (int c0 = 0; c0 < 64; c0 += 8) {
        f32x4 Dv[8], dc[8];
#pragma unroll
        for (int q = 0; q < 8; ++q) { const size_t item = ((size_t)(b * 64 + c0 + q) * 4 + h); { const u32x2 d2 = __builtin_nontemporal_load((const GAS u32x2*)(Dp + item * 8192 + el)); Dv[q] = (f32x4){bflo(d2.x), bfhi(d2.x), bflo(d2.y), bfhi(d2.y)}; } dc[q] = *(const GAS f32x4*)(Cp + item * 64 + d0); }
#pragma unroll
        for (int q = 0; q < 8; ++q) { const size_t item = ((size_t)(b * 64 + c0 + q) * 4 + h);
            u32x2 o; o.x = pk2(S[0], S[1]); o.y = pk2(S[2], S[3]);
            *(GAS u32x2*)(Sp + item * 8192 + el) = o;
            S = S * dc[q] + Dv[q]; }
    }
}

struct Gl3Pre { f32x4 gb0, gb1, gr0, gr1; u32x4 kf, q, v0, v1, s0, s1; };
template <bool HGRN>
__device__ __forceinline__ void gla_prefetch3(const Params& p, int tid, int item, Gl3Pre& pre) {
    const int h = item & 3, bc = item >> 2, j = tid >> 3, cg = tid & 7;
    const GAS bf16_t* Y = (const GAS bf16_t*)(p.ws + WS_Y);
    const GAS float* Gg = (const GAS float*)(Y + ((size_t)bc * 64 + j) * D + (HGRN ? 0 : 512) + 128 * h) + 8 * cg;
    const GAS float* Gr = (const GAS float*)(Y + ((size_t)bc * 64 + 31) * D + (HGRN ? 0 : 512) + 128 * h) + 8 * cg;
    pre.gb0 = *(const GAS f32x4*)Gg; pre.gb1 = *(const GAS f32x4*)(Gg + 4); pre.gr0 = *(const GAS f32x4*)Gr; pre.gr1 = *(const GAS f32x4*)(Gr + 4);
    const GAS bf16_t* ur = (const GAS bf16_t*)(p.ws + WS_U) + ((size_t)bc * 64 + j) * UPITCH;
    pre.kf = *(const GAS u32x4*)(ur + (HGRN ? HG_F : GL_K) + 64 * h + 8 * cg);
    pre.q = *(const GAS u32x4*)(ur + (HGRN ? HG_Q : GL_Q) + 64 * h + 8 * cg);
    const GAS u32x4* vs = (const GAS u32x4*)(ur + (HGRN ? HG_I : GL_V) + 128 * h + 16 * cg); pre.v0 = vs[0]; pre.v1 = vs[1];
    const GAS bf16_t* Sg = (const GAS bf16_t*)(p.ws + MX_BASE + (HGRN ? GX_S_O : GX_S_E)) + (size_t)item * 8192;
    pre.s0 = __builtin_nontemporal_load((const GAS u32x4*)(Sg + (size_t)(tid >> 3) * 64 + 8 * (tid & 7)));
    pre.s1 = __builtin_nontemporal_load((const GAS u32x4*)(Sg + (size_t)((tid + 512) >> 3) * 64 + 8 * (tid & 7)));
}
template <bool HGRN>
__device__ __forceinline__ void gla_pass3_item(const Params& p, const Ctx& C0, int layer, int item, int next_item, Gl3Pre& pre) {
    Ctx C = C0; asm volatile("" : "+s"(C.wave)); asm volatile("" : "+v"(C.tid)); C.lane = C.tid & 63;
    const int h = item & 3, bc = item >> 2, jl = layer >> 1;
    const GAS bf16_t* urow0 = (const GAS bf16_t*)(p.ws + WS_U) + (size_t)bc * 64 * UPITCH;
    GAS bf16_t* Y = (GAS bf16_t*)(p.ws + WS_Y);
    LAS float* Gt = (LAS float*)(C.lds + GL_GT);
    const int j = C.tid >> 3, cg = C.tid & 7;
    GAS unsigned char* mx = p.ws + MX_BASE;
    const GAS bf16_t* Sg = (const GAS bf16_t*)(mx + (HGRN ? GX_S_O : GX_S_E)) + (size_t)item * 8192;
    u32x2 gvv[4];
    { const int at_ = C.wave & 3, eh_ = C.wave >> 2; const size_t tk_ = (size_t)bc * 64 + 16 * at_ + (C.lane & 15);
      const GAS bf16_t* gp_ = (const GAS bf16_t*)(p.ws + WS_U) + tk_ * UPITCH + (HGRN ? HG_G : GL_G) + 128 * h + 64 * eh_ + 4 * (C.lane >> 4);
#pragma unroll
      for (int et = 0; et < 4; ++et) gvv[et] = *(const GAS u32x2*)(gp_ + 16 * et); }
    float kreg[8];
    if constexpr (HGRN) {
        float fr[8]; unpack8(pre.kf, fr);
        const GAS float* lb = (const GAS float*)(p.ws + WS_LB) + layer * 256 + 64 * h + 8 * cg;
#pragma unroll
        for (int q = 0; q < 8; ++q) { const float l = lb[q]; kreg[q] = (1.f - l) * (1.f - sigmoidf_(fr[q])); }
    } else unpack8(pre.kf, kreg);
    { LAS u32x4* dst = (LAS u32x4*)(C.lds + GL_VT + j * TS2 + 32 * cg); dst[0] = pre.v0; dst[1] = pre.v1; }
    *(LAS u32x4*)(C.lds + GL_ST + (C.tid >> 3) * TS + 16 * (C.tid & 7)) = pre.s0;
    *(LAS u32x4*)(C.lds + GL_ST + ((C.tid + 512) >> 3) * TS + 16 * (C.tid & 7)) = pre.s1;
    { float qv[8]; unpack8(pre.q, qv);
      const float qs = HGRN ? 1.f : 0.125f;
      float qm[8], q2[8], km[8];
#pragma unroll
      for (int q = 0; q < 8; ++q) { const float bj = q < 4 ? pre.gb0[q & 3] : pre.gb1[q & 3], br = q < 4 ? pre.gr0[q & 3] : pre.gr1[q & 3]; const float qq = qv[q] * qs;
          qm[q] = qq * __expf(bj - br); q2[q] = qq * __expf(bj); km[q] = kreg[q] * __expf(br - bj); }
      *(LAS u32x4*)(C.lds + GL_QM + j * TS + 16 * cg) = pack8(qm);
      *(LAS u32x4*)(C.lds + GL_Q2 + j * TS + 16 * cg) = pack8(q2);
      *(LAS u32x4*)(C.lds + GL_KM + j * TS + 16 * cg) = pack8(km); }
    gla_prefetch3<HGRN>(p, C.tid, next_item, pre);
    LDS_BARRIER();
    {
      const LAS unsigned char* Qm = C.lds + GL_QM; const LAS unsigned char* Km = C.lds + GL_KM; LAS unsigned char* Pl = C.lds + GL_PL;
#pragma unroll
      for (int q = 0; q < 2; ++q) { const int id = 2 * C.wave + q, at = id >> 2, bt = id & 3; f32x4 acc = {0.f, 0.f, 0.f, 0.f};
          if (bt <= at) {
#pragma unroll
              for (int ks = 0; ks < 2; ++ks) acc = MFMA16(rf_lds(Km, TS, 16 * bt, 32 * ks, C.lane), rf_lds(Qm, TS, 16 * at, 32 * ks, C.lane), acc);
          SETTLE(acc);
              const int i = 16 * at + (C.lane & 15), j0 = 16 * bt + 4 * (C.lane >> 4);
#pragma unroll
              for (int r = 0; r < 4; ++r) acc[r] = (j0 + r <= i) ? acc[r] : 0.f; }
          st4_lds(Pl, TS, 16 * at + (C.lane & 15), 16 * bt + 4 * (C.lane >> 4), acc); } }
    LDS_BARRIER();
    { const int at = C.wave & 3, eh = C.wave >> 2, i = 16 * at + (C.lane & 15), g4 = 4 * (C.lane >> 4);
      const LAS unsigned char* Vt = C.lds + GL_VT; const LAS unsigned char* St = C.lds + GL_ST; const LAS unsigned char* Pl = C.lds + GL_PL; const LAS unsigned char* Q2 = C.lds + GL_Q2;
      LAS float* RS = (LAS float*)(C.lds + GL_RS);
      bf16x8 bp[2], bq[2];
#pragma unroll
      for (int ks = 0; ks < 2; ++ks) { bp[ks] = rf_lds(Pl, TS, 16 * at, 32 * ks, C.lane); bq[ks] = rf_lds(Q2, TS, 16 * at, 32 * ks, C.lane); }
      bf16x8 av[2][4]; tf_2x4<TS2>(Vt, 0, 64 * eh, C.lane, av);
      f32x4 acc[4]; float ss = 0.f;
      bf16x8 sf[2][4];
#pragma unroll
      for (int et = 0; et < 4; ++et) { sf[0][et] = rf_lds(St, TS, 64 * eh + 16 * et, 0, C.lane); sf[1][et] = rf_lds(St, TS, 64 * eh + 16 * et, 32, C.lane); acc[et] = (f32x4){0.f, 0.f, 0.f, 0.f}; }
#pragma unroll
      for (int ks = 0; ks < 2; ++ks) {
#pragma unroll
          for (int et = 0; et < 4; ++et) acc[et] = MFMA16(av[ks][et], bp[ks], acc[et]);
#pragma unroll
          for (int et = 0; et < 4; ++et) acc[et] = MFMA16(sf[ks][et], bq[ks], acc[et]); }
      SETTLE4(acc[0], acc[1], acc[2], acc[3]);
#pragma unroll
      for (int et = 0; et < 4; ++et) { const f32x4 a = acc[et]; ss += (a[0] * a[0] + a[1] * a[1]) + (a[2] * a[2] + a[3] * a[3]); }
      ss += __shfl_xor(ss, 16); ss += __shfl_xor(ss, 32);
      if (C.lane < 16) RS[eh * 64 + i] = ss;
      LDS_BARRIER();
      const float rstd = rsqrtf((RS[i] + RS[64 + i]) * (1.f / 128.f) + NORM_EPS);
      const GAS float* gain = (HGRN ? p.c_norm_gain : p.b_norm_gain) + jl * 128;
      const size_t tk = (size_t)bc * 64 + i;
      const GAS bf16_t* gp = (const GAS bf16_t*)(p.ws + WS_U) + tk * UPITCH + (HGRN ? HG_G : GL_G) + 128 * h;
      GAS bf16_t* yp = Y + tk * D + (HGRN ? 0 : 512) + 128 * h;
#pragma unroll
      for (int et = 0; et < 4; ++et) { const int e = 64 * eh + 16 * et + g4; const u32x2 gv = gvv[et]; const f32x4 gn = *(const GAS f32x4*)(gain + e);
          const float g0 = siluf_(bflo(gv.x)), g1 = siluf_(bfhi(gv.x)), g2 = siluf_(bflo(gv.y)), g3 = siluf_(bfhi(gv.y));
          u32x2 o; o.x = pk2(acc[et][0] * rstd * gn[0] * g0, acc[et][1] * rstd * gn[1] * g1); o.y = pk2(acc[et][2] * rstd * gn[2] * g2, acc[et][3] * rstd * gn[3] * g3);
          *(GAS u32x2*)(yp + e) = o; } }
    LDS_BARRIER();
}
constexpr int SD_BMT = 0, SD_CMT = 9216, SD_X = 18432  , SD_HS = 55296  , SD_PL = 92160  , SD_DTL = 129024  , SD_CUM = 130048  , SD_SEG = 131072  , SD_RS = 131328  ;

constexpr int SD_CW = 132096;
constexpr int SD_GN = SD_CW + 5 * 384 * 4;
constexpr int SD_HK = SD_GN + 1024;
constexpr int SD_END = SD_HK + 64;
__device__ __forceinline__ float ssd_dt_load(const Ctx& C, int grp, const GAS bf16_t* urow0) {
    const int j = (C.tid & 255) >> 2, hh = C.tid & 3, head = 4 * grp + hh;
    return bf2f(urow0[(size_t)j * UPITCH + SD_DT + head]);
}
__device__ __forceinline__ void ssd_stage_dt(const Ctx& C, float raw_in) {
    LAS float* DTL = (LAS float*)(C.lds + SD_DTL); LAS float* CUM = (LAS float*)(C.lds + SD_CUM); const LAS float* HK = (const LAS float*)(C.lds + SD_HK);
    if (C.tid < 256) { const int j = C.tid >> 2, hh = C.tid & 3;
        const float raw = raw_in + HK[hh];
        const float dt = softplusf_(raw); DTL[j * 4 + hh] = dt; CUM[j * 4 + hh] = -dt * HK[4 + hh]; }
    LDS_BARRIER();
    lds_cumsum64<4, true>(CUM, 4, (LAS float*)(C.lds + SD_SEG), C.tid);
}
__device__ __forceinline__ void ssd_load_cw(const Params& p, const Ctx& C, int layer, int grp) {
    const int jl = layer >> 1; LAS float* cwl = (LAS float*)(C.lds + SD_CW);
    for (int i = C.tid; i < 5 * 384; i += 512) { const int tap = i / 384, lc = i % 384;
        const int ch = lc < 256 ? 256 * grp + lc : (lc < 320 ? 512 + 64 * grp + (lc - 256) : 640 + 64 * grp + (lc - 320));
        cwl[i] = tap < 4 ? p.d_conv_w[(size_t)jl * 4 * 768 + tap * 768 + ch] : p.d_conv_b[jl * 768 + ch]; }
    if (C.tid < 256) ((LAS float*)(C.lds + SD_GN))[C.tid] = p.d_norm_gain[jl * 512 + 256 * grp + C.tid];
    if (C.tid < 12) { const int k = C.tid >> 2, head = 4 * grp + (C.tid & 3);
        ((LAS float*)(C.lds + SD_HK))[C.tid] = k == 0 ? p.d_dt_bias[jl * 8 + head] : k == 1 ? __expf(p.d_a_log[jl * 8 + head]) : p.d_skip[jl * 8 + head]; }
}
struct Conv4 { u32x4 r[4]; };
__device__ __forceinline__ void ssd_conv_load(const GAS bf16_t* useq, int pos, int ch, Conv4& cv) {
#pragma unroll
    for (int i = 0; i < 4; ++i) { const int pp = pos - 3 + i; cv.r[i] = *(const GAS u32x4*)(useq + (size_t)(pp >= 0 ? pp : 0) * UPITCH + SD_XBC + ch); }
}
__device__ __forceinline__ void ssd_conv_apply(const LAS float* cwl, int lc, int pos, const Conv4& cv, float (&o)[8]) {
    { const f32x4 b0 = *(const LAS f32x4*)(cwl + 4 * 384 + lc), b1 = *(const LAS f32x4*)(cwl + 4 * 384 + lc + 4);
      o[0] = b0[0]; o[1] = b0[1]; o[2] = b0[2]; o[3] = b0[3]; o[4] = b1[0]; o[5] = b1[1]; o[6] = b1[2]; o[7] = b1[3]; }
#pragma unroll
    for (int i = 0; i < 4; ++i) { const int pp = pos - 3 + i;
        u32x4 raw = cv.r[i]; if (pp < 0) raw = (u32x4){0u, 0u, 0u, 0u};
        float xv[8]; unpack8(raw, xv);
        const f32x4 w0 = *(const LAS f32x4*)(cwl + i * 384 + lc), w1 = *(const LAS f32x4*)(cwl + i * 384 + lc + 4);
        o[0] += w0[0] * xv[0]; o[1] += w0[1] * xv[1]; o[2] += w0[2] * xv[2]; o[3] += w0[3] * xv[3]; o[4] += w1[0] * xv[4]; o[5] += w1[1] * xv[5]; o[6] += w1[2] * xv[6]; o[7] += w1[3] * xv[7]; }
#pragma unroll
    for (int q = 0; q < 8; ++q) o[q] = siluf_(o[q]);
}
__device__ __forceinline__ void ssd_pass1_item(const Params& p, const Ctx& C0, int layer, int item) {
    Ctx C = C0; asm volatile("" : "+s"(C.wave)); asm volatile("" : "+v"(C.tid)); C.lane = C.tid & 63;
    const int grp = item & 1, bc = item >> 1, c = bc & 63, jl = layer >> 1;
    const GAS bf16_t* U = (const GAS bf16_t*)(p.ws + WS_U);
    const GAS bf16_t* urow0 = U + (size_t)bc * 64 * UPITCH; const GAS bf16_t* useq = U + (size_t)(bc >> 6) * SEQ * UPITCH;
    LAS float* DTL = (LAS float*)(C.lds + SD_DTL); LAS float* CUM = (LAS float*)(C.lds + SD_CUM); const LAS float* cwl = (const LAS float*)(C.lds + SD_CW);
    GAS unsigned char* mx = p.ws + MX_BASE;
    const float dtraw = ssd_dt_load(C, grp, urow0);
    const int j = C.tid >> 3, cg = C.tid & 7;
    Conv4 cv[5];
#pragma unroll
    for (int blk = 0; blk < 5; ++blk) ssd_conv_load(useq, c * 64 + j, blk < 4 ? 256 * grp + 64 * blk + 8 * cg : 512 + 64 * grp + 8 * cg, cv[blk]);
    ssd_stage_dt(C, dtraw);
#pragma unroll
    for (int blk = 0; blk < 5; ++blk) { float o[8];
        if (blk < 4) { ssd_conv_apply(cwl, 64 * blk + 8 * cg, c * 64 + j, cv[blk], o);
            *(GAS u32x4*)((GAS bf16_t*)(p.ws + WS_Y) + ((size_t)bc * 64 + j) * D + 512 + 256 * grp + 64 * blk + 8 * cg) = pack8(o);
            const float s = DTL[j * 4 + blk] * __expf(CUM[63 * 4 + blk] - CUM[j * 4 + blk]);
#pragma unroll
            for (int q = 0; q < 8; ++q) o[q] *= s;
            *(LAS u32x4*)(C.lds + SD_X + blk * TILE64 + j * TS + 16 * cg) = pack8(o);
        } else { ssd_conv_apply(cwl, 256 + 8 * cg, c * 64 + j, cv[blk], o); const u32x4 pk = pack8(o); *(LAS u32x4*)(C.lds + SD_BMT + j * TS + 16 * cg) = pk;
            *(GAS u32x4*)((GAS bf16_t*)(mx + SX_BM) + (size_t)item * 4096 + j * 64 + 8 * cg) = pk; } }
    LDS_BARRIER();
    { const int hh = C.wave >> 1; const LAS unsigned char* Xt = C.lds + SD_X + hh * TILE64; const LAS unsigned char* Bt = C.lds + SD_BMT;
      const size_t ih = (size_t)bc * 8 + 4 * grp + hh;
      GAS bf16_t* STg = (GAS bf16_t*)(mx + SX_ST) + ih * 4096;
      if ((C.wave & 1) == 0 && C.lane == 0) ((GAS float*)(mx + SX_DEC))[ih] = __expf(CUM[63 * 4 + hh]);
      bf16x8 ab[2][4]; tf_2x4<TS>(Bt, 0, 0, C.lane, ab);
#pragma unroll
      for (int q = 0; q < 2; ++q) { const int at = 2 * (C.wave & 1) + q;
          bf16x8 bx[2]; tf_2x1<TS>(Xt, 0, 16 * at, C.lane, bx);
          f32x4 acc4[4];
#pragma unroll
          for (int bt = 0; bt < 4; ++bt) acc4[bt] = (f32x4){0.f, 0.f, 0.f, 0.f};
#pragma unroll
          for (int ks = 0; ks < 2; ++ks)
#pragma unroll
              for (int bt = 0; bt < 4; ++bt) acc4[bt] = MFMA16(ab[ks][bt], bx[ks], acc4[bt]);
          SETTLE4(acc4[0], acc4[1], acc4[2], acc4[3]);
#pragma unroll
          for (int bt = 0; bt < 4; ++bt) { const f32x4 acc = acc4[bt];
              { u32x2 o; o.x = pk2(acc[0], acc[1]); o.y = pk2(acc[2], acc[3]); *(GAS u32x2*)(STg + (size_t)(16 * at + (C.lane & 15)) * 64 + 16 * bt + 4 * (C.lane >> 4)) = o; } } } }
    LDS_BARRIER();
}
__device__ __forceinline__ void ssd_pass2_job(const Params& p, int job, int lane) {
    GAS unsigned char* mx = p.ws + MX_BASE;
    const int bh = job >> 4, slab = job & 15, b = bh >> 3, head = bh & 7;
    const int el = slab * 256 + lane * 4;
    f32x4 S = {0.f, 0.f, 0.f, 0.f};
#pragma unroll 1
    for (int c0 = 0; c0 < 64; c0 += 8) {
        f32x4 Dv[8]; float dc[8];
#pragma unroll
        for (int q = 0; q < 8; ++q) { const size_t ih = (size_t)(b * 64 + c0 + q) * 8 + head; { const u32x2 d2 = __builtin_nontemporal_load((const GAS u32x2*)((const GAS bf16_t*)(mx + SX_ST) + ih * 4096 + el)); Dv[q] = (f32x4){bflo(d2.x), bfhi(d2.x), bflo(d2.y), bfhi(d2.y)}; } dc[q] = ((const GAS float*)(mx + SX_DEC))[ih]; }
#pragma unroll
        for (int q = 0; q < 8; ++q) { const size_t ih = (size_t)(b * 64 + c0 + q) * 8 + head;
            u32x2 o; o.x = pk2(S[0], S[1]); o.y = pk2(S[2], S[3]);
            *(GAS u32x2*)((GAS bf16_t*)(mx + SX_S) + ih * 4096 + el) = o;
            S = S * dc[q] + Dv[q]; }
    }
}
__device__ __forceinline__ void ssd_pass3_item(const Params& p, const Ctx& C0, int layer, int item) {
    Ctx C = C0; asm volatile("" : "+s"(C.wave)); asm volatile("" : "+v"(C.tid)); C.lane = C.tid & 63;
    const int grp = item & 1, bc = item >> 1, c = bc & 63, jl = layer >> 1;
    const GAS bf16_t* U = (const GAS bf16_t*)(p.ws + WS_U);
    const GAS bf16_t* urow0 = U + (size_t)bc * 64 * UPITCH; const GAS bf16_t* useq = U + (size_t)(bc >> 6) * SEQ * UPITCH;
    LAS float* DTL = (LAS float*)(C.lds + SD_DTL); LAS float* CUM = (LAS float*)(C.lds + SD_CUM); LAS float* RS = (LAS float*)(C.lds + SD_RS); const LAS float* cwl = (const LAS float*)(C.lds + SD_CW);
    GAS unsigned char* mx = p.ws + MX_BASE;
    GAS bf16_t* Y = (GAS bf16_t*)(p.ws + WS_Y);
    const float dtraw = ssd_dt_load(C, grp, urow0);
    const int j = C.tid >> 3, cg = C.tid & 7;
    u32x4 xraw[4], bmraw; Conv4 cvc;
#pragma unroll
    for (int blk = 0; blk < 4; ++blk) xraw[blk] = *(const GAS u32x4*)(Y + ((size_t)bc * 64 + j) * D + 512 + 256 * grp + 64 * blk + 8 * cg);
    bmraw = *(const GAS u32x4*)((const GAS bf16_t*)(mx + SX_BM) + (size_t)item * 4096 + j * 64 + 8 * cg);
    ssd_conv_load(useq, c * 64 + j, 640 + 64 * grp + 8 * cg, cvc);
    u32x4 sreg[4];
#pragma unroll
    for (int k4 = 0; k4 < 4; ++k4) { const GAS bf16_t* Sg = (const GAS bf16_t*)(mx + SX_S) + ((size_t)bc * 8 + 4 * grp + k4) * 4096;
        sreg[k4] = __builtin_nontemporal_load((const GAS u32x4*)(Sg + (size_t)j * 64 + 8 * cg)); }
    ssd_stage_dt(C, dtraw);
#pragma unroll
    for (int blk = 0; blk < 4; ++blk) { float o[8]; unpack8(xraw[blk], o);
        const float s = DTL[j * 4 + blk];
#pragma unroll
        for (int q = 0; q < 8; ++q) o[q] *= s;
        *(LAS u32x4*)(C.lds + SD_X + blk * TILE64 + j * TS + 16 * cg) = pack8(o); }
    *(LAS u32x4*)(C.lds + SD_BMT + j * TS + 16 * cg) = bmraw;
    { float o[8]; ssd_conv_apply(cwl, 320 + 8 * cg, c * 64 + j, cvc, o); *(LAS u32x4*)(C.lds + SD_CMT + j * TS + 16 * cg) = pack8(o); }
#pragma unroll
    for (int k4 = 0; k4 < 4; ++k4) *(LAS u32x4*)(C.lds + SD_HS + k4 * TILE64 + j * TS + 16 * cg) = sreg[k4];
    LDS_BARRIER();
    {
      const LAS unsigned char* Cm = C.lds + SD_CMT; const LAS unsigned char* Bm = C.lds + SD_BMT;
#pragma unroll
      for (int q = 0; q < 2; ++q) { const int id = 2 * C.wave + q, at = id >> 2, bt = id & 3; f32x4 acc = {0.f, 0.f, 0.f, 0.f};
          const int tt = 16 * at + (C.lane & 15), s0 = 16 * bt + 4 * (C.lane >> 4);
          if (bt <= at) {
#pragma unroll
              for (int ks = 0; ks < 2; ++ks) acc = MFMA16(rf_lds(Bm, TS, 16 * bt, 32 * ks, C.lane), rf_lds(Cm, TS, 16 * at, 32 * ks, C.lane), acc); }
          SETTLE(acc);
#pragma unroll
          for (int hh = 0; hh < 4; ++hh) { f32x4 v; const float ct = CUM[tt * 4 + hh];
#pragma unroll
              for (int r = 0; r < 4; ++r) { const float e = __expf(ct - CUM[(s0 + r) * 4 + hh]); v[r] = (bt <= at && s0 + r <= tt) ? acc[r] * e : 0.f; }
              st4_lds(C.lds + SD_PL + hh * TILE64, TS, tt, s0, v); } } }
    LDS_BARRIER();
    { const int at = C.wave & 3, hp = C.wave >> 2, tt = 16 * at + (C.lane & 15), g4 = 4 * (C.lane >> 4);
      const LAS unsigned char* Cm = C.lds + SD_CMT;
      bf16x8 bc_[2]; bc_[0] = rf_lds(Cm, TS, 16 * at, 0, C.lane); bc_[1] = rf_lds(Cm, TS, 16 * at, 32, C.lane);
      const size_t tk = (size_t)bc * 64 + tt;
      f32x4 yv[2][4]; float ss = 0.f;
#pragma unroll
      for (int q = 0; q < 2; ++q) { const int hh = 2 * hp + q, head = 4 * grp + hh;
          const LAS unsigned char* Hs = C.lds + SD_HS + hh * TILE64; const LAS unsigned char* Xt = C.lds + SD_X + hh * TILE64; const LAS unsigned char* Pl = C.lds + SD_PL + hh * TILE64;
          bf16x8 bp[2]; bp[0] = rf_lds(Pl, TS, 16 * at, 0, C.lane); bp[1] = rf_lds(Pl, TS, 16 * at, 32, C.lane);
          bf16x8 ax[2][4]; tf_2x4<TS>(Xt, 0, 0, C.lane, ax);
          const float ec = __expf(CUM[tt * 4 + hh]), rdt = rcpf_(DTL[tt * 4 + hh]), skip = ((const LAS float*)(C.lds + SD_HK))[8 + hh];
          const GAS bf16_t* zp = U + tk * UPITCH + SD_Z + 64 * head;
          bf16x8 hf[2][4]; f32x4 a4[4];
#pragma unroll
          for (int pt = 0; pt < 4; ++pt) { hf[0][pt] = rf_lds(Hs, TS, 16 * pt, 0, C.lane); hf[1][pt] = rf_lds(Hs, TS, 16 * pt, 32, C.lane); a4[pt] = (f32x4){0.f, 0.f, 0.f, 0.f}; }
#pragma unroll
          for (int ks = 0; ks < 2; ++ks)
#pragma unroll
              for (int pt = 0; pt < 4; ++pt) a4[pt] = MFMA16(hf[ks][pt], bc_[ks], a4[pt]);
          SETTLE4(a4[0], a4[1], a4[2], a4[3]);
#pragma unroll
          for (int pt = 0; pt < 4; ++pt) a4[pt] = a4[pt] * ec;
#pragma unroll
          for (int ks = 0; ks < 2; ++ks)
#pragma unroll
              for (int pt = 0; pt < 4; ++pt) a4[pt] = MFMA16(ax[ks][pt], bp[ks], a4[pt]);
          SETTLE4(a4[0], a4[1], a4[2], a4[3]);
#pragma unroll
          for (int pt = 0; pt < 4; ++pt) { f32x4 a = a4[pt];
              const f32x4 xh = ld4_lds(Xt, TS, tt, 16 * pt + g4) * rdt;
              const u32x2 zv = *(const GAS u32x2*)(zp + 16 * pt + g4);
              a[0] = (a[0] + skip * xh[0]) * siluf_(bflo(zv.x)); a[1] = (a[1] + skip * xh[1]) * siluf_(bfhi(zv.x)); a[2] = (a[2] + skip * xh[2]) * siluf_(bflo(zv.y)); a[3] = (a[3] + skip * xh[3]) * siluf_(bfhi(zv.y));
              yv[q][pt] = a; ss += (a[0] * a[0] + a[1] * a[1]) + (a[2] * a[2] + a[3] * a[3]); } }
      ss += __shfl_xor(ss, 16); ss += __shfl_xor(ss, 32);
      if (C.lane < 16) RS[hp * 64 + tt] = ss;
      LDS_BARRIER();
      const float rstd = rsqrtf((RS[tt] + RS[64 + tt]) * (1.f / 256.f) + NORM_EPS);
#pragma unroll
      for (int q = 0; q < 2; ++q) { const int hh = 2 * hp + q, head = 4 * grp + hh;
          const LAS float* gn = (const LAS float*)(C.lds + SD_GN) + 64 * hh; GAS bf16_t* yp = Y + tk * D + 512 + 64 * head;
#pragma unroll
          for (int pt = 0; pt < 4; ++pt) { const f32x4 g = *(const LAS f32x4*)(gn + 16 * pt + g4); const f32x4 a = yv[q][pt] * rstd * g;
              u32x2 o; o.x = pk2(a[0], a[1]); o.y = pk2(a[2], a[3]); *(GAS u32x2*)(yp + 16 * pt + g4) = o; } } }
    LDS_BARRIER();
}
constexpr int RK_LW = 0, RK_AA = 17408, RK_NA = 0, RK_NB = 9216, RK_TA = 18432, RK_TB = 27648, RK_SEG = 40960, RK_ECL = 43008, RK_TW = 43520, RK_AD = 52736, RK_WZ = 43520,
              RK_KKG = 61952, RK_BI = 71168, RK_KTI = 80384, RK_RG = 89600, RK_V = 98816, RK_MBR = 108032, RK_MKR = 117248, RK_N0 = 126464, RK_AK = 135680, RK_KH = RK_BI, RK_END = 144896;

__device__ __forceinline__ void rk_shift8(const GAS bf16_t* cur, const GAS bf16_t* prv, bool has_prev, const LAS float* mu, float (&o)[8]) {
    const u32x4 cr = *(const GAS u32x4*)cur, pr = *(const GAS u32x4*)(has_prev ? prv : cur);
    float c[8], q[8]; unpack8(cr, c); unpack8(pr, q);
    const f32x4 m0 = *(const LAS f32x4*)mu, m1 = *(const LAS f32x4*)(mu + 4);
#pragma unroll
    for (int i = 0; i < 8; ++i) { const float m = i < 4 ? m0[i & 3] : m1[i & 3]; const float qq = has_prev ? q[i] : 0.f; o[i] = c[i] + m * (qq - c[i]); }
}
__device__ __forceinline__ float tanhf_(float x) { const float e = __expf(-2.f * fabsf(x)); const float t = (1.f - e) * rcpf_(1.f + e); return x < 0.f ? -t : t; }

#ifdef DBG_RW
#define RWCHK(cond, bit) do { if (layer == 0 && __any((int)(cond))) { GAS unsigned* f_ = (GAS unsigned*)(p.ws + WS_CTL) + 8192; if (C.lane == 0 && !(__hip_atomic_load(f_, __ATOMIC_RELAXED, __HIP_MEMORY_SCOPE_AGENT) & (bit))) atomicOr(f_, (bit)); } } while (0)
#else
#define RWCHK(cond, bit) do { } while (0)
#endif
#ifdef DBG_DUMP
#define RWDUMP(ldsoff, nbytes, gofs) do { if (layer == 0 && item < 1024) { const int rs_ = ((nbytes) == 64 * TS2) ? TS2 : TS; const int vb_ = rs_ - 16; for (int i_ = C.tid * 16; i_ < 64 * vb_; i_ += 512 * 16) { const int r_ = i_ / vb_, c_ = i_ % vb_; *(GAS u32x4*)(p.ws + WS_Y + (gofs) + (size_t)item * (nbytes) + r_ * rs_ + c_) = *(const LAS u32x4*)(L + (ldsoff) + r_ * rs_ + c_); } } } while (0)
#else
#define RWDUMP(ldsoff, nbytes, gofs) do { } while (0)
#endif

constexpr int RK_CONST = RK_END;
struct RkPre { u32x4 cur[5], prv[5]; };
__device__ __forceinline__ void rk_prefetch(const Params& p, int tid, int h, int item, RkPre& pre) {
    const int bc = item >> 3, j = tid >> 3, cg = tid & 7;
    const GAS bf16_t* cur = (const GAS bf16_t*)(p.ws + WS_U) + ((size_t)bc * 64 + j) * UPITCH; const bool hp = ((bc & 63) * 64 + j) != 0;
    const GAS bf16_t* prv = hp ? cur - UPITCH : cur;
    const int col[5] = {RW_R + 64 * h + 8 * cg, RW_K + 64 * h + 8 * cg, RW_V + 64 * h + 8 * cg, RW_WD + 8 * cg, RW_AD + 8 * cg};
#pragma unroll
    for (int q = 0; q < 5; ++q) { pre.cur[q] = *(const GAS u32x4*)(cur + col[q]); pre.prv[q] = *(const GAS u32x4*)(prv + col[q]); }
}
__device__ __forceinline__ void rk_shift8r(const u32x4 cur, const u32x4 prv, bool has_prev, const LAS float* mu, float (&o)[8]) {
    float c[8], q[8]; unpack8(cur, c); unpack8(prv, q);
    const f32x4 m0 = *(const LAS f32x4*)mu, m1 = *(const LAS f32x4*)(mu + 4);
#pragma unroll
    for (int i = 0; i < 8; ++i) { const float m = i < 4 ? m0[i & 3] : m1[i & 3]; const float qq = has_prev ? q[i] : 0.f; o[i] = c[i] + m * (qq - c[i]); }
}
__device__ __forceinline__ void rk_load_const(const Params& p, const Ctx& C, int layer, int h) {
    const int jl = layer >> 1; LAS float* K = (LAS float*)(C.lds + RK_CONST);
    for (int i = C.tid; i < 640; i += 512) { float v;
        if (i < 320) { const int g = i >> 6, n = i & 63; const int col = g == 0 ? RW_R + 64 * h + n : g == 1 ? RW_K + 64 * h + n : g == 2 ? RW_V + 64 * h + n : g == 3 ? RW_WD + n : RW_AD + n; v = p.a_mu[(size_t)jl * RWKV_IN + col]; }
        else { const int g = (i - 320) >> 6, n = i & 63; const GAS float* src = g == 0 ? p.a_k_k : g == 1 ? p.a_k_a : g == 2 ? p.a_r_k : g == 3 ? p.a_w0 : p.a_a0; v = src[jl * 512 + 64 * h + n]; }
        K[i] = v; }
}
__device__ __forceinline__ void rwkv_pass1_item(const Params& p, const Ctx& C0, int layer, int item, int next_item, RkPre& pre, const bf16x8 (&wf)[4][2]) {
    Ctx C = C0; asm volatile("" : "+s"(C.wave)); asm volatile("" : "+v"(C.tid)); C.lane = C.tid & 63;
    const int h = item & 7, bc = item >> 3, c = bc & 63, jl = layer >> 1;
    const GAS bf16_t* urow0 = (const GAS bf16_t*)(p.ws + WS_U) + (size_t)bc * 64 * UPITCH;
    GAS unsigned char* mx = p.ws + MX_BASE;
    LAS unsigned char* L = C.lds;
    LAS float* LW = (LAS float*)(L + RK_LW); LAS float* AA = (LAS float*)(L + RK_AA); LAS float* ECL = (LAS float*)(L + RK_ECL);
    const int j = C.tid >> 3, cg = C.tid & 7, lane = C.lane, w = C.wave;
    const int g4 = 4 * (lane >> 4), l15 = lane & 15;
    float rr[8], kk[8], vv[8];
    const LAS float* KC = (const LAS float*)(L + RK_CONST);
    { const bool hp = (c * 64 + j) != 0;
      rk_shift8r(pre.cur[0], pre.prv[0], hp, KC + 0 * 64 + 8 * cg, rr);
      rk_shift8r(pre.cur[1], pre.prv[1], hp, KC + 1 * 64 + 8 * cg, kk);
      rk_shift8r(pre.cur[2], pre.prv[2], hp, KC + 2 * 64 + 8 * cg, vv);
      float t[8];
      rk_shift8r(pre.cur[3], pre.prv[3], hp, KC + 3 * 64 + 8 * cg, t);
#pragma unroll
      for (int q = 0; q < 8; ++q) t[q] = tanhf_(t[q]);
      *(LAS u32x4*)(L + RK_TW + j * TS + 16 * cg) = pack8(t);
      rk_shift8r(pre.cur[4], pre.prv[4], hp, KC + 4 * 64 + 8 * cg, t);
      *(LAS u32x4*)(L + RK_AD + j * TS + 16 * cg) = pack8(t);
      rk_prefetch(p, C.tid, h, next_item, pre); }
    LDS_BARRIER();
    { const int prod = w >> 2, at = w & 3;
      const LAS unsigned char* src = L + (prod ? RK_AD : RK_TW);
      const LAS float* bias = KC + (prod ? 576 : 512);
      LAS float* dst = prod ? AA : LW;
      bf16x8 bj[2]; bj[0] = rf_lds(src, TS, 16 * at, 0, lane); bj[1] = rf_lds(src, TS, 16 * at, 32, lane);
      f32x4 acc4[4];
#pragma unroll
      for (int bt = 0; bt < 4; ++bt) acc4[bt] = *(const LAS f32x4*)(bias + 16 * bt + g4);
#pragma unroll
      for (int ks = 0; ks < 2; ++ks)
#pragma unroll
          for (int bt = 0; bt < 4; ++bt) acc4[bt] = MFMA16(wf[bt][ks], bj[ks], acc4[bt]);
      SETTLE4(acc4[0], acc4[1], acc4[2], acc4[3]);
#pragma unroll
      for (int bt = 0; bt < 4; ++bt) { f32x4 acc = acc4[bt];
#pragma unroll
          for (int r = 0; r < 4; ++r) acc[r] = prod ? sigmoidf_(acc[r]) : -0.6065306597f * sigmoidf_(acc[r]);
          *(LAS f32x4*)(dst + (16 * at + l15) * FS + 16 * bt + g4) = acc; } }
    LDS_BARRIER();
    float lw[8];
#pragma unroll
    for (int q = 0; q < 8; ++q) lw[q] = LW[j * FS + 8 * cg + q];
    LDS_BARRIER();
    lds_cumsum64<64, true>(LW, FS, (LAS float*)(L + RK_SEG), C.tid);
    { const LAS float* k_k = KC + 320 + 8 * cg; const LAS float* k_a = KC + 384 + 8 * cg; const LAS float* r_k = KC + 448 + 8 * cg;
      float kn[8], ss = 0.f, bon = 0.f, kt[8], bb[8], cs[8];
#pragma unroll
      for (int q = 0; q < 8; ++q) { kn[q] = kk[q] * k_k[q]; ss += kn[q] * kn[q]; }
      ss += __shfl_xor(ss, 1); ss += __shfl_xor(ss, 2); ss += __shfl_xor(ss, 4);
      const float rn = rsqrtf(ss + 1e-12f);
#pragma unroll
      for (int q = 0; q < 8; ++q) { const float a = AA[j * FS + 8 * cg + q]; kn[q] *= rn; kt[q] = kk[q] * (1.f + (a - 1.f) * k_a[q]); bb[q] = a * kn[q]; bon += rr[q] * kt[q] * r_k[q]; cs[q] = LW[j * FS + 8 * cg + q]; }
#pragma unroll
      for (int q = 0; q < 1; ++q) { }
      bon += __shfl_xor(bon, 1); bon += __shfl_xor(bon, 2); bon += __shfl_xor(bon, 4);
      if (cg == 0) ((GAS float*)(mx + RW_BON))[(size_t)item * 64 + j] = bon;
      float o[8];
#pragma unroll
      for (int q = 0; q < 8; ++q) o[q] = kn[q] * __expf(cs[q] - lw[q]);
      *(LAS u32x4*)(L + RK_KKG + j * TS + 16 * cg) = pack8(o);
#pragma unroll
      for (int q = 0; q < 8; ++q) o[q] = bb[q] * __expf(-cs[q]);
      *(LAS u32x4*)(L + RK_BI + j * TS + 16 * cg) = pack8(o);
#pragma unroll
      for (int q = 0; q < 8; ++q) o[q] = kt[q] * __expf(-cs[q]);
      *(LAS u32x4*)(L + RK_KTI + j * TS + 16 * cg) = pack8(o);
#pragma unroll
      for (int q = 0; q < 8; ++q) o[q] = rr[q] * __expf(cs[q]);
      *(LAS u32x4*)(L + RK_RG + j * TS + 16 * cg) = pack8(o);
      *(LAS u32x4*)(L + RK_V + j * TS + 16 * cg) = pack8(vv);
      if (j == 63) {
#pragma unroll
          for (int q = 0; q < 8; ++q) ECL[8 * cg + q] = __expf(cs[q]); } }
    LDS_BARRIER();
    { const int prod = w >> 1;
      const LAS unsigned char* bsrc = L + (prod <= 1 ? RK_KKG : (prod == 2 ? RK_BI : RK_RG));
      const LAS unsigned char* asrc = L + (prod == 0 ? RK_BI : (prod == 1 ? RK_KTI : (prod == 2 ? RK_RG : RK_KTI)));
      LAS unsigned char* dst = L + (prod == 0 ? RK_N0 : (prod == 1 ? RK_AK : (prod == 2 ? RK_MBR : RK_MKR)));
#pragma unroll
      for (int q = 0; q < 2; ++q) { const int at = 2 * (w & 1) + q;
          bf16x8 bj[2]; bj[0] = rf_lds(bsrc, TS, 16 * at, 0, lane); bj[1] = rf_lds(bsrc, TS, 16 * at, 32, lane);
          bf16x8 af[2][4]; f32x4 acc4[4];
#pragma unroll
          for (int bt = 0; bt < 4; ++bt) { af[0][bt] = rf_lds(asrc, TS, 16 * bt, 0, lane); af[1][bt] = rf_lds(asrc, TS, 16 * bt, 32, lane); acc4[bt] = (f32x4){0.f, 0.f, 0.f, 0.f}; }
#pragma unroll
          for (int ks = 0; ks < 2; ++ks)
#pragma unroll
              for (int bt = 0; bt < 4; ++bt) acc4[bt] = MFMA16(af[ks][bt], bj[ks], acc4[bt]);
          SETTLE4(acc4[0], acc4[1], acc4[2], acc4[3]);
#pragma unroll
          for (int bt = 0; bt < 4; ++bt) { f32x4 acc = acc4[bt];
              const int a = 16 * at + l15, b0 = 16 * bt + g4;
#pragma unroll
              for (int r = 0; r < 4; ++r) { const int b = b0 + r; const bool keep = prod <= 1 ? (b < a) : (prod == 2 ? (a <= b) : (b <= a)); acc[r] = keep ? acc[r] : 0.f; }
#pragma unroll
              for (int r = 0; r < 4; ++r) RWCHK(!(fabsf(acc[r]) < (prod == 0 ? 1.5f : 1e3f)), prod == 0 ? 1u : 2u);
              st4_lds(dst, TS, a, b0, acc);
              if (prod == 0) { f32x4 t0;
#pragma unroll
                  for (int r = 0; r < 4; ++r) t0[r] = ((b0 + r) == a ? 1.f : 0.f) - acc[r];
                  st4_lds(L + RK_TA, TS, a, b0, t0);
                  if (at < 2 && bt >= 2) { u32x2 zz; asm volatile("v_mov_b32 %0, 0\n\tv_mov_b32 %1, 0" : "=v"(zz.x), "=v"(zz.y)); *(LAS u32x2*)(L + RK_TB + a * TS + b0 * 2) = zz; } } } } }
    LDS_BARRIER();
    {
        int nsrc = RK_N0, ndst = RK_NA, tsrc = RK_TA, tdst = RK_TB;
        for (int st = 0; st < 6; ++st) {
            const int jb = w & 3, prod = w >> 2;
            const bool doN = (st < 5), doT = (st > 0);
            if ((prod == 0 && doN) || (prod == 1 && doT)) {
                const LAS unsigned char* bs = L + (prod == 0 ? nsrc : tsrc); const LAS unsigned char* as = L + nsrc; LAS unsigned char* dst = L + (prod == 0 ? ndst : tdst);
                if (jb < 2) { const int q2 = 2 * jb;
                    bf16x8 bj[2]; bj[0] = rf_lds(bs, TS, 16 * q2, 32 * jb, lane); bj[1] = rf_lds(bs, TS, 16 * (q2 + 1), 32 * jb, lane);
                    bf16x8 aa[2]; tf_1x2<TS>(as, 32 * jb, 16 * q2, lane, aa);
                    f32x4 acc4[4];
#pragma unroll
                    for (int i = 0; i < 2; ++i)
#pragma unroll
                        for (int jj = 0; jj < 2; ++jj) { acc4[2 * i + jj] = (f32x4){0.f, 0.f, 0.f, 0.f}; if (prod == 1) acc4[2 * i + jj] = ld4_lds(bs, TS, 16 * (q2 + i) + l15, 16 * (q2 + jj) + g4); }
#pragma unroll
                    for (int i = 0; i < 2; ++i)
#pragma unroll
                        for (int jj = 0; jj < 2; ++jj) acc4[2 * i + jj] = MFMA16(aa[jj], bj[i], acc4[2 * i + jj]);
                    SETTLE4(acc4[0], acc4[1], acc4[2], acc4[3]);
#pragma unroll
                    for (int i = 0; i < 2; ++i)
#pragma unroll
                        for (int jj = 0; jj < 2; ++jj) st4_lds(dst, TS, 16 * (q2 + i) + l15, 16 * (q2 + jj) + g4, acc4[2 * i + jj]);
                } else { const int at = jb;
                    bf16x8 bj[2]; bj[0] = rf_lds(bs, TS, 16 * at, 0, lane); bj[1] = rf_lds(bs, TS, 16 * at, 32, lane);
                    bf16x8 a0[2], a1[2]; tf_1x2<TS>(as, 0, 0, lane, a0); tf_1x2<TS>(as, 32, 0, lane, a1);
                    f32x4 acc2[2];
#pragma unroll
                    for (int jj = 0; jj < 2; ++jj) { acc2[jj] = (f32x4){0.f, 0.f, 0.f, 0.f}; if (prod == 1) acc2[jj] = ld4_lds(bs, TS, 16 * at + l15, 16 * jj + g4); }
#pragma unroll
                    for (int jj = 0; jj < 2; ++jj) acc2[jj] = MFMA16(a0[jj], bj[0], acc2[jj]);
#pragma unroll
                    for (int jj = 0; jj < 2; ++jj) acc2[jj] = MFMA16(a1[jj], bj[1], acc2[jj]);
                    SETTLE(acc2[0]); SETTLE(acc2[1]);
#pragma unroll
                    for (int jj = 0; jj < 2; ++jj) st4_lds(dst, TS, 16 * at + l15, 16 * jj + g4, acc2[jj]);
                }
            }
            LDS_BARRIER();
            if (doT) { const int t = tsrc; tsrc = tdst; tdst = t; }
            if (doN) { nsrc = ndst; ndst = (ndst == RK_NA) ? RK_NB : RK_NA; }
        }
        { const int at = w & 3, half = w >> 2; const LAS unsigned char* Tt = L + tsrc;
          bf16x8 bj[2]; tf_2x1<TS>(Tt, 0, 16 * at, lane, bj);
          const LAS unsigned char* as = L + (half ? RK_MBR : RK_BI);
          bf16x8 aa[2][4]; tf_2x4<TS>(as, 0, 0, lane, aa);
          f32x4 acc4[4];
#pragma unroll
          for (int bt = 0; bt < 4; ++bt) acc4[bt] = (f32x4){0.f, 0.f, 0.f, 0.f};
#pragma unroll
          for (int ks = 0; ks < 2; ++ks)
#pragma unroll
              for (int bt = 0; bt < 4; ++bt) acc4[bt] = MFMA16(aa[ks][bt], bj[ks], acc4[bt]);
          SETTLE4(acc4[0], acc4[1], acc4[2], acc4[3]);
#pragma unroll
          for (int bt = 0; bt < 4; ++bt) { f32x4 acc = acc4[bt];
              if (!half) { const f32x4 e = *(const LAS f32x4*)(ECL + 16 * bt + g4); acc = acc * e; }
#pragma unroll
              for (int r = 0; r < 4; ++r) RWCHK(!(fabsf(acc[r]) < 1e4f), 8u);
              st4_lds(L + RK_WZ, TS2, 16 * at + l15, 64 * half + 16 * bt + g4, acc); } }
    }
    LDS_BARRIER();
    { const int prod = w >> 1; const size_t io = (size_t)item * 4096;
      GAS bf16_t* Pt = (GAS bf16_t*)(mx + RW_PT) + io; GAS bf16_t* Rh = (GAS bf16_t*)(mx + RW_RH) + io; GAS bf16_t* Mh = (GAS bf16_t*)(mx + RW_MH) + io;
      bf16x8 ax[2][4];
      if (prod == 2) tf_2x4<TS2>(L + RK_WZ, 0, 0, lane, ax); else tf_2x4<TS>(L + (prod == 3 ? RK_AK : RK_KKG), 0, 0, lane, ax);
#pragma unroll
      for (int q = 0; q < 2; ++q) { const int at = 2 * (w & 1) + q; const int a = 16 * at + l15;
          bf16x8 bj[2];
          if (prod == 0) tf_2x1<TS2>(L + RK_WZ, 0, 16 * at, lane, bj);
          else if (prod == 2) tf_2x1<TS>(L + RK_AK, 0, 16 * at, lane, bj);
          else tf_2x1<TS2>(L + RK_WZ, 0, 64 + 16 * at, lane, bj);
          f32x4 acc4[4];
#pragma unroll
          for (int bt = 0; bt < 4; ++bt) acc4[bt] = (f32x4){0.f, 0.f, 0.f, 0.f};
#pragma unroll
          for (int ks = 0; ks < 2; ++ks)
#pragma unroll
              for (int bt = 0; bt < 4; ++bt) acc4[bt] = MFMA16(ax[ks][bt], bj[ks], acc4[bt]);
          SETTLE4(acc4[0], acc4[1], acc4[2], acc4[3]);
#pragma unroll
          for (int bt = 0; bt < 4; ++bt) { f32x4 acc = acc4[bt]; const int b0 = 16 * bt + g4;
              f32x4 o;
#pragma unroll
              for (int r = 0; r < 4; ++r) RWCHK(!(fabsf(acc[r]) < 1e4f), 16u);
              if (prod == 0) { const float e = ECL[a];
#pragma unroll
                  for (int r = 0; r < 4; ++r) o[r] = ((b0 + r) == a ? e : 0.f) - acc[r];
                  RWCHK(!(fabsf(o[0]) < 1e4f) || !(fabsf(o[1]) < 1e4f) || !(fabsf(o[2]) < 1e4f) || !(fabsf(o[3]) < 1e4f), 1u);
                  u32x2 pk; pk.x = pk2(o[0], o[1]); pk.y = pk2(o[2], o[3]); *(GAS u32x2*)(Pt + (size_t)a * 64 + b0) = pk;
              } else if (prod == 1) { o = ld4_lds(L + RK_RG, TS, a, b0) - acc;
                  RWCHK(!(fabsf(o[0]) < 1e4f) || !(fabsf(o[1]) < 1e4f) || !(fabsf(o[2]) < 1e4f) || !(fabsf(o[3]) < 1e4f), 2u);
                  u32x2 pk; pk.x = pk2(o[0], o[1]); pk.y = pk2(o[2], o[3]); *(GAS u32x2*)(Rh + (size_t)a * 64 + b0) = pk;
              } else if (prod == 2) { const f32x4 e = *(const LAS f32x4*)(ECL + b0); o = ld4_lds(L + RK_KTI, TS, a, b0) * e - acc;
                  st4_lds(L + RK_KH, TS, a, b0, o);
              } else { o = ld4_lds(L + RK_MKR, TS, a, b0) - acc;
                  u32x2 pk; pk.x = pk2(o[0], o[1]); pk.y = pk2(o[2], o[3]); *(GAS u32x2*)(Mh + (size_t)a * 64 + b0) = pk; } } } }
    LDS_BARRIER();
    { GAS bf16_t* Qt = (GAS bf16_t*)(mx + RW_QT) + (size_t)item * 4096;
      bf16x8 bk[2]; tf_2x1<TS>(L + RK_KH, 0, 16 * (w >> 1), lane, bk);
#pragma unroll
      for (int q = 0; q < 2; ++q) { const int id = 2 * w + q, at = id >> 2, bt = id & 3; f32x4 acc = {0.f, 0.f, 0.f, 0.f};
          bf16x8 avq[2]; tf_2x1<TS>(L + RK_V, 0, 16 * bt, lane, avq);
#pragma unroll
          for (int ks = 0; ks < 2; ++ks) acc = MFMA16(avq[ks], bk[ks], acc);
          SETTLE(acc);
#pragma unroll
          for (int r = 0; r < 4; ++r) RWCHK(true, 32u);
          u32x2 pk; pk.x = pk2(acc[0], acc[1]); pk.y = pk2(acc[2], acc[3]); *(GAS u32x2*)(Qt + (size_t)(16 * at + l15) * 64 + 16 * bt + g4) = pk; } }
    LDS_BARRIER();
    RWDUMP(RK_MBR, TILE64, 0); RWDUMP(RK_MKR, TILE64, (size_t)10 << 20); RWDUMP(RK_WZ, 64 * TS2, (size_t)20 << 20); RWDUMP(RK_RG, TILE64, (size_t)40 << 20); RWDUMP(RK_AK, TILE64, (size_t)50 << 20);
    LDS_BARRIER();
}

__device__ __forceinline__ void rwkv_pass2_job(const Params& p, LAS unsigned char* scr  , int job, int lane) {
    GAS unsigned char* mx = p.ws + MX_BASE;
    const int bh = job >> 2, vq = job & 3, b = bh >> 3, h = bh & 7, g4 = 4 * (lane >> 4), l15 = lane & 15;
    f32x4 S[4];
#pragma unroll
    for (int nt = 0; nt < 4; ++nt) S[nt] = (f32x4){0.f, 0.f, 0.f, 0.f};
    bf16x8 bp[4][2]; u32x2 qv[4];
    { const size_t io = ((size_t)(b * 64) * 8 + h) * 4096; const GAS bf16_t* Pt = (const GAS bf16_t*)(mx + RW_PT) + io; const GAS bf16_t* Qt = (const GAS bf16_t*)(mx + RW_QT) + io;
#pragma unroll
      for (int nt = 0; nt < 4; ++nt) { bp[nt][0] = rf_glb(Pt, 64, 16 * nt, 0, lane); bp[nt][1] = rf_glb(Pt, 64, 16 * nt, 32, lane); qv[nt] = *(const GAS u32x2*)(Qt + (size_t)(16 * nt + l15) * 64 + 16 * vq + g4); } }
#pragma unroll 1
    for (int c = 0; c < 64; ++c) {
        const size_t io = ((size_t)(b * 64 + c) * 8 + h) * 4096;
        GAS bf16_t* Sg = (GAS bf16_t*)(mx + RW_S) + io;
        bf16x8 bpn[4][2]; u32x2 qvn[4];
        { const int cn = c < 63 ? c + 1 : 63; const size_t ion = ((size_t)(b * 64 + cn) * 8 + h) * 4096;
          const GAS bf16_t* Pt = (const GAS bf16_t*)(mx + RW_PT) + ion; const GAS bf16_t* Qt = (const GAS bf16_t*)(mx + RW_QT) + ion;
#pragma unroll
          for (int nt = 0; nt < 4; ++nt) { bpn[nt][0] = rf_glb(Pt, 64, 16 * nt, 0, lane); bpn[nt][1] = rf_glb(Pt, 64, 16 * nt, 32, lane); qvn[nt] = *(const GAS u32x2*)(Qt + (size_t)(16 * nt + l15) * 64 + 16 * vq + g4); } }
#pragma unroll
        for (int nt = 0; nt < 4; ++nt)
#pragma unroll
            for (int r = 0; r < 4; ++r) *(LAS bf16_t*)(scr + (g4 + r) * TS + (16 * nt + l15) * 2) = (bf16_t)(pk2(S[nt][r], 0.f) & 0xffffu);
        asm volatile("s_waitcnt lgkmcnt(0)" ::: "memory");
        bf16x8 af[2]; af[0] = rf_lds(scr, TS, 0, 0, lane); af[1] = rf_lds(scr, TS, 0, 32, lane);
        asm volatile("s_waitcnt lgkmcnt(0)" ::: "memory");
        *(GAS bf16x8*)(Sg + (size_t)(16 * vq + l15) * 64 + 8 * (lane >> 4)) = af[0];
        *(GAS bf16x8*)(Sg + (size_t)(16 * vq + l15) * 64 + 32 + 8 * (lane >> 4)) = af[1];
#pragma unroll
        for (int nt = 0; nt < 4; ++nt) { f32x4 acc = {bflo(qv[nt].x), bfhi(qv[nt].x), bflo(qv[nt].y), bfhi(qv[nt].y)};
            acc = MFMA16(af[0], bp[nt][0], acc); acc = MFMA16(af[1], bp[nt][1], acc); S[nt] = acc; }
        SETTLE(S[0]); SETTLE(S[1]); SETTLE(S[2]); SETTLE(S[3]);
#pragma unroll
        for (int nt = 0; nt < 4; ++nt) { bp[nt][0] = bpn[nt][0]; bp[nt][1] = bpn[nt][1]; qv[nt] = qvn[nt]; }
    }
}

constexpr int R3_S0 = 0, R3_RH = 9216, R3_MH = 18432, R3_V = 27648, R3_SG = 36864, R3_HALF = 54272;
constexpr int R3_GT = 2 * R3_HALF, R3_GT_SZ = 64 * TS2, R3_KC = R3_GT + 2 * R3_GT_SZ, R3_KC_SZ = 320 * 4, R3_END = R3_KC + 2 * R3_KC_SZ;
__device__ __forceinline__ void rwkv_p3_load_const(const Params& p, const Ctx& C, int layer) {
    const int half = C.wave >> 2, th = C.tid & 255, h = (2 * C.bid + half) & 7, jl = layer >> 1;
    const GAS bf16_t* Gt = (const GAS bf16_t*)(p.ws + WS_GUPT) + ((size_t)jl * 512 + 64 * h) * 128;
#pragma unroll
    for (int q = 0; q < 4; ++q) { const int idx = th + 256 * q, r = idx >> 4, ch = idx & 15;
        *(LAS u32x4*)(C.lds + R3_GT + half * R3_GT_SZ + r * TS2 + 16 * ch) = *(const GAS u32x4*)(Gt + (size_t)r * 128 + 8 * ch); }
    LAS float* K = (LAS float*)(C.lds + R3_KC + half * R3_KC_SZ); const GAS float* mu = p.a_mu + (size_t)jl * RWKV_IN;
    for (int i = th; i < 320; i += 256)
        K[i] = i < 64 ? mu[RW_V + 64 * h + i] : i < 192 ? mu[RW_GD + (i - 64)] : i < 256 ? p.a_ln_gain[jl * 512 + 64 * h + (i - 192)] : p.a_ln_bias[jl * 512 + 64 * h + (i - 256)];
}
struct R3Pre { u32x4 cur[6], prv[6], s[2], rh[2], mh[2]; };
__device__ __forceinline__ void rwkv_p3_prefetch(const Params& p, int tid, int wave, int pair, R3Pre& pre) {
    const int half = wave >> 2, item = 2 * pair + half, h = item & 7, bc = item >> 3, c = bc & 63, th = tid & 255, j = th >> 2, cq = th & 3;
    const GAS bf16_t* cur = (const GAS bf16_t*)(p.ws + WS_U) + ((size_t)bc * 64 + j) * UPITCH; const bool hp = (c * 64 + j) != 0; const GAS bf16_t* prv = hp ? cur - UPITCH : cur;
#pragma unroll
    for (int q = 0; q < 6; ++q) { const int col = q < 2 ? RW_V + 64 * h + 16 * cq + 8 * q : RW_GD + 32 * cq + 8 * (q - 2); pre.cur[q] = *(const GAS u32x4*)(cur + col); pre.prv[q] = *(const GAS u32x4*)(prv + col); }
    GAS unsigned char* mx = p.ws + MX_BASE; const size_t io = (size_t)item * 4096;
    const GAS bf16_t* Sg = (const GAS bf16_t*)(mx + RW_S) + io; const GAS bf16_t* Rh = (const GAS bf16_t*)(mx + RW_RH) + io; const GAS bf16_t* Mh = (const GAS bf16_t*)(mx + RW_MH) + io;
#pragma unroll
    for (int q = 0; q < 2; ++q) { const int idx = th + 256 * q, r = idx >> 3, ch = idx & 7;
        pre.s[q] = __builtin_nontemporal_load((const GAS u32x4*)(Sg + (size_t)r * 64 + 8 * ch));
        pre.rh[q] = __builtin_nontemporal_load((const GAS u32x4*)(Rh + (size_t)r * 64 + 8 * ch));
        pre.mh[q] = __builtin_nontemporal_load((const GAS u32x4*)(Mh + (size_t)r * 64 + 8 * ch)); }
}
__device__ __forceinline__ void rwkv_pass3_pair(const Params& p, const Ctx& C0, int layer, int pair, int next_pair, R3Pre& pre) {
    Ctx C = C0; asm volatile("" : "+s"(C.wave)); asm volatile("" : "+v"(C.tid)); C.lane = C.tid & 63;
    const int half = C.wave >> 2, item = 2 * pair + half, h = item & 7, bc = item >> 3, c = bc & 63, jl = layer >> 1;
    GAS unsigned char* mx = p.ws + MX_BASE;
    LAS unsigned char* L = C.lds + half * R3_HALF;
    GAS bf16_t* Y = (GAS bf16_t*)(p.ws + WS_Y);
    const int th = C.tid & 255, lane = C.lane, g4 = 4 * (lane >> 4), l15 = lane & 15;
    const LAS float* KC = (const LAS float*)(C.lds + R3_KC + half * R3_KC_SZ); const LAS unsigned char* GtL = C.lds + R3_GT + half * R3_GT_SZ;
    const float bon = ((const GAS float*)(mx + RW_BON))[(size_t)item * 64 + 16 * (C.wave & 3) + l15];
    { const int j = th >> 2, cq = th & 3; const bool hp = (c * 64 + j) != 0;
      float t[8];
#pragma unroll
      for (int q = 0; q < 2; ++q) { rk_shift8r(pre.cur[q], pre.prv[q], hp, KC + 16 * cq + 8 * q, t); *(LAS u32x4*)(L + R3_V + j * TS + 32 * cq + 16 * q) = pack8(t); }
#pragma unroll
      for (int q = 0; q < 4; ++q) { rk_shift8r(pre.cur[2 + q], pre.prv[2 + q], hp, KC + 64 + 32 * cq + 8 * q, t);
#pragma unroll
          for (int i = 0; i < 8; ++i) t[i] = sigmoidf_(t[i]);
          *(LAS u32x4*)(L + R3_SG + j * TS2 + 64 * cq + 16 * q) = pack8(t); }
#pragma unroll
      for (int q = 0; q < 2; ++q) { const int idx = th + 256 * q, r = idx >> 3, ch = idx & 7;
          *(LAS u32x4*)(L + R3_S0 + r * TS + 16 * ch) = pre.s[q];
          *(LAS u32x4*)(L + R3_RH + r * TS + 16 * ch) = pre.rh[q];
          *(LAS u32x4*)(L + R3_MH + r * TS + 16 * ch) = pre.mh[q]; } }
    rwkv_p3_prefetch(p, C.tid, C.wave, next_pair, pre);
    LDS_BARRIER();
    { const int tb = C.wave & 3, t = 16 * tb + l15; const size_t tk = (size_t)bc * 64 + t;
      bf16x8 br[2], bm[2], bg[4];
#pragma unroll
      for (int ks = 0; ks < 2; ++ks) { br[ks] = rf_lds(L + R3_RH, TS, 16 * tb, 32 * ks, lane); bm[ks] = rf_lds(L + R3_MH, TS, 16 * tb, 32 * ks, lane); }
#pragma unroll
      for (int ks = 0; ks < 4; ++ks) bg[ks] = rf_lds(L + R3_SG, TS2, 16 * tb, 32 * ks, lane);
      bf16x8 av[2][4]; tf_2x4<TS>(L + R3_V, 0, 0, lane, av);
      f32x4 y[4], gt[4]; float s = 0.f;
      bf16x8 s0f[2][4];
#pragma unroll
      for (int mt = 0; mt < 4; ++mt) { s0f[0][mt] = rf_lds(L + R3_S0, TS, 16 * mt, 0, lane); s0f[1][mt] = rf_lds(L + R3_S0, TS, 16 * mt, 32, lane); y[mt] = (f32x4){0.f, 0.f, 0.f, 0.f}; gt[mt] = (f32x4){0.f, 0.f, 0.f, 0.f}; }
#pragma unroll
      for (int ks = 0; ks < 2; ++ks) {
#pragma unroll
          for (int mt = 0; mt < 4; ++mt) y[mt] = MFMA16(s0f[ks][mt], br[ks], y[mt]);
#pragma unroll
          for (int mt = 0; mt < 4; ++mt) y[mt] = MFMA16(av[ks][mt], bm[ks], y[mt]); }
#pragma unroll
      for (int ks = 0; ks < 4; ++ks)
#pragma unroll
          for (int mt = 0; mt < 4; ++mt) gt[mt] = MFMA16(rf_lds(GtL, TS2, 16 * mt, 32 * ks, lane), bg[ks], gt[mt]);
      SETTLE4(y[0], y[1], y[2], y[3]); SETTLE4(gt[0], gt[1], gt[2], gt[3]);
#pragma unroll
      for (int mt = 0; mt < 4; ++mt) s += (y[mt][0] + y[mt][1]) + (y[mt][2] + y[mt][3]);
      s += __shfl_xor(s, 16); s += __shfl_xor(s, 32);
      const float mean = s * (1.f / 64.f); float s2 = 0.f;
#pragma unroll
      for (int mt = 0; mt < 4; ++mt)
#pragma unroll
          for (int r = 0; r < 4; ++r) { const float d = y[mt][r] - mean; s2 += d * d; }
      s2 += __shfl_xor(s2, 16); s2 += __shfl_xor(s2, 32);
      const float rstd = rsqrtf(s2 * (1.f / 64.f) + 64e-5f);
      const LAS float* lg = KC + 192; const LAS float* lb = KC + 256;
      GAS bf16_t* yp = Y + tk * D + 64 * h;
#pragma unroll
      for (int mt = 0; mt < 4; ++mt) { const int v0 = 16 * mt + g4; const f32x4 G = *(const LAS f32x4*)(lg + v0), Bv = *(const LAS f32x4*)(lb + v0); const f32x4 vv = ld4_lds(L + R3_V, TS, t, v0);
          f32x4 o;
#pragma unroll
          for (int r = 0; r < 4; ++r) o[r] = ((y[mt][r] - mean) * rstd * G[r] + Bv[r] + bon * vv[r]) * gt[mt][r];
          u32x2 pk; pk.x = pk2(o[0], o[1]); pk.y = pk2(o[2], o[3]); *(GAS u32x2*)(yp + v0) = pk; } }
    LDS_BARRIER();
}
constexpr int LDS_BYTES = 150528;
constexpr int LDS_TAB = 131072;
constexpr int LDS_P2SCR = 135168;
constexpr int LDS_BARW = LDS_BYTES - 16;
constexpr int N_PHASES = 2 + 9 * DEPTH;
static_assert(SD_END <= LDS_BARW && RK_CONST + 2560 <= LDS_BARW && SD_RS + 512 <= LDS_BARW && R3_END <= LDS_BARW, "LDS map");

typedef const __attribute__((address_space(4))) Params* KParams;
__global__ void __launch_bounds__(512, 2) mk_fwd(Params p_arg) {
    extern __shared__ __attribute__((aligned(16))) unsigned char lds_raw[];
    KParams kp0 = (KParams)__builtin_amdgcn_kernarg_segment_ptr();
    Params p;
    Ctx C; C.lds = (LAS unsigned char*)lds_raw; C.G = gridDim.x; C.bid = blockIdx.x;
    const int wave0 = __builtin_amdgcn_readfirstlane(threadIdx.x >> 6);
    C.wave = wave0; C.lane = __builtin_amdgcn_mbcnt_hi(~0u, __builtin_amdgcn_mbcnt_lo(~0u, 0u)); C.tid = wave0 * 64 + C.lane;
    const int lo = (int)kp0->ph_lo, hi = (int)kp0->ph_hi;
    GAS unsigned char* const ws0 = kp0->ws;
    if (C.tid == 0) *(LAS u32x4*)(C.lds + LDS_BARW) = (u32x4){0u, 0u, 0u, 0u};
    __syncthreads();
    XcdBarrier bar; bar.bar = (GAS unsigned*)(ws0 + WS_CTL) + CW_BAR; bar.x = 0; bar.st = (volatile LAS unsigned*)(C.lds + LDS_BARW);
    if (hi - lo > 1) bar = xcd_barrier_post((GAS unsigned*)(ws0 + WS_CTL) + CW_BAR, (volatile LAS unsigned*)(C.lds + LDS_BARW), C.tid);
#define FRESH() do { KParams kq_ = kp0; asm volatile("" : "+s"(kq_)); { const __attribute__((address_space(4))) unsigned long long* kw_ = (const __attribute__((address_space(4))) unsigned long long*)kq_; unsigned long long* pw_ = (unsigned long long*)&p; _Pragma("unroll") for (int i_ = 0; i_ < (int)(sizeof(Params) / 8); ++i_) pw_[i_] = kw_[i_]; } int wv_ = wave0; asm volatile("" : "+s"(wv_)); \
        unsigned mk_ = ~0u; asm volatile("" : "+s"(mk_)); int ln_ = __builtin_amdgcn_mbcnt_hi(mk_, __builtin_amdgcn_mbcnt_lo(mk_, 0u)); asm volatile("" : "+v"(ln_)); C.wave = wv_; C.lane = ln_; C.tid = wv_ * 64 + ln_; } while (0)
#ifndef PH_MASK
#define PH_MASK 0xFFFF
#endif
#define PM(b) ((PH_MASK >> (b)) & 1)
#ifndef REP_MASK
#define REP_MASK 0
#endif
#define RP(b) for (int rep_ = 0; rep_ < 1 + ((REP_MASK >> (b)) & 1); ++rep_)
#ifdef DBG_TIME
#define STAMP(k) do { if (blockIdx.x == 0 && C.tid == 0) ((GAS unsigned long long*)(ws0 + WS_END - 32768))[(k)] = wall_clock64(); } while (0)
#else
#define STAMP(k) do { } while (0)
#endif
#define IN(k) (lo <= (k) && (k) < hi)
#define SEAM(k) do { if (IN(k) && IN((k) + 1)) { FRESH(); xcd_barrier(bar, C.tid); if ((REP_MASK >> 15) & 1) { xcd_barrier(bar, C.tid); xcd_barrier(bar, C.tid); } STAMP((k) + 1); } } while (0)
    STAMP(0);
    if (PM(0) && IN(0)) RP(0) { FRESH(); p0_prologue(p, C); __syncthreads(); }
    SEAM(0);
#pragma nounroll
    for (int l = 0; l < DEPTH; ++l) {
        const int P = 1 + 9 * l; const bool odd = (l & 1) != 0;
        if (PM(1) && IN(P)) { if ((REP_MASK >> 1) & 1) { FRESH(); norm_phase<false, true>(p, C, l); __syncthreads(); } FRESH(); norm_phase<false>(p, C, l); }
        SEAM(P);
        if (PM(2) && IN(P + 1)) RP(2) { FRESH();
            const GAS bf16_t* W = odd ? (const GAS bf16_t*)(p.ws + WS_WINO) + (size_t)(l >> 1) * NPO * D : (const GAS bf16_t*)(p.ws + WS_WINE) + (size_t)(l >> 1) * NPE * D;
            pg8::StaticOrder S; S.init(p.ws + WS_H, W, T, odd ? NPO : NPE, D, C.G, C.bid);
            EpiU E{(GAS bf16_t*)(p.ws + WS_U)};
            pg8::gemm_phase<EpiU, pg8::StaticOrder, false>(C.lds, C.tid, D, S, E);
        }
        SEAM(P + 1);
        if (IN(P + 2)) { FRESH();
            if (!odd) { if (PM(3)) RP(3) { const int h = C.bid & 7; rk_load_const(p, C, l, h); RkPre pre; rk_prefetch(p, C.tid, h, C.bid, pre);
                            bf16x8 wf[4][2]; { const int prod = C.wave >> 2; const GAS bf16_t* Wt = (const GAS bf16_t*)(p.ws + (prod ? WS_AUPT : WS_WUPT)) + ((size_t)(l >> 1) * 512 + 64 * h) * 64;
#pragma unroll
                              for (int bt = 0; bt < 4; ++bt) { wf[bt][0] = rf_glb(Wt, 64, 16 * bt, 0, C.lane); wf[bt][1] = rf_glb(Wt, 64, 16 * bt, 32, C.lane); } }
                            __syncthreads();
                            for (int it = C.bid; it < 4096; it += C.G) rwkv_pass1_item(p, C, l, it, (it + C.G < 4096) ? it + C.G : it, pre, wf); }
                        if (PM(4)) RP(4) { gla_stage_aup<false>(p, C, l, C.bid & 3); GlPre pre1; gla_prefetch1<false>(p, C.tid, C.bid, pre1); __syncthreads(); for (int it = C.bid; it < 2048; it += C.G) gla_pass1_item<false>(p, C, l, it, (it + C.G < 2048) ? it + C.G : it, pre1); } }
            else      { if (PM(4)) RP(4) { GlPre pre1; gla_prefetch1<true>(p, C.tid, C.bid, pre1); for (int it = C.bid; it < 2048; it += C.G) gla_pass1_item<true>(p, C, l, it, (it + C.G < 2048) ? it + C.G : it, pre1); }
                        if (PM(5)) RP(5) { ssd_load_cw(p, C, l, C.bid & 1); __syncthreads(); for (int it = C.bid; it < 1024; it += C.G) ssd_pass1_item(p, C, l, it); } }
        }
        SEAM(P + 2);
        if (PM(6) && IN(P + 3)) RP(6) { FRESH();
            if (!odd) { if (C.wave == 0) { for (int job = C.bid; job < 256; job += C.G) rwkv_pass2_job(p, C.lds + LDS_P2SCR, job, C.lane); }
                        else if (C.wave <= 4) { for (int job = C.bid * 4 + C.wave - 1; job < 1024; job += C.G * 4) gla_pass2_job<false>(p, job, C.lane); } }
            else      { if (C.wave < 4) { for (int job = C.bid * 4 + C.wave; job < 1024; job += C.G * 4) gla_pass2_job<true>(p, job, C.lane); }
                        else { for (int job = C.bid * 4 + C.wave - 4; job < 1024; job += C.G * 4) ssd_pass2_job(p, job, C.lane); } }
        }
        SEAM(P + 3);
        if (IN(P + 4)) { FRESH();
            if (!odd) { if (PM(7)) RP(7) { rwkv_p3_load_const(p, C, l); R3Pre pre3; rwkv_p3_prefetch(p, C.tid, C.wave, C.bid, pre3); __syncthreads(); for (int it = C.bid; it < 2048; it += C.G) rwkv_pass3_pair(p, C, l, it, (it + C.G < 2048) ? it + C.G : it, pre3); __syncthreads(); }
                        if (PM(8)) RP(8) { Gl3Pre pre3; gla_prefetch3<false>(p, C.tid, C.bid, pre3); for (int it = C.bid; it < 2048; it += C.G) gla_pass3_item<false>(p, C, l, it, (it + C.G < 2048) ? it + C.G : it, pre3); } }
            else      { if (PM(8)) RP(8) { Gl3Pre pre3; gla_prefetch3<true>(p, C.tid, C.bid, pre3); for (int it = C.bid; it < 2048; it += C.G) gla_pass3_item<true>(p, C, l, it, (it + C.G < 2048) ? it + C.G : it, pre3); }
                        if (PM(9)) RP(9) { ssd_load_cw(p, C, l, C.bid & 1); __syncthreads(); for (int it = C.bid; it < 1024; it += C.G) ssd_pass3_item(p, C, l, it); } }
        }
        SEAM(P + 4);
        if (PM(10) && IN(P + 5)) { FRESH();
            pg8::StaticOrder S; S.init(p.ws + WS_Y, (const GAS bf16_t*)(p.ws + WS_WOUT) + (size_t)l * D * D, T, D, D, C.G, C.bid);
            EpiOut E{(GAS bf16_t*)(p.ws + WS_XB), (const GAS float*)(p.ws + WS_MOD) + (size_t)l * NB * 6 * D + 2 * D};
            pg8::gemm_phase<EpiOut, pg8::StaticOrder, false>(C.lds, C.tid, D, S, E);
        }
        SEAM(P + 5);
        if (PM(11) && IN(P + 6)) { if ((REP_MASK >> 11) & 1) { FRESH(); route_phase<true>(p, C, l); __syncthreads(); } FRESH(); route_phase<false>(p, C, l); }
        SEAM(P + 6);
        if (PM(12) && IN(P + 7)) RP(12) { FRESH();
            LAS int* tab = (LAS int*)(C.lds + LDS_TAB); moe_table(p, C, l, tab);
            MoeOrder S{(const GAS char*)(p.ws + WS_H), (const GAS char*)(p.ws + moe_wgu(l)), D, (size_t)1024 * D * 2, tab, (const GAS int*)(p.ws + WS_LISTA), C.G, C.bid, false};
            EpiUp E{(GAS bf16_t*)(p.ws + WS_ACT)};
            pg8::gemm_phase<EpiUp, MoeOrder, true>(C.lds, C.tid, D, S, E);
            FRESH(); moe_convert_tail(p, C, l, (const LAS int*)(C.lds + LDS_TAB), 0);
        }
        SEAM(P + 7);
        if (PM(13) && IN(P + 8)) RP(13) { FRESH();
            LAS int* tab = (LAS int*)(C.lds + LDS_TAB); moe_table(p, C, l, tab);
            MoeOrder S{(const GAS char*)(p.ws + WS_ACT), (const GAS char*)(p.ws + moe_wdn(l)), DEXP, (size_t)D * DEXP * 2, tab, (const GAS int*)(p.ws + WS_LISTA), C.G, C.bid, true};
            EpiDown E{(GAS bf16_t*)(p.ws + WS_YB), (const GAS int*)(p.ws + WS_LISTA), (const GAS float*)(p.ws + WS_LISTW)};
            pg8::gemm_phase<EpiDown, MoeOrder, false>(C.lds, C.tid, DEXP, S, E);
            FRESH(); moe_convert_tail(p, C, l, (const LAS int*)(C.lds + LDS_TAB), 1);
        }
        SEAM(P + 8);
    }
    if (PM(14) && IN(N_PHASES - 1)) { FRESH(); norm_phase<true>(p, C, DEPTH - 1); }
    __syncthreads(); STAMP(N_PHASES);
#undef IN
#undef PM
#undef SEAM
}


#ifdef DBG
constexpr int CW_DBG = 8192;
__global__ void dbg_scan(const void* base, int rows, int cols, int pitch, int is_f32, unsigned* flags, unsigned bit, float thr = 1e30f) {
    bool bad = false;
    for (size_t i = (size_t)blockIdx.x * blockDim.x + threadIdx.x; i < (size_t)rows * cols; i += (size_t)gridDim.x * blockDim.x) {
        const size_t r = i / cols, c = i % cols;
        float v = is_f32 ? ((const float*)base)[r * pitch + c] : bf2f(((const bf16_t*)base)[r * pitch + c]);
        if (!(fabsf(v) < thr)) bad = true;
    }
    if (bad) atomicOr(flags, bit);
}

__global__ void dbg_count(const void* base, size_t n, int is_f32, unsigned long long* cnt) {
    unsigned long long c = 0;
    for (size_t i = (size_t)blockIdx.x * blockDim.x + threadIdx.x; i < n; i += (size_t)gridDim.x * blockDim.x) {
        float v = is_f32 ? ((const float*)base)[i] : bf2f(((const bf16_t*)base)[i]);
        if (!(fabsf(v) < 1e30f)) ++c;
    }
    if (c) atomicAdd(cnt, c);
}
__global__ void dbg_log2(const unsigned long long* cnt, unsigned* flags) { unsigned long long c = *cnt; unsigned k = 0; while (c) { ++k; c >>= 1; } *flags = k; }

__global__ void dbg_sum(const void* base, int rows, int cols, int pitch, int esz, unsigned long long* slot) {
    unsigned long long c = 0;
    for (size_t i = (size_t)blockIdx.x * blockDim.x + threadIdx.x; i < (size_t)rows * cols; i += (size_t)gridDim.x * blockDim.x) {
        const size_t r = i / cols, cc = i % cols;
        const unsigned v = esz == 4 ? ((const unsigned*)base)[r * pitch + cc] : (unsigned)((const unsigned short*)base)[r * pitch + cc];
        c += (unsigned long long)v * (unsigned long long)(1 + (i & 1023));
    }
    atomicAdd(slot, c);
}
__global__ void dbg_cmpmask(const unsigned long long* s1, const unsigned long long* s2, int n, unsigned* flags) { unsigned f = 0; for (int i = 0; i < n; ++i) if (s1[i] != s2[i]) f |= 1u << i; *flags = f; }
__global__ void dbg_cmp(const unsigned long long* s1, const unsigned long long* s2, int n, unsigned* flags) { unsigned f = 0; for (int i = n - 1; i >= 0; --i) if (s1[i] != s2[i]) f = (unsigned)i; *flags = f; }
__global__ void dbg_emit(float* out, const unsigned* flags) {
    const size_t i = (size_t)blockIdx.x * blockDim.x + threadIdx.x;
    if (i < (size_t)T * D) out[i] = (i == 0) ? sqrtf((float)(flags[0] + flags[1]) * (float)T * (float)D) : 0.f;
}
#endif

#ifdef DBG_TIME
__global__ void dbg_time_emit(float* out, const unsigned long long* st) {
    const size_t i = (size_t)blockIdx.x * blockDim.x + threadIdx.x;
    const float da = (float)(st[DBG_TA1] - st[DBG_TA0]) * 0.01f, db = (float)(st[DBG_TB1] - st[DBG_TB0]) * 0.01f;
    if (i < (size_t)T * D) out[i] = (i == 0) ? db : sqrtf(da);
}
#endif
extern "C" void kernel_launch(void* const* d_in, const int* in_sizes, int n_in, void* d_out, int out_size, void* d_ws, size_t ws_size, hipStream_t stream) {
    static int grid = 0;
    if (grid == 0) {
        if (n_in != 36 || out_size != T * D || ws_size < WS_END) { fprintf(stderr, "kernel_launch: unexpected shapes (n_in %d out %d ws %zu need %zu)\n", n_in, out_size, ws_size, (size_t)WS_END); grid = -1; return; }
        int dev = 0, cus = 0, per_cu = 0;
        if (hipGetDevice(&dev) != hipSuccess || hipDeviceGetAttribute(&cus, hipDeviceAttributeMultiprocessorCount, dev) != hipSuccess) { grid = -1; return; }
        if (hipFuncSetAttribute((const void*)mk_fwd, hipFuncAttributeMaxDynamicSharedMemorySize, LDS_BYTES) != hipSuccess) { fprintf(stderr, "kernel_launch: hipFuncSetAttribute failed\n"); grid = -1; return; }
        if (hipOccupancyMaxActiveBlocksPerMultiprocessor(&per_cu, (const void*)mk_fwd, 512, LDS_BYTES) != hipSuccess || per_cu < 1) { fprintf(stderr, "kernel_launch: occupancy query says %d\n", per_cu); (void)hipGetLastError(); grid = -1; return; }
        grid = cus; if (grid % 8) { fprintf(stderr, "kernel_launch: grid %d is not a multiple of 8\n", grid); grid = -1; return; }
    }
    if (grid < 0) return;
#ifdef DBG_MEMSET_ALL
    (void)hipMemsetAsync((char*)d_ws, 0, WS_END, stream);
#else
    (void)hipMemsetAsync((char*)d_ws + WS_CTL, 0, CTL_BYTES, stream);
#endif
    Params p{};
    const float** pp = (const float**)&p;
    for (int i = 0; i < 36; ++i) pp[i] = (const float*)d_in[i];
    p.out = (GAS float*)d_out; p.ws = (GAS unsigned char*)d_ws;
#if MK_LAUNCHES == 1
    p.ph_lo = 0; p.ph_hi = N_PHASES;
    hipLaunchKernelGGL(mk_fwd, dim3(grid), dim3(512), LDS_BYTES, stream, p);
#ifdef DBG_TIME
    hipLaunchKernelGGL(dbg_time_emit, dim3(T * D / 256), dim3(256), 0, stream, (float*)d_out, (const unsigned long long*)((unsigned char*)d_ws + WS_END - 32768));
#endif
#else
#ifdef DBG_TWICE
    (void)hipMemsetAsync((char*)d_ws + WS_END - 65536, 0, 65536, stream);
    for (int rep = 0; rep < 2; ++rep) { if (rep) (void)hipMemsetAsync((char*)d_ws + WS_CTL, 0, CTL_BYTES, stream);
#else
    { const int rep = 0; (void)rep;
#endif
    for (int ph = 0; ph < N_PHASES; ++ph) { p.ph_lo = ph; p.ph_hi = ph + 1; hipLaunchKernelGGL(mk_fwd, dim3(grid), dim3(512), LDS_BYTES, stream, p);
#ifdef DBG
        unsigned char* ws = (unsigned char*)d_ws; unsigned* fl = (unsigned*)(ws + WS_CTL) + CW_DBG;
        DBG_HOOKS
#endif
    }
    }
#ifdef DBG
    { unsigned* fl = (unsigned*)((unsigned char*)d_ws + WS_CTL) + CW_DBG;
      hipLaunchKernelGGL(dbg_scan, dim3(1024), dim3(256), 0, stream, (const void*)d_out, T, D, D, 1, fl, DBG_FINAL_BIT);
      hipLaunchKernelGGL(dbg_emit, dim3(T * D / 256), dim3(256), 0, stream, (float*)d_out, (const unsigned*)fl); }
#endif
#endif
}
```

```cpp
#include <hip/hip_runtime.h>
#include <stdint.h>
#include <stdio.h>

#ifndef MK_LAUNCHES
#define MK_LAUNCHES 1
#endif

#define LAS __attribute__((address_space(3)))
#if defined(__HIP_DEVICE_COMPILE__)
#define GAS __attribute__((address_space(1)))
#else
#define GAS
#endif
typedef unsigned short bf16_t;
typedef short bf16x8 __attribute__((ext_vector_type(8)));
typedef unsigned short u16x4 __attribute__((ext_vector_type(4)));
typedef float f32x4 __attribute__((ext_vector_type(4)));
typedef float f32x2 __attribute__((ext_vector_type(2)));
typedef unsigned u32x4 __attribute__((ext_vector_type(4)));
typedef unsigned u32x2 __attribute__((ext_vector_type(2)));

constexpr int D = 1024, NB = 8, SEQ = 4096, T = NB * SEQ, DEPTH = 4, CH = 64, NCH = SEQ / CH;
constexpr int EVEN_IN = 3344, ODD_IN = 2824, NPE = 3584, NPO = 3072, UPITCH = 3584;
constexpr int RW_R = 0, RW_K = 512, RW_V = 1024, RW_WD = 1536, RW_AD = 1600, RW_GD = 1664, RWKV_IN = 1792;
constexpr int GL_Q = 1792, GL_K = 2048, GL_V = 2304, GL_AD = 2816, GL_G = 2832;
constexpr int HG_Q = 0, HG_F = 256, HG_I = 512, HG_G = 1024, HGRN_IN = 1536;
constexpr int SD_Z = 1536, SD_XBC = 2048, SD_XS = 2048, SD_BM = 2560, SD_CM = 2688, SD_DT = 2816;
constexpr int NEXP = 16, DEXP = 512;
constexpr float NORM_EPS = 1e-6f;

constexpr size_t al256(size_t x) { return (x + 255) & ~(size_t)255; }
constexpr size_t WS_CTL = 0;
constexpr size_t CTL_BYTES = 65536;
constexpr size_t WS_MOD = WS_CTL + CTL_BYTES;
constexpr size_t WS_LB = WS_MOD + al256((size_t)DEPTH * NB * 6 * D * 4);
constexpr size_t WS_WINE = WS_LB + al256((size_t)DEPTH * 256 * 4);
constexpr size_t WS_WINO = WS_WINE + (size_t)2 * NPE * D * 2;
constexpr size_t WS_WOUT = WS_WINO + (size_t)2 * NPO * D * 2;
constexpr size_t WS_WGU = WS_WOUT + (size_t)4 * D * D * 2;
constexpr size_t WS_WDN = WS_WGU + (size_t)NEXP * 1024 * D * 2;
constexpr size_t WS_WUPT = WS_WDN + (size_t)NEXP * D * DEXP * 2;
constexpr size_t WS_AUPT = WS_WUPT + (size_t)2 * 512 * 64 * 2;
constexpr size_t WS_GUPT = WS_AUPT + (size_t)2 * 512 * 64 * 2;
constexpr size_t WS_LISTA = WS_GUPT + (size_t)2 * 512 * 128 * 2;
constexpr size_t WS_LISTW = WS_LISTA + (size_t)NEXP * T * 4;
constexpr size_t WS_Y = WS_LISTW + (size_t)NEXP * T * 4;
constexpr size_t WS_U = WS_Y + (size_t)T * D * 2;
constexpr size_t WS_H = WS_U + (size_t)T * UPITCH * 2;
constexpr size_t WS_MIX = WS_H + (size_t)T * D * 2;
constexpr size_t MIX_BYTES = (size_t)162 * 1024 * 1024;
constexpr size_t WS_XB = WS_MIX + MIX_BYTES;
constexpr size_t WS_END = WS_XB + (size_t)T * D * 2;
constexpr size_t WS_PGU = WS_XB - (size_t)NEXP * 1024 * D * 2 - (size_t)NEXP * D * DEXP * 2;
constexpr size_t WS_PDN = WS_PGU + (size_t)NEXP * 1024 * D * 2;
__host__ __device__ constexpr size_t moe_wgu(int layer) { return (layer & 1) ? WS_PGU : WS_WGU; }
__host__ __device__ constexpr size_t moe_wdn(int layer) { return (layer & 1) ? WS_PDN : WS_WDN; }
constexpr size_t WS_ACT = WS_U;
constexpr size_t ACT_ROWS = (size_t)(2 * T / 256 + NEXP) * 256;
constexpr size_t WS_YB = WS_ACT + al256(ACT_ROWS * DEXP * 2);
static_assert(WS_YB + (size_t)2 * T * D * 2 <= WS_H, "MoE aliases overflow U");
static_assert(WS_END <= (size_t)706000000, "workspace larger than the guaranteed ws_size");
constexpr int CW_BAR = 0;
constexpr int CW_CNT = 4096;

typedef __bf16 bf16x2_t __attribute__((ext_vector_type(2)));
__device__ __forceinline__ unsigned pk2(float lo, float hi) { const f32x2 v = {lo, hi}; const bf16x2_t b = __builtin_convertvector(v, bf16x2_t); return __builtin_bit_cast(unsigned, b); }
__device__ __forceinline__ float bflo(unsigned u) { return __uint_as_float(u << 16); }
__device__ __forceinline__ float bfhi(unsigned u) { return __uint_as_float(u & 0xffff0000u); }
__device__ __forceinline__ float bf2f(bf16_t b) { return __uint_as_float(((unsigned)b) << 16); }
__device__ __forceinline__ float rcpf_(float x) { return __builtin_amdgcn_rcpf(x); }
__device__ __forceinline__ float sigmoidf_(float x) { return rcpf_(1.f + __expf(-x)); }
__device__ __forceinline__ float siluf_(float x) { return x * rcpf_(1.f + __expf(-x)); }
__device__ __forceinline__ float softplusf_(float x) { return x > 20.f ? x : (x < -15.f ? __expf(x) : __logf(1.f + __expf(x))); }
__device__ __forceinline__ float logsigmoidf_(float x) { return fminf(x, 0.f) - __logf(1.f + __expf(-fabsf(x))); }
__device__ __forceinline__ void unpack8(const u32x4 v, float (&f)[8]) {
    f[0] = bflo(v.x); f[1] = bfhi(v.x); f[2] = bflo(v.y); f[3] = bfhi(v.y); f[4] = bflo(v.z); f[5] = bfhi(v.z); f[6] = bflo(v.w); f[7] = bfhi(v.w);
}
__device__ __forceinline__ u32x4 pack8(const float (&f)[8]) { u32x4 o; o.x = pk2(f[0], f[1]); o.y = pk2(f[2], f[3]); o.z = pk2(f[4], f[5]); o.w = pk2(f[6], f[7]); return o; }
__device__ __forceinline__ float wave_sum(float v) {
#pragma unroll
    for (int o = 1; o < 64; o <<= 1) v += __shfl_xor(v, o);
    return v;
}
#define MFMA16(a, b, c) __builtin_amdgcn_mfma_f32_16x16x32_bf16((a), (b), (c), 0, 0, 0)
#define SETTLE(acc) asm volatile("s_nop 7\n\ts_nop 7\n\ts_nop 7" : "+v"(acc))
#define LDS_BARRIER() asm volatile("s_waitcnt lgkmcnt(0)\n\ts_barrier" ::: "memory")
#define SETTLE4(a0, a1, a2, a3) asm volatile("s_nop 7\n\ts_nop 7\n\ts_nop 7" : "+v"(a0), "+v"(a1), "+v"(a2), "+v"(a3))

__device__ __forceinline__ bf16x8 rf_lds(const LAS unsigned char* tile, int strideB, int r0, int c0, int lane) {
    return *(const LAS bf16x8*)(tile + (r0 + (lane & 15)) * strideB + (c0 + 8 * (lane >> 4)) * 2);
}
__device__ __forceinline__ bf16x8 tf_lds(const LAS unsigned char* tile, int strideB, int r0, int c0, int lane) {
    const int g = lane >> 4, q = (lane & 15) >> 2, p = lane & 3;
    const unsigned a0 = (unsigned)(uintptr_t)tile + (unsigned)((r0 + 8 * g + q) * strideB + (c0 + 4 * p) * 2);
    const unsigned a1 = a0 + 4u * (unsigned)strideB;
    u16x4 lo, hi;
    asm volatile("ds_read_b64_tr_b16 %0, %2\n\tds_read_b64_tr_b16 %1, %3\n\ts_waitcnt lgkmcnt(0)" : "=&v"(lo), "=&v"(hi) : "v"(a0), "v"(a1) : "memory");
    bf16x8 r;
    r[0] = (short)lo[0]; r[1] = (short)lo[1]; r[2] = (short)lo[2]; r[3] = (short)lo[3]; r[4] = (short)hi[0]; r[5] = (short)hi[1]; r[6] = (short)hi[2]; r[7] = (short)hi[3];
    return r;
}

template <int STRIDE, int O0, int O1, int O2, int O3>
__device__ __forceinline__ void tf4_issue(unsigned a, u16x4& l0, u16x4& h0, u16x4& l1, u16x4& h1, u16x4& l2, u16x4& h2, u16x4& l3, u16x4& h3) {
    asm volatile("ds_read_b64_tr_b16 %0, %8 offset:%9\n\tds_read_b64_tr_b16 %1, %8 offset:%10\n\tds_read_b64_tr_b16 %2, %8 offset:%11\n\tds_read_b64_tr_b16 %3, %8 offset:%12\n\t"
                 "ds_read_b64_tr_b16 %4, %8 offset:%13\n\tds_read_b64_tr_b16 %5, %8 offset:%14\n\tds_read_b64_tr_b16 %6, %8 offset:%15\n\tds_read_b64_tr_b16 %7, %8 offset:%16"
                 : "=&v"(l0), "=&v"(h0), "=&v"(l1), "=&v"(h1), "=&v"(l2), "=&v"(h2), "=&v"(l3), "=&v"(h3)
                 : "v"(a), "n"(O0), "n"(O0 + 4 * STRIDE), "n"(O1), "n"(O1 + 4 * STRIDE), "n"(O2), "n"(O2 + 4 * STRIDE), "n"(O3), "n"(O3 + 4 * STRIDE) : "memory");
}
__device__ __forceinline__ bf16x8 tf_join(const u16x4 lo, const u16x4 hi) {
    bf16x8 r; r[0] = (short)lo[0]; r[1] = (short)lo[1]; r[2] = (short)lo[2]; r[3] = (short)lo[3]; r[4] = (short)hi[0]; r[5] = (short)hi[1]; r[6] = (short)hi[2]; r[7] = (short)hi[3]; return r;
}
__device__ __forceinline__ unsigned tf_base(const LAS unsigned char* tile, int strideB, int r0, int c0, int lane) {
    const int g = lane >> 4, q = (lane & 15) >> 2, p = lane & 3;
    return (unsigned)(uintptr_t)tile + (unsigned)((r0 + 8 * g + q) * strideB + (c0 + 4 * p) * 2);
}
template <int STRIDE>
__device__ __forceinline__ void tf_2x4(const LAS unsigned char* tile, int r0, int c0, int lane, bf16x8 (&f)[2][4]) {
    const unsigned a = tf_base(tile, STRIDE, r0, c0, lane);
    u16x4 l[8], h[8];
    tf4_issue<STRIDE, 0, 32, 64, 96>(a, l[0], h[0], l[1], h[1], l[2], h[2], l[3], h[3]);
    tf4_issue<STRIDE, 32 * STRIDE, 32 * STRIDE + 32, 32 * STRIDE + 64, 32 * STRIDE + 96>(a, l[4], h[4], l[5], h[5], l[6], h[6], l[7], h[7]);
    asm volatile("s_waitcnt lgkmcnt(0)" : "+v"(l[0]), "+v"(h[0]), "+v"(l[1]), "+v"(h[1]), "+v"(l[2]), "+v"(h[2]), "+v"(l[3]), "+v"(h[3]), "+v"(l[4]), "+v"(h[4]), "+v"(l[5]), "+v"(h[5]), "+v"(l[6]), "+v"(h[6]), "+v"(l[7]), "+v"(h[7]) :: "memory");
#pragma unroll
    for (int ks = 0; ks < 2; ++ks)
#pragma unroll
        for (int bt = 0; bt < 4; ++bt) f[ks][bt] = tf_join(l[4 * ks + bt], h[4 * ks + bt]);
}
template <int STRIDE>
__device__ __forceinline__ void tf_2x1(const LAS unsigned char* tile, int r0, int c0, int lane, bf16x8 (&f)[2]) {
    const unsigned a = tf_base(tile, STRIDE, r0, c0, lane);
    u16x4 l0, h0, l1, h1;
    asm volatile("ds_read_b64_tr_b16 %0, %4\n\tds_read_b64_tr_b16 %1, %4 offset:%5\n\tds_read_b64_tr_b16 %2, %4 offset:%6\n\tds_read_b64_tr_b16 %3, %4 offset:%7\n\ts_waitcnt lgkmcnt(0)"
                 : "=&v"(l0), "=&v"(h0), "=&v"(l1), "=&v"(h1) : "v"(a), "n"(4 * STRIDE), "n"(32 * STRIDE), "n"(36 * STRIDE) : "memory");
    f[0] = tf_join(l0, h0); f[1] = tf_join(l1, h1);
}
template <int STRIDE>
__device__ __forceinline__ void tf_1x2(const LAS unsigned char* tile, int r0, int c0, int lane, bf16x8 (&f)[2]) {
    const unsigned a = tf_base(tile, STRIDE, r0, c0, lane);
    u16x4 l0, h0, l1, h1;
    asm volatile("ds_read_b64_tr_b16 %0, %4\n\tds_read_b64_tr_b16 %1, %4 offset:%5\n\tds_read_b64_tr_b16 %2, %4 offset:%6\n\tds_read_b64_tr_b16 %3, %4 offset:%7\n\ts_waitcnt lgkmcnt(0)"
                 : "=&v"(l0), "=&v"(h0), "=&v"(l1), "=&v"(h1) : "v"(a), "n"(4 * STRIDE), "n"(32), "n"(32 + 4 * STRIDE) : "memory");
    f[0] = tf_join(l0, h0); f[1] = tf_join(l1, h1);
}
__device__ __forceinline__ bf16x8 rf_glb(const GAS bf16_t* base, int ld, int r0, int c0, int lane) {
    return *(const GAS bf16x8*)(base + (size_t)(r0 + (lane & 15)) * ld + c0 + 8 * (lane >> 4));
}
__device__ __forceinline__ void st4_lds(LAS unsigned char* tile, int strideB, int row, int col, f32x4 v) {
    u32x2 o; o.x = pk2(v[0], v[1]); o.y = pk2(v[2], v[3]);
    *(LAS u32x2*)(tile + row * strideB + col * 2) = o;
}
__device__ __forceinline__ f32x4 ld4_lds(const LAS unsigned char* tile, int strideB, int row, int col) {
    const u32x2 o = *(const LAS u32x2*)(tile + row * strideB + col * 2);
    return (f32x4){bflo(o.x), bfhi(o.x), bflo(o.y), bfhi(o.y)};
}
constexpr int TS = 144;
constexpr int TS2 = 272;
constexpr int TILE64 = 64 * TS;
constexpr int FS = 68;
constexpr int FTILE = 64 * FS * 4;

#define XB_TMO      128
#define XB_XCNT(j)  (256  + 64 * (j))
#define XB_XSUB(j)  (1280 + 64 * (j))
#define XB_XGEN(j)  (2304 + 64 * (j))
#define XB_TOP      3328
#define XB_TOPGEN   3392
#define XCD_BAR_WORDS 3456
#define XB_SPIN_CAP (1u << 18)
__device__ __forceinline__ unsigned xb_ld(GAS unsigned* p)              { return __hip_atomic_load(p, __ATOMIC_RELAXED, __HIP_MEMORY_SCOPE_AGENT); }
__device__ __forceinline__ unsigned xb_add(GAS unsigned* p, unsigned v) { return __hip_atomic_fetch_add(p, v, __ATOMIC_RELAXED, __HIP_MEMORY_SCOPE_AGENT); }
__device__ __forceinline__ unsigned xb_xcc_id() { return (unsigned)__builtin_amdgcn_s_getreg((3 << 11) | 20) & 0xFu; }
#define XB_SPIN(cond, bar) do { unsigned _sp = 0; while (cond) { __builtin_amdgcn_s_sleep(1); \
    if ((++_sp & 255u) == 0u) { if (xb_ld(&(bar)[XB_TMO])) break; if (_sp > XB_SPIN_CAP) { atomicAdd(&(bar)[XB_TMO], 1u); break; } } } } while (0)
struct XcdBarrier { GAS unsigned* bar; unsigned x; volatile LAS unsigned* st; };
__device__ __forceinline__ XcdBarrier xcd_barrier_post(GAS unsigned* bar, volatile LAS unsigned* st, int tid) {
    XcdBarrier b; b.bar = bar; b.x = xb_xcc_id(); b.st = st;
    if (tid == 0) (void)xb_add(&bar[XB_XCNT(b.x)], 1u);
    return b;
}
__device__ __forceinline__ void xcd_barrier_complete(GAS unsigned* bar, unsigned x, unsigned& nloc, unsigned& nx) {
    const unsigned G = gridDim.x * gridDim.y * gridDim.z;
    unsigned sum, cnt, mine, sp = 0u;
    for (;;) {
        sum = 0u; cnt = 0u; mine = 0u;
#pragma unroll
        for (unsigned j = 0; j < 16; ++j) { const unsigned c = xb_ld(&bar[XB_XCNT(j)]); sum += c; cnt += (c > 0u) ? 1u : 0u; mine = (j == x) ? c : mine; }
        if (sum == G) break;
        __builtin_amdgcn_s_sleep(1);
        if ((++sp & 255u) == 0u) { if (xb_ld(&bar[XB_TMO])) break; if (sp > XB_SPIN_CAP) { atomicAdd(&bar[XB_TMO], 1u); break; } }
    }
    nloc = mine > 0u ? mine : 1u; nx = cnt > 0u ? cnt : 1u;
}
__device__ __forceinline__ void xcd_barrier(const XcdBarrier& b, int tid) {
    asm volatile("s_waitcnt vmcnt(0)" ::: "memory");
    __syncthreads();
    if (tid == 0) {
        GAS unsigned* bar = b.bar;
        __builtin_amdgcn_s_waitcnt(0);
        unsigned nloc = b.st[0], nx = b.st[1];
        if (nloc == 0u) { xcd_barrier_complete(bar, b.x, nloc, nx); b.st[0] = nloc; b.st[1] = nx; }
        const unsigned old = xb_add(&bar[XB_XSUB(b.x)], 1u);
        const unsigned gen = old / nloc;
        if (old + 1u == (gen + 1u) * nloc) {
            __builtin_amdgcn_fence(__ATOMIC_RELEASE, "agent");
            asm volatile("s_waitcnt vmcnt(0)" ::: "memory");
            const unsigned og = xb_add(&bar[XB_TOP], 1u);
            const unsigned tg = og / nx;
            if (og + 1u == (tg + 1u) * nx) xb_add(&bar[XB_TOPGEN], 1u);
            else XB_SPIN(xb_ld(&bar[XB_TOPGEN]) == tg, bar);
            __builtin_amdgcn_fence(__ATOMIC_ACQUIRE, "agent");
            xb_add(&bar[XB_XGEN(b.x)], 1u);
            asm volatile("s_waitcnt vmcnt(0)" ::: "memory");
        } else {
            XB_SPIN(xb_ld(&bar[XB_XGEN(b.x)]) == gen, bar);
            __builtin_amdgcn_fence(__ATOMIC_ACQUIRE, "agent");
            asm volatile("s_waitcnt vmcnt(0)" ::: "memory");
        }
    }
    __syncthreads();
}
namespace pg8 {
constexpr int BM = 256, BK = 64, HALF = 128, HTB = HALF * BK * 2, STAGE_BYTES = 8 * HTB, NXCD = 8, WGM = 8;
__host__ __device__ __forceinline__ int lds_byte(int r, int c) { const int st = (r >> 4) * 2 + (c >> 5), rr = r & 15, cc = c & 31, ob = rr * 64 + cc * 2; return st * 1024 + (ob ^ (((ob >> 9) & 1) << 5)); }
__host__ __device__ __forceinline__ void stage_rc(int b, int& R, int& C) { const int st = b / 1024, sb = b % 1024, swz = sb ^ (((sb >> 9) & 1) << 5); R = (st >> 1) * 16 + swz / 64; C = (st & 1) * 32 + (swz % 64) / 2; }
__host__ __device__ __forceinline__ int perm32(int rho) { const int n = rho >> 4, i = rho & 15; return 8 * (i >> 2) + 4 * n + (i & 3); }

struct Unit { int pm, pn, e, ml; };

struct StaticOrder {
    const GAS char* A; const GAS char* Bt; int K;
    int nM, nN, nwg, G, c;
    __device__ void init(const GAS void* A_, const GAS void* Bt_, int M, int N, int K_, int G_, int c_) { A = (const GAS char*)A_; Bt = (const GAS char*)Bt_; K = K_; nM = M / BM; nN = N / BM; nwg = nM * nN; G = G_; c = c_; }
    __device__ bool next(int i, Unit& u) const {
        const long L = (long)i * G + c; if (L >= nwg) return false;
        int wgid = (int)L; { const int q = nwg / NXCD, r = nwg % NXCD, xcd = wgid % NXCD, off = wgid / NXCD; wgid = (xcd < r ? xcd * (q + 1) : r * (q + 1) + (xcd - r) * q) + off; }
        const int nig = WGM * nN, gid = wgid / nig, fm = gid * WGM, gsz = (nM - fm) < WGM ? (nM - fm) : WGM;
        u.pm = fm + ((wgid % nig) % gsz); u.pn = (wgid % nig) / gsz; u.e = 0; u.ml = 0; return true;
    }
    __device__ __forceinline__ const GAS char* a_base(const Unit& u) const { return A + (size_t)u.pm * BM * K * 2; }
    __device__ __forceinline__ const GAS char* b_base(const Unit& u) const { return Bt + (size_t)u.pn * BM * K * 2; }
    __device__ __forceinline__ void a_rows(const Unit&, int, unsigned (&)[2][2]) const {}
};

template <class Epi, class Sched, bool GATHER>
__device__ __forceinline__ void gemm_phase(LAS unsigned char* lds, const int tid_, const int K, const Sched& S, const Epi& E) {
    const int tid = tid_, wid = __builtin_amdgcn_readfirstlane(tid >> 6), lane = tid & 63, wr = wid >> 2, wc = wid & 3, fr = lane & 15, fq = lane >> 4;
    const int nt = K / BK;
    unsigned voffA[2], voffB[2];
#pragma unroll
    for (int i = 0; i < 2; ++i) { int R, C; stage_rc(tid * 16 + i * 8192, R, C); const int Rb = Epi::PERM ? ((R & ~31) + perm32(R & 31)) : R;
        voffA[i] = (unsigned)(R * K + C) * 2u; voffB[i] = (unsigned)(Rb * K + C) * 2u; }
    const size_t kstep = (size_t)(BK * 2);
    const size_t hstep = (size_t)HALF * K * 2;
    const unsigned ldsw = (unsigned)wid * 1024u;
    const int aoff = lds_byte(wr * 64 + fr, fq * 8), boff = lds_byte(wc * 32 + fr, fq * 8);
    unsigned offC[2][2], offN[2][2];
#define PG8_SA(b, h) (((b) * 2 + (h)) * HTB)
#define PG8_SB(b, h) ((4 + (b) * 2 + (h)) * HTB)
#define PG8_STAGE(bufoff, gbase, voff) do { _Pragma("unroll") for (int _i = 0; _i < 2; ++_i) \
        __builtin_amdgcn_global_load_lds((const GAS unsigned*)((const GAS char*)(gbase) + (voff)[_i]), (LAS unsigned*)(lds + (bufoff) + ldsw + _i * 8192), 16, 0, 0); } while (0)
#define PG8_STAGE_A(bufoff, gb, h, offs) do { if constexpr (GATHER) { PG8_STAGE(bufoff, gb, (offs)[h]); } else { PG8_STAGE(bufoff, (gb) + (h) * hstep, voffA); } } while (0)
#define PG8_LDA(dst, b, h) do { _Pragma("unroll") for (int m = 0; m < 4; ++m) _Pragma("unroll") for (int k = 0; k < 2; ++k) dst[m][k] = *(const LAS bf16x8*)(lds + PG8_SA(b, h) + aoff + m * 2048 + k * 1024); } while (0)
#define PG8_LDB(dst, b, h) do { _Pragma("unroll") for (int n = 0; n < 2; ++n) _Pragma("unroll") for (int k = 0; k < 2; ++k) dst[n][k] = *(const LAS bf16x8*)(lds + PG8_SB(b, h) + boff + n * 2048 + k * 1024); } while (0)
#define PG8_MMA(ai, bj, At, Bt) do { __builtin_amdgcn_s_setprio(1); _Pragma("unroll") for (int m = 0; m < 4; ++m) _Pragma("unroll") for (int n = 0; n < 2; ++n) _Pragma("unroll") for (int k = 0; k < 2; ++k) \
        acc[ai][bj][m][n] = __builtin_amdgcn_mfma_f32_16x16x32_bf16(Bt[n][k], At[m][k], acc[ai][bj][m][n], 0, 0, 0); __builtin_amdgcn_s_setprio(0); } while (0)
#define PG8_WAIT_V(n) asm volatile("s_waitcnt vmcnt(" #n ")" ::: "memory")
#define PG8_WAIT_L(n) asm volatile("s_waitcnt lgkmcnt(" #n ")" ::: "memory")
#define PG8_BAR __builtin_amdgcn_s_barrier()
#define PG8_SCHED __builtin_amdgcn_sched_barrier(0)
    Unit cur, nxt; int ui = 0;
    if (!S.next(0, cur)) return;
    f32x4 acc[2][2][4][2];
#pragma unroll
    for (int a = 0; a < 2; ++a)
#pragma unroll
        for (int b = 0; b < 2; ++b)
#pragma unroll
            for (int m = 0; m < 4; ++m)
#pragma unroll
                for (int n = 0; n < 2; ++n) acc[a][b][m][n] = (f32x4){0.f, 0.f, 0.f, 0.f};
    bf16x8 At[4][2], B0[2][2], B1[2][2];
    const GAS char* cA = S.a_base(cur); const GAS char* cB = S.b_base(cur);
    if constexpr (GATHER) { int tz = tid; asm volatile("" : "+v"(tz)); S.a_rows(cur, tz, offC);
#pragma unroll
        for (int h = 0; h < 2; ++h)
#pragma unroll
            for (int i = 0; i < 2; ++i) offN[h][i] = offC[h][i]; }
    PG8_STAGE(PG8_SB(0, 0), cB, voffB); PG8_STAGE(PG8_SB(0, 1), cB + hstep, voffB); PG8_STAGE_A(PG8_SA(0, 0), cA, 0, offC); PG8_STAGE_A(PG8_SA(0, 1), cA, 1, offC);
    if (wr == 1) PG8_BAR;
    PG8_WAIT_V(2); PG8_BAR;
    PG8_STAGE(PG8_SB(1, 0), cB + kstep, voffB); PG8_STAGE_A(PG8_SA(1, 0), cA + kstep, 0, offC); PG8_STAGE(PG8_SB(1, 1), cB + hstep + kstep, voffB);
    PG8_WAIT_V(6); PG8_BAR;
    for (;;) {
        const bool has_next = S.next(ui + 1, nxt);
        const GAS char* nA = has_next ? S.a_base(nxt) : cA; const GAS char* nB = has_next ? S.b_base(nxt) : cB;
        if constexpr (GATHER) { if (has_next) { int tz = tid; asm volatile("" : "+v"(tz)); S.a_rows(nxt, tz, offN); } }
        for (int t = 0; t < nt; t += 2) {
            const bool last = (t == nt - 2);
            const GAS char* a1 = cA + (size_t)(t + 1) * kstep;
            const GAS char* a2 = last ? nA : cA + (size_t)(t + 2) * kstep; const GAS char* b2 = last ? nB : cB + (size_t)(t + 2) * kstep;
            const GAS char* a3 = a2 + kstep; const GAS char* b3 = b2 + kstep;
            unsigned o2[2][2];
            if constexpr (GATHER) {
#pragma unroll
                for (int h = 0; h < 2; ++h)
#pragma unroll
                    for (int i = 0; i < 2; ++i) o2[h][i] = last ? offN[h][i] : offC[h][i]; }
            PG8_LDB(B0, 0, 0); PG8_LDB(B1, 0, 1); PG8_SCHED; PG8_LDA(At, 0, 0); PG8_STAGE_A(PG8_SA(1, 1), a1, 1, offC);
            PG8_WAIT_V(8); PG8_WAIT_L(0); PG8_BAR; PG8_MMA(0, 0, At, B0); PG8_MMA(0, 1, At, B1); PG8_BAR; PG8_SCHED;
            PG8_LDA(At, 0, 1); PG8_STAGE(PG8_SB(0, 0), b2, voffB); PG8_STAGE(PG8_SB(0, 1), b2 + hstep, voffB); PG8_STAGE_A(PG8_SA(0, 0), a2, 0, o2);
            PG8_WAIT_V(8); PG8_WAIT_L(0); PG8_BAR; PG8_MMA(1, 0, At, B0); PG8_MMA(1, 1, At, B1); PG8_BAR; PG8_SCHED;
            PG8_LDB(B0, 1, 0); PG8_LDB(B1, 1, 1); PG8_SCHED; PG8_LDA(At, 1, 0); PG8_STAGE_A(PG8_SA(0, 1), a2, 1, o2);
            PG8_WAIT_V(8); PG8_WAIT_L(0); PG8_BAR; PG8_MMA(0, 0, At, B0); PG8_MMA(0, 1, At, B1); PG8_BAR; PG8_SCHED;
            PG8_LDA(At, 1, 1); PG8_STAGE(PG8_SB(1, 0), b3, voffB); PG8_STAGE(PG8_SB(1, 1), b3 + hstep, voffB); PG8_STAGE_A(PG8_SA(1, 0), a3, 0, o2);
            PG8_WAIT_V(8); PG8_WAIT_L(0); PG8_BAR; PG8_MMA(1, 0, At, B0); PG8_MMA(1, 1, At, B1); PG8_BAR; PG8_SCHED;
        }
        if (wr == 0) PG8_BAR;
        asm volatile("s_nop 7\n\ts_nop 7\n\ts_nop 7" ::: "memory");
        { int tz = tid; asm volatile("" : "+v"(tz)); int wz = wid; asm volatile("" : "+s"(wz)); const int l2 = tz & 63;
          E(acc, cur, wz >> 2, wz & 3, l2 & 15, l2 >> 4); }
        if (!has_next) break;
#pragma unroll
        for (int a = 0; a < 2; ++a)
#pragma unroll
            for (int b = 0; b < 2; ++b)
#pragma unroll
                for (int m = 0; m < 4; ++m)
#pragma unroll
                    for (int n = 0; n < 2; ++n) acc[a][b][m][n] = (f32x4){0.f, 0.f, 0.f, 0.f};
        cur = nxt; cA = nA; cB = nB; ++ui;
        if constexpr (GATHER) {
#pragma unroll
            for (int h = 0; h < 2; ++h)
#pragma unroll
                for (int i = 0; i < 2; ++i) offC[h][i] = offN[h][i]; }
        if (wr == 1) PG8_BAR;
    }
    PG8_WAIT_V(0);
    PG8_BAR;
#undef PG8_SA
#undef PG8_SB
#undef PG8_STAGE
#undef PG8_STAGE_A
#undef PG8_LDA
#undef PG8_LDB
#undef PG8_MMA
#undef PG8_WAIT_V
#undef PG8_WAIT_L
#undef PG8_BAR
#undef PG8_SCHED
}
}
struct Params {
    const GAS float* x; const GAS float* c; const GAS float* norm_gain; const GAS float* w_ada; const GAS float* b_ada; const GAS float* w_in_even; const GAS float* w_in_odd; const GAS float* w_out;
    const GAS float* a_mu; const GAS float* a_w0; const GAS float* a_w_up; const GAS float* a_a0; const GAS float* a_a_up; const GAS float* a_g_up; const GAS float* a_k_k; const GAS float* a_k_a; const GAS float* a_r_k;
    const GAS float* a_ln_gain; const GAS float* a_ln_bias; const GAS float* b_alpha_up; const GAS float* b_alpha_bias; const GAS float* b_norm_gain; const GAS float* c_lb; const GAS float* c_norm_gain;
    const GAS float* d_conv_w; const GAS float* d_conv_b; const GAS float* d_dt_bias; const GAS float* d_a_log; const GAS float* d_skip; const GAS float* d_norm_gain;
    const GAS float* w_router; const GAS float* router_bias; const GAS float* w_gate; const GAS float* w_up; const GAS float* w_down; const GAS float* final_gain;
    GAS float* out; GAS unsigned char* ws;
    long long ph_lo, ph_hi;
};

struct Ctx {
    LAS unsigned char* lds; int tid, lane, wave, G, bid;
};

__device__ __forceinline__ void cvt_item(const GAS float* W, int K, int N, int ldw, GAS bf16_t* WT, int mode, LAS float* scr, int kb, int nb, int lane) {
    const int k0 = 64 * kb, n0 = 32 * nb;
    const int c4 = lane & 7, kr = lane >> 3; const int nn = n0 + 4 * c4;
    f32x4 v[8];
    if (nn + 3 < N && (ldw & 3) == 0) {
#pragma unroll
        for (int i = 0; i < 8; ++i) v[i] = __builtin_nontemporal_load((const GAS f32x4*)(W + (size_t)(k0 + 8 * i + kr) * ldw + nn));
    } else {
#pragma unroll
        for (int i = 0; i < 8; ++i) { const GAS float* r = W + (size_t)(k0 + 8 * i + kr) * ldw;
            v[i][0] = (nn + 0 < N) ? r[nn + 0] : 0.f; v[i][1] = (nn + 1 < N) ? r[nn + 1] : 0.f; v[i][2] = (nn + 2 < N) ? r[nn + 2] : 0.f; v[i][3] = (nn + 3 < N) ? r[nn + 3] : 0.f; }
    }
#pragma unroll
    for (int i = 0; i < 8; ++i) *(LAS f32x4*)(scr + (8 * i + kr) * 36 + 4 * c4) = v[i];
    asm volatile("s_waitcnt lgkmcnt(0)" ::: "memory");
    const int c = lane & 7;
#pragma unroll
    for (int j = 0; j < 4; ++j) { const int n = (lane >> 3) + 8 * j; const LAS float* s = scr + (8 * c) * 36 + n;
        u32x4 o; o.x = pk2(s[0 * 36], s[1 * 36]); o.y = pk2(s[2 * 36], s[3 * 36]); o.z = pk2(s[4 * 36], s[5 * 36]); o.w = pk2(s[6 * 36], s[7 * 36]);
        const int ng = n0 + n; const int row = mode == 0 ? ng : ((ng >> 7) * 256 + (mode == 2 ? 128 : 0) + (ng & 127));
        *(GAS u32x4*)(WT + (size_t)row * K + k0 + 8 * c) = o; }
    asm volatile("s_waitcnt lgkmcnt(0)" ::: "memory");
}
__device__ __forceinline__ void moe_convert(const Params& p, const Ctx& C, int layer, int w, int nw, int part  ) {
    LAS float* scr = (LAS float*)(C.lds + C.wave * 16384);
    GAS bf16_t* WGU = (GAS bf16_t*)(p.ws + moe_wgu(layer)); GAS bf16_t* WDN = (GAS bf16_t*)(p.ws + moe_wdn(layer));
    if (part != 1)
        for (int it = w; it < NEXP * 512; it += nw) { const int e = it >> 9, r = it & 511; const size_t wofs = ((size_t)layer * NEXP + e) * (size_t)D * DEXP;
            if (r < 256) cvt_item(p.w_gate + wofs, D, DEXP, DEXP, WGU + (size_t)e * 1024 * D, 1, scr, r >> 4, r & 15, C.lane);
            else         cvt_item(p.w_up + wofs, D, DEXP, DEXP, WGU + (size_t)e * 1024 * D, 2, scr, (r - 256) >> 4, (r - 256) & 15, C.lane); }
    if (part != 0)
        for (int it = w; it < NEXP * 256; it += nw) { const int e = it >> 8, r = it & 255; const size_t wofs = ((size_t)layer * NEXP + e) * (size_t)D * DEXP;
            cvt_item(p.w_down + wofs, DEXP, D, D, WDN + (size_t)e * D * DEXP, 0, scr, r >> 5, r & 31, C.lane); }
}
__device__ __forceinline__ void moe_convert_tail(const Params& p, const Ctx& C, int layer, const LAS int* tab, int part) {
    if (layer + 1 >= DEPTH) return;
    const int U = __builtin_amdgcn_readfirstlane(tab[16]) * 4, lo = U % C.G;
    if (lo != 0 && C.bid < lo) return;
    const int j = lo == 0 ? C.bid : C.bid - lo, nidle = lo == 0 ? C.G : C.G - lo;
    moe_convert(p, C, layer + 1, j * 8 + C.wave, nidle * 8, part);
}

__device__ __forceinline__ void p0_prologue(const Params& p, const Ctx& C) {
    {
        LAS float* cs = (LAS float*)C.lds;
        LAS float* red = (LAS float*)(C.lds + 32768);
        for (int i = C.tid; i < NB * D; i += 512) cs[i] = siluf_(p.c[i]);
        __syncthreads();
        GAS float* mod = (GAS float*)(p.ws + WS_MOD);
        for (int it = C.bid; it < DEPTH * 96; it += C.G) {
            const int l = it / 96, cg = it % 96;
            const GAS float* W = p.w_ada + (size_t)l * D * 6 * D + 64 * cg + C.lane;
            float acc[8];
#pragma unroll
            for (int b = 0; b < 8; ++b) acc[b] = 0.f;
            const int k0 = 128 * C.wave;
#pragma unroll 8
            for (int k = 0; k < 128; ++k) { const float wv = W[(size_t)(k0 + k) * 6 * D];
#pragma unroll
                for (int b = 0; b < 8; ++b) acc[b] += cs[b * D + k0 + k] * wv; }
#pragma unroll
            for (int b = 0; b < 8; ++b) red[(C.wave * 8 + b) * 64 + C.lane] = acc[b];
            __syncthreads();
            { const int b = C.tid >> 6, col = C.tid & 63; float s = p.b_ada[l * 6 * D + 64 * cg + col];
#pragma unroll
              for (int w = 0; w < 8; ++w) s += red[(w * 8 + b) * 64 + col];
              mod[((size_t)l * NB + b) * 6 * D + 64 * cg + col] = s; }
            __syncthreads();
        }
    }
    if (C.bid == 0 && C.tid < 256) {
        float v[4], m = -1e30f;
#pragma unroll
        for (int l = 0; l < 4; ++l) { v[l] = p.c_lb[l * 256 + C.tid]; m = fmaxf(m, v[l]); }
        float s = 0.f;
#pragma unroll
        for (int l = 0; l < 4; ++l) { v[l] = __expf(v[l] - m); s += v[l]; }
        GAS float* lb = (GAS float*)(p.ws + WS_LB); float cum = 0.f; const float c0 = v[0] / s;
#pragma unroll
        for (int l = 0; l < 4; ++l) { cum += v[l] / s; lb[l * 256 + C.tid] = cum - c0; }
    }
    __syncthreads();
    {
        LAS float* scr = (LAS float*)(C.lds + C.wave * 16384);
        const int gw = C.bid * 8 + C.wave, NGW = C.G * 8;
        constexpr int I_E = 16 * (NPE / 32), I_O = 16 * (NPO / 32), I_W = 16 * 32, I_S1 = 16, I_S2 = 32;
        constexpr int NIT = 2 * I_E + 2 * I_O + 4 * I_W + 2 * (2 * I_S1 + I_S2);
        for (int it = gw; it < NIT; it += NGW) {
            int r = it;
            if (r < 2 * I_E) { const int j = r / I_E; r %= I_E; cvt_item(p.w_in_even + (size_t)j * D * EVEN_IN, D, EVEN_IN, EVEN_IN, (GAS bf16_t*)(p.ws + WS_WINE) + (size_t)j * NPE * D, 0, scr, r / (NPE / 32), r % (NPE / 32), C.lane); continue; }
            r -= 2 * I_E;
            if (r < 2 * I_O) { const int j = r / I_O; r %= I_O; cvt_item(p.w_in_odd + (size_t)j * D * ODD_IN, D, ODD_IN, ODD_IN, (GAS bf16_t*)(p.ws + WS_WINO) + (size_t)j * NPO * D, 0, scr, r / (NPO / 32), r % (NPO / 32), C.lane); continue; }
            r -= 2 * I_O;
            if (r < 4 * I_W) { const int l = r / I_W; r %= I_W; cvt_item(p.w_out + (size_t)l * D * D, D, D, D, (GAS bf16_t*)(p.ws + WS_WOUT) + (size_t)l * D * D, 0, scr, r / 32, r % 32, C.lane); continue; }
            r -= 4 * I_W;
            { const int j = r / (2 * I_S1 + I_S2); r %= (2 * I_S1 + I_S2);
              if (r < I_S1) cvt_item(p.a_w_up + (size_t)j * 64 * 512, 64, 512, 512, (GAS bf16_t*)(p.ws + WS_WUPT) + (size_t)j * 512 * 64, 0, scr, 0, r, C.lane);
              else if (r < 2 * I_S1) cvt_item(p.a_a_up + (size_t)j * 64 * 512, 64, 512, 512, (GAS bf16_t*)(p.ws + WS_AUPT) + (size_t)j * 512 * 64, 0, scr, 0, r - I_S1, C.lane);
              else { r -= 2 * I_S1; cvt_item(p.a_g_up + (size_t)j * 128 * 512, 128, 512, 512, (GAS bf16_t*)(p.ws + WS_GUPT) + (size_t)j * 512 * 128, 0, scr, r >> 4, r & 15, C.lane); } }
        }
        moe_convert(p, C, 0, gw, NGW, -1);
    }
}

template <bool FINAL, bool DRY = false>
__device__ __forceinline__ void norm_phase(const Params& p, const Ctx& C, int layer) {
    const int gw = C.bid * 8 + C.wave, NGW = C.G * 8;
    const GAS float* mod = (const GAS float*)(p.ws + WS_MOD);
    const GAS bf16_t* YB = (const GAS bf16_t*)(p.ws + WS_YB);
    GAS bf16_t* H = (GAS bf16_t*)(p.ws + WS_H); GAS bf16_t* XB = (GAS bf16_t*)(p.ws + WS_XB);
    const bool first = (layer == 0) && !FINAL;
    const int lprev = FINAL ? DEPTH - 1 : layer - 1;
    for (int blk = gw; blk < T / 16; blk += NGW) {
        const int row0 = blk * 16, b = row0 >> 12;
        f32x4 gf[4], ca[4], cb[4];
#pragma unroll
        for (int j = 0; j < 4; ++j) {
            gf[j] = first ? (f32x4){0.f, 0.f, 0.f, 0.f} : *((const GAS f32x4*)(mod + ((size_t)lprev * NB + b) * 6 * D + 5 * D) + C.lane + 64 * j);
            if (FINAL) { ca[j] = *((const GAS f32x4*)p.final_gain + C.lane + 64 * j); cb[j] = (f32x4){0.f, 0.f, 0.f, 0.f}; }
            else { const GAS float* m = mod + ((size_t)layer * NB + b) * 6 * D;
                const f32x4 g = *((const GAS f32x4*)(p.norm_gain + (size_t)layer * 2 * D) + C.lane + 64 * j); const f32x4 sc = *((const GAS f32x4*)(m + D) + C.lane + 64 * j);
                ca[j] = g * (1.f + sc); cb[j] = *((const GAS f32x4*)m + C.lane + 64 * j); } }
#pragma unroll 1
        for (int r4 = 0; r4 < 16; r4 += 4) {
            f32x4 v[4][4]; u32x2 ya[4][4], yc[4][4];
#pragma unroll
            for (int q = 0; q < 4; ++q) { const int row = row0 + r4 + q;
                if (first) { const GAS f32x4* xr = (const GAS f32x4*)(p.x + (size_t)row * D) + C.lane;
#pragma unroll
                    for (int j = 0; j < 4; ++j) v[q][j] = __builtin_nontemporal_load(xr + 64 * j);
                } else { const GAS u32x2* xr = (const GAS u32x2*)(XB + (size_t)row * D) + C.lane;
#pragma unroll
                    for (int j = 0; j < 4; ++j) { const u32x2 t = xr[64 * j]; v[q][j] = (f32x4){bflo(t.x), bfhi(t.x), bflo(t.y), bfhi(t.y)}; }
                    const GAS u32x2* y0 = (const GAS u32x2*)(YB + (size_t)(2 * row) * D) + C.lane; const GAS u32x2* y1 = (const GAS u32x2*)(YB + (size_t)(2 * row + 1) * D) + C.lane;
#pragma unroll
                    for (int j = 0; j < 4; ++j) { ya[q][j] = __builtin_nontemporal_load(y0 + 64 * j); yc[q][j] = __builtin_nontemporal_load(y1 + 64 * j); } } }
#pragma unroll
            for (int q = 0; q < 4; ++q) { const int row = row0 + r4 + q;
                if (!first) {
#pragma unroll
                    for (int j = 0; j < 4; ++j) { const u32x2 a = ya[q][j], c2 = yc[q][j];
                        v[q][j][0] += gf[j][0] * (bflo(a.x) + bflo(c2.x)); v[q][j][1] += gf[j][1] * (bfhi(a.x) + bfhi(c2.x)); v[q][j][2] += gf[j][2] * (bflo(a.y) + bflo(c2.y)); v[q][j][3] += gf[j][3] * (bfhi(a.y) + bfhi(c2.y)); } }
                float s2 = 0.f;
#pragma unroll
                for (int j = 0; j < 4; ++j) s2 += (v[q][j][0] * v[q][j][0] + v[q][j][1] * v[q][j][1]) + (v[q][j][2] * v[q][j][2] + v[q][j][3] * v[q][j][3]);
                const float rstd = rsqrtf(wave_sum(s2) * (1.f / D) + NORM_EPS);
                if (FINAL) { GAS f32x4* o = (GAS f32x4*)(p.out + (size_t)row * D) + C.lane;
#pragma unroll
                    for (int j = 0; j < 4; ++j) o[64 * j] = v[q][j] * rstd * ca[j];
                } else {
                    GAS u32x2* xo = (GAS u32x2*)(XB + (size_t)row * D) + C.lane; GAS u32x2* ho = (GAS u32x2*)(H + (size_t)row * D) + C.lane;
#pragma unroll
                    for (int j = 0; j < 4; ++j) { if (!DRY) { u32x2 xs; xs.x = pk2(v[q][j][0], v[q][j][1]); xs.y = pk2(v[q][j][2], v[q][j][3]); xo[64 * j] = xs; }
                        const f32x4 h = v[q][j] * rstd * ca[j] + cb[j]; u32x2 o; o.x = pk2(h[0], h[1]); o.y = pk2(h[2], h[3]); ho[64 * j] = o; } } }
        }
    }
}

template <bool DRY = false>
__device__ __forceinline__ void route_phase(const Params& p, const Ctx& C, int layer) {
    LAS float* wr_l = (LAS float*)C.lds;
    LAS int* lcnt = (LAS int*)(C.lds + 65536);
    LAS int* lbase = lcnt + 16;
    LAS int* rinfo = lcnt + 32;
    LAS float* rgate = (LAS float*)(rinfo + 256);
    const GAS float* mod = (const GAS float*)(p.ws + WS_MOD);
    GAS bf16_t* H = (GAS bf16_t*)(p.ws + WS_H);
    GAS unsigned* cnt = (GAS unsigned*)(p.ws + WS_CTL) + CW_CNT + layer * 16;
    GAS int* lista = (GAS int*)(p.ws + WS_LISTA); GAS float* listw = (GAS float*)(p.ws + WS_LISTW);
    { f32x4 wv[8];
#pragma unroll
      for (int k = 0; k < 8; ++k) wv[k] = *((const GAS f32x4*)p.w_router + C.tid + 512 * k);
#pragma unroll
      for (int k = 0; k < 8; ++k) { const int i = 4 * (C.tid + 512 * k);
#pragma unroll
          for (int q = 0; q < 4; ++q) wr_l[((i & 15) + q) * D + (i >> 4)] = wv[k][q]; } }
    float rb[16];
#pragma unroll
    for (int e = 0; e < 16; ++e) rb[e] = p.router_bias[e];
    for (int blk = C.bid; blk < T / 128; blk += C.G) {
        if (C.tid < 16) lcnt[C.tid] = 0;
        __syncthreads();
        const int b = (blk * 128) >> 12;
        f32x4 ca[4], cb[4];
        { const GAS float* m = mod + ((size_t)layer * NB + b) * 6 * D;
#pragma unroll
          for (int j = 0; j < 4; ++j) { const f32x4 g = *((const GAS f32x4*)(p.norm_gain + (size_t)layer * 2 * D + D) + C.lane + 64 * j); const f32x4 sc = *((const GAS f32x4*)(m + 4 * D) + C.lane + 64 * j);
              ca[j] = g * (1.f + sc); cb[j] = *((const GAS f32x4*)(m + 3 * D) + C.lane + 64 * j); } }
#pragma unroll 1
        for (int rr = 0; rr < 16; rr += 2) {
            f32x4 v[2][4];
#pragma unroll
            for (int q = 0; q < 2; ++q) { const GAS u32x2* xr = (const GAS u32x2*)((const GAS bf16_t*)(p.ws + WS_XB) + (size_t)(blk * 128 + C.wave * 16 + rr + q) * D) + C.lane;
#pragma unroll
                for (int j = 0; j < 4; ++j) { const u32x2 t = xr[64 * j]; v[q][j] = (f32x4){bflo(t.x), bfhi(t.x), bflo(t.y), bfhi(t.y)}; } }
#pragma unroll
            for (int q = 0; q < 2; ++q) {
                const int rl = C.wave * 16 + rr + q, row = blk * 128 + rl;
                float s2 = 0.f;
#pragma unroll
                for (int j = 0; j < 4; ++j) s2 += (v[q][j][0] * v[q][j][0] + v[q][j][1] * v[q][j][1]) + (v[q][j][2] * v[q][j][2] + v[q][j][3] * v[q][j][3]);
                const float rstd = rsqrtf(wave_sum(s2) * (1.f / D) + NORM_EPS);
                GAS u32x2* ho = (GAS u32x2*)(H + (size_t)row * D) + C.lane;
                float lg[16];
#pragma unroll
                for (int e = 0; e < 16; ++e) lg[e] = 0.f;
#pragma unroll
                for (int j = 0; j < 4; ++j) { const f32x4 h = v[q][j] * rstd * ca[j] + cb[j]; u32x2 o; o.x = pk2(h[0], h[1]); o.y = pk2(h[2], h[3]); ho[64 * j] = o;
#pragma unroll
                    for (int e = 0; e < 16; ++e) { const f32x4 w4 = *(const LAS f32x4*)(wr_l + e * D + 4 * (C.lane + 64 * j)); lg[e] += (h[0] * w4[0] + h[1] * w4[1]) + (h[2] * w4[2] + h[3] * w4[3]); } }
                float r8[8], r4[4], r2[2], r1;
                { const bool hi = (C.lane & 32) != 0;
#pragma unroll
                  for (int k = 0; k < 8; ++k) { const float keep = hi ? lg[k + 8] : lg[k], send = hi ? lg[k] : lg[k + 8]; r8[k] = keep + __shfl_xor(send, 32); } }
                { const bool hi = (C.lane & 16) != 0;
#pragma unroll
                  for (int k = 0; k < 4; ++k) { const float keep = hi ? r8[k + 4] : r8[k], send = hi ? r8[k] : r8[k + 4]; r4[k] = keep + __shfl_xor(send, 16); } }
                { const bool hi = (C.lane & 8) != 0;
#pragma unroll
                  for (int k = 0; k < 2; ++k) { const float keep = hi ? r4[k + 2] : r4[k], send = hi ? r4[k] : r4[k + 2]; r2[k] = keep + __shfl_xor(send, 8); } }
                { const bool hi = (C.lane & 4) != 0; const float keep = hi ? r2[1] : r2[0], send = hi ? r2[0] : r2[1]; r1 = keep + __shfl_xor(send, 4); }
                r1 += __shfl_xor(r1, 2); r1 += __shfl_xor(r1, 1);
                const float myscore = sigmoidf_(r1);
                float sc16[16];
#pragma unroll
                for (int e = 0; e < 16; ++e) sc16[e] = __shfl(myscore, 4 * e);
                float sel[16];
#pragma unroll
                for (int e = 0; e < 16; ++e) sel[e] = sc16[e] + rb[e];
                int grp = 0; float best = -1e30f;
#pragma unroll
                for (int g = 0; g < 4; ++g) { float m1 = -1e30f, m2 = -1e30f;
#pragma unroll
                    for (int t = 0; t < 4; ++t) { const float s = sel[4 * g + t]; if (s > m1) { m2 = m1; m1 = s; } else if (s > m2) m2 = s; }
                    const float gs = m1 + m2; if (gs > best) { best = gs; grp = g; } }
                int i1 = 0, i2 = 0; float m1 = -1e30f, m2 = -1e30f; float s1 = 0.f, s2g = 0.f;
#pragma unroll
                for (int e = 0; e < 16; ++e) { if ((e >> 2) == grp) { const float s = sel[e]; if (s > m1) { m2 = m1; i2 = i1; s2g = s1; m1 = s; i1 = e; s1 = sc16[e]; } else if (s > m2) { m2 = s; i2 = e; s2g = sc16[e]; } } }
                const float inv = 1.f / (s1 + s2g);
                if (C.lane == 0 && !DRY) {
                    const int sl1 = __hip_atomic_fetch_add(&lcnt[i1], 1, __ATOMIC_RELAXED, __HIP_MEMORY_SCOPE_WORKGROUP), sl2 = __hip_atomic_fetch_add(&lcnt[i2], 1, __ATOMIC_RELAXED, __HIP_MEMORY_SCOPE_WORKGROUP);
                    rinfo[rl * 2 + 0] = i1 | (sl1 << 8); rinfo[rl * 2 + 1] = i2 | (sl2 << 8); rgate[rl * 2 + 0] = s1 * inv; rgate[rl * 2 + 1] = s2g * inv;
                }
            }
        }
        __syncthreads();
        if (C.tid < 16 && !DRY) lbase[C.tid] = (int)__hip_atomic_fetch_add(&cnt[C.tid], (unsigned)lcnt[C.tid], __ATOMIC_RELAXED, __HIP_MEMORY_SCOPE_AGENT);
        __syncthreads();
        if (C.tid < 256 && !DRY) { const int rl = C.tid >> 1, k = C.tid & 1; const int inf = rinfo[C.tid]; const int e = inf & 255, sl = inf >> 8;
            const size_t idx = (size_t)e * T + lbase[e] + sl; lista[idx] = (blk * 128 + rl) * 2 + k; listw[idx] = rgate[C.tid]; }
        __syncthreads();
    }
}
struct EpiU {
    static constexpr bool PERM = true;
    GAS bf16_t* O;
    __device__ __forceinline__ void operator()(const f32x4 (&acc)[2][2][4][2], const pg8::Unit& u, int wr, int wc, int fr, int fq) const {
        const int row0 = u.pm * 256 + wr * 64 + fr, col0 = u.pn * 256 + wc * 32 + 8 * fq;
#pragma unroll
        for (int ai = 0; ai < 2; ++ai)
#pragma unroll
            for (int m = 0; m < 4; ++m) { GAS bf16_t* rowp = O + (size_t)(row0 + ai * 128 + m * 16) * UPITCH + col0;
#pragma unroll
                for (int bj = 0; bj < 2; ++bj) { const f32x4 v0 = acc[ai][bj][m][0], v1 = acc[ai][bj][m][1];
                    u32x4 o; o.x = pk2(v0[0], v0[1]); o.y = pk2(v0[2], v0[3]); o.z = pk2(v1[0], v1[1]); o.w = pk2(v1[2], v1[3]);
                    *(GAS u32x4*)(rowp + bj * 128) = o; } }
    }
};
struct EpiOut {
    static constexpr bool PERM = true;
    GAS bf16_t* X; const GAS float* gm;
    __device__ __forceinline__ void operator()(const f32x4 (&acc)[2][2][4][2], const pg8::Unit& u, int wr, int wc, int fr, int fq) const {
        const int row0 = u.pm * 256 + wr * 64 + fr, col0 = u.pn * 256 + wc * 32 + 8 * fq;
        const GAS float* g = gm + (size_t)(row0 >> 12) * 6 * D + col0;
        f32x4 gv[2][2];
#pragma unroll
        for (int bj = 0; bj < 2; ++bj)
#pragma unroll
            for (int n = 0; n < 2; ++n) gv[bj][n] = *(const GAS f32x4*)(g + bj * 128 + n * 4);
        u32x4 xr[2][4][2];
#pragma unroll
        for (int ai = 0; ai < 2; ++ai)
#pragma unroll
            for (int m = 0; m < 4; ++m) { const GAS bf16_t* rowp = X + (size_t)(row0 + ai * 128 + m * 16) * D + col0;
#pragma unroll
                for (int bj = 0; bj < 2; ++bj) xr[ai][m][bj] = *(const GAS u32x4*)(rowp + bj * 128); }
        asm volatile("" ::: "memory");
#pragma unroll
        for (int ai = 0; ai < 2; ++ai)
#pragma unroll
            for (int m = 0; m < 4; ++m) { GAS bf16_t* rowp = X + (size_t)(row0 + ai * 128 + m * 16) * D + col0;
#pragma unroll
                for (int bj = 0; bj < 2; ++bj) { GAS u32x4* q = (GAS u32x4*)(rowp + bj * 128); float xv[8]; unpack8(xr[ai][m][bj], xv);
                    const f32x4 a0 = acc[ai][bj][m][0] * gv[bj][0], a1 = acc[ai][bj][m][1] * gv[bj][1];
                    xv[0] += a0[0]; xv[1] += a0[1]; xv[2] += a0[2]; xv[3] += a0[3]; xv[4] += a1[0]; xv[5] += a1[1]; xv[6] += a1[2]; xv[7] += a1[3];
                    *q = pack8(xv); } }
    }
};
struct EpiUp {
    static constexpr bool PERM = true;
    GAS bf16_t* ACT;
    __device__ __forceinline__ void operator()(const f32x4 (&acc)[2][2][4][2], const pg8::Unit& u, int wr, int wc, int fr, int fq) const {
        const int row0 = u.pm * 256 + wr * 64 + fr, col0 = u.pn * 128 + wc * 32 + 8 * fq;
#pragma unroll
        for (int ai = 0; ai < 2; ++ai)
#pragma unroll
            for (int m = 0; m < 4; ++m) { GAS bf16_t* rowp = ACT + (size_t)(row0 + ai * 128 + m * 16) * DEXP + col0;
                float r[8];
#pragma unroll
                for (int n = 0; n < 2; ++n)
#pragma unroll
                    for (int q = 0; q < 4; ++q) r[4 * n + q] = siluf_(acc[ai][0][m][n][q]) * acc[ai][1][m][n][q];
                *(GAS u32x4*)rowp = pack8(r); }
    }
};
struct EpiDown {
    static constexpr bool PERM = true;
    GAS bf16_t* YB; const GAS int* lista; const GAS float* listw;
    __device__ __forceinline__ void operator()(const f32x4 (&acc)[2][2][4][2], const pg8::Unit& u, int wr, int wc, int fr, int fq) const {
        const int rl0 = wr * 64 + fr, col0 = u.pn * 256 + wc * 32 + 8 * fq;
        const GAS int* la = lista + ((size_t)u.e * T + (size_t)u.ml * 256); const GAS float* lw = listw + ((size_t)u.e * T + (size_t)u.ml * 256);
        const int nrows = u.pm;
        int a8[8]; float w8[8];
#pragma unroll
        for (int k = 0; k < 8; ++k) { const int rl = rl0 + (k >> 2) * 128 + (k & 3) * 16; a8[k] = la[rl]; w8[k] = lw[rl]; }
#pragma unroll
        for (int k = 0; k < 8; ++k) asm volatile("" :: "v"(a8[k]), "v"(w8[k]));
#pragma unroll
        for (int ai = 0; ai < 2; ++ai)
#pragma unroll
            for (int m = 0; m < 4; ++m) { const int rl = rl0 + ai * 128 + m * 16;
                if (rl < nrows) { const int a = a8[ai * 4 + m]; const float w = w8[ai * 4 + m]; GAS bf16_t* rowp = YB + (size_t)a * D + col0;
#pragma unroll
                    for (int bj = 0; bj < 2; ++bj) { const f32x4 v0 = acc[ai][bj][m][0] * w, v1 = acc[ai][bj][m][1] * w;
                        u32x4 o; o.x = pk2(v0[0], v0[1]); o.y = pk2(v0[2], v0[3]); o.z = pk2(v1[0], v1[1]); o.w = pk2(v1[2], v1[3]);
                        *(GAS u32x4*)(rowp + bj * 128) = o; } } }
    }
};
struct MoeOrder {
    const GAS char* A; const GAS char* Bt; int K; size_t estride; const LAS int* tab; const GAS int* lista; int G, c; bool down;
    __device__ bool next(int i, pg8::Unit& u) const {
        const int L = i * G + c; const int NT = __builtin_amdgcn_readfirstlane(tab[16]);
        if (L >= NT * 4) return false;
        const int mt = L >> 2; const int e = __builtin_amdgcn_readfirstlane(tab[34 + mt]);
        const int t0 = __builtin_amdgcn_readfirstlane(tab[e]), cn = __builtin_amdgcn_readfirstlane(tab[17 + e]);
        u.pn = L & 3; u.e = e; u.ml = mt - t0;
        const int left = cn - u.ml * 256;
        u.pm = down ? (left < 256 ? left : 256) : mt;
        return true;
    }
    __device__ __forceinline__ const GAS char* a_base(const pg8::Unit& u) const { return down ? A + (size_t)(__builtin_amdgcn_readfirstlane(tab[u.e]) + u.ml) * 256 * K * 2 : A; }
    __device__ __forceinline__ const GAS char* b_base(const pg8::Unit& u) const { return Bt + (size_t)u.e * estride + (size_t)u.pn * 256 * K * 2; }
    __device__ __forceinline__ void a_rows(const pg8::Unit& u, int tz, unsigned (&off)[2][2]) const {
        const int n = __builtin_amdgcn_readfirstlane(tab[17 + u.e]) - u.ml * 256; const GAS int* lp = lista + ((size_t)u.e * T + (size_t)u.ml * 256);
#pragma unroll
        for (int i = 0; i < 2; ++i) { int R, Cc; pg8::stage_rc(tz * 16 + i * 8192, R, Cc);
#pragma unroll
            for (int h = 0; h < 2; ++h) { const unsigned r = (unsigned)(128 * h + R); const int tok = lp[((int)r < n) ? r : 0u] >> 1; off[h][i] = (unsigned)tok * (unsigned)(K * 2) + (unsigned)Cc * 2u; } }
    }
    static constexpr int GROWS = 133120;
    __device__ __forceinline__ void a_rows_issue(LAS unsigned char* lds, const pg8::Unit& u, int tz) const {
        const int n = __builtin_amdgcn_readfirstlane(tab[17 + u.e]) - u.ml * 256; const GAS int* lp = lista + ((size_t)u.e * T + (size_t)u.ml * 256);
        const int wv = __builtin_amdgcn_readfirstlane(tz >> 6);
#pragma unroll
        for (int i = 0; i < 2; ++i) { int R, Cc; pg8::stage_rc(tz * 16 + i * 8192, R, Cc);
#pragma unroll
            for (int h = 0; h < 2; ++h) { const unsigned r = (unsigned)(128 * h + R);
                __builtin_amdgcn_global_load_lds((const GAS unsigned*)(lp + (((int)r < n) ? r : 0u)), (LAS unsigned*)(lds + GROWS + (2 * h + i) * 2048 + wv * 256), 4, 0, 0); } }
    }
    __device__ __forceinline__ void a_rows_finish(const LAS unsigned char* lds, int tz, unsigned (&off)[2][2]) const {
#pragma unroll
        for (int i = 0; i < 2; ++i) { int R, Cc; pg8::stage_rc(tz * 16 + i * 8192, R, Cc);
#pragma unroll
            for (int h = 0; h < 2; ++h) { const int raw = *(const LAS int*)(lds + GROWS + (2 * h + i) * 2048 + tz * 4); off[h][i] = (unsigned)(raw >> 1) * (unsigned)(K * 2) + (unsigned)Cc * 2u; } }
    }
};
__device__ __forceinline__ void moe_table(const Params& p, const Ctx& C, int layer, LAS int* tab) {
    if (C.tid < 16) { const GAS unsigned* cnt = (const GAS unsigned*)(p.ws + WS_CTL) + CW_CNT + layer * 16;
        tab[17 + C.tid] = (int)__hip_atomic_load(cnt + C.tid, __ATOMIC_RELAXED, __HIP_MEMORY_SCOPE_AGENT); }
    __syncthreads();
    if (C.tid == 0) { int acc = 0;
        for (int e = 0; e < 16; ++e) { const int n = tab[17 + e]; tab[e] = acc; acc += (n + 255) >> 8; }
        tab[16] = acc; }
    __syncthreads();
    for (int t = C.tid; t < tab[16]; t += 512) { int e = 0;
#pragma unroll
        for (int q = 1; q < 16; ++q) e += (tab[q] <= t) ? 1 : 0;
        tab[34 + t] = e; }
    __syncthreads();
}
constexpr size_t MX_BASE = WS_H;
constexpr size_t MX_AVAIL = WS_END - WS_H;
constexpr size_t M64 = (size_t)64 * 64;
constexpr size_t RW_PT = 0, RW_QT = RW_PT + 4096 * M64 * 2, RW_RH = RW_QT + 4096 * M64 * 2, RW_MH = RW_RH + 4096 * M64 * 2, RW_S = RW_MH + 4096 * M64 * 2, RW_BON = RW_S + 4096 * M64 * 2;
constexpr size_t GX_D_E = RW_BON + 4096 * 64 * 4;
constexpr size_t GX_S_E = GX_D_E + (size_t)2048 * 128 * 64 * 2;
constexpr size_t GX_DEC_E = GX_S_E + (size_t)2048 * 128 * 64 * 2;
constexpr size_t MX_END_E = GX_DEC_E + (size_t)2048 * 64 * 4;
constexpr size_t GX_D_O = 0, GX_S_O = GX_D_O + (size_t)2048 * 128 * 64 * 2, GX_DEC_O = GX_S_O + (size_t)2048 * 128 * 64 * 2;
constexpr size_t SX_ST = GX_DEC_O + (size_t)2048 * 64 * 4;
constexpr size_t SX_S = SX_ST + 4096 * M64 * 2;
constexpr size_t SX_DEC = SX_S + 4096 * M64 * 2;
constexpr size_t MX_END_O = SX_DEC + 4096 * 4;
static_assert(MX_END_E <= WS_XB - WS_H && MX_END_O <= WS_PGU - WS_H, "mixer scratch overflow");

template <int NC, bool LDSB = false>
__device__ __forceinline__ void lds_cumsum64(LAS float* tile, int stride, LAS float* seg, int tid) {
    const int n = tid % NC, s = tid / NC; const bool act = tid < 8 * NC;
    float v[8];
    if (act) {
#pragma unroll
        for (int i = 0; i < 8; ++i) v[i] = tile[(8 * s + i) * stride + n];
#pragma unroll
        for (int i = 1; i < 8; ++i) v[i] += v[i - 1];
        seg[s * NC + n] = v[7];
    }
    if constexpr (LDSB) LDS_BARRIER(); else __syncthreads();
    if (act) { float off = 0.f;
#pragma unroll
        for (int q = 0; q < 8; ++q) off += (q < s) ? seg[q * NC + n] : 0.f;
#pragma unroll
        for (int i = 0; i < 8; ++i) tile[(8 * s + i) * stride + n] = v[i] + off; }
    if constexpr (LDSB) LDS_BARRIER(); else __syncthreads();
}

constexpr int GL_GT = 0, GL_SEG = 17408, GL_AUP = 19456, GL_KD = 24576, GL_KM = 24576, GL_QM = 33792, GL_Q2 = 43008, GL_VT = 52224, GL_ST = 69632, GL_PL = 88064, GL_RS = 97280;

template <bool HGRN>
__device__ __forceinline__ void gla_stage_g(const Params& p, const Ctx& C, int layer, int h, const u32x4 a0, const u32x4 a1, const u32x4 kk, float (&kreg)[8]) {
    const int j = C.tid >> 3, cg = C.tid & 7, jl = layer >> 1;
    LAS float* Gt = (LAS float*)(C.lds + GL_GT);
    float g[8];
    if constexpr (HGRN) {
        float fr[8]; unpack8(a0, fr);
        const GAS float* lb = (const GAS float*)(p.ws + WS_LB) + layer * 256 + 64 * h + 8 * cg;
#pragma unroll
        for (int q = 0; q < 8; ++q) { const float l = lb[q]; const float f = l + (1.f - l) * sigmoidf_(fr[q]); g[q] = __logf(f); kreg[q] = 1.f - f; }
    } else {
        LAS float* AUP = (LAS float*)(C.lds + GL_AUP);
        float ad[16]; { float t0[8], t1[8]; unpack8(a0, t0); unpack8(a1, t1);
#pragma unroll
            for (int q = 0; q < 8; ++q) { ad[q] = t0[q]; ad[8 + q] = t1[q]; } }
#pragma unroll
        for (int q = 0; q < 8; ++q) { float x = AUP[16 * 64 + 8 * cg + q];
#pragma unroll
            for (int r = 0; r < 16; ++r) x += ad[r] * AUP[r * 64 + 8 * cg + q];
            g[q] = logsigmoidf_(x) * (1.f / 16.f); }
        unpack8(kk, kreg);
    }
    *(LAS f32x4*)(Gt + j * FS + 8 * cg) = (f32x4){g[0], g[1], g[2], g[3]};
    *(LAS f32x4*)(Gt + j * FS + 8 * cg + 4) = (f32x4){g[4], g[5], g[6], g[7]};
    (void)jl;
}
template <bool HGRN>
__device__ __forceinline__ void gla_stage_aup(const Params& p, const Ctx& C, int layer, int h) {
    if constexpr (!HGRN) { const int jl = layer >> 1; LAS float* AUP = (LAS float*)(C.lds + GL_AUP);
        for (int i = C.tid; i < 16 * 64; i += 512) AUP[i] = p.b_alpha_up[(size_t)jl * 16 * 256 + (i >> 6) * 256 + 64 * h + (i & 63)];
        if (C.tid < 64) AUP[16 * 64 + C.tid] = p.b_alpha_bias[jl * 256 + 64 * h + C.tid]; }
}
__device__ __forceinline__ void gla_stage_v(const Ctx& C, const GAS bf16_t* urow0, int vcol) {
    const int j = C.tid >> 3, cg = C.tid & 7;
    const GAS u32x4* src = (const GAS u32x4*)(urow0 + (size_t)j * UPITCH + vcol + 16 * cg);
    LAS u32x4* dst = (LAS u32x4*)(C.lds + GL_VT + j * TS2 + 32 * cg);
    dst[0] = src[0]; dst[1] = src[1];
}

struct GlPre { u32x4 a0, a1, k, v0, v1; };
template <bool HGRN>
__device__ __forceinline__ void gla_prefetch1(const Params& p, int tid, int item, GlPre& pre) {
    const int h = item & 3, bc = item >> 2, j = tid >> 3, cg = tid & 7;
    const GAS bf16_t* ur = (const GAS bf16_t*)(p.ws + WS_U) + ((size_t)bc * 64 + j) * UPITCH;
    if constexpr (HGRN) { pre.a0 = *(const GAS u32x4*)(ur + HG_F + 64 * h + 8 * cg); pre.a1 = pre.a0; pre.k = pre.a0; }
    else { pre.a0 = *(const GAS u32x4*)(ur + GL_AD); pre.a1 = *(const GAS u32x4*)(ur + GL_AD + 8); pre.k = *(const GAS u32x4*)(ur + GL_K + 64 * h + 8 * cg); }
    const GAS u32x4* vs = (const GAS u32x4*)(ur + (HGRN ? HG_I : GL_V) + 128 * h + 16 * cg); pre.v0 = vs[0]; pre.v1 = vs[1];
}
template <bool HGRN>
__device__ __forceinline__ void gla_pass1_item(const Params& p, const Ctx& C0, int layer, int item, int next_item, GlPre& pre) {
    Ctx C = C0; asm volatile("" : "+s"(C.wave)); asm volatile("" : "+v"(C.tid)); C.lane = C.tid & 63;
    const int h = item & 3, bc = item >> 2;
    const GAS bf16_t* urow0 = (const GAS bf16_t*)(p.ws + WS_U) + (size_t)bc * 64 * UPITCH;
    LAS float* Gt = (LAS float*)(C.lds + GL_GT);
    const int j = C.tid >> 3, cg = C.tid & 7;
    GAS unsigned char* mx = p.ws + MX_BASE;
    GAS bf16_t* Dg = (GAS bf16_t*)(mx + (HGRN ? GX_D_O : GX_D_E)) + (size_t)item * 128 * 64;
    GAS float* DECg = (GAS float*)(mx + (HGRN ? GX_DEC_O : GX_DEC_E)) + (size_t)item * 64;
    float kreg[8];
    gla_stage_g<HGRN>(p, C, layer, h, pre.a0, pre.a1, pre.k, kreg);
    { LAS u32x4* dst = (LAS u32x4*)(C.lds + GL_VT + j * TS2 + 32 * cg); dst[0] = pre.v0; dst[1] = pre.v1; }
    gla_prefetch1<HGRN>(p, C.tid, next_item, pre);
    LDS_BARRIER();
    lds_cumsum64<64, true>(Gt, FS, (LAS float*)(C.lds + GL_SEG), C.tid);
    { float kd[8]; float bjv[8];
#pragma unroll
      for (int q = 0; q < 8; ++q) { const float bj = Gt[j * FS + 8 * cg + q], bl = Gt[63 * FS + 8 * cg + q]; bjv[q] = bj; kd[q] = kreg[q] * __expf(bl - bj); if (j == 63) DECg[8 * cg + q] = __expf(bl); }
      *(LAS u32x4*)(C.lds + GL_KD + j * TS + 16 * cg) = pack8(kd);
      GAS float* Gg = (GAS float*)((GAS bf16_t*)(p.ws + WS_Y) + ((size_t)bc * 64 + j) * D + (HGRN ? 0 : 512) + 128 * h) + 8 * cg;
      *(GAS f32x4*)Gg = (f32x4){bjv[0], bjv[1], bjv[2], bjv[3]}; *(GAS f32x4*)(Gg + 4) = (f32x4){bjv[4], bjv[5], bjv[6], bjv[7]}; }
    LDS_BARRIER();
    { const int e0 = 16 * C.wave; const LAS unsigned char* Vt = C.lds + GL_VT; const LAS unsigned char* Kd = C.lds + GL_KD;
      bf16x8 bv[2], ak[2][4]; tf_2x1<TS2>(Vt, 0, e0, C.lane, bv); tf_2x4<TS>(Kd, 0, 0, C.lane, ak);
      f32x4 acc4[4];
#pragma unroll
      for (int bt = 0; bt < 4; ++bt) acc4[bt] = (f32x4){0.f, 0.f, 0.f, 0.f};
#pragma unroll
      for (int ks = 0; ks < 2; ++ks)
#pragma unroll
          for (int bt = 0; bt < 4; ++bt) acc4[bt] = MFMA16(ak[ks][bt], bv[ks], acc4[bt]);
      SETTLE4(acc4[0], acc4[1], acc4[2], acc4[3]);
#pragma unroll
      for (int bt = 0; bt < 4; ++bt) { const f32x4 acc = acc4[bt];
          { u32x2 o; o.x = pk2(acc[0], acc[1]); o.y = pk2(acc[2], acc[3]); *(GAS u32x2*)(Dg + (size_t)(e0 + (C.lane & 15)) * 64 + 16 * bt + 4 * (C.lane >> 4)) = o; } } }
    LDS_BARRIER();
}

template <bool HGRN>
__device__ __forceinline__ void gla_pass2_job(const Params& p, int job, int lane) {
    GAS unsigned char* mx = p.ws + MX_BASE;
    const int bh = job >> 5, slab = job & 31, b = bh >> 2, h = bh & 3;
    const int el = slab * 256 + lane * 4;
    const int d0 = el & 63;
    f32x4 S = {0.f, 0.f, 0.f, 0.f};
    const GAS bf16_t* Dp = (const GAS bf16_t*)(mx + (HGRN ? GX_D_O : GX_D_E)); const GAS float* Cp = (const GAS float*)(mx + (HGRN ? GX_DEC_O : GX_DEC_E)); GAS bf16_t* Sp = (GAS bf16_t*)(mx + (HGRN ? GX_S_O : GX_S_E));
#pragma unroll 1
    for (int c0 = 0; c0 < 64; c0 += 8) {
        f32x4 Dv[8], dc[8];
#pragma unroll
        for (int q = 0; q < 8; ++q) { const size_t item = ((size_t)(b * 64 + c0 + q) * 4 + h); { const u32x2 d2 = __builtin_nontemporal_load((const GAS u32x2*)(Dp + item * 8192 + el)); Dv[q] = (f32x4){bflo(d2.x), bfhi(d2.x), bflo(d2.y), bfhi(d2.y)}; } dc[q] = *(const GAS f32x4*)(Cp + item * 64 + d0); }
#pragma unroll
        for (int q = 0; q < 8; ++q) { const size_t item = ((size_t)(b * 64 + c0 + q) * 4 + h);
            u32x2 o; o.x = pk2(S[0], S[1]); o.y = pk2(S[2], S[3]);
            *(GAS u32x2*)(Sp + item * 8192 + el) = o;
            S = S * dc[q] + Dv[q]; }
    }
}

struct Gl3Pre { f32x4 gb0, gb1, gr0, gr1; u32x4 kf, q, v0, v1, s0, s1; };
template <bool HGRN>
__device__ __forceinline__ void gla_prefetch3(const Params& p, int tid, int item, Gl3Pre& pre) {
    const int h = item & 3, bc = item >> 2, j = tid >> 3, cg = tid & 7;
    const GAS bf16_t* Y = (const GAS bf16_t*)(p.ws + WS_Y);
    const GAS float* Gg = (const GAS float*)(Y + ((size_t)bc * 64 + j) * D + (HGRN ? 0 : 512) + 128 * h) + 8 * cg;
    const GAS float* Gr = (const GAS float*)(Y + ((size_t)bc * 64 + 31) * D + (HGRN ? 0 : 512) + 128 * h) + 8 * cg;
    pre.gb0 = *(const GAS f32x4*)Gg; pre.gb1 = *(const GAS f32x4*)(Gg + 4); pre.gr0 = *(const GAS f32x4*)Gr; pre.gr1 = *(const GAS f32x4*)(Gr + 4);
    const GAS bf16_t* ur = (const GAS bf16_t*)(p.ws + WS_U) + ((size_t)bc * 64 + j) * UPITCH;
    pre.kf = *(const GAS u32x4*)(ur + (HGRN ? HG_F : GL_K) + 64 * h + 8 * cg);
    pre.q = *(const GAS u32x4*)(ur + (HGRN ? HG_Q : GL_Q) + 64 * h + 8 * cg);
    const GAS u32x4* vs = (const GAS u32x4*)(ur + (HGRN ? HG_I : GL_V) + 128 * h + 16 * cg); pre.v0 = vs[0]; pre.v1 = vs[1];
    const GAS bf16_t* Sg = (const GAS bf16_t*)(p.ws + MX_BASE + (HGRN ? GX_S_O : GX_S_E)) + (size_t)item * 8192;
    pre.s0 = __builtin_nontemporal_load((const GAS u32x4*)(Sg + (size_t)(tid >> 3) * 64 + 8 * (tid & 7)));
    pre.s1 = __builtin_nontemporal_load((const GAS u32x4*)(Sg + (size_t)((tid + 512) >> 3) * 64 + 8 * (tid & 7)));
}
template <bool HGRN>
__device__ __forceinline__ void gla_pass3_item(const Params& p, const Ctx& C0, int layer, int item, int next_item, Gl3Pre& pre) {
    Ctx C = C0; asm volatile("" : "+s"(C.wave)); asm volatile("" : "+v"(C.tid)); C.lane = C.tid & 63;
    const int h = item & 3, bc = item >> 2, jl = layer >> 1;
    const GAS bf16_t* urow0 = (const GAS bf16_t*)(p.ws + WS_U) + (size_t)bc * 64 * UPITCH;
    GAS bf16_t* Y = (GAS bf16_t*)(p.ws + WS_Y);
    LAS float* Gt = (LAS float*)(C.lds + GL_GT);
    const int j = C.tid >> 3, cg = C.tid & 7;
    GAS unsigned char* mx = p.ws + MX_BASE;
    const GAS bf16_t* Sg = (const GAS bf16_t*)(mx + (HGRN ? GX_S_O : GX_S_E)) + (size_t)item * 8192;
    u32x2 gvv[4];
    { const int at_ = C.wave & 3, eh_ = C.wave >> 2; const size_t tk_ = (size_t)bc * 64 + 16 * at_ + (C.lane & 15);
      const GAS bf16_t* gp_ = (const GAS bf16_t*)(p.ws + WS_U) + tk_ * UPITCH + (HGRN ? HG_G : GL_G) + 128 * h + 64 * eh_ + 4 * (C.lane >> 4);
#pragma unroll
      for (int et = 0; et < 4; ++et) gvv[et] = *(const GAS u32x2*)(gp_ + 16 * et); }
    f32x4 gnv[4];
    { const GAS float* gain_ = (HGRN ? p.c_norm_gain : p.b_norm_gain) + (layer >> 1) * 128 + 64 * (C.wave >> 2) + 4 * (C.lane >> 4);
#pragma unroll
      for (int et = 0; et < 4; ++et) gnv[et] = *(const GAS f32x4*)(gain_ + 16 * et); }
    float kreg[8];
    if constexpr (HGRN) {
        float fr[8]; unpack8(pre.kf, fr);
        const GAS float* lb = (const GAS float*)(p.ws + WS_LB) + layer * 256 + 64 * h + 8 * cg;
#pragma unroll
        for (int q = 0; q < 8; ++q) { const float l = lb[q]; kreg[q] = (1.f - l) * (1.f - sigmoidf_(fr[q])); }
    } else unpack8(pre.kf, kreg);
    { LAS u32x4* dst = (LAS u32x4*)(C.lds + GL_VT + j * TS2 + 32 * cg); dst[0] = pre.v0; dst[1] = pre.v1; }
    *(LAS u32x4*)(C.lds + GL_ST + (C.tid >> 3) * TS + 16 * (C.tid & 7)) = pre.s0;
    *(LAS u32x4*)(C.lds + GL_ST + ((C.tid + 512) >> 3) * TS + 16 * (C.tid & 7)) = pre.s1;
    { float qv[8]; unpack8(pre.q, qv);
      const float qs = HGRN ? 1.f : 0.125f;
      float qm[8], q2[8], km[8];
#pragma unroll
      for (int q = 0; q < 8; ++q) { const float bj = q < 4 ? pre.gb0[q & 3] : pre.gb1[q & 3], br = q < 4 ? pre.gr0[q & 3] : pre.gr1[q & 3]; const float qq = qv[q] * qs;
          qm[q] = qq * __expf(bj - br); q2[q] = qq * __expf(bj); km[q] = kreg[q] * __expf(br - bj); }
      *(LAS u32x4*)(C.lds + GL_QM + j * TS + 16 * cg) = pack8(qm);
      *(LAS u32x4*)(C.lds + GL_Q2 + j * TS + 16 * cg) = pack8(q2);
      *(LAS u32x4*)(C.lds + GL_KM + j * TS + 16 * cg) = pack8(km); }
    gla_prefetch3<HGRN>(p, C.tid, next_item, pre);
    LDS_BARRIER();
    {
      const LAS unsigned char* Qm = C.lds + GL_QM; const LAS unsigned char* Km = C.lds + GL_KM; LAS unsigned char* Pl = C.lds + GL_PL;
#pragma unroll
      for (int q = 0; q < 2; ++q) { const int id = 2 * C.wave + q, at = id >> 2, bt = id & 3; f32x4 acc = {0.f, 0.f, 0.f, 0.f};
          if (bt <= at) {
#pragma unroll
              for (int ks = 0; ks < 2; ++ks) acc = MFMA16(rf_lds(Km, TS, 16 * bt, 32 * ks, C.lane), rf_lds(Qm, TS, 16 * at, 32 * ks, C.lane), acc);
          SETTLE(acc);
              const int i = 16 * at + (C.lane & 15), j0 = 16 * bt + 4 * (C.lane >> 4);
#pragma unroll
              for (int r = 0; r < 4; ++r) acc[r] = (j0 + r <= i) ? acc[r] : 0.f; }
          st4_lds(Pl, TS, 16 * at + (C.lane & 15), 16 * bt + 4 * (C.lane >> 4), acc); } }
    LDS_BARRIER();
    { const int at = C.wave & 3, eh = C.wave >> 2, i = 16 * at + (C.lane & 15), g4 = 4 * (C.lane >> 4);
      const LAS unsigned char* Vt = C.lds + GL_VT; const LAS unsigned char* St = C.lds + GL_ST; const LAS unsigned char* Pl = C.lds + GL_PL; const LAS unsigned char* Q2 = C.lds + GL_Q2;
      LAS float* RS = (LAS float*)(C.lds + GL_RS);
      bf16x8 bp[2], bq[2];
#pragma unroll
      for (int ks = 0; ks < 2; ++ks) { bp[ks] = rf_lds(Pl, TS, 16 * at, 32 * ks, C.lane); bq[ks] = rf_lds(Q2, TS, 16 * at, 32 * ks, C.lane); }
      bf16x8 av[2][4]; tf_2x4<TS2>(Vt, 0, 64 * eh, C.lane, av);
      f32x4 acc[4]; float ss = 0.f;
      bf16x8 sf[2][4];
#pragma unroll
      for (int et = 0; et < 4; ++et) { sf[0][et] = rf_lds(St, TS, 64 * eh + 16 * et, 0, C.lane); sf[1][et] = rf_lds(St, TS, 64 * eh + 16 * et, 32, C.lane); acc[et] = (f32x4){0.f, 0.f, 0.f, 0.f}; }
#pragma unroll
      for (int ks = 0; ks < 2; ++ks) {
#pragma unroll
          for (int et = 0; et < 4; ++et) acc[et] = MFMA16(av[ks][et], bp[ks], acc[et]);
#pragma unroll
          for (int et = 0; et < 4; ++et) acc[et] = MFMA16(sf[ks][et], bq[ks], acc[et]); }
      SETTLE4(acc[0], acc[1], acc[2], acc[3]);
#pragma unroll
      for (int et = 0; et < 4; ++et) { const f32x4 a = acc[et]; ss += (a[0] * a[0] + a[1] * a[1]) + (a[2] * a[2] + a[3] * a[3]); }
      ss += __shfl_xor(ss, 16); ss += __shfl_xor(ss, 32);
      if (C.lane < 16) RS[eh * 64 + i] = ss;
      LDS_BARRIER();
      const float rstd = rsqrtf((RS[i] + RS[64 + i]) * (1.f / 128.f) + NORM_EPS);
      const GAS float* gain = (HGRN ? p.c_norm_gain : p.b_norm_gain) + jl * 128;
      const size_t tk = (size_t)bc * 64 + i;
      const GAS bf16_t* gp = (const GAS bf16_t*)(p.ws + WS_U) + tk * UPITCH + (HGRN ? HG_G : GL_G) + 128 * h;
      GAS bf16_t* yp = Y + tk * D + (HGRN ? 0 : 512) + 128 * h;
#pragma unroll
      for (int et = 0; et < 4; ++et) { const int e = 64 * eh + 16 * et + g4; const u32x2 gv = gvv[et]; const f32x4 gn = gnv[et];
          const float g0 = siluf_(bflo(gv.x)), g1 = siluf_(bfhi(gv.x)), g2 = siluf_(bflo(gv.y)), g3 = siluf_(bfhi(gv.y));
          u32x2 o; o.x = pk2(acc[et][0] * rstd * gn[0] * g0, acc[et][1] * rstd * gn[1] * g1); o.y = pk2(acc[et][2] * rstd * gn[2] * g2, acc[et][3] * rstd * gn[3] * g3);
          *(GAS u32x2*)(yp + e) = o; } }
    LDS_BARRIER();
}
constexpr int SD_BMT = 0, SD_CMT = 9216, SD_X = 18432  , SD_HS = 55296  , SD_PL = 92160  , SD_DTL = 129024  , SD_CUM = 130048  , SD_SEG = 131072  , SD_RS = 131328  ;

constexpr int SD_CW = 132096;
constexpr int SD_GN = SD_CW + 5 * 384 * 4;
constexpr int SD_HK = SD_GN + 1024;
constexpr int SD_END = SD_HK + 64;
__device__ __forceinline__ float ssd_dt_load(const Ctx& C, int grp, const GAS bf16_t* urow0) {
    const int j = (C.tid & 255) >> 2, hh = C.tid & 3, head = 4 * grp + hh;
    return bf2f(urow0[(size_t)j * UPITCH + SD_DT + head]);
}
__device__ __forceinline__ void ssd_stage_dt(const Ctx& C, float raw_in) {
    LAS float* DTL = (LAS float*)(C.lds + SD_DTL); LAS float* CUM = (LAS float*)(C.lds + SD_CUM); const LAS float* HK = (const LAS float*)(C.lds + SD_HK);
    if (C.tid < 256) { const int j = C.tid >> 2, hh = C.tid & 3;
        const float raw = raw_in + HK[hh];
        const float dt = softplusf_(raw); DTL[j * 4 + hh] = dt; CUM[j * 4 + hh] = -dt * HK[4 + hh]; }
    LDS_BARRIER();
    lds_cumsum64<4, true>(CUM, 4, (LAS float*)(C.lds + SD_SEG), C.tid);
}
__device__ __forceinline__ void ssd_load_cw(const Params& p, const Ctx& C, int layer, int grp) {
    const int jl = layer >> 1; LAS float* cwl = (LAS float*)(C.lds + SD_CW);
    for (int i = C.tid; i < 5 * 384; i += 512) { const int tap = i / 384, lc = i % 384;
        const int ch = lc < 256 ? 256 * grp + lc : (lc < 320 ? 512 + 64 * grp + (lc - 256) : 640 + 64 * grp + (lc - 320));
        cwl[i] = tap < 4 ? p.d_conv_w[(size_t)jl * 4 * 768 + tap * 768 + ch] : p.d_conv_b[jl * 768 + ch]; }
    if (C.tid < 256) ((LAS float*)(C.lds + SD_GN))[C.tid] = p.d_norm_gain[jl * 512 + 256 * grp + C.tid];
    if (C.tid < 12) { const int k = C.tid >> 2, head = 4 * grp + (C.tid & 3);
        ((LAS float*)(C.lds + SD_HK))[C.tid] = k == 0 ? p.d_dt_bias[jl * 8 + head] : k == 1 ? __expf(p.d_a_log[jl * 8 + head]) : p.d_skip[jl * 8 + head]; }
}
struct Conv4 { u32x4 r[4]; };
__device__ __forceinline__ void ssd_conv_load(const GAS bf16_t* useq, int pos, int ch, Conv4& cv) {
#pragma unroll
    for (int i = 0; i < 4; ++i) { const int pp = pos - 3 + i; cv.r[i] = *(const GAS u32x4*)(useq + (size_t)(pp >= 0 ? pp : 0) * UPITCH + SD_XBC + ch); }
}
__device__ __forceinline__ void ssd_conv_apply(const LAS float* cwl, int lc, int pos, const Conv4& cv, float (&o)[8]) {
    { const f32x4 b0 = *(const LAS f32x4*)(cwl + 4 * 384 + lc), b1 = *(const LAS f32x4*)(cwl + 4 * 384 + lc + 4);
      o[0] = b0[0]; o[1] = b0[1]; o[2] = b0[2]; o[3] = b0[3]; o[4] = b1[0]; o[5] = b1[1]; o[6] = b1[2]; o[7] = b1[3]; }
#pragma unroll
    for (int i = 0; i < 4; ++i) { const int pp = pos - 3 + i;
        u32x4 raw = cv.r[i]; if (pp < 0) raw = (u32x4){0u, 0u, 0u, 0u};
        float xv[8]; unpack8(raw, xv);
        const f32x4 w0 = *(const LAS f32x4*)(cwl + i * 384 + lc), w1 = *(const LAS f32x4*)(cwl + i * 384 + lc + 4);
        o[0] += w0[0] * xv[0]; o[1] += w0[1] * xv[1]; o[2] += w0[2] * xv[2]; o[3] += w0[3] * xv[3]; o[4] += w1[0] * xv[4]; o[5] += w1[1] * xv[5]; o[6] += w1[2] * xv[6]; o[7] += w1[3] * xv[7]; }
#pragma unroll
    for (int q = 0; q < 8; ++q) o[q] = siluf_(o[q]);
}
__device__ __forceinline__ void ssd_pass1_item(const Params& p, const Ctx& C0, int layer, int item) {
    Ctx C = C0; asm volatile("" : "+s"(C.wave)); asm volatile("" : "+v"(C.tid)); C.lane = C.tid & 63;
    const int grp = item & 1, bc = item >> 1, c = bc & 63, jl = layer >> 1;
    const GAS bf16_t* U = (const GAS bf16_t*)(p.ws + WS_U);
    const GAS bf16_t* urow0 = U + (size_t)bc * 64 * UPITCH; const GAS bf16_t* useq = U + (size_t)(bc >> 6) * SEQ * UPITCH;
    LAS float* DTL = (LAS float*)(C.lds + SD_DTL); LAS float* CUM = (LAS float*)(C.lds + SD_CUM); const LAS float* cwl = (const LAS float*)(C.lds + SD_CW);
    GAS unsigned char* mx = p.ws + MX_BASE;
    const float dtraw = ssd_dt_load(C, grp, urow0);
    const int j = C.tid >> 3, cg = C.tid & 7;
    Conv4 cv[5];
#pragma unroll
    for (int blk = 0; blk < 5; ++blk) ssd_conv_load(useq, c * 64 + j, blk < 4 ? 256 * grp + 64 * blk + 8 * cg : 512 + 64 * grp + 8 * cg, cv[blk]);
    ssd_stage_dt(C, dtraw);
#pragma unroll
    for (int blk = 0; blk < 5; ++blk) { float o[8];
        if (blk < 4) { ssd_conv_apply(cwl, 64 * blk + 8 * cg, c * 64 + j, cv[blk], o);
            const float s = DTL[j * 4 + blk] * __expf(CUM[63 * 4 + blk] - CUM[j * 4 + blk]);
#pragma unroll
            for (int q = 0; q < 8; ++q) o[q] *= s;
            *(LAS u32x4*)(C.lds + SD_X + blk * TILE64 + j * TS + 16 * cg) = pack8(o);
        } else { ssd_conv_apply(cwl, 256 + 8 * cg, c * 64 + j, cv[blk], o); *(LAS u32x4*)(C.lds + SD_BMT + j * TS + 16 * cg) = pack8(o); } }
    LDS_BARRIER();
    { const int hh = C.wave >> 1; const LAS unsigned char* Xt = C.lds + SD_X + hh * TILE64; const LAS unsigned char* Bt = C.lds + SD_BMT;
      const size_t ih = (size_t)bc * 8 + 4 * grp + hh;
      GAS bf16_t* STg = (GAS bf16_t*)(mx + SX_ST) + ih * 4096;
      if ((C.wave & 1) == 0 && C.lane == 0) ((GAS float*)(mx + SX_DEC))[ih] = __expf(CUM[63 * 4 + hh]);
      bf16x8 ab[2][4]; tf_2x4<TS>(Bt, 0, 0, C.lane, ab);
#pragma unroll
      for (int q = 0; q < 2; ++q) { const int at = 2 * (C.wave & 1) + q;
          bf16x8 bx[2]; tf_2x1<TS>(Xt, 0, 16 * at, C.lane, bx);
          f32x4 acc4[4];
#pragma unroll
          for (int bt = 0; bt < 4; ++bt) acc4[bt] = (f32x4){0.f, 0.f, 0.f, 0.f};
#pragma unroll
          for (int ks = 0; ks < 2; ++ks)
#pragma unroll
              for (int bt = 0; bt < 4; ++bt) acc4[bt] = MFMA16(ab[ks][bt], bx[ks], acc4[bt]);
          SETTLE4(acc4[0], acc4[1], acc4[2], acc4[3]);
#pragma unroll
          for (int bt = 0; bt < 4; ++bt) { const f32x4 acc = acc4[bt];
              { u32x2 o; o.x = pk2(acc[0], acc[1]); o.y = pk2(acc[2], acc[3]); *(GAS u32x2*)(STg + (size_t)(16 * at + (C.lane & 15)) * 64 + 16 * bt + 4 * (C.lane >> 4)) = o; } } } }
    LDS_BARRIER();
}
__device__ __forceinline__ void ssd_pass2_job(const Params& p, int job, int lane) {
    GAS unsigned char* mx = p.ws + MX_BASE;
    const int bh = job >> 4, slab = job & 15, b = bh >> 3, head = bh & 7;
    const int el = slab * 256 + lane * 4;
    f32x4 S = {0.f, 0.f, 0.f, 0.f};
#pragma unroll 1
    for (int c0 = 0; c0 < 64; c0 += 8) {
        f32x4 Dv[8]; float dc[8];
#pragma unroll
        for (int q = 0; q < 8; ++q) { const size_t ih = (size_t)(b * 64 + c0 + q) * 8 + head; { const u32x2 d2 = __builtin_nontemporal_load((const GAS u32x2*)((const GAS bf16_t*)(mx + SX_ST) + ih * 4096 + el)); Dv[q] = (f32x4){bflo(d2.x), bfhi(d2.x), bflo(d2.y), bfhi(d2.y)}; } dc[q] = ((const GAS float*)(mx + SX_DEC))[ih]; }
#pragma unroll
        for (int q = 0; q < 8; ++q) { const size_t ih = (size_t)(b * 64 + c0 + q) * 8 + head;
            u32x2 o; o.x = pk2(S[0], S[1]); o.y = pk2(S[2], S[3]);
            *(GAS u32x2*)((GAS bf16_t*)(mx + SX_S) + ih * 4096 + el) = o;
            S = S * dc[q] + Dv[q]; }
    }
}
__device__ __forceinline__ void ssd_pass3_item(const Params& p, const Ctx& C0, int layer, int item) {
    Ctx C = C0; asm volatile("" : "+s"(C.wave)); asm volatile("" : "+v"(C.tid)); C.lane = C.tid & 63;
    const int grp = item & 1, bc = item >> 1, c = bc & 63, jl = layer >> 1;
    const GAS bf16_t* U = (const GAS bf16_t*)(p.ws + WS_U);
    const GAS bf16_t* urow0 = U + (size_t)bc * 64 * UPITCH; const GAS bf16_t* useq = U + (size_t)(bc >> 6) * SEQ * UPITCH;
    LAS float* DTL = (LAS float*)(C.lds + SD_DTL); LAS float* CUM = (LAS float*)(C.lds + SD_CUM); LAS float* RS = (LAS float*)(C.lds + SD_RS); const LAS float* cwl = (const LAS float*)(C.lds + SD_CW);
    GAS unsigned char* mx = p.ws + MX_BASE;
    GAS bf16_t* Y = (GAS bf16_t*)(p.ws + WS_Y);
    const float dtraw = ssd_dt_load(C, grp, urow0);
    const int j = C.tid >> 3, cg = C.tid & 7;
    Conv4 cv[6];
#pragma unroll
    for (int blk = 0; blk < 6; ++blk) ssd_conv_load(useq, c * 64 + j, blk < 4 ? 256 * grp + 64 * blk + 8 * cg : (blk == 4 ? 512 : 640) + 64 * grp + 8 * cg, cv[blk]);
    u32x4 sreg[4];
#pragma unroll
    for (int k4 = 0; k4 < 4; ++k4) { const GAS bf16_t* Sg = (const GAS bf16_t*)(mx + SX_S) + ((size_t)bc * 8 + 4 * grp + k4) * 4096;
        sreg[k4] = __builtin_nontemporal_load((const GAS u32x4*)(Sg + (size_t)j * 64 + 8 * cg)); }
    ssd_stage_dt(C, dtraw);
#pragma unroll
    for (int blk = 0; blk < 6; ++blk) { float o[8];
        if (blk < 4) { ssd_conv_apply(cwl, 64 * blk + 8 * cg, c * 64 + j, cv[blk], o);
            const float s = DTL[j * 4 + blk];
#pragma unroll
            for (int q = 0; q < 8; ++q) o[q] *= s;
            *(LAS u32x4*)(C.lds + SD_X + blk * TILE64 + j * TS + 16 * cg) = pack8(o);
        } else if (blk == 4) { ssd_conv_apply(cwl, 256 + 8 * cg, c * 64 + j, cv[blk], o); *(LAS u32x4*)(C.lds + SD_BMT + j * TS + 16 * cg) = pack8(o);
        } else { ssd_conv_apply(cwl, 320 + 8 * cg, c * 64 + j, cv[blk], o); *(LAS u32x4*)(C.lds + SD_CMT + j * TS + 16 * cg) = pack8(o); } }
#pragma unroll
    for (int k4 = 0; k4 < 4; ++k4) *(LAS u32x4*)(C.lds + SD_HS + k4 * TILE64 + j * TS + 16 * cg) = sreg[k4];
    LDS_BARRIER();
    {
      const LAS unsigned char* Cm = C.lds + SD_CMT; const LAS unsigned char* Bm = C.lds + SD_BMT;
#pragma unroll
      for (int q = 0; q < 2; ++q) { const int id = 2 * C.wave + q, at = id >> 2, bt = id & 3; f32x4 acc = {0.f, 0.f, 0.f, 0.f};
          const int tt = 16 * at + (C.lane & 15), s0 = 16 * bt + 4 * (C.lane >> 4);
          if (bt <= at) {
#pragma unroll
              for (int ks = 0; ks < 2; ++ks) acc = MFMA16(rf_lds(Bm, TS, 16 * bt, 32 * ks, C.lane), rf_lds(Cm, TS, 16 * at, 32 * ks, C.lane), acc); }
          SETTLE(acc);
#pragma unroll
          for (int hh = 0; hh < 4; ++hh) { f32x4 v; const float ct = CUM[tt * 4 + hh];
#pragma unroll
              for (int r = 0; r < 4; ++r) { const float e = __expf(ct - CUM[(s0 + r) * 4 + hh]); v[r] = (bt <= at && s0 + r <= tt) ? acc[r] * e : 0.f; }
              st4_lds(C.lds + SD_PL + hh * TILE64, TS, tt, s0, v); } } }
    LDS_BARRIER();
    { const int at = C.wave & 3, hp = C.wave >> 2, tt = 16 * at + (C.lane & 15), g4 = 4 * (C.lane >> 4);
      const LAS unsigned char* Cm = C.lds + SD_CMT;
      bf16x8 bc_[2]; bc_[0] = rf_lds(Cm, TS, 16 * at, 0, C.lane); bc_[1] = rf_lds(Cm, TS, 16 * at, 32, C.lane);
      const size_t tk = (size_t)bc * 64 + tt;
      f32x4 yv[2][4]; float ss = 0.f;
#pragma unroll
      for (int q = 0; q < 2; ++q) { const int hh = 2 * hp + q, head = 4 * grp + hh;
          const LAS unsigned char* Hs = C.lds + SD_HS + hh * TILE64; const LAS unsigned char* Xt = C.lds + SD_X + hh * TILE64; const LAS unsigned char* Pl = C.lds + SD_PL + hh * TILE64;
          bf16x8 bp[2]; bp[0] = rf_lds(Pl, TS, 16 * at, 0, C.lane); bp[1] = rf_lds(Pl, TS, 16 * at, 32, C.lane);
          bf16x8 ax[2][4]; tf_2x4<TS>(Xt, 0, 0, C.lane, ax);
          const float ec = __expf(CUM[tt * 4 + hh]), rdt = rcpf_(DTL[tt * 4 + hh]), skip = ((const LAS float*)(C.lds + SD_HK))[8 + hh];
          const GAS bf16_t* zp = U + tk * UPITCH + SD_Z + 64 * head;
          bf16x8 hf[2][4]; f32x4 a4[4];
#pragma unroll
          for (int pt = 0; pt < 4; ++pt) { hf[0][pt] = rf_lds(Hs, TS, 16 * pt, 0, C.lane); hf[1][pt] = rf_lds(Hs, TS, 16 * pt, 32, C.lane); a4[pt] = (f32x4){0.f, 0.f, 0.f, 0.f}; }
#pragma unroll
          for (int ks = 0; ks < 2; ++ks)
#pragma unroll
              for (int pt = 0; pt < 4; ++pt) a4[pt] = MFMA16(hf[ks][pt], bc_[ks], a4[pt]);
          SETTLE4(a4[0], a4[1], a4[2], a4[3]);
#pragma unroll
          for (int pt = 0; pt < 4; ++pt) a4[pt] = a4[pt] * ec;
#pragma unroll
          for (int ks = 0; ks < 2; ++ks)
#pragma unroll
              for (int pt = 0; pt < 4; ++pt) a4[pt] = MFMA16(ax[ks][pt], bp[ks], a4[pt]);
          SETTLE4(a4[0], a4[1], a4[2], a4[3]);
#pragma unroll
          for (int pt = 0; pt < 4; ++pt) { f32x4 a = a4[pt];
              const f32x4 xh = ld4_lds(Xt, TS, tt, 16 * pt + g4) * rdt;
              const u32x2 zv = *(const GAS u32x2*)(zp + 16 * pt + g4);
              a[0] = (a[0] + skip * xh[0]) * siluf_(bflo(zv.x)); a[1] = (a[1] + skip * xh[1]) * siluf_(bfhi(zv.x)); a[2] = (a[2] + skip * xh[2]) * siluf_(bflo(zv.y)); a[3] = (a[3] + skip * xh[3]) * siluf_(bfhi(zv.y));
              yv[q][pt] = a; ss += (a[0] * a[0] + a[1] * a[1]) + (a[2] * a[2] + a[3] * a[3]); } }
      ss += __shfl_xor(ss, 16); ss += __shfl_xor(ss, 32);
      if (C.lane < 16) RS[hp * 64 + tt] = ss;
      LDS_BARRIER();
      const float rstd = rsqrtf((RS[tt] + RS[64 + tt]) * (1.f / 256.f) + NORM_EPS);
#pragma unroll
      for (int q = 0; q < 2; ++q) { const int hh = 2 * hp + q, head = 4 * grp + hh;
          const LAS float* gn = (const LAS float*)(C.lds + SD_GN) + 64 * hh; GAS bf16_t* yp = Y + tk * D + 512 + 64 * head;
#pragma unroll
          for (int pt = 0; pt < 4; ++pt) { const f32x4 g = *(const LAS f32x4*)(gn + 16 * pt + g4); const f32x4 a = yv[q][pt] * rstd * g;
              u32x2 o; o.x = pk2(a[0], a[1]); o.y = pk2(a[2], a[3]); *(GAS u32x2*)(yp + 16 * pt + g4) = o; } } }
    LDS_BARRIER();
}
constexpr int RK_LW = 0, RK_AA = 17408, RK_NA = 0, RK_NB = 9216, RK_TA = 18432, RK_TB = 27648, RK_SEG = 40960, RK_ECL = 43008, RK_TW = 43520, RK_AD = 52736, RK_WZ = 43520,
              RK_KKG = 61952, RK_BI = 71168, RK_KTI = 80384, RK_RG = 89600, RK_V = 98816, RK_MBR = 108032, RK_MKR = 117248, RK_N0 = 126464, RK_AK = 135680, RK_KH = RK_BI, RK_END = 144896;

__device__ __forceinline__ void rk_shift8(const GAS bf16_t* cur, const GAS bf16_t* prv, bool has_prev, const LAS float* mu, float (&o)[8]) {
    const u32x4 cr = *(const GAS u32x4*)cur, pr = *(const GAS u32x4*)(has_prev ? prv : cur);
    float c[8], q[8]; unpack8(cr, c); unpack8(pr, q);
    const f32x4 m0 = *(const LAS f32x4*)mu, m1 = *(const LAS f32x4*)(mu + 4);
#pragma unroll
    for (int i = 0; i < 8; ++i) { const float m = i < 4 ? m0[i & 3] : m1[i & 3]; const float qq = has_prev ? q[i] : 0.f; o[i] = c[i] + m * (qq - c[i]); }
}
__device__ __forceinline__ float tanhf_(float x) { const float e = __expf(-2.f * fabsf(x)); const float t = (1.f - e) * rcpf_(1.f + e); return x < 0.f ? -t : t; }

#ifdef DBG_RW
#define RWCHK(cond, bit) do { if (layer == 0 && __any((int)(cond))) { GAS unsigned* f_ = (GAS unsigned*)(p.ws + WS_CTL) + 8192; if (C.lane == 0 && !(__hip_atomic_load(f_, __ATOMIC_RELAXED, __HIP_MEMORY_SCOPE_AGENT) & (bit))) atomicOr(f_, (bit)); } } while (0)
#else
#define RWCHK(cond, bit) do { } while (0)
#endif
#ifdef DBG_DUMP
#define RWDUMP(ldsoff, nbytes, gofs) do { if (layer == 0 && item < 1024) { const int rs_ = ((nbytes) == 64 * TS2) ? TS2 : TS; const int vb_ = rs_ - 16; for (int i_ = C.tid * 16; i_ < 64 * vb_; i_ += 512 * 16) { const int r_ = i_ / vb_, c_ = i_ % vb_; *(GAS u32x4*)(p.ws + WS_Y + (gofs) + (size_t)item * (nbytes) + r_ * rs_ + c_) = *(const LAS u32x4*)(L + (ldsoff) + r_ * rs_ + c_); } } } while (0)
#else
#define RWDUMP(ldsoff, nbytes, gofs) do { } while (0)
#endif

constexpr int RK_CONST = RK_END;
struct RkPre { u32x4 cur[5], prv[5]; };
__device__ __forceinline__ void rk_prefetch(const Params& p, int tid, int h, int item, RkPre& pre) {
    const int bc = item >> 3, j = tid >> 3, cg = tid & 7;
    const GAS bf16_t* cur = (const GAS bf16_t*)(p.ws + WS_U) + ((size_t)bc * 64 + j) * UPITCH; const bool hp = ((bc & 63) * 64 + j) != 0;
    const GAS bf16_t* prv = hp ? cur - UPITCH : cur;
    const int col[5] = {RW_R + 64 * h + 8 * cg, RW_K + 64 * h + 8 * cg, RW_V + 64 * h + 8 * cg, RW_WD + 8 * cg, RW_AD + 8 * cg};
#pragma unroll
    for (int q = 0; q < 5; ++q) { pre.cur[q] = *(const GAS u32x4*)(cur + col[q]); pre.prv[q] = *(const GAS u32x4*)(prv + col[q]); }
}
__device__ __forceinline__ void rk_shift8r(const u32x4 cur, const u32x4 prv, bool has_prev, const LAS float* mu, float (&o)[8]) {
    float c[8], q[8]; unpack8(cur, c); unpack8(prv, q);
    const f32x4 m0 = *(const LAS f32x4*)mu, m1 = *(const LAS f32x4*)(mu + 4);
#pragma unroll
    for (int i = 0; i < 8; ++i) { const float m = i < 4 ? m0[i & 3] : m1[i & 3]; const float qq = has_prev ? q[i] : 0.f; o[i] = c[i] + m * (qq - c[i]); }
}
__device__ __forceinline__ void rk_load_const(const Params& p, const Ctx& C, int layer, int h) {
    const int jl = layer >> 1; LAS float* K = (LAS float*)(C.lds + RK_CONST);
    for (int i = C.tid; i < 640; i += 512) { float v;
        if (i < 320) { const int g = i >> 6, n = i & 63; const int col = g == 0 ? RW_R + 64 * h + n : g == 1 ? RW_K + 64 * h + n : g == 2 ? RW_V + 64 * h + n : g == 3 ? RW_WD + n : RW_AD + n; v = p.a_mu[(size_t)jl * RWKV_IN + col]; }
        else { const int g = (i - 320) >> 6, n = i & 63; const GAS float* src = g == 0 ? p.a_k_k : g == 1 ? p.a_k_a : g == 2 ? p.a_r_k : g == 3 ? p.a_w0 : p.a_a0; v = src[jl * 512 + 64 * h + n]; }
        K[i] = v; }
}
__device__ __forceinline__ void rwkv_pass1_item(const Params& p, const Ctx& C0, int layer, int item, int next_item, RkPre& pre, const bf16x8 (&wf)[4][2]) {
    Ctx C = C0; asm volatile("" : "+s"(C.wave)); asm volatile("" : "+v"(C.tid)); C.lane = C.tid & 63;
    const int h = item & 7, bc = item >> 3, c = bc & 63, jl = layer >> 1;
    const GAS bf16_t* urow0 = (const GAS bf16_t*)(p.ws + WS_U) + (size_t)bc * 64 * UPITCH;
    GAS unsigned char* mx = p.ws + MX_BASE;
    LAS unsigned char* L = C.lds;
    LAS float* LW = (LAS float*)(L + RK_LW); LAS float* AA = (LAS float*)(L + RK_AA); LAS float* ECL = (LAS float*)(L + RK_ECL);
    const int j = C.tid >> 3, cg = C.tid & 7, lane = C.lane, w = C.wave;
    const int g4 = 4 * (lane >> 4), l15 = lane & 15;
    float rr[8], kk[8], vv[8];
    const LAS float* KC = (const LAS float*)(L + RK_CONST);
    { const bool hp = (c * 64 + j) != 0;
      rk_shift8r(pre.cur[0], pre.prv[0], hp, KC + 0 * 64 + 8 * cg, rr);
      rk_shift8r(pre.cur[1], pre.prv[1], hp, KC + 1 * 64 + 8 * cg, kk);
      rk_shift8r(pre.cur[2], pre.prv[2], hp, KC + 2 * 64 + 8 * cg, vv);
      float t[8];
      rk_shift8r(pre.cur[3], pre.prv[3], hp, KC + 3 * 64 + 8 * cg, t);
#pragma unroll
      for (int q = 0; q < 8; ++q) t[q] = tanhf_(t[q]);
      *(LAS u32x4*)(L + RK_TW + j * TS + 16 * cg) = pack8(t);
      rk_shift8r(pre.cur[4], pre.prv[4], hp, KC + 4 * 64 + 8 * cg, t);
      *(LAS u32x4*)(L + RK_AD + j * TS + 16 * cg) = pack8(t);
      rk_prefetch(p, C.tid, h, next_item, pre); }
    LDS_BARRIER();
    { const int prod = w >> 2, at = w & 3;
      const LAS unsigned char* src = L + (prod ? RK_AD : RK_TW);
      const LAS float* bias = KC + (prod ? 576 : 512);
      LAS float* dst = prod ? AA : LW;
      bf16x8 bj[2]; bj[0] = rf_lds(src, TS, 16 * at, 0, lane); bj[1] = rf_lds(src, TS, 16 * at, 32, lane);
      f32x4 acc4[4];
#pragma unroll
      for (int bt = 0; bt < 4; ++bt) acc4[bt] = *(const LAS f32x4*)(bias + 16 * bt + g4);
#pragma unroll
      for (int ks = 0; ks < 2; ++ks)
#pragma unroll
          for (int bt = 0; bt < 4; ++bt) acc4[bt] = MFMA16(wf[bt][ks], bj[ks], acc4[bt]);
      SETTLE4(acc4[0], acc4[1], acc4[2], acc4[3]);
#pragma unroll
      for (int bt = 0; bt < 4; ++bt) { f32x4 acc = acc4[bt];
#pragma unroll
          for (int r = 0; r < 4; ++r) acc[r] = prod ? sigmoidf_(acc[r]) : -0.6065306597f * sigmoidf_(acc[r]);
          *(LAS f32x4*)(dst + (16 * at + l15) * FS + 16 * bt + g4) = acc; } }
    LDS_BARRIER();
    float lw[8];
#pragma unroll
    for (int q = 0; q < 8; ++q) lw[q] = LW[j * FS + 8 * cg + q];
    LDS_BARRIER();
    lds_cumsum64<64, true>(LW, FS, (LAS float*)(L + RK_SEG), C.tid);
    { const LAS float* k_k = KC + 320 + 8 * cg; const LAS float* k_a = KC + 384 + 8 * cg; const LAS float* r_k = KC + 448 + 8 * cg;
      float kn[8], ss = 0.f, bon = 0.f, kt[8], bb[8], cs[8];
#pragma unroll
      for (int q = 0; q < 8; ++q) { kn[q] = kk[q] * k_k[q]; ss += kn[q] * kn[q]; }
      ss += __shfl_xor(ss, 1); ss += __shfl_xor(ss, 2); ss += __shfl_xor(ss, 4);
      const float rn = rsqrtf(ss + 1e-12f);
#pragma unroll
      for (int q = 0; q < 8; ++q) { const float a = AA[j * FS + 8 * cg + q]; kn[q] *= rn; kt[q] = kk[q] * (1.f + (a - 1.f) * k_a[q]); bb[q] = a * kn[q]; bon += rr[q] * kt[q] * r_k[q]; cs[q] = LW[j * FS + 8 * cg + q]; }
#pragma unroll
      for (int q = 0; q < 1; ++q) { }
      bon += __shfl_xor(bon, 1); bon += __shfl_xor(bon, 2); bon += __shfl_xor(bon, 4);
      if (cg == 0) ((GAS float*)(mx + RW_BON))[(size_t)item * 64 + j] = bon;
      float o[8];
#pragma unroll
      for (int q = 0; q < 8; ++q) o[q] = kn[q] * __expf(cs[q] - lw[q]);
      *(LAS u32x4*)(L + RK_KKG + j * TS + 16 * cg) = pack8(o);
#pragma unroll
      for (int q = 0; q < 8; ++q) o[q] = bb[q] * __expf(-cs[q]);
      *(LAS u32x4*)(L + RK_BI + j * TS + 16 * cg) = pack8(o);
#pragma unroll
      for (int q = 0; q < 8; ++q) o[q] = kt[q] * __expf(-cs[q]);
      *(LAS u32x4*)(L + RK_KTI + j * TS + 16 * cg) = pack8(o);
#pragma unroll
      for (int q = 0; q < 8; ++q) o[q] = rr[q] * __expf(cs[q]);
      *(LAS u32x4*)(L + RK_RG + j * TS + 16 * cg) = pack8(o);
      *(LAS u32x4*)(L + RK_V + j * TS + 16 * cg) = pack8(vv);
      if (j == 63) {
#pragma unroll
          for (int q = 0; q < 8; ++q) ECL[8 * cg + q] = __expf(cs[q]); } }
    LDS_BARRIER();
    { const int prod = w >> 1;
      const LAS unsigned char* bsrc = L + (prod <= 1 ? RK_KKG : (prod == 2 ? RK_BI : RK_RG));
      const LAS unsigned char* asrc = L + (prod == 0 ? RK_BI : (prod == 1 ? RK_KTI : (prod == 2 ? RK_RG : RK_KTI)));
      LAS unsigned char* dst = L + (prod == 0 ? RK_N0 : (prod == 1 ? RK_AK : (prod == 2 ? RK_MBR : RK_MKR)));
#pragma unroll
      for (int q = 0; q < 2; ++q) { const int at = 2 * (w & 1) + q;
          bf16x8 bj[2]; bj[0] = rf_lds(bsrc, TS, 16 * at, 0, lane); bj[1] = rf_lds(bsrc, TS, 16 * at, 32, lane);
          bf16x8 af[2][4]; f32x4 acc4[4];
#pragma unroll
          for (int bt = 0; bt < 4; ++bt) { af[0][bt] = rf_lds(asrc, TS, 16 * bt, 0, lane); af[1][bt] = rf_lds(asrc, TS, 16 * bt, 32, lane); acc4[bt] = (f32x4){0.f, 0.f, 0.f, 0.f}; }
#pragma unroll
          for (int ks = 0; ks < 2; ++ks)
#pragma unroll
              for (int bt = 0; bt < 4; ++bt) acc4[bt] = MFMA16(af[ks][bt], bj[ks], acc4[bt]);
          SETTLE4(acc4[0], acc4[1], acc4[2], acc4[3]);
#pragma unroll
          for (int bt = 0; bt < 4; ++bt) { f32x4 acc = acc4[bt];
              const int a = 16 * at + l15, b0 = 16 * bt + g4;
#pragma unroll
              for (int r = 0; r < 4; ++r) { const int b = b0 + r; const bool keep = prod <= 1 ? (b < a) : (prod == 2 ? (a <= b) : (b <= a)); acc[r] = keep ? acc[r] : 0.f; }
#pragma unroll
              for (int r = 0; r < 4; ++r) RWCHK(!(fabsf(acc[r]) < (prod == 0 ? 1.5f : 1e3f)), prod == 0 ? 1u : 2u);
              st4_lds(dst, TS, a, b0, acc);
              if (prod == 0) { f32x4 t0;
#pragma unroll
                  for (int r = 0; r < 4; ++r) t0[r] = ((b0 + r) == a ? 1.f : 0.f) - acc[r];
                  st4_lds(L + RK_TA, TS, a, b0, t0);
                  if (at < 2 && bt >= 2) { u32x2 zz; asm volatile("v_mov_b32 %0, 0\n\tv_mov_b32 %1, 0" : "=v"(zz.x), "=v"(zz.y)); *(LAS u32x2*)(L + RK_TB + a * TS + b0 * 2) = zz; } } } } }
    LDS_BARRIER();
    {
        int nsrc = RK_N0, ndst = RK_NA, tsrc = RK_TA, tdst = RK_TB;
        for (int st = 0; st < 6; ++st) {
            const int jb = w & 3, prod = w >> 2;
            const bool doN = (st < 5), doT = (st > 0);
            if ((prod == 0 && doN) || (prod == 1 && doT)) {
                const LAS unsigned char* bs = L + (prod == 0 ? nsrc : tsrc); const LAS unsigned char* as = L + nsrc; LAS unsigned char* dst = L + (prod == 0 ? ndst : tdst);
                if (jb < 2) { const int q2 = 2 * jb;
                    bf16x8 bj[2]; bj[0] = rf_lds(bs, TS, 16 * q2, 32 * jb, lane); bj[1] = rf_lds(bs, TS, 16 * (q2 + 1), 32 * jb, lane);
                    bf16x8 aa[2]; tf_1x2<TS>(as, 32 * jb, 16 * q2, lane, aa);
                    f32x4 acc4[4];
#pragma unroll
                    for (int i = 0; i < 2; ++i)
#pragma unroll
                        for (int jj = 0; jj < 2; ++jj) { acc4[2 * i + jj] = (f32x4){0.f, 0.f, 0.f, 0.f}; if (prod == 1) acc4[2 * i + jj] = ld4_lds(bs, TS, 16 * (q2 + i) + l15, 16 * (q2 + jj) + g4); }
#pragma unroll
                    for (int i = 0; i < 2; ++i)
#pragma unroll
                        for (int jj = 0; jj < 2; ++jj) acc4[2 * i + jj] = MFMA16(aa[jj], bj[i], acc4[2 * i + jj]);
                    SETTLE4(acc4[0], acc4[1], acc4[2], acc4[3]);
#pragma unroll
                    for (int i = 0; i < 2; ++i)
#pragma unroll
                        for (int jj = 0; jj < 2; ++jj) st4_lds(dst, TS, 16 * (q2 + i) + l15, 16 * (q2 + jj) + g4, acc4[2 * i + jj]);
                } else { const int at = jb;
                    bf16x8 bj[2]; bj[0] = rf_lds(bs, TS, 16 * at, 0, lane); bj[1] = rf_lds(bs, TS, 16 * at, 32, lane);
                    bf16x8 a0[2], a1[2]; tf_1x2<TS>(as, 0, 0, lane, a0); tf_1x2<TS>(as, 32, 0, lane, a1);
                    f32x4 acc2[2];
#pragma unroll
                    for (int jj = 0; jj < 2; ++jj) { acc2[jj] = (f32x4){0.f, 0.f, 0.f, 0.f}; if (prod == 1) acc2[jj] = ld4_lds(bs, TS, 16 * at + l15, 16 * jj + g4); }
#pragma unroll
                    for (int jj = 0; jj < 2; ++jj) acc2[jj] = MFMA16(a0[jj], bj[0], acc2[jj]);
#pragma unroll
                    for (int jj = 0; jj < 2; ++jj) acc2[jj] = MFMA16(a1[jj], bj[1], acc2[jj]);
                    SETTLE(acc2[0]); SETTLE(acc2[1]);
#pragma unroll
                    for (int jj = 0; jj < 2; ++jj) st4_lds(dst, TS, 16 * at + l15, 16 * jj + g4, acc2[jj]);
                }
            }
            LDS_BARRIER();
            if (doT) { const int t = tsrc; tsrc = tdst; tdst = t; }
            if (doN) { nsrc = ndst; ndst = (ndst == RK_NA) ? RK_NB : RK_NA; }
        }
        { const int at = w & 3, half = w >> 2; const LAS unsigned char* Tt = L + tsrc;
          bf16x8 bj[2]; tf_2x1<TS>(Tt, 0, 16 * at, lane, bj);
          const LAS unsigned char* as = L + (half ? RK_MBR : RK_BI);
          bf16x8 aa[2][4]; tf_2x4<TS>(as, 0, 0, lane, aa);
          f32x4 acc4[4];
#pragma unroll
          for (int bt = 0; bt < 4; ++bt) acc4[bt] = (f32x4){0.f, 0.f, 0.f, 0.f};
#pragma unroll
          for (int ks = 0; ks < 2; ++ks)
#pragma unroll
              for (int bt = 0; bt < 4; ++bt) acc4[bt] = MFMA16(aa[ks][bt], bj[ks], acc4[bt]);
          SETTLE4(acc4[0], acc4[1], acc4[2], acc4[3]);
#pragma unroll
          for (int bt = 0; bt < 4; ++bt) { f32x4 acc = acc4[bt];
              if (!half) { const f32x4 e = *(const LAS f32x4*)(ECL + 16 * bt + g4); acc = acc * e; }
#pragma unroll
              for (int r = 0; r < 4; ++r) RWCHK(!(fabsf(acc[r]) < 1e4f), 8u);
              st4_lds(L + RK_WZ, TS2, 16 * at + l15, 64 * half + 16 * bt + g4, acc); } }
    }
    LDS_BARRIER();
    { const int prod = w >> 1; const size_t io = (size_t)item * 4096;
      GAS bf16_t* Pt = (GAS bf16_t*)(mx + RW_PT) + io; GAS bf16_t* Rh = (GAS bf16_t*)(mx + RW_RH) + io; GAS bf16_t* Mh = (GAS bf16_t*)(mx + RW_MH) + io;
      bf16x8 ax[2][4];
      if (prod == 2) tf_2x4<TS2>(L + RK_WZ, 0, 0, lane, ax); else tf_2x4<TS>(L + (prod == 3 ? RK_AK : RK_KKG), 0, 0, lane, ax);
#pragma unroll
      for (int q = 0; q < 2; ++q) { const int at = 2 * (w & 1) + q; const int a = 16 * at + l15;
          bf16x8 bj[2];
          if (prod == 0) tf_2x1<TS2>(L + RK_WZ, 0, 16 * at, lane, bj);
          else if (prod == 2) tf_2x1<TS>(L + RK_AK, 0, 16 * at, lane, bj);
          else tf_2x1<TS2>(L + RK_WZ, 0, 64 + 16 * at, lane, bj);
          f32x4 acc4[4];
#pragma unroll
          for (int bt = 0; bt < 4; ++bt) acc4[bt] = (f32x4){0.f, 0.f, 0.f, 0.f};
#pragma unroll
          for (int ks = 0; ks < 2; ++ks)
#pragma unroll
              for (int bt = 0; bt < 4; ++bt) acc4[bt] = MFMA16(ax[ks][bt], bj[ks], acc4[bt]);
          SETTLE4(acc4[0], acc4[1], acc4[2], acc4[3]);
#pragma unroll
          for (int bt = 0; bt < 4; ++bt) { f32x4 acc = acc4[bt]; const int b0 = 16 * bt + g4;
              f32x4 o;
#pragma unroll
              for (int r = 0; r < 4; ++r) RWCHK(!(fabsf(acc[r]) < 1e4f), 16u);
              if (prod == 0) { const float e = ECL[a];
#pragma unroll
                  for (int r = 0; r < 4; ++r) o[r] = ((b0 + r) == a ? e : 0.f) - acc[r];
                  RWCHK(!(fabsf(o[0]) < 1e4f) || !(fabsf(o[1]) < 1e4f) || !(fabsf(o[2]) < 1e4f) || !(fabsf(o[3]) < 1e4f), 1u);
                  u32x2 pk; pk.x = pk2(o[0], o[1]); pk.y = pk2(o[2], o[3]); *(GAS u32x2*)(Pt + (size_t)a * 64 + b0) = pk;
              } else if (prod == 1) { o = ld4_lds(L + RK_RG, TS, a, b0) - acc;
                  RWCHK(!(fabsf(o[0]) < 1e4f) || !(fabsf(o[1]) < 1e4f) || !(fabsf(o[2]) < 1e4f) || !(fabsf(o[3]) < 1e4f), 2u);
                  u32x2 pk; pk.x = pk2(o[0], o[1]); pk.y = pk2(o[2], o[3]); *(GAS u32x2*)(Rh + (size_t)a * 64 + b0) = pk;
              } else if (prod == 2) { const f32x4 e = *(const LAS f32x4*)(ECL + b0); o = ld4_lds(L + RK_KTI, TS, a, b0) * e - acc;
                  st4_lds(L + RK_KH, TS, a, b0, o);
              } else { o = ld4_lds(L + RK_MKR, TS, a, b0) - acc;
                  u32x2 pk; pk.x = pk2(o[0], o[1]); pk.y = pk2(o[2], o[3]); *(GAS u32x2*)(Mh + (size_t)a * 64 + b0) = pk; } } } }
    LDS_BARRIER();
    { GAS bf16_t* Qt = (GAS bf16_t*)(mx + RW_QT) + (size_t)item * 4096;
      bf16x8 bk[2]; tf_2x1<TS>(L + RK_KH, 0, 16 * (w >> 1), lane, bk);
#pragma unroll
      for (int q = 0; q < 2; ++q) { const int id = 2 * w + q, at = id >> 2, bt = id & 3; f32x4 acc = {0.f, 0.f, 0.f, 0.f};
          bf16x8 avq[2]; tf_2x1<TS>(L + RK_V, 0, 16 * bt, lane, avq);
#pragma unroll
          for (int ks = 0; ks < 2; ++ks) acc = MFMA16(avq[ks], bk[ks], acc);
          SETTLE(acc);
#pragma unroll
          for (int r = 0; r < 4; ++r) RWCHK(true, 32u);
          u32x2 pk; pk.x = pk2(acc[0], acc[1]); pk.y = pk2(acc[2], acc[3]); *(GAS u32x2*)(Qt + (size_t)(16 * at + l15) * 64 + 16 * bt + g4) = pk; } }
    LDS_BARRIER();
    RWDUMP(RK_MBR, TILE64, 0); RWDUMP(RK_MKR, TILE64, (size_t)10 << 20); RWDUMP(RK_WZ, 64 * TS2, (size_t)20 << 20); RWDUMP(RK_RG, TILE64, (size_t)40 << 20); RWDUMP(RK_AK, TILE64, (size_t)50 << 20);
    LDS_BARRIER();
}

__device__ __forceinline__ void rwkv_pass2_job(const Params& p, LAS unsigned char* scr  , int job, int lane) {
    GAS unsigned char* mx = p.ws + MX_BASE;
    const int bh = job >> 2, vq = job & 3, b = bh >> 3, h = bh & 7, g4 = 4 * (lane >> 4), l15 = lane & 15;
    f32x4 S[4];
#pragma unroll
    for (int nt = 0; nt < 4; ++nt) S[nt] = (f32x4){0.f, 0.f, 0.f, 0.f};
    bf16x8 bp[4][2]; u32x2 qv[4];
    { const size_t io = ((size_t)(b * 64) * 8 + h) * 4096; const GAS bf16_t* Pt = (const GAS bf16_t*)(mx + RW_PT) + io; const GAS bf16_t* Qt = (const GAS bf16_t*)(mx + RW_QT) + io;
#pragma unroll
      for (int nt = 0; nt < 4; ++nt) { bp[nt][0] = rf_glb(Pt, 64, 16 * nt, 0, lane); bp[nt][1] = rf_glb(Pt, 64, 16 * nt, 32, lane); qv[nt] = *(const GAS u32x2*)(Qt + (size_t)(16 * nt + l15) * 64 + 16 * vq + g4); } }
#pragma unroll 1
    for (int c = 0; c < 64; ++c) {
        const size_t io = ((size_t)(b * 64 + c) * 8 + h) * 4096;
        GAS bf16_t* Sg = (GAS bf16_t*)(mx + RW_S) + io;
        bf16x8 bpn[4][2]; u32x2 qvn[4];
        { const int cn = c < 63 ? c + 1 : 63; const size_t ion = ((size_t)(b * 64 + cn) * 8 + h) * 4096;
          const GAS bf16_t* Pt = (const GAS bf16_t*)(mx + RW_PT) + ion; const GAS bf16_t* Qt = (const GAS bf16_t*)(mx + RW_QT) + ion;
#pragma unroll
          for (int nt = 0; nt < 4; ++nt) { bpn[nt][0] = rf_glb(Pt, 64, 16 * nt, 0, lane); bpn[nt][1] = rf_glb(Pt, 64, 16 * nt, 32, lane); qvn[nt] = *(const GAS u32x2*)(Qt + (size_t)(16 * nt + l15) * 64 + 16 * vq + g4); } }
#pragma unroll
        for (int nt = 0; nt < 4; ++nt)
#pragma unroll
            for (int r = 0; r < 4; ++r) *(LAS bf16_t*)(scr + (g4 + r) * TS + (16 * nt + l15) * 2) = (bf16_t)(pk2(S[nt][r], 0.f) & 0xffffu);
        asm volatile("s_waitcnt lgkmcnt(0)" ::: "memory");
        bf16x8 af[2]; af[0] = rf_lds(scr, TS, 0, 0, lane); af[1] = rf_lds(scr, TS, 0, 32, lane);
        asm volatile("s_waitcnt lgkmcnt(0)" ::: "memory");
        *(GAS bf16x8*)(Sg + (size_t)(16 * vq + l15) * 64 + 8 * (lane >> 4)) = af[0];
        *(GAS bf16x8*)(Sg + (size_t)(16 * vq + l15) * 64 + 32 + 8 * (lane >> 4)) = af[1];
#pragma unroll
        for (int nt = 0; nt < 4; ++nt) { f32x4 acc = {bflo(qv[nt].x), bfhi(qv[nt].x), bflo(qv[nt].y), bfhi(qv[nt].y)};
            acc = MFMA16(af[0], bp[nt][0], acc); acc = MFMA16(af[1], bp[nt][1], acc); S[nt] = acc; }
        SETTLE(S[0]); SETTLE(S[1]); SETTLE(S[2]); SETTLE(S[3]);
#pragma unroll
        for (int nt = 0; nt < 4; ++nt) { bp[nt][0] = bpn[nt][0]; bp[nt][1] = bpn[nt][1]; qv[nt] = qvn[nt]; }
    }
}

constexpr int R3_S0 = 0, R3_RH = 9216, R3_MH = 18432, R3_V = 27648, R3_SG = 36864, R3_HALF = 54272;
constexpr int R3_GT = 2 * R3_HALF, R3_GT_SZ = 64 * TS2, R3_KC = R3_GT + 2 * R3_GT_SZ, R3_KC_SZ = 320 * 4, R3_END = R3_KC + 2 * R3_KC_SZ;
__device__ __forceinline__ void rwkv_p3_load_const(const Params& p, const Ctx& C, int layer) {
    const int half = C.wave >> 2, th = C.tid & 255, h = (2 * C.bid + half) & 7, jl = layer >> 1;
    const GAS bf16_t* Gt = (const GAS bf16_t*)(p.ws + WS_GUPT) + ((size_t)jl * 512 + 64 * h) * 128;
#pragma unroll
    for (int q = 0; q < 4; ++q) { const int idx = th + 256 * q, r = idx >> 4, ch = idx & 15;
        *(LAS u32x4*)(C.lds + R3_GT + half * R3_GT_SZ + r * TS2 + 16 * ch) = *(const GAS u32x4*)(Gt + (size_t)r * 128 + 8 * ch); }
    LAS float* K = (LAS float*)(C.lds + R3_KC + half * R3_KC_SZ); const GAS float* mu = p.a_mu + (size_t)jl * RWKV_IN;
    for (int i = th; i < 320; i += 256)
        K[i] = i < 64 ? mu[RW_V + 64 * h + i] : i < 192 ? mu[RW_GD + (i - 64)] : i < 256 ? p.a_ln_gain[jl * 512 + 64 * h + (i - 192)] : p.a_ln_bias[jl * 512 + 64 * h + (i - 256)];
}
struct R3Pre { u32x4 cur[6], prv[6], s[2], rh[2], mh[2]; };
__device__ __forceinline__ void rwkv_p3_prefetch(const Params& p, int tid, int wave, int pair, R3Pre& pre) {
    const int half = wave >> 2, item = 2 * pair + half, h = item & 7, bc = item >> 3, c = bc & 63, th = tid & 255, j = th >> 2, cq = th & 3;
    const GAS bf16_t* cur = (const GAS bf16_t*)(p.ws + WS_U) + ((size_t)bc * 64 + j) * UPITCH; const bool hp = (c * 64 + j) != 0; const GAS bf16_t* prv = hp ? cur - UPITCH : cur;
#pragma unroll
    for (int q = 0; q < 6; ++q) { const int col = q < 2 ? RW_V + 64 * h + 16 * cq + 8 * q : RW_GD + 32 * cq + 8 * (q - 2); pre.cur[q] = *(const GAS u32x4*)(cur + col); pre.prv[q] = *(const GAS u32x4*)(prv + col); }
    GAS unsigned char* mx = p.ws + MX_BASE; const size_t io = (size_t)item * 4096;
    const GAS bf16_t* Sg = (const GAS bf16_t*)(mx + RW_S) + io; const GAS bf16_t* Rh = (const GAS bf16_t*)(mx + RW_RH) + io; const GAS bf16_t* Mh = (const GAS bf16_t*)(mx + RW_MH) + io;
#pragma unroll
    for (int q = 0; q < 2; ++q) { const int idx = th + 256 * q, r = idx >> 3, ch = idx & 7;
        pre.s[q] = __builtin_nontemporal_load((const GAS u32x4*)(Sg + (size_t)r * 64 + 8 * ch));
        pre.rh[q] = __builtin_nontemporal_load((const GAS u32x4*)(Rh + (size_t)r * 64 + 8 * ch));
        pre.mh[q] = __builtin_nontemporal_load((const GAS u32x4*)(Mh + (size_t)r * 64 + 8 * ch)); }
}
__device__ __forceinline__ void rwkv_pass3_pair(const Params& p, const Ctx& C0, int layer, int pair, int next_pair, R3Pre& pre) {
    Ctx C = C0; asm volatile("" : "+s"(C.wave)); asm volatile("" : "+v"(C.tid)); C.lane = C.tid & 63;
    const int half = C.wave >> 2, item = 2 * pair + half, h = item & 7, bc = item >> 3, c = bc & 63, jl = layer >> 1;
    GAS unsigned char* mx = p.ws + MX_BASE;
    LAS unsigned char* L = C.lds + half * R3_HALF;
    GAS bf16_t* Y = (GAS bf16_t*)(p.ws + WS_Y);
    const int th = C.tid & 255, lane = C.lane, g4 = 4 * (lane >> 4), l15 = lane & 15;
    const LAS float* KC = (const LAS float*)(C.lds + R3_KC + half * R3_KC_SZ); const LAS unsigned char* GtL = C.lds + R3_GT + half * R3_GT_SZ;
    const float bon = ((const GAS float*)(mx + RW_BON))[(size_t)item * 64 + 16 * (C.wave & 3) + l15];
    { const int j = th >> 2, cq = th & 3; const bool hp = (c * 64 + j) != 0;
      float t[8];
#pragma unroll
      for (int q = 0; q < 2; ++q) { rk_shift8r(pre.cur[q], pre.prv[q], hp, KC + 16 * cq + 8 * q, t); *(LAS u32x4*)(L + R3_V + j * TS + 32 * cq + 16 * q) = pack8(t); }
#pragma unroll
      for (int q = 0; q < 4; ++q) { rk_shift8r(pre.cur[2 + q], pre.prv[2 + q], hp, KC + 64 + 32 * cq + 8 * q, t);
#pragma unroll
          for (int i = 0; i < 8; ++i) t[i] = sigmoidf_(t[i]);
          *(LAS u32x4*)(L + R3_SG + j * TS2 + 64 * cq + 16 * q) = pack8(t); }
#pragma unroll
      for (int q = 0; q < 2; ++q) { const int idx = th + 256 * q, r = idx >> 3, ch = idx & 7;
          *(LAS u32x4*)(L + R3_S0 + r * TS + 16 * ch) = pre.s[q];
          *(LAS u32x4*)(L + R3_RH + r * TS + 16 * ch) = pre.rh[q];
          *(LAS u32x4*)(L + R3_MH + r * TS + 16 * ch) = pre.mh[q]; } }
    rwkv_p3_prefetch(p, C.tid, C.wave, next_pair, pre);
    LDS_BARRIER();
    { const int tb = C.wave & 3, t = 16 * tb + l15; const size_t tk = (size_t)bc * 64 + t;
      bf16x8 br[2], bm[2], bg[4];
#pragma unroll
      for (int ks = 0; ks < 2; ++ks) { br[ks] = rf_lds(L + R3_RH, TS, 16 * tb, 32 * ks, lane); bm[ks] = rf_lds(L + R3_MH, TS, 16 * tb, 32 * ks, lane); }
#pragma unroll
      for (int ks = 0; ks < 4; ++ks) bg[ks] = rf_lds(L + R3_SG, TS2, 16 * tb, 32 * ks, lane);
      bf16x8 av[2][4]; tf_2x4<TS>(L + R3_V, 0, 0, lane, av);
      f32x4 y[4], gt[4]; float s = 0.f;
      bf16x8 s0f[2][4];
#pragma unroll
      for (int mt = 0; mt < 4; ++mt) { s0f[0][mt] = rf_lds(L + R3_S0, TS, 16 * mt, 0, lane); s0f[1][mt] = rf_lds(L + R3_S0, TS, 16 * mt, 32, lane); y[mt] = (f32x4){0.f, 0.f, 0.f, 0.f}; gt[mt] = (f32x4){0.f, 0.f, 0.f, 0.f}; }
#pragma unroll
      for (int ks = 0; ks < 2; ++ks) {
#pragma unroll
          for (int mt = 0; mt < 4; ++mt) y[mt] = MFMA16(s0f[ks][mt], br[ks], y[mt]);
#pragma unroll
          for (int mt = 0; mt < 4; ++mt) y[mt] = MFMA16(av[ks][mt], bm[ks], y[mt]); }
#pragma unroll
      for (int ks = 0; ks < 4; ++ks)
#pragma unroll
          for (int mt = 0; mt < 4; ++mt) gt[mt] = MFMA16(rf_lds(GtL, TS2, 16 * mt, 32 * ks, lane), bg[ks], gt[mt]);
      SETTLE4(y[0], y[1], y[2], y[3]); SETTLE4(gt[0], gt[1], gt[2], gt[3]);
#pragma unroll
      for (int mt = 0; mt < 4; ++mt) s += (y[mt][0] + y[mt][1]) + (y[mt][2] + y[mt][3]);
      s += __shfl_xor(s, 16); s += __shfl_xor(s, 32);
      const float mean = s * (1.f / 64.f); float s2 = 0.f;
#pragma unroll
      for (int mt = 0; mt < 4; ++mt)
#pragma unroll
          for (int r = 0; r < 4; ++r) { const float d = y[mt][r] - mean; s2 += d * d; }
      s2 += __shfl_xor(s2, 16); s2 += __shfl_xor(s2, 32);
      const float rstd = rsqrtf(s2 * (1.f / 64.f) + 64e-5f);
      const LAS float* lg = KC + 192; const LAS float* lb = KC + 256;
      GAS bf16_t* yp = Y + tk * D + 64 * h;
#pragma unroll
      for (int mt = 0; mt < 4; ++mt) { const int v0 = 16 * mt + g4; const f32x4 G = *(const LAS f32x4*)(lg + v0), Bv = *(const LAS f32x4*)(lb + v0); const f32x4 vv = ld4_lds(L + R3_V, TS, t, v0);
          f32x4 o;
#pragma unroll
          for (int r = 0; r < 4; ++r) o[r] = ((y[mt][r] - mean) * rstd * G[r] + Bv[r] + bon * vv[r]) * gt[mt][r];
          u32x2 pk; pk.x = pk2(o[0], o[1]); pk.y = pk2(o[2], o[3]); *(GAS u32x2*)(yp + v0) = pk; } }
    LDS_BARRIER();
}
constexpr int LDS_BYTES = 150528;
constexpr int LDS_TAB = 131072;
constexpr int LDS_P2SCR = 135168;
constexpr int LDS_BARW = LDS_BYTES - 16;
constexpr int N_PHASES = 2 + 9 * DEPTH;
static_assert(SD_END <= LDS_BARW && RK_CONST + 2560 <= LDS_BARW && SD_RS + 512 <= LDS_BARW && R3_END <= LDS_BARW, "LDS map");

typedef const __attribute__((address_space(4))) Params* KParams;
__global__ void __launch_bounds__(512, 2) mk_fwd(Params p_arg) {
    extern __shared__ __attribute__((aligned(16))) unsigned char lds_raw[];
    KParams kp0 = (KParams)__builtin_amdgcn_kernarg_segment_ptr();
    Params p;
    Ctx C; C.lds = (LAS unsigned char*)lds_raw; C.G = gridDim.x; C.bid = blockIdx.x;
    const int wave0 = __builtin_amdgcn_readfirstlane(threadIdx.x >> 6);
    C.wave = wave0; C.lane = __builtin_amdgcn_mbcnt_hi(~0u, __builtin_amdgcn_mbcnt_lo(~0u, 0u)); C.tid = wave0 * 64 + C.lane;
    const int lo = (int)kp0->ph_lo, hi = (int)kp0->ph_hi;
    GAS unsigned char* const ws0 = kp0->ws;
    if (C.tid == 0) *(LAS u32x4*)(C.lds + LDS_BARW) = (u32x4){0u, 0u, 0u, 0u};
    __syncthreads();
    XcdBarrier bar; bar.bar = (GAS unsigned*)(ws0 + WS_CTL) + CW_BAR; bar.x = 0; bar.st = (volatile LAS unsigned*)(C.lds + LDS_BARW);
    if (hi - lo > 1) bar = xcd_barrier_post((GAS unsigned*)(ws0 + WS_CTL) + CW_BAR, (volatile LAS unsigned*)(C.lds + LDS_BARW), C.tid);
#define FRESH() do { KParams kq_ = kp0; asm volatile("" : "+s"(kq_)); { const __attribute__((address_space(4))) unsigned long long* kw_ = (const __attribute__((address_space(4))) unsigned long long*)kq_; unsigned long long* pw_ = (unsigned long long*)&p; _Pragma("unroll") for (int i_ = 0; i_ < (int)(sizeof(Params) / 8); ++i_) pw_[i_] = kw_[i_]; } int wv_ = wave0; asm volatile("" : "+s"(wv_)); \
        unsigned mk_ = ~0u; asm volatile("" : "+s"(mk_)); int ln_ = __builtin_amdgcn_mbcnt_hi(mk_, __builtin_amdgcn_mbcnt_lo(mk_, 0u)); asm volatile("" : "+v"(ln_)); C.wave = wv_; C.lane = ln_; C.tid = wv_ * 64 + ln_; } while (0)
#ifndef PH_MASK
#define PH_MASK 0xFFFF
#endif
#define PM(b) ((PH_MASK >> (b)) & 1)
#ifndef REP_MASK
#define REP_MASK 0
#endif
#define RP(b) for (int rep_ = 0; rep_ < 1 + ((REP_MASK >> (b)) & 1); ++rep_)
#ifdef DBG_TIME
#define STAMP(k) do { if (blockIdx.x == 0 && C.tid == 0) ((GAS unsigned long long*)(ws0 + WS_END - 32768))[(k)] = wall_clock64(); } while (0)
#else
#define STAMP(k) do { } while (0)
#endif
#define IN(k) (lo <= (k) && (k) < hi)
#define SEAM(k) do { if (IN(k) && IN((k) + 1)) { FRESH(); xcd_barrier(bar, C.tid); if ((REP_MASK >> 15) & 1) { xcd_barrier(bar, C.tid); xcd_barrier(bar, C.tid); } STAMP((k) + 1); } } while (0)
    STAMP(0);
    if (PM(0) && IN(0)) RP(0) { FRESH(); p0_prologue(p, C); __syncthreads(); }
    SEAM(0);
#pragma nounroll
    for (int l = 0; l < DEPTH; ++l) {
        const int P = 1 + 9 * l; const bool odd = (l & 1) != 0;
        if (PM(1) && IN(P)) { if ((REP_MASK >> 1) & 1) { FRESH(); norm_phase<false, true>(p, C, l); __syncthreads(); } FRESH(); norm_phase<false>(p, C, l); }
        SEAM(P);
        if (PM(2) && IN(P + 1)) RP(2) { FRESH();
            const GAS bf16_t* W = odd ? (const GAS bf16_t*)(p.ws + WS_WINO) + (size_t)(l >> 1) * NPO * D : (const GAS bf16_t*)(p.ws + WS_WINE) + (size_t)(l >> 1) * NPE * D;
            pg8::StaticOrder S; S.init(p.ws + WS_H, W, T, odd ? NPO : NPE, D, C.G, C.bid);
            EpiU E{(GAS bf16_t*)(p.ws + WS_U)};
            pg8::gemm_phase<EpiU, pg8::StaticOrder, false>(C.lds, C.tid, D, S, E);
        }
        SEAM(P + 1);
        if (IN(P + 2)) { FRESH();
            if (!odd) { if (PM(3)) RP(3) { const int h = C.bid & 7; rk_load_const(p, C, l, h); RkPre pre; rk_prefetch(p, C.tid, h, C.bid, pre);
                            bf16x8 wf[4][2]; { const int prod = C.wave >> 2; const GAS bf16_t* Wt = (const GAS bf16_t*)(p.ws + (prod ? WS_AUPT : WS_WUPT)) + ((size_t)(l >> 1) * 512 + 64 * h) * 64;
#pragma unroll
                              for (int bt = 0; bt < 4; ++bt) { wf[bt][0] = rf_glb(Wt, 64, 16 * bt, 0, C.lane); wf[bt][1] = rf_glb(Wt, 64, 16 * bt, 32, C.lane); } }
                            __syncthreads();
                            for (int it = C.bid; it < 4096; it += C.G) rwkv_pass1_item(p, C, l, it, (it + C.G < 4096) ? it + C.G : it, pre, wf); }
                        if (PM(4)) RP(4) { gla_stage_aup<false>(p, C, l, C.bid & 3); GlPre pre1; gla_prefetch1<false>(p, C.tid, C.bid, pre1); __syncthreads(); for (int it = C.bid; it < 2048; it += C.G) gla_pass1_item<false>(p, C, l, it, (it + C.G < 2048) ? it + C.G : it, pre1); } }
            else      { if (PM(4)) RP(4) { GlPre pre1; gla_prefetch1<true>(p, C.tid, C.bid, pre1); for (int it = C.bid; it < 2048; it += C.G) gla_pass1_item<true>(p, C, l, it, (it + C.G < 2048) ? it + C.G : it, pre1); }
                        if (PM(5)) RP(5) { ssd_load_cw(p, C, l, C.bid & 1); __syncthreads(); for (int it = C.bid; it < 1024; it += C.G) ssd_pass1_item(p, C, l, it); } }
        }
        SEAM(P + 2);
        if (PM(6) && IN(P + 3)) RP(6) { FRESH();
            if (!odd) { if (C.wave == 0) { for (int job = C.bid; job < 256; job += C.G) rwkv_pass2_job(p, C.lds + LDS_P2SCR, job, C.lane); }
                        else if (C.wave <= 4) { for (int job = C.bid * 4 + C.wave - 1; job < 1024; job += C.G * 4) gla_pass2_job<false>(p, job, C.lane); } }
            else      { if (C.wave < 4) { for (int job = C.bid * 4 + C.wave; job < 1024; job += C.G * 4) gla_pass2_job<true>(p, job, C.lane); }
                        else { for (int job = C.bid * 4 + C.wave - 4; job < 1024; job += C.G * 4) ssd_pass2_job(p, job, C.lane); } }
        }
        SEAM(P + 3);
        if (IN(P + 4)) { FRESH();
            if (!odd) { if (PM(7)) RP(7) { rwkv_p3_load_const(p, C, l); R3Pre pre3; rwkv_p3_prefetch(p, C.tid, C.wave, C.bid, pre3); __syncthreads(); for (int it = C.bid; it < 2048; it += C.G) rwkv_pass3_pair(p, C, l, it, (it + C.G < 2048) ? it + C.G : it, pre3); __syncthreads(); }
                        if (PM(8)) RP(8) { Gl3Pre pre3; gla_prefetch3<false>(p, C.tid, C.bid, pre3); for (int it = C.bid; it < 2048; it += C.G) gla_pass3_item<false>(p, C, l, it, (it + C.G < 2048) ? it + C.G : it, pre3); } }
            else      { if (PM(8)) RP(8) { Gl3Pre pre3; gla_prefetch3<true>(p, C.tid, C.bid, pre3); for (int it = C.bid; it < 2048; it += C.G) gla_pass3_item<true>(p, C, l, it, (it + C.G < 2048) ? it + C.G : it, pre3); }
                        if (PM(9)) RP(9) { ssd_load_cw(p, C, l, C.bid & 1); __syncthreads(); for (int it = C.bid; it < 1024; it += C.G) ssd_pass3_item(p, C, l, it); } }
        }
        SEAM(P + 4);
        if (PM(10) && IN(P + 5)) { FRESH();
            pg8::StaticOrder S; S.init(p.ws + WS_Y, (const GAS bf16_t*)(p.ws + WS_WOUT) + (size_t)l * D * D, T, D, D, C.G, C.bid);
            EpiOut E{(GAS bf16_t*)(p.ws + WS_XB), (const GAS float*)(p.ws + WS_MOD) + (size_t)l * NB * 6 * D + 2 * D};
            pg8::gemm_phase<EpiOut, pg8::StaticOrder, false>(C.lds, C.tid, D, S, E);
        }
        SEAM(P + 5);
        if (PM(11) && IN(P + 6)) { if ((REP_MASK >> 11) & 1) { FRESH(); route_phase<true>(p, C, l); __syncthreads(); } FRESH(); route_phase<false>(p, C, l); }
        SEAM(P + 6);
        if (PM(12) && IN(P + 7)) RP(12) { FRESH();
            LAS int* tab = (LAS int*)(C.lds + LDS_TAB); moe_table(p, C, l, tab);
            MoeOrder S{(const GAS char*)(p.ws + WS_H), (const GAS char*)(p.ws + moe_wgu(l)), D, (size_t)1024 * D * 2, tab, (const GAS int*)(p.ws + WS_LISTA), C.G, C.bid, false};
            EpiUp E{(GAS bf16_t*)(p.ws + WS_ACT)};
            pg8::gemm_phase<EpiUp, MoeOrder, true>(C.lds, C.tid, D, S, E);
            FRESH(); moe_convert_tail(p, C, l, (const LAS int*)(C.lds + LDS_TAB), 0);
        }
        SEAM(P + 7);
        if (PM(13) && IN(P + 8)) RP(13) { FRESH();
            LAS int* tab = (LAS int*)(C.lds + LDS_TAB); moe_table(p, C, l, tab);
            MoeOrder S{(const GAS char*)(p.ws + WS_ACT), (const GAS char*)(p.ws + moe_wdn(l)), DEXP, (size_t)D * DEXP * 2, tab, (const GAS int*)(p.ws + WS_LISTA), C.G, C.bid, true};
            EpiDown E{(GAS bf16_t*)(p.ws + WS_YB), (const GAS int*)(p.ws + WS_LISTA), (const GAS float*)(p.ws + WS_LISTW)};
            pg8::gemm_phase<EpiDown, MoeOrder, false>(C.lds, C.tid, DEXP, S, E);
            FRESH(); moe_convert_tail(p, C, l, (const LAS int*)(C.lds + LDS_TAB), 1);
        }
        SEAM(P + 8);
    }
    if (PM(14) && IN(N_PHASES - 1)) { FRESH(); norm_phase<true>(p, C, DEPTH - 1); }
    __syncthreads(); STAMP(N_PHASES);
#undef IN
#undef PM
#undef SEAM
}


#ifdef DBG
constexpr int CW_DBG = 8192;
__global__ void dbg_scan(const void* base, int rows, int cols, int pitch, int is_f32, unsigned* flags, unsigned bit, float thr = 1e30f) {
    bool bad = false;
    for (size_t i = (size_t)blockIdx.x * blockDim.x + threadIdx.x; i < (size_t)rows * cols; i += (size_t)gridDim.x * blockDim.x) {
        const size_t r = i / cols, c = i % cols;
        float v = is_f32 ? ((const float*)base)[r * pitch + c] : bf2f(((const bf16_t*)base)[r * pitch + c]);
        if (!(fabsf(v) < thr)) bad = true;
    }
    if (bad) atomicOr(flags, bit);
}

__global__ void dbg_count(const void* base, size_t n, int is_f32, unsigned long long* cnt) {
    unsigned long long c = 0;
    for (size_t i = (size_t)blockIdx.x * blockDim.x + threadIdx.x; i < n; i += (size_t)gridDim.x * blockDim.x) {
        float v = is_f32 ? ((const float*)base)[i] : bf2f(((const bf16_t*)base)[i]);
        if (!(fabsf(v) < 1e30f)) ++c;
    }
    if (c) atomicAdd(cnt, c);
}
__global__ void dbg_log2(const unsigned long long* cnt, unsigned* flags) { unsigned long long c = *cnt; unsigned k = 0; while (c) { ++k; c >>= 1; } *flags = k; }

__global__ void dbg_sum(const void* base, int rows, int cols, int pitch, int esz, unsigned long long* slot) {
    unsigned long long c = 0;
    for (size_t i = (size_t)blockIdx.x * blockDim.x + threadIdx.x; i < (size_t)rows * cols; i += (size_t)gridDim.x * blockDim.x) {
        const size_t r = i / cols, cc = i % cols;
        const unsigned v = esz == 4 ? ((const unsigned*)base)[r * pitch + cc] : (unsigned)((const unsigned short*)base)[r * pitch + cc];
        c += (unsigned long long)v * (unsigned long long)(1 + (i & 1023));
    }
    atomicAdd(slot, c);
}
__global__ void dbg_cmpmask(const unsigned long long* s1, const unsigned long long* s2, int n, unsigned* flags) { unsigned f = 0; for (int i = 0; i < n; ++i) if (s1[i] != s2[i]) f |= 1u << i; *flags = f; }
__global__ void dbg_cmp(const unsigned long long* s1, const unsigned long long* s2, int n, unsigned* flags) { unsigned f = 0; for (int i = n - 1; i >= 0; --i) if (s1[i] != s2[i]) f = (unsigned)i; *flags = f; }
__global__ void dbg_emit(float* out, const unsigned* flags) {
    const size_t i = (size_t)blockIdx.x * blockDim.x + threadIdx.x;
    if (i < (size_t)T * D) out[i] = (i == 0) ? sqrtf((float)(flags[0] + flags[1]) * (float)T * (float)D) : 0.f;
}
#endif

#ifdef DBG_TIME
__global__ void dbg_time_emit(float* out, const unsigned long long* st) {
    const size_t i = (size_t)blockIdx.x * blockDim.x + threadIdx.x;
    const float da = (float)(st[DBG_TA1] - st[DBG_TA0]) * 0.01f, db = (float)(st[DBG_TB1] - st[DBG_TB0]) * 0.01f;
    if (i < (size_t)T * D) out[i] = (i == 0) ? db : sqrtf(da);
}
#endif
extern "C" void kernel_launch(void* const* d_in, const int* in_sizes, int n_in, void* d_out, int out_size, void* d_ws, size_t ws_size, hipStream_t stream) {
    static int grid = 0;
    if (grid == 0) {
        if (n_in != 36 || out_size != T * D || ws_size < WS_END) { fprintf(stderr, "kernel_launch: unexpected shapes (n_in %d out %d ws %zu need %zu)\n", n_in, out_size, ws_size, (size_t)WS_END); grid = -1; return; }
        int dev = 0, cus = 0, per_cu = 0;
        if (hipGetDevice(&dev) != hipSuccess || hipDeviceGetAttribute(&cus, hipDeviceAttributeMultiprocessorCount, dev) != hipSuccess) { grid = -1; return; }
        if (hipFuncSetAttribute((const void*)mk_fwd, hipFuncAttributeMaxDynamicSharedMemorySize, LDS_BYTES) != hipSuccess) { fprintf(stderr, "kernel_launch: hipFuncSetAttribute failed\n"); grid = -1; return; }
        if (hipOccupancyMaxActiveBlocksPerMultiprocessor(&per_cu, (const void*)mk_fwd, 512, LDS_BYTES) != hipSuccess || per_cu < 1) { fprintf(stderr, "kernel_launch: occupancy query says %d\n", per_cu); (void)hipGetLastError(); grid = -1; return; }
        grid = cus; if (grid % 8) { fprintf(stderr, "kernel_launch: grid %d is not a multiple of 8\n", grid); grid = -1; return; }
    }
    if (grid < 0) return;
#ifdef DBG_MEMSET_ALL
    (void)hipMemsetAsync((char*)d_ws, 0, WS_END, stream);
#else
    (void)hipMemsetAsync((char*)d_ws + WS_CTL, 0, CTL_BYTES, stream);
#endif
    Params p{};
    const float** pp = (const float**)&p;
    for (int i = 0; i < 36; ++i) pp[i] = (const float*)d_in[i];
    p.out = (GAS float*)d_out; p.ws = (GAS unsigned char*)d_ws;
#if MK_LAUNCHES == 1
    p.ph_lo = 0; p.ph_hi = N_PHASES;
    hipLaunchKernelGGL(mk_fwd, dim3(grid), dim3(512), LDS_BYTES, stream, p);
#ifdef DBG_TIME
    hipLaunchKernelGGL(dbg_time_emit, dim3(T * D / 256), dim3(256), 0, stream, (float*)d_out, (const unsigned long long*)((unsigned char*)d_ws + WS_END - 32768));
#endif
#else
#ifdef DBG_TWICE
    (void)hipMemsetAsync((char*)d_ws + WS_END - 65536, 0, 65536, stream);
    for (int rep = 0; rep < 2; ++rep) { if (rep) (void)hipMemsetAsync((char*)d_ws + WS_CTL, 0, CTL_BYTES, stream);
#else
    { const int rep = 0; (void)rep;
#endif
    for (int ph = 0; ph < N_PHASES; ++ph) { p.ph_lo = ph; p.ph_hi = ph + 1; hipLaunchKernelGGL(mk_fwd, dim3(grid), dim3(512), LDS_BYTES, stream, p);
#ifdef DBG
        unsigned char* ws = (unsigned char*)d_ws; unsigned* fl = (unsigned*)(ws + WS_CTL) + CW_DBG;
        DBG_HOOKS
#endif
    }
    }
#ifdef DBG
    { unsigned* fl = (unsigned*)((unsigned char*)d_ws + WS_CTL) + CW_DBG;
      hipLaunchKernelGGL(dbg_scan, dim3(1024), dim3(256), 0, stream, (const void*)d_out, T, D, D, 1, fl, DBG_FINAL_BIT);
      hipLaunchKernelGGL(dbg_emit, dim3(T * D / 256), dim3(256), 0, stream, (float*)d_out, (const unsigned*)fl); }
#endif
#endif
}
```

```cpp
#include <hip/hip_runtime.h>
#include <stdint.h>
#include <stdio.h>

#ifndef MK_LAUNCHES
#define MK_LAUNCHES 1
#endif

#define LAS __attribute__((address_space(3)))
#if defined(__HIP_DEVICE_COMPILE__)
#define GAS __attribute__((address_space(1)))
#else
#define GAS
#endif
typedef unsigned short bf16_t;
typedef short bf16x8 __attribute__((ext_vector_type(8)));
typedef unsigned short u16x4 __attribute__((ext_vector_type(4)));
typedef float f32x4 __attribute__((ext_vector_type(4)));
typedef float f32x2 __attribute__((ext_vector_type(2)));
typedef unsigned u32x4 __attribute__((ext_vector_type(4)));
typedef unsigned u32x2 __attribute__((ext_vector_type(2)));

constexpr int D = 1024, NB = 8, SEQ = 4096, T = NB * SEQ, DEPTH = 4, CH = 64, NCH = SEQ / CH;
constexpr int EVEN_IN = 3344, ODD_IN = 2824, NPE = 3584, NPO = 3072, UPITCH = 3584;
constexpr int RW_R = 0, RW_K = 512, RW_V = 1024, RW_WD = 1536, RW_AD = 1600, RW_GD = 1664, RWKV_IN = 1792;
constexpr int GL_Q = 1792, GL_K = 2048, GL_V = 2304, GL_AD = 2816, GL_G = 2832;
constexpr int HG_Q = 0, HG_F = 256, HG_I = 512, HG_G = 1024, HGRN_IN = 1536;
constexpr int SD_Z = 1536, SD_XBC = 2048, SD_XS = 2048, SD_BM = 2560, SD_CM = 2688, SD_DT = 2816;
constexpr int NEXP = 16, DEXP = 512;
constexpr float NORM_EPS = 1e-6f;

constexpr size_t al256(size_t x) { return (x + 255) & ~(size_t)255; }
constexpr size_t WS_CTL = 0;
constexpr size_t CTL_BYTES = 65536;
constexpr size_t WS_MOD = WS_CTL + CTL_BYTES;
constexpr size_t WS_LB = WS_MOD + al256((size_t)DEPTH * NB * 6 * D * 4);
constexpr size_t WS_WINE = WS_LB + al256((size_t)DEPTH * 256 * 4);
constexpr size_t WS_WINO = WS_WINE + (size_t)2 * NPE * D * 2;
constexpr size_t WS_WOUT = WS_WINO + (size_t)2 * NPO * D * 2;
constexpr size_t WS_WGU = WS_WOUT + (size_t)4 * D * D * 2;
constexpr size_t WS_WDN = WS_WGU + (size_t)NEXP * 1024 * D * 2;
constexpr size_t WS_WUPT = WS_WDN + (size_t)NEXP * D * DEXP * 2;
constexpr size_t WS_AUPT = WS_WUPT + (size_t)2 * 512 * 64 * 2;
constexpr size_t WS_GUPT = WS_AUPT + (size_t)2 * 512 * 64 * 2;
constexpr size_t WS_LISTA = WS_GUPT + (size_t)2 * 512 * 128 * 2;
constexpr size_t WS_LISTW = WS_LISTA + (size_t)NEXP * T * 4;
constexpr size_t WS_Y = WS_LISTW + (size_t)NEXP * T * 4;
constexpr size_t WS_U = WS_Y + (size_t)T * D * 2;
constexpr size_t WS_H = WS_U + (size_t)T * UPITCH * 2;
constexpr size_t WS_MIX = WS_H + (size_t)T * D * 2;
constexpr size_t MIX_BYTES = (size_t)162 * 1024 * 1024;
constexpr size_t WS_XB = WS_MIX + MIX_BYTES;
constexpr size_t WS_END = WS_XB + (size_t)T * D * 2;
constexpr size_t WS_PGU = WS_XB - (size_t)NEXP * 1024 * D * 2 - (size_t)NEXP * D * DEXP * 2;
constexpr size_t WS_PDN = WS_PGU + (size_t)NEXP * 1024 * D * 2;
__host__ __device__ constexpr size_t moe_wgu(int layer) { return (layer & 1) ? WS_PGU : WS_WGU; }
__host__ __device__ constexpr size_t moe_wdn(int layer) { return (layer & 1) ? WS_PDN : WS_WDN; }
constexpr size_t WS_ACT = WS_U;
constexpr size_t ACT_ROWS = (size_t)(2 * T / 256 + NEXP) * 256;
constexpr size_t WS_YB = WS_ACT + al256(ACT_ROWS * DEXP * 2);
static_assert(WS_YB + (size_t)2 * T * D * 2 <= WS_H, "MoE aliases overflow U");
static_assert(WS_END <= (size_t)706000000, "workspace larger than the guaranteed ws_size");
constexpr int CW_BAR = 0;
constexpr int CW_CNT = 4096;

typedef __bf16 bf16x2_t __attribute__((ext_vector_type(2)));
__device__ __forceinline__ unsigned pk2(float lo, float hi) { const f32x2 v = {lo, hi}; const bf16x2_t b = __builtin_convertvector(v, bf16x2_t); return __builtin_bit_cast(unsigned, b); }
__device__ __forceinline__ float bflo(unsigned u) { return __uint_as_float(u << 16); }
__device__ __forceinline__ float bfhi(unsigned u) { return __uint_as_float(u & 0xffff0000u); }
__device__ __forceinline__ float bf2f(bf16_t b) { return __uint_as_float(((unsigned)b) << 16); }
__device__ __forceinline__ float rcpf_(float x) { return __builtin_amdgcn_rcpf(x); }
__device__ __forceinline__ float sigmoidf_(float x) { return rcpf_(1.f + __expf(-x)); }
__device__ __forceinline__ float siluf_(float x) { return x * rcpf_(1.f + __expf(-x)); }
__device__ __forceinline__ float softplusf_(float x) { return x > 20.f ? x : (x < -15.f ? __expf(x) : __logf(1.f + __expf(x))); }
__device__ __forceinline__ float logsigmoidf_(float x) { return fminf(x, 0.f) - __logf(1.f + __expf(-fabsf(x))); }
__device__ __forceinline__ void unpack8(const u32x4 v, float (&f)[8]) {
    f[0] = bflo(v.x); f[1] = bfhi(v.x); f[2] = bflo(v.y); f[3] = bfhi(v.y); f[4] = bflo(v.z); f[5] = bfhi(v.z); f[6] = bflo(v.w); f[7] = bfhi(v.w);
}
__device__ __forceinline__ u32x4 pack8(const float (&f)[8]) { u32x4 o; o.x = pk2(f[0], f[1]); o.y = pk2(f[2], f[3]); o.z = pk2(f[4], f[5]); o.w = pk2(f[6], f[7]); return o; }
__device__ __forceinline__ float wave_sum(float v) {
#pragma unroll
    for (int o = 1; o < 64; o <<= 1) v += __shfl_xor(v, o);
    return v;
}
#define MFMA16(a, b, c) __builtin_amdgcn_mfma_f32_16x16x32_bf16((a), (b), (c), 0, 0, 0)
#define SETTLE(acc) asm volatile("s_nop 7\n\ts_nop 7\n\ts_nop 7" : "+v"(acc))
#define LDS_BARRIER() asm volatile("s_waitcnt lgkmcnt(0)\n\ts_barrier" ::: "memory")
#define SETTLE4(a0, a1, a2, a3) asm volatile("s_nop 7\n\ts_nop 7\n\ts_nop 7" : "+v"(a0), "+v"(a1), "+v"(a2), "+v"(a3))

__device__ __forceinline__ bf16x8 rf_lds(const LAS unsigned char* tile, int strideB, int r0, int c0, int lane) {
    return *(const LAS bf16x8*)(tile + (r0 + (lane & 15)) * strideB + (c0 + 8 * (lane >> 4)) * 2);
}
__device__ __forceinline__ bf16x8 tf_lds(const LAS unsigned char* tile, int strideB, int r0, int c0, int lane) {
    const int g = lane >> 4, q = (lane & 15) >> 2, p = lane & 3;
    const unsigned a0 = (unsigned)(uintptr_t)tile + (unsigned)((r0 + 8 * g + q) * strideB + (c0 + 4 * p) * 2);
    const unsigned a1 = a0 + 4u * (unsigned)strideB;
    u16x4 lo, hi;
    asm volatile("ds_read_b64_tr_b16 %0, %2\n\tds_read_b64_tr_b16 %1, %3\n\ts_waitcnt lgkmcnt(0)" : "=&v"(lo), "=&v"(hi) : "v"(a0), "v"(a1) : "memory");
    bf16x8 r;
    r[0] = (short)lo[0]; r[1] = (short)lo[1]; r[2] = (short)lo[2]; r[3] = (short)lo[3]; r[4] = (short)hi[0]; r[5] = (short)hi[1]; r[6] = (short)hi[2]; r[7] = (short)hi[3];
    return r;
}

template <int STRIDE, int O0, int O1, int O2, int O3>
__device__ __forceinline__ void tf4_issue(unsigned a, u16x4& l0, u16x4& h0, u16x4& l1, u16x4& h1, u16x4& l2, u16x4& h2, u16x4& l3, u16x4& h3) {
    asm volatile("ds_read_b64_tr_b16 %0, %8 offset:%9\n\tds_read_b64_tr_b16 %1, %8 offset:%10\n\tds_read_b64_tr_b16 %2, %8 offset:%11\n\tds_read_b64_tr_b16 %3, %8 offset:%12\n\t"
                 "ds_read_b64_tr_b16 %4, %8 offset:%13\n\tds_read_b64_tr_b16 %5, %8 offset:%14\n\tds_read_b64_tr_b16 %6, %8 offset:%15\n\tds_read_b64_tr_b16 %7, %8 offset:%16"
                 : "=&v"(l0), "=&v"(h0), "=&v"(l1), "=&v"(h1), "=&v"(l2), "=&v"(h2), "=&v"(l3), "=&v"(h3)
                 : "v"(a), "n"(O0), "n"(O0 + 4 * STRIDE), "n"(O1), "n"(O1 + 4 * STRIDE), "n"(O2), "n"(O2 + 4 * STRIDE), "n"(O3), "n"(O3 + 4 * STRIDE) : "memory");
}
__device__ __forceinline__ bf16x8 tf_join(const u16x4 lo, const u16x4 hi) {
    bf16x8 r; r[0] = (short)lo[0]; r[1] = (short)lo[1]; r[2] = (short)lo[2]; r[3] = (short)lo[3]; r[4] = (short)hi[0]; r[5] = (short)hi[1]; r[6] = (short)hi[2]; r[7] = (short)hi[3]; return r;
}
__device__ __forceinline__ unsigned tf_base(const LAS unsigned char* tile, int strideB, int r0, int c0, int lane) {
    const int g = lane >> 4, q = (lane & 15) >> 2, p = lane & 3;
    return (unsigned)(uintptr_t)tile + (unsigned)((r0 + 8 * g + q) * strideB + (c0 + 4 * p) * 2);
}
template <int STRIDE>
__device__ __forceinline__ void tf_2x4(const LAS unsigned char* tile, int r0, int c0, int lane, bf16x8 (&f)[2][4]) {
    const unsigned a = tf_base(tile, STRIDE, r0, c0, lane);
    u16x4 l[8], h[8];
    tf4_issue<STRIDE, 0, 32, 64, 96>(a, l[0], h[0], l[1], h[1], l[2], h[2], l[3], h[3]);
    tf4_issue<STRIDE, 32 * STRIDE, 32 * STRIDE + 32, 32 * STRIDE + 64, 32 * STRIDE + 96>(a, l[4], h[4], l[5], h[5], l[6], h[6], l[7], h[7]);
    asm volatile("s_waitcnt lgkmcnt(0)" : "+v"(l[0]), "+v"(h[0]), "+v"(l[1]), "+v"(h[1]), "+v"(l[2]), "+v"(h[2]), "+v"(l[3]), "+v"(h[3]), "+v"(l[4]), "+v"(h[4]), "+v"(l[5]), "+v"(h[5]), "+v"(l[6]), "+v"(h[6]), "+v"(l[7]), "+v"(h[7]) :: "memory");
#pragma unroll
    for (int ks = 0; ks < 2; ++ks)
#pragma unroll
        for (int bt = 0; bt < 4; ++bt) f[ks][bt] = tf_join(l[4 * ks + bt], h[4 * ks + bt]);
}
template <int STRIDE>
__device__ __forceinline__ void tf_2x1(const LAS unsigned char* tile, int r0, int c0, int lane, bf16x8 (&f)[2]) {
    const unsigned a = tf_base(tile, STRIDE, r0, c0, lane);
    u16x4 l0, h0, l1, h1;
    asm volatile("ds_read_b64_tr_b16 %0, %4\n\tds_read_b64_tr_b16 %1, %4 offset:%5\n\tds_read_b64_tr_b16 %2, %4 offset:%6\n\tds_read_b64_tr_b16 %3, %4 offset:%7\n\ts_waitcnt lgkmcnt(0)"
                 : "=&v"(l0), "=&v"(h0), "=&v"(l1), "=&v"(h1) : "v"(a), "n"(4 * STRIDE), "n"(32 * STRIDE), "n"(36 * STRIDE) : "memory");
    f[0] = tf_join(l0, h0); f[1] = tf_join(l1, h1);
}
template <int STRIDE>
__device__ __forceinline__ void tf_1x2(const LAS unsigned char* tile, int r0, int c0, int lane, bf16x8 (&f)[2]) {
    const unsigned a = tf_base(tile, STRIDE, r0, c0, lane);
    u16x4 l0, h0, l1, h1;
    asm volatile("ds_read_b64_tr_b16 %0, %4\n\tds_read_b64_tr_b16 %1, %4 offset:%5\n\tds_read_b64_tr_b16 %2, %4 offset:%6\n\tds_read_b64_tr_b16 %3, %4 offset:%7\n\ts_waitcnt lgkmcnt(0)"
                 : "=&v"(l0), "=&v"(h0), "=&v"(l1), "=&v"(h1) : "v"(a), "n"(4 * STRIDE), "n"(32), "n"(32 + 4 * STRIDE) : "memory");
    f[0] = tf_join(l0, h0); f[1] = tf_join(l1, h1);
}
__device__ __forceinline__ bf16x8 rf_glb(const GAS bf16_t* base, int ld, int r0, int c0, int lane) {
    return *(const GAS bf16x8*)(base + (size_t)(r0 + (lane & 15)) * ld + c0 + 8 * (lane >> 4));
}
__device__ __forceinline__ void st4_lds(LAS unsigned char* tile, int strideB, int row, int col, f32x4 v) {
    u32x2 o; o.x = pk2(v[0], v[1]); o.y = pk2(v[2], v[3]);
    *(LAS u32x2*)(tile + row * strideB + col * 2) = o;
}
__device__ __forceinline__ f32x4 ld4_lds(const LAS unsigned char* tile, int strideB, int row, int col) {
    const u32x2 o = *(const LAS u32x2*)(tile + row * strideB + col * 2);
    return (f32x4){bflo(o.x), bfhi(o.x), bflo(o.y), bfhi(o.y)};
}
constexpr int TS = 144;
constexpr int TS2 = 272;
constexpr int TILE64 = 64 * TS;
constexpr int FS = 68;
constexpr int FTILE = 64 * FS * 4;

#define XB_TMO      128
#define XB_XCNT(j)  (256  + 64 * (j))
#define XB_XSUB(j)  (1280 + 64 * (j))
#define XB_XGEN(j)  (2304 + 64 * (j))
#define XB_TOP      3328
#define XB_TOPGEN   3392
#define XCD_BAR_WORDS 3456
#define XB_SPIN_CAP (1u << 18)
__device__ __forceinline__ unsigned xb_ld(GAS unsigned* p)              { return __hip_atomic_load(p, __ATOMIC_RELAXED, __HIP_MEMORY_SCOPE_AGENT); }
__device__ __forceinline__ unsigned xb_add(GAS unsigned* p, unsigned v) { return __hip_atomic_fetch_add(p, v, __ATOMIC_RELAXED, __HIP_MEMORY_SCOPE_AGENT); }
__device__ __forceinline__ unsigned xb_xcc_id() { return (unsigned)__builtin_amdgcn_s_getreg((3 << 11) | 20) & 0xFu; }
#define XB_SPIN(cond, bar) do { unsigned _sp = 0; while (cond) { __builtin_amdgcn_s_sleep(1); \
    if ((++_sp & 255u) == 0u) { if (xb_ld(&(bar)[XB_TMO])) break; if (_sp > XB_SPIN_CAP) { atomicAdd(&(bar)[XB_TMO], 1u); break; } } } } while (0)
struct XcdBarrier { GAS unsigned* bar; unsigned x; volatile LAS unsigned* st; };
__device__ __forceinline__ XcdBarrier xcd_barrier_post(GAS unsigned* bar, volatile LAS unsigned* st, int tid) {
    XcdBarrier b; b.bar = bar; b.x = xb_xcc_id(); b.st = st;
    if (tid == 0) (void)xb_add(&bar[XB_XCNT(b.x)], 1u);
    return b;
}
__device__ __forceinline__ void xcd_barrier_complete(GAS unsigned* bar, unsigned x, unsigned& nloc, unsigned& nx) {
    const unsigned G = gridDim.x * gridDim.y * gridDim.z;
    unsigned sum, cnt, mine, sp = 0u;
    for (;;) {
        sum = 0u; cnt = 0u; mine = 0u;
#pragma unroll
        for (unsigned j = 0; j < 16; ++j) { const unsigned c = xb_ld(&bar[XB_XCNT(j)]); sum += c; cnt += (c > 0u) ? 1u : 0u; mine = (j == x) ? c : mine; }
        if (sum == G) break;
        __builtin_amdgcn_s_sleep(1);
        if ((++sp & 255u) == 0u) { if (xb_ld(&bar[XB_TMO])) break; if (sp > XB_SPIN_CAP) { atomicAdd(&bar[XB_TMO], 1u); break; } }
    }
    nloc = mine > 0u ? mine : 1u; nx = cnt > 0u ? cnt : 1u;
}
__device__ __forceinline__ void xcd_barrier(const XcdBarrier& b, int tid) {
    asm volatile("s_waitcnt vmcnt(0)" ::: "memory");
    __syncthreads();
    if (tid == 0) {
        GAS unsigned* bar = b.bar;
        __builtin_amdgcn_s_waitcnt(0);
        unsigned nloc = b.st[0], nx = b.st[1];
        if (nloc == 0u) { xcd_barrier_complete(bar, b.x, nloc, nx); b.st[0] = nloc; b.st[1] = nx; }
        const unsigned old = xb_add(&bar[XB_XSUB(b.x)], 1u);
        const unsigned gen = old / nloc;
        if (old + 1u == (gen + 1u) * nloc) {
            __builtin_amdgcn_fence(__ATOMIC_RELEASE, "agent");
            asm volatile("s_waitcnt vmcnt(0)" ::: "memory");
            const unsigned og = xb_add(&bar[XB_TOP], 1u);
            const unsigned tg = og / nx;
            if (og + 1u == (tg + 1u) * nx) xb_add(&bar[XB_TOPGEN], 1u);
            else XB_SPIN(xb_ld(&bar[XB_TOPGEN]) == tg, bar);
            __builtin_amdgcn_fence(__ATOMIC_ACQUIRE, "agent");
            xb_add(&bar[XB_XGEN(b.x)], 1u);
            asm volatile("s_waitcnt vmcnt(0)" ::: "memory");
        } else {
            XB_SPIN(xb_ld(&bar[XB_XGEN(b.x)]) == gen, bar);
            __builtin_amdgcn_fence(__ATOMIC_ACQUIRE, "agent");
            asm volatile("s_waitcnt vmcnt(0)" ::: "memory");
        }
    }
    __syncthreads();
}
namespace pg8 {
constexpr int BM = 256, BK = 64, HALF = 128, HTB = HALF * BK * 2, STAGE_BYTES = 8 * HTB, NXCD = 8, WGM = 8;
__host__ __device__ __forceinline__ int lds_byte(int r, int c) { const int st = (r >> 4) * 2 + (c >> 5), rr = r & 15, cc = c & 31, ob = rr * 64 + cc * 2; return st * 1024 + (ob ^ (((ob >> 9) & 1) << 5)); }
__host__ __device__ __forceinline__ void stage_rc(int b, int& R, int& C) { const int st = b / 1024, sb = b % 1024, swz = sb ^ (((sb >> 9) & 1) << 5); R = (st >> 1) * 16 + swz / 64; C = (st & 1) * 32 + (swz % 64) / 2; }
__host__ __device__ __forceinline__ int perm32(int rho) { const int n = rho >> 4, i = rho & 15; return 8 * (i >> 2) + 4 * n + (i & 3); }

struct Unit { int pm, pn, e, ml; };

struct StaticOrder {
    const GAS char* A; const GAS char* Bt; int K;
    int nM, nN, nwg, G, c;
    __device__ void init(const GAS void* A_, const GAS void* Bt_, int M, int N, int K_, int G_, int c_) { A = (const GAS char*)A_; Bt = (const GAS char*)Bt_; K = K_; nM = M / BM; nN = N / BM; nwg = nM * nN; G = G_; c = c_; }
    __device__ bool next(int i, Unit& u) const {
        const long L = (long)i * G + c; if (L >= nwg) return false;
        int wgid = (int)L; { const int q = nwg / NXCD, r = nwg % NXCD, xcd = wgid % NXCD, off = wgid / NXCD; wgid = (xcd < r ? xcd * (q + 1) : r * (q + 1) + (xcd - r) * q) + off; }
        const int nig = WGM * nN, gid = wgid / nig, fm = gid * WGM, gsz = (nM - fm) < WGM ? (nM - fm) : WGM;
        u.pm = fm + ((wgid % nig) % gsz); u.pn = (wgid % nig) / gsz; u.e = 0; u.ml = 0; return true;
    }
    __device__ __forceinline__ const GAS char* a_base(const Unit& u) const { return A + (size_t)u.pm * BM * K * 2; }
    __device__ __forceinline__ const GAS char* b_base(const Unit& u) const { return Bt + (size_t)u.pn * BM * K * 2; }
    __device__ __forceinline__ void a_rows(const Unit&, int, unsigned (&)[2][2]) const {}
};

template <class Epi, class Sched, bool GATHER>
__device__ __forceinline__ void gemm_phase(LAS unsigned char* lds, const int tid_, const int K, const Sched& S, const Epi& E) {
    const int tid = tid_, wid = __builtin_amdgcn_readfirstlane(tid >> 6), lane = tid & 63, wr = wid >> 2, wc = wid & 3, fr = lane & 15, fq = lane >> 4;
    const int nt = K / BK;
    unsigned voffA[2], voffB[2];
#pragma unroll
    for (int i = 0; i < 2; ++i) { int R, C; stage_rc(tid * 16 + i * 8192, R, C); const int Rb = Epi::PERM ? ((R & ~31) + perm32(R & 31)) : R;
        voffA[i] = (unsigned)(R * K + C) * 2u; voffB[i] = (unsigned)(Rb * K + C) * 2u; }
    const size_t kstep = (size_t)(BK * 2);
    const size_t hstep = (size_t)HALF * K * 2;
    const unsigned ldsw = (unsigned)wid * 1024u;
    const int aoff = lds_byte(wr * 64 + fr, fq * 8), boff = lds_byte(wc * 32 + fr, fq * 8);
    unsigned offC[2][2], offN[2][2];
#define PG8_SA(b, h) (((b) * 2 + (h)) * HTB)
#define PG8_SB(b, h) ((4 + (b) * 2 + (h)) * HTB)
#define PG8_STAGE(bufoff, gbase, voff) do { _Pragma("unroll") for (int _i = 0; _i < 2; ++_i) \
        __builtin_amdgcn_global_load_lds((const GAS unsigned*)((const GAS char*)(gbase) + (voff)[_i]), (LAS unsigned*)(lds + (bufoff) + ldsw + _i * 8192), 16, 0, 0); } while (0)
#define PG8_STAGE_A(bufoff, gb, h, offs) do { if constexpr (GATHER) { PG8_STAGE(bufoff, gb, (offs)[h]); } else { PG8_STAGE(bufoff, (gb) + (h) * hstep, voffA); } } while (0)
#define PG8_LDA(dst, b, h) do { _Pragma("unroll") for (int m = 0; m < 4; ++m) _Pragma("unroll") for (int k = 0; k < 2; ++k) dst[m][k] = *(const LAS bf16x8*)(lds + PG8_SA(b, h) + aoff + m * 2048 + k * 1024); } while (0)
#define PG8_LDB(dst, b, h) do { _Pragma("unroll") for (int n = 0; n < 2; ++n) _Pragma("unroll") for (int k = 0; k < 2; ++k) dst[n][k] = *(const LAS bf16x8*)(lds + PG8_SB(b, h) + boff + n * 2048 + k * 1024); } while (0)
#define PG8_MMA(ai, bj, At, Bt) do { __builtin_amdgcn_s_setprio(1); _Pragma("unroll") for (int m = 0; m < 4; ++m) _Pragma("unroll") for (int n = 0; n < 2; ++n) _Pragma("unroll") for (int k = 0; k < 2; ++k) \
        acc[ai][bj][m][n] = __builtin_amdgcn_mfma_f32_16x16x32_bf16(Bt[n][k], At[m][k], acc[ai][bj][m][n], 0, 0, 0); __builtin_amdgcn_s_setprio(0); } while (0)
#define PG8_WAIT_V(n) asm volatile("s_waitcnt vmcnt(" #n ")" ::: "memory")
#define PG8_WAIT_L(n) asm volatile("s_waitcnt lgkmcnt(" #n ")" ::: "memory")
#define PG8_BAR __builtin_amdgcn_s_barrier()
#define PG8_SCHED __builtin_amdgcn_sched_barrier(0)
    Unit cur, nxt; int ui = 0;
    if (!S.next(0, cur)) return;
    f32x4 acc[2][2][4][2];
#pragma unroll
    for (int a = 0; a < 2; ++a)
#pragma unroll
        for (int b = 0; b < 2; ++b)
#pragma unroll
            for (int m = 0; m < 4; ++m)
#pragma unroll
                for (int n = 0; n < 2; ++n) acc[a][b][m][n] = (f32x4){0.f, 0.f, 0.f, 0.f};
    bf16x8 At[4][2], B0[2][2], B1[2][2];
    const GAS char* cA = S.a_base(cur); const GAS char* cB = S.b_base(cur);
    if constexpr (GATHER) { int tz = tid; asm volatile("" : "+v"(tz)); S.a_rows(cur, tz, offC);
#pragma unroll
        for (int h = 0; h < 2; ++h)
#pragma unroll
            for (int i = 0; i < 2; ++i) offN[h][i] = offC[h][i]; }
    PG8_STAGE(PG8_SB(0, 0), cB, voffB); PG8_STAGE(PG8_SB(0, 1), cB + hstep, voffB); PG8_STAGE_A(PG8_SA(0, 0), cA, 0, offC); PG8_STAGE_A(PG8_SA(0, 1), cA, 1, offC);
    if (wr == 1) PG8_BAR;
    PG8_WAIT_V(2); PG8_BAR;
    PG8_STAGE(PG8_SB(1, 0), cB + kstep, voffB); PG8_STAGE_A(PG8_SA(1, 0), cA + kstep, 0, offC); PG8_STAGE(PG8_SB(1, 1), cB + hstep + kstep, voffB);
    PG8_WAIT_V(6); PG8_BAR;
    for (;;) {
        const bool has_next = S.next(ui + 1, nxt);
        const GAS char* nA = has_next ? S.a_base(nxt) : cA; const GAS char* nB = has_next ? S.b_base(nxt) : cB;
        if constexpr (GATHER) { if (has_next) { int tz = tid; asm volatile("" : "+v"(tz)); S.a_rows(nxt, tz, offN); } }
        for (int t = 0; t < nt; t += 2) {
            const bool last = (t == nt - 2);
            const GAS char* a1 = cA + (size_t)(t + 1) * kstep;
            const GAS char* a2 = last ? nA : cA + (size_t)(t + 2) * kstep; const GAS char* b2 = last ? nB : cB + (size_t)(t + 2) * kstep;
            const GAS char* a3 = a2 + kstep; const GAS char* b3 = b2 + kstep;
            unsigned o2[2][2];
            if constexpr (GATHER) {
#pragma unroll
                for (int h = 0; h < 2; ++h)
#pragma unroll
                    for (int i = 0; i < 2; ++i) o2[h][i] = last ? offN[h][i] : offC[h][i]; }
            PG8_LDB(B0, 0, 0); PG8_LDB(B1, 0, 1); PG8_SCHED; PG8_LDA(At, 0, 0); PG8_STAGE_A(PG8_SA(1, 1), a1, 1, offC);
            PG8_WAIT_V(8); PG8_WAIT_L(0); PG8_BAR; PG8_MMA(0, 0, At, B0); PG8_MMA(0, 1, At, B1); PG8_BAR; PG8_SCHED;
            PG8_LDA(At, 0, 1); PG8_STAGE(PG8_SB(0, 0), b2, voffB); PG8_STAGE(PG8_SB(0, 1), b2 + hstep, voffB); PG8_STAGE_A(PG8_SA(0, 0), a2, 0, o2);
            PG8_WAIT_V(8); PG8_WAIT_L(0); PG8_BAR; PG8_MMA(1, 0, At, B0); PG8_MMA(1, 1, At, B1); PG8_BAR; PG8_SCHED;
            PG8_LDB(B0, 1, 0); PG8_LDB(B1, 1, 1); PG8_SCHED; PG8_LDA(At, 1, 0); PG8_STAGE_A(PG8_SA(0, 1), a2, 1, o2);
            PG8_WAIT_V(8); PG8_WAIT_L(0); PG8_BAR; PG8_MMA(0, 0, At, B0); PG8_MMA(0, 1, At, B1); PG8_BAR; PG8_SCHED;
            PG8_LDA(At, 1, 1); PG8_STAGE(PG8_SB(1, 0), b3, voffB); PG8_STAGE(PG8_SB(1, 1), b3 + hstep, voffB); PG8_STAGE_A(PG8_SA(1, 0), a3, 0, o2);
            PG8_WAIT_V(8); PG8_WAIT_L(0); PG8_BAR; PG8_MMA(1, 0, At, B0); PG8_MMA(1, 1, At, B1); PG8_BAR; PG8_SCHED;
        }
        if (wr == 0) PG8_BAR;
        asm volatile("s_nop 7\n\ts_nop 7\n\ts_nop 7" ::: "memory");
        { int tz = tid; asm volatile("" : "+v"(tz)); int wz = wid; asm volatile("" : "+s"(wz)); const int l2 = tz & 63;
          E(acc, cur, wz >> 2, wz & 3, l2 & 15, l2 >> 4); }
        if (!has_next) break;
#pragma unroll
        for (int a = 0; a < 2; ++a)
#pragma unroll
            for (int b = 0; b < 2; ++b)
#pragma unroll
                for (int m = 0; m < 4; ++m)
#pragma unroll
                    for (int n = 0; n < 2; ++n) acc[a][b][m][n] = (f32x4){0.f, 0.f, 0.f, 0.f};
        cur = nxt; cA = nA; cB = nB; ++ui;
        if constexpr (GATHER) {
#pragma unroll
            for (int h = 0; h < 2; ++h)
#pragma unroll
                for (int i = 0; i < 2; ++i) offC[h][i] = offN[h][i]; }
        if (wr == 1) PG8_BAR;
    }
    PG8_WAIT_V(0);
    PG8_BAR;
#undef PG8_SA
#undef PG8_SB
#undef PG8_STAGE
#undef PG8_STAGE_A
#undef PG8_LDA
#undef PG8_LDB
#undef PG8_MMA
#undef PG8_WAIT_V
#undef PG8_WAIT_L
#undef PG8_BAR
#undef PG8_SCHED
}
}
struct Params {
    const GAS float* x; const GAS float* c; const GAS float* norm_gain; const GAS float* w_ada; const GAS float* b_ada; const GAS float* w_in_even; const GAS float* w_in_odd; const GAS float* w_out;
    const GAS float* a_mu; const GAS float* a_w0; const GAS float* a_w_up; const GAS float* a_a0; const GAS float* a_a_up; const GAS float* a_g_up; const GAS float* a_k_k; const GAS float* a_k_a; const GAS float* a_r_k;
    const GAS float* a_ln_gain; const GAS float* a_ln_bias; const GAS float* b_alpha_up; const GAS float* b_alpha_bias; const GAS float* b_norm_gain; const GAS float* c_lb; const GAS float* c_norm_gain;
    const GAS float* d_conv_w; const GAS float* d_conv_b; const GAS float* d_dt_bias; const GAS float* d_a_log; const GAS float* d_skip; const GAS float* d_norm_gain;
    const GAS float* w_router; const GAS float* router_bias; const GAS float* w_gate; const GAS float* w_up; const GAS float* w_down; const GAS float* final_gain;
    GAS float* out; GAS unsigned char* ws;
    long long ph_lo, ph_hi;
};

struct Ctx {
    LAS unsigned char* lds; int tid, lane, wave, G, bid;
};

__device__ __forceinline__ void cvt_item(const GAS float* W, int K, int N, int ldw, GAS bf16_t* WT, int mode, LAS float* scr, int kb, int nb, int lane) {
    const int k0 = 64 * kb, n0 = 32 * nb;
    const int c4 = lane & 7, kr = lane >> 3; const int nn = n0 + 4 * c4;
    f32x4 v[8];
    if (nn + 3 < N && (ldw & 3) == 0) {
#pragma unroll
        for (int i = 0; i < 8; ++i) v[i] = __builtin_nontemporal_load((const GAS f32x4*)(W + (size_t)(k0 + 8 * i + kr) * ldw + nn));
    } else {
#pragma unroll
        for (int i = 0; i < 8; ++i) { const GAS float* r = W + (size_t)(k0 + 8 * i + kr) * ldw;
            v[i][0] = (nn + 0 < N) ? r[nn + 0] : 0.f; v[i][1] = (nn + 1 < N) ? r[nn + 1] : 0.f; v[i][2] = (nn + 2 < N) ? r[nn + 2] : 0.f; v[i][3] = (nn + 3 < N) ? r[nn + 3] : 0.f; }
    }
#pragma unroll
    for (int i = 0; i < 8; ++i) *(LAS f32x4*)(scr + (8 * i + kr) * 36 + 4 * c4) = v[i];
    asm volatile("s_waitcnt lgkmcnt(0)" ::: "memory");
    const int c = lane & 7;
#pragma unroll
    for (int j = 0; j < 4; ++j) { const int n = (lane >> 3) + 8 * j; const LAS float* s = scr + (8 * c) * 36 + n;
        u32x4 o; o.x = pk2(s[0 * 36], s[1 * 36]); o.y = pk2(s[2 * 36], s[3 * 36]); o.z = pk2(s[4 * 36], s[5 * 36]); o.w = pk2(s[6 * 36], s[7 * 36]);
        const int ng = n0 + n; const int row = mode == 0 ? ng : ((ng >> 7) * 256 + (mode == 2 ? 128 : 0) + (ng & 127));
        *(GAS u32x4*)(WT + (size_t)row * K + k0 + 8 * c) = o; }
    asm volatile("s_waitcnt lgkmcnt(0)" ::: "memory");
}
__device__ __forceinline__ void moe_convert(const Params& p, const Ctx& C, int layer, int w, int nw, int part  ) {
    LAS float* scr = (LAS float*)(C.lds + C.wave * 16384);
    GAS bf16_t* WGU = (GAS bf16_t*)(p.ws + moe_wgu(layer)); GAS bf16_t* WDN = (GAS bf16_t*)(p.ws + moe_wdn(layer));
    if (part != 1)
        for (int it = w; it < NEXP * 512; it += nw) { const int e = it >> 9, r = it & 511; const size_t wofs = ((size_t)layer * NEXP + e) * (size_t)D * DEXP;
            if (r < 256) cvt_item(p.w_gate + wofs, D, DEXP, DEXP, WGU + (size_t)e * 1024 * D, 1, scr, r >> 4, r & 15, C.lane);
            else         cvt_item(p.w_up + wofs, D, DEXP, DEXP, WGU + (size_t)e * 1024 * D, 2, scr, (r - 256) >> 4, (r - 256) & 15, C.lane); }
    if (part != 0)
        for (int it = w; it < NEXP * 256; it += nw) { const int e = it >> 8, r = it & 255; const size_t wofs = ((size_t)layer * NEXP + e) * (size_t)D * DEXP;
            cvt_item(p.w_down + wofs, DEXP, D, D, WDN + (size_t)e * D * DEXP, 0, scr, r >> 5, r & 31, C.lane); }
}
__device__ __forceinline__ int moe_slot(int c, int G) { return (G & 7) ? c : (c & 7) * (G >> 3) + (c >> 3); }
__device__ __forceinline__ void moe_convert_tail(const Params& p, const Ctx& C, int layer, const LAS int* tab, int part) {
    if (layer + 1 >= DEPTH) return;
    const int U = __builtin_amdgcn_readfirstlane(tab[16]) * 4, lo = U % C.G, slot = moe_slot(C.bid, C.G);
    if (lo != 0 && slot < lo) return;
    const int j = lo == 0 ? slot : slot - lo, nidle = lo == 0 ? C.G : C.G - lo;
    moe_convert(p, C, layer + 1, j * 8 + C.wave, nidle * 8, part);
}

__device__ __forceinline__ void p0_prologue(const Params& p, const Ctx& C) {
    {
        LAS float* cs = (LAS float*)C.lds;
        LAS float* red = (LAS float*)(C.lds + 32768);
        for (int i = C.tid; i < NB * D; i += 512) cs[i] = siluf_(p.c[i]);
        __syncthreads();
        GAS float* mod = (GAS float*)(p.ws + WS_MOD);
        for (int it = C.bid; it < DEPTH * 96; it += C.G) {
            const int l = it / 96, cg = it % 96;
            const GAS float* W = p.w_ada + (size_t)l * D * 6 * D + 64 * cg + C.lane;
            float acc[8];
#pragma unroll
            for (int b = 0; b < 8; ++b) acc[b] = 0.f;
            const int k0 = 128 * C.wave;
#pragma unroll 8
            for (int k = 0; k < 128; ++k) { const float wv = W[(size_t)(k0 + k) * 6 * D];
#pragma unroll
                for (int b = 0; b < 8; ++b) acc[b] += cs[b * D + k0 + k] * wv; }
#pragma unroll
            for (int b = 0; b < 8; ++b) red[(C.wave * 8 + b) * 64 + C.lane] = acc[b];
            __syncthreads();
            { const int b = C.tid >> 6, col = C.tid & 63; float s = p.b_ada[l * 6 * D + 64 * cg + col];
#pragma unroll
              for (int w = 0; w < 8; ++w) s += red[(w * 8 + b) * 64 + col];
              mod[((size_t)l * NB + b) * 6 * D + 64 * cg + col] = s; }
            __syncthreads();
        }
    }
    if (C.bid == 0 && C.tid < 256) {
        float v[4], m = -1e30f;
#pragma unroll
        for (int l = 0; l < 4; ++l) { v[l] = p.c_lb[l * 256 + C.tid]; m = fmaxf(m, v[l]); }
        float s = 0.f;
#pragma unroll
        for (int l = 0; l < 4; ++l) { v[l] = __expf(v[l] - m); s += v[l]; }
        GAS float* lb = (GAS float*)(p.ws + WS_LB); float cum = 0.f; const float c0 = v[0] / s;
#pragma unroll
        for (int l = 0; l < 4; ++l) { cum += v[l] / s; lb[l * 256 + C.tid] = cum - c0; }
    }
    __syncthreads();
    {
        LAS float* scr = (LAS float*)(C.lds + C.wave * 16384);
        const int gw = C.bid * 8 + C.wave, NGW = C.G * 8;
        constexpr int I_E = 16 * (NPE / 32), I_O = 16 * (NPO / 32), I_W = 16 * 32, I_S1 = 16, I_S2 = 32;
        constexpr int NIT = 2 * I_E + 2 * I_O + 4 * I_W + 2 * (2 * I_S1 + I_S2);
        for (int it = gw; it < NIT; it += NGW) {
            int r = it;
            if (r < 2 * I_E) { const int j = r / I_E; r %= I_E; cvt_item(p.w_in_even + (size_t)j * D * EVEN_IN, D, EVEN_IN, EVEN_IN, (GAS bf16_t*)(p.ws + WS_WINE) + (size_t)j * NPE * D, 0, scr, r / (NPE / 32), r % (NPE / 32), C.lane); continue; }
            r -= 2 * I_E;
            if (r < 2 * I_O) { const int j = r / I_O; r %= I_O; cvt_item(p.w_in_odd + (size_t)j * D * ODD_IN, D, ODD_IN, ODD_IN, (GAS bf16_t*)(p.ws + WS_WINO) + (size_t)j * NPO * D, 0, scr, r / (NPO / 32), r % (NPO / 32), C.lane); continue; }
            r -= 2 * I_O;
            if (r < 4 * I_W) { const int l = r / I_W; r %= I_W; cvt_item(p.w_out + (size_t)l * D * D, D, D, D, (GAS bf16_t*)(p.ws + WS_WOUT) + (size_t)l * D * D, 0, scr, r / 32, r % 32, C.lane); continue; }
            r -= 4 * I_W;
            { const int j = r / (2 * I_S1 + I_S2); r %= (2 * I_S1 + I_S2);
              if (r < I_S1) cvt_item(p.a_w_up + (size_t)j * 64 * 512, 64, 512, 512, (GAS bf16_t*)(p.ws + WS_WUPT) + (size_t)j * 512 * 64, 0, scr, 0, r, C.lane);
              else if (r < 2 * I_S1) cvt_item(p.a_a_up + (size_t)j * 64 * 512, 64, 512, 512, (GAS bf16_t*)(p.ws + WS_AUPT) + (size_t)j * 512 * 64, 0, scr, 0, r - I_S1, C.lane);
              else { r -= 2 * I_S1; cvt_item(p.a_g_up + (size_t)j * 128 * 512, 128, 512, 512, (GAS bf16_t*)(p.ws + WS_GUPT) + (size_t)j * 512 * 128, 0, scr, r >> 4, r & 15, C.lane); } }
        }
        moe_convert(p, C, 0, gw, NGW, -1);
    }
}

template <bool FINAL, bool DRY = false>
__device__ __forceinline__ void norm_phase(const Params& p, const Ctx& C, int layer) {
    const int gw = C.bid * 8 + C.wave, NGW = C.G * 8;
    const GAS float* mod = (const GAS float*)(p.ws + WS_MOD);
    const GAS bf16_t* YB = (const GAS bf16_t*)(p.ws + WS_YB);
    GAS bf16_t* H = (GAS bf16_t*)(p.ws + WS_H); GAS bf16_t* XB = (GAS bf16_t*)(p.ws + WS_XB);
    const bool first = (layer == 0) && !FINAL;
    const int lprev = FINAL ? DEPTH - 1 : layer - 1;
    for (int blk = gw; blk < T / 16; blk += NGW) {
        const int row0 = blk * 16, b = row0 >> 12;
        f32x4 gf[4], ca[4], cb[4];
#pragma unroll
        for (int j = 0; j < 4; ++j) {
            gf[j] = first ? (f32x4){0.f, 0.f, 0.f, 0.f} : *((const GAS f32x4*)(mod + ((size_t)lprev * NB + b) * 6 * D + 5 * D) + C.lane + 64 * j);
            if (FINAL) { ca[j] = *((const GAS f32x4*)p.final_gain + C.lane + 64 * j); cb[j] = (f32x4){0.f, 0.f, 0.f, 0.f}; }
            else { const GAS float* m = mod + ((size_t)layer * NB + b) * 6 * D;
                const f32x4 g = *((const GAS f32x4*)(p.norm_gain + (size_t)layer * 2 * D) + C.lane + 64 * j); const f32x4 sc = *((const GAS f32x4*)(m + D) + C.lane + 64 * j);
                ca[j] = g * (1.f + sc); cb[j] = *((const GAS f32x4*)m + C.lane + 64 * j); } }
#pragma unroll 1
        for (int r4 = 0; r4 < 16; r4 += 4) {
            f32x4 v[4][4]; u32x2 ya[4][4], yc[4][4];
#pragma unroll
            for (int q = 0; q < 4; ++q) { const int row = row0 + r4 + q;
                if (first) { const GAS f32x4* xr = (const GAS f32x4*)(p.x + (size_t)row * D) + C.lane;
#pragma unroll
                    for (int j = 0; j < 4; ++j) v[q][j] = __builtin_nontemporal_load(xr + 64 * j);
                } else { const GAS u32x2* xr = (const GAS u32x2*)(XB + (size_t)row * D) + C.lane;
#pragma unroll
                    for (int j = 0; j < 4; ++j) { const u32x2 t = xr[64 * j]; v[q][j] = (f32x4){bflo(t.x), bfhi(t.x), bflo(t.y), bfhi(t.y)}; }
                    const GAS u32x2* y0 = (const GAS u32x2*)(YB + (size_t)(2 * row) * D) + C.lane; const GAS u32x2* y1 = (const GAS u32x2*)(YB + (size_t)(2 * row + 1) * D) + C.lane;
#pragma unroll
                    for (int j = 0; j < 4; ++j) { ya[q][j] = __builtin_nontemporal_load(y0 + 64 * j); yc[q][j] = __builtin_nontemporal_load(y1 + 64 * j); } } }
#pragma unroll
            for (int q = 0; q < 4; ++q) { const int row = row0 + r4 + q;
                if (!first) {
#pragma unroll
                    for (int j = 0; j < 4; ++j) { const u32x2 a = ya[q][j], c2 = yc[q][j];
                        v[q][j][0] += gf[j][0] * (bflo(a.x) + bflo(c2.x)); v[q][j][1] += gf[j][1] * (bfhi(a.x) + bfhi(c2.x)); v[q][j][2] += gf[j][2] * (bflo(a.y) + bflo(c2.y)); v[q][j][3] += gf[j][3] * (bfhi(a.y) + bfhi(c2.y)); } }
                float s2 = 0.f;
#pragma unroll
                for (int j = 0; j < 4; ++j) s2 += (v[q][j][0] * v[q][j][0] + v[q][j][1] * v[q][j][1]) + (v[q][j][2] * v[q][j][2] + v[q][j][3] * v[q][j][3]);
                const float rstd = rsqrtf(wave_sum(s2) * (1.f / D) + NORM_EPS);
                if (FINAL) { GAS f32x4* o = (GAS f32x4*)(p.out + (size_t)row * D) + C.lane;
#pragma unroll
                    for (int j = 0; j < 4; ++j) o[64 * j] = v[q][j] * rstd * ca[j];
                } else {
                    GAS u32x2* xo = (GAS u32x2*)(XB + (size_t)row * D) + C.lane; GAS u32x2* ho = (GAS u32x2*)(H + (size_t)row * D) + C.lane;
#pragma unroll
                    for (int j = 0; j < 4; ++j) { if (!DRY) { u32x2 xs; xs.x = pk2(v[q][j][0], v[q][j][1]); xs.y = pk2(v[q][j][2], v[q][j][3]); xo[64 * j] = xs; }
                        const f32x4 h = v[q][j] * rstd * ca[j] + cb[j]; u32x2 o; o.x = pk2(h[0], h[1]); o.y = pk2(h[2], h[3]); ho[64 * j] = o; } } }
        }
    }
}

template <bool DRY = false>
__device__ __forceinline__ void route_phase(const Params& p, const Ctx& C, int layer) {
    LAS float* wr_l = (LAS float*)C.lds;
    LAS int* lcnt = (LAS int*)(C.lds + 65536);
    LAS int* lbase = lcnt + 16;
    LAS int* rinfo = lcnt + 32;
    LAS float* rgate = (LAS float*)(rinfo + 256);
    const GAS float* mod = (const GAS float*)(p.ws + WS_MOD);
    GAS bf16_t* H = (GAS bf16_t*)(p.ws + WS_H);
    GAS unsigned* cnt = (GAS unsigned*)(p.ws + WS_CTL) + CW_CNT + layer * 16;
    GAS int* lista = (GAS int*)(p.ws + WS_LISTA); GAS float* listw = (GAS float*)(p.ws + WS_LISTW);
    { f32x4 wv[8];
#pragma unroll
      for (int k = 0; k < 8; ++k) wv[k] = *((const GAS f32x4*)p.w_router + C.tid + 512 * k);
#pragma unroll
      for (int k = 0; k < 8; ++k) { const int i = 4 * (C.tid + 512 * k);
#pragma unroll
          for (int q = 0; q < 4; ++q) wr_l[((i & 15) + q) * D + (i >> 4)] = wv[k][q]; } }
    float rb[16];
#pragma unroll
    for (int e = 0; e < 16; ++e) rb[e] = p.router_bias[e];
    for (int blk = C.bid; blk < T / 128; blk += C.G) {
        if (C.tid < 16) lcnt[C.tid] = 0;
        __syncthreads();
        const int b = (blk * 128) >> 12;
        f32x4 ca[4], cb[4];
        { const GAS float* m = mod + ((size_t)layer * NB + b) * 6 * D;
#pragma unroll
          for (int j = 0; j < 4; ++j) { const f32x4 g = *((const GAS f32x4*)(p.norm_gain + (size_t)layer * 2 * D + D) + C.lane + 64 * j); const f32x4 sc = *((const GAS f32x4*)(m + 4 * D) + C.lane + 64 * j);
              ca[j] = g * (1.f + sc); cb[j] = *((const GAS f32x4*)(m + 3 * D) + C.lane + 64 * j); } }
#pragma unroll 1
        for (int rr = 0; rr < 16; rr += 2) {
            f32x4 v[2][4];
#pragma unroll
            for (int q = 0; q < 2; ++q) { const GAS u32x2* xr = (const GAS u32x2*)((const GAS bf16_t*)(p.ws + WS_XB) + (size_t)(blk * 128 + C.wave * 16 + rr + q) * D) + C.lane;
#pragma unroll
                for (int j = 0; j < 4; ++j) { const u32x2 t = xr[64 * j]; v[q][j] = (f32x4){bflo(t.x), bfhi(t.x), bflo(t.y), bfhi(t.y)}; } }
#pragma unroll
            for (int q = 0; q < 2; ++q) {
                const int rl = C.wave * 16 + rr + q, row = blk * 128 + rl;
                float s2 = 0.f;
#pragma unroll
                for (int j = 0; j < 4; ++j) s2 += (v[q][j][0] * v[q][j][0] + v[q][j][1] * v[q][j][1]) + (v[q][j][2] * v[q][j][2] + v[q][j][3] * v[q][j][3]);
                const float rstd = rsqrtf(wave_sum(s2) * (1.f / D) + NORM_EPS);
                GAS u32x2* ho = (GAS u32x2*)(H + (size_t)row * D) + C.lane;
                float lg[16];
#pragma unroll
                for (int e = 0; e < 16; ++e) lg[e] = 0.f;
#pragma unroll
                for (int j = 0; j < 4; ++j) { const f32x4 h = v[q][j] * rstd * ca[j] + cb[j]; u32x2 o; o.x = pk2(h[0], h[1]); o.y = pk2(h[2], h[3]); ho[64 * j] = o;
#pragma unroll
                    for (int e = 0; e < 16; ++e) { const f32x4 w4 = *(const LAS f32x4*)(wr_l + e * D + 4 * (C.lane + 64 * j)); lg[e] += (h[0] * w4[0] + h[1] * w4[1]) + (h[2] * w4[2] + h[3] * w4[3]); } }
                float r8[8], r4[4], r2[2], r1;
                { const bool hi = (C.lane & 32) != 0;
#pragma unroll
                  for (int k = 0; k < 8; ++k) { const float keep = hi ? lg[k + 8] : lg[k], send = hi ? lg[k] : lg[k + 8]; r8[k] = keep + __shfl_xor(send, 32); } }
                { const bool hi = (C.lane & 16) != 0;
#pragma unroll
                  for (int k = 0; k < 4; ++k) { const float keep = hi ? r8[k + 4] : r8[k], send = hi ? r8[k] : r8[k + 4]; r4[k] = keep + __shfl_xor(send, 16); } }
                { const bool hi = (C.lane & 8) != 0;
#pragma unroll
                  for (int k = 0; k < 2; ++k) { const float keep = hi ? r4[k + 2] : r4[k], send = hi ? r4[k] : r4[k + 2]; r2[k] = keep + __shfl_xor(send, 8); } }
                { const bool hi = (C.lane & 4) != 0; const float keep = hi ? r2[1] : r2[0], send = hi ? r2[0] : r2[1]; r1 = keep + __shfl_xor(send, 4); }
                r1 += __shfl_xor(r1, 2); r1 += __shfl_xor(r1, 1);
                const float myscore = sigmoidf_(r1);
                float sc16[16];
#pragma unroll
                for (int e = 0; e < 16; ++e) sc16[e] = __shfl(myscore, 4 * e);
                float sel[16];
#pragma unroll
                for (int e = 0; e < 16; ++e) sel[e] = sc16[e] + rb[e];
                int grp = 0; float best = -1e30f;
#pragma unroll
                for (int g = 0; g < 4; ++g) { float m1 = -1e30f, m2 = -1e30f;
#pragma unroll
                    for (int t = 0; t < 4; ++t) { const float s = sel[4 * g + t]; if (s > m1) { m2 = m1; m1 = s; } else if (s > m2) m2 = s; }
                    const float gs = m1 + m2; if (gs > best) { best = gs; grp = g; } }
                int i1 = 0, i2 = 0; float m1 = -1e30f, m2 = -1e30f; float s1 = 0.f, s2g = 0.f;
#pragma unroll
                for (int e = 0; e < 16; ++e) { if ((e >> 2) == grp) { const float s = sel[e]; if (s > m1) { m2 = m1; i2 = i1; s2g = s1; m1 = s; i1 = e; s1 = sc16[e]; } else if (s > m2) { m2 = s; i2 = e; s2g = sc16[e]; } } }
                const float inv = 1.f / (s1 + s2g);
                if (C.lane == 0 && !DRY) {
                    const int sl1 = __hip_atomic_fetch_add(&lcnt[i1], 1, __ATOMIC_RELAXED, __HIP_MEMORY_SCOPE_WORKGROUP), sl2 = __hip_atomic_fetch_add(&lcnt[i2], 1, __ATOMIC_RELAXED, __HIP_MEMORY_SCOPE_WORKGROUP);
                    rinfo[rl * 2 + 0] = i1 | (sl1 << 8); rinfo[rl * 2 + 1] = i2 | (sl2 << 8); rgate[rl * 2 + 0] = s1 * inv; rgate[rl * 2 + 1] = s2g * inv;
                }
            }
        }
        __syncthreads();
        if (C.tid < 16 && !DRY) lbase[C.tid] = (int)__hip_atomic_fetch_add(&cnt[C.tid], (unsigned)lcnt[C.tid], __ATOMIC_RELAXED, __HIP_MEMORY_SCOPE_AGENT);
        __syncthreads();
        if (C.tid < 256 && !DRY) { const int rl = C.tid >> 1, k = C.tid & 1; const int inf = rinfo[C.tid]; const int e = inf & 255, sl = inf >> 8;
            const size_t idx = (size_t)e * T + lbase[e] + sl; lista[idx] = (blk * 128 + rl) * 2 + k; listw[idx] = rgate[C.tid]; }
        __syncthreads();
    }
}
struct EpiU {
    static constexpr bool PERM = true;
    GAS bf16_t* O;
    __device__ __forceinline__ void operator()(const f32x4 (&acc)[2][2][4][2], const pg8::Unit& u, int wr, int wc, int fr, int fq) const {
        const int row0 = u.pm * 256 + wr * 64 + fr, col0 = u.pn * 256 + wc * 32 + 8 * fq;
#pragma unroll
        for (int ai = 0; ai < 2; ++ai)
#pragma unroll
            for (int m = 0; m < 4; ++m) { GAS bf16_t* rowp = O + (size_t)(row0 + ai * 128 + m * 16) * UPITCH + col0;
#pragma unroll
                for (int bj = 0; bj < 2; ++bj) { const f32x4 v0 = acc[ai][bj][m][0], v1 = acc[ai][bj][m][1];
                    u32x4 o; o.x = pk2(v0[0], v0[1]); o.y = pk2(v0[2], v0[3]); o.z = pk2(v1[0], v1[1]); o.w = pk2(v1[2], v1[3]);
                    *(GAS u32x4*)(rowp + bj * 128) = o; } }
    }
};
struct EpiOut {
    static constexpr bool PERM = true;
    GAS bf16_t* X; const GAS float* gm;
    __device__ __forceinline__ void operator()(const f32x4 (&acc)[2][2][4][2], const pg8::Unit& u, int wr, int wc, int fr, int fq) const {
        const int row0 = u.pm * 256 + wr * 64 + fr, col0 = u.pn * 256 + wc * 32 + 8 * fq;
        const GAS float* g = gm + (size_t)(row0 >> 12) * 6 * D + col0;
        f32x4 gv[2][2];
#pragma unroll
        for (int bj = 0; bj < 2; ++bj)
#pragma unroll
            for (int n = 0; n < 2; ++n) gv[bj][n] = *(const GAS f32x4*)(g + bj * 128 + n * 4);
        u32x4 xr[2][4][2];
#pragma unroll
        for (int ai = 0; ai < 2; ++ai)
#pragma unroll
            for (int m = 0; m < 4; ++m) { const GAS bf16_t* rowp = X + (size_t)(row0 + ai * 128 + m * 16) * D + col0;
#pragma unroll
                for (int bj = 0; bj < 2; ++bj) xr[ai][m][bj] = *(const GAS u32x4*)(rowp + bj * 128); }
        asm volatile("" ::: "memory");
#pragma unroll
        for (int ai = 0; ai < 2; ++ai)
#pragma unroll
            for (int m = 0; m < 4; ++m) { GAS bf16_t* rowp = X + (size_t)(row0 + ai * 128 + m * 16) * D + col0;
#pragma unroll
                for (int bj = 0; bj < 2; ++bj) { GAS u32x4* q = (GAS u32x4*)(rowp + bj * 128); float xv[8]; unpack8(xr[ai][m][bj], xv);
                    const f32x4 a0 = acc[ai][bj][m][0] * gv[bj][0], a1 = acc[ai][bj][m][1] * gv[bj][1];
                    xv[0] += a0[0]; xv[1] += a0[1]; xv[2] += a0[2]; xv[3] += a0[3]; xv[4] += a1[0]; xv[5] += a1[1]; xv[6] += a1[2]; xv[7] += a1[3];
                    *q = pack8(xv); } }
    }
};
struct EpiUp {
    static constexpr bool PERM = true;
    GAS bf16_t* ACT;
    __device__ __forceinline__ void operator()(const f32x4 (&acc)[2][2][4][2], const pg8::Unit& u, int wr, int wc, int fr, int fq) const {
        const int row0 = u.pm * 256 + wr * 64 + fr, col0 = u.pn * 128 + wc * 32 + 8 * fq;
#pragma unroll
        for (int ai = 0; ai < 2; ++ai)
#pragma unroll
            for (int m = 0; m < 4; ++m) { GAS bf16_t* rowp = ACT + (size_t)(row0 + ai * 128 + m * 16) * DEXP + col0;
                float r[8];
#pragma unroll
                for (int n = 0; n < 2; ++n)
#pragma unroll
                    for (int q = 0; q < 4; ++q) r[4 * n + q] = siluf_(acc[ai][0][m][n][q]) * acc[ai][1][m][n][q];
                *(GAS u32x4*)rowp = pack8(r); }
    }
};
struct EpiDown {
    static constexpr bool PERM = true;
    GAS bf16_t* YB; const GAS int* lista; const GAS float* listw;
    __device__ __forceinline__ void operator()(const f32x4 (&acc)[2][2][4][2], const pg8::Unit& u, int wr, int wc, int fr, int fq) const {
        const int rl0 = wr * 64 + fr, col0 = u.pn * 256 + wc * 32 + 8 * fq;
        const GAS int* la = lista + ((size_t)u.e * T + (size_t)u.ml * 256); const GAS float* lw = listw + ((size_t)u.e * T + (size_t)u.ml * 256);
        const int nrows = u.pm;
        int a8[8]; float w8[8];
#pragma unroll
        for (int k = 0; k < 8; ++k) { const int rl = rl0 + (k >> 2) * 128 + (k & 3) * 16; a8[k] = la[rl]; w8[k] = lw[rl]; }
#pragma unroll
        for (int k = 0; k < 8; ++k) asm volatile("" :: "v"(a8[k]), "v"(w8[k]));
#pragma unroll
        for (int ai = 0; ai < 2; ++ai)
#pragma unroll
            for (int m = 0; m < 4; ++m) { const int rl = rl0 + ai * 128 + m * 16;
                if (rl < nrows) { const int a = a8[ai * 4 + m]; const float w = w8[ai * 4 + m]; GAS bf16_t* rowp = YB + (size_t)a * D + col0;
#pragma unroll
                    for (int bj = 0; bj < 2; ++bj) { const f32x4 v0 = acc[ai][bj][m][0] * w, v1 = acc[ai][bj][m][1] * w;
                        u32x4 o; o.x = pk2(v0[0], v0[1]); o.y = pk2(v0[2], v0[3]); o.z = pk2(v1[0], v1[1]); o.w = pk2(v1[2], v1[3]);
                        *(GAS u32x4*)(rowp + bj * 128) = o; } } }
    }
};
struct MoeOrder {
    const GAS char* A; const GAS char* Bt; int K; size_t estride; const LAS int* tab; const GAS int* lista; int G, c; bool down;
    __device__ bool next(int i, pg8::Unit& u) const {
        const int L = i * G + moe_slot(c, G); const int NT = __builtin_amdgcn_readfirstlane(tab[16]);
        if (L >= NT * 4) return false;
        const int mt = L >> 2; const int e = __builtin_amdgcn_readfirstlane(tab[34 + mt]);
        const int t0 = __builtin_amdgcn_readfirstlane(tab[e]), cn = __builtin_amdgcn_readfirstlane(tab[17 + e]);
        u.pn = L & 3; u.e = e; u.ml = mt - t0;
        const int left = cn - u.ml * 256;
        u.pm = down ? (left < 256 ? left : 256) : mt;
        return true;
    }
    __device__ __forceinline__ const GAS char* a_base(const pg8::Unit& u) const { return down ? A + (size_t)(__builtin_amdgcn_readfirstlane(tab[u.e]) + u.ml) * 256 * K * 2 : A; }
    __device__ __forceinline__ const GAS char* b_base(const pg8::Unit& u) const { return Bt + (size_t)u.e * estride + (size_t)u.pn * 256 * K * 2; }
    __device__ __forceinline__ void a_rows(const pg8::Unit& u, int tz, unsigned (&off)[2][2]) const {
        const int n = __builtin_amdgcn_readfirstlane(tab[17 + u.e]) - u.ml * 256; const GAS int* lp = lista + ((size_t)u.e * T + (size_t)u.ml * 256);
#pragma unroll
        for (int i = 0; i < 2; ++i) { int R, Cc; pg8::stage_rc(tz * 16 + i * 8192, R, Cc);
#pragma unroll
            for (int h = 0; h < 2; ++h) { const unsigned r = (unsigned)(128 * h + R); const int tok = lp[((int)r < n) ? r : 0u] >> 1; off[h][i] = (unsigned)tok * (unsigned)(K * 2) + (unsigned)Cc * 2u; } }
    }
    static constexpr int GROWS = 133120;
    __device__ __forceinline__ void a_rows_issue(LAS unsigned char* lds, const pg8::Unit& u, int tz) const {
        const int n = __builtin_amdgcn_readfirstlane(tab[17 + u.e]) - u.ml * 256; const GAS int* lp = lista + ((size_t)u.e * T + (size_t)u.ml * 256);
        const int wv = __builtin_amdgcn_readfirstlane(tz >> 6);
#pragma unroll
        for (int i = 0; i < 2; ++i) { int R, Cc; pg8::stage_rc(tz * 16 + i * 8192, R, Cc);
#pragma unroll
            for (int h = 0; h < 2; ++h) { const unsigned r = (unsigned)(128 * h + R);
                __builtin_amdgcn_global_load_lds((const GAS unsigned*)(lp + (((int)r < n) ? r : 0u)), (LAS unsigned*)(lds + GROWS + (2 * h + i) * 2048 + wv * 256), 4, 0, 0); } }
    }
    __device__ __forceinline__ void a_rows_finish(const LAS unsigned char* lds, int tz, unsigned (&off)[2][2]) const {
#pragma unroll
        for (int i = 0; i < 2; ++i) { int R, Cc; pg8::stage_rc(tz * 16 + i * 8192, R, Cc);
#pragma unroll
            for (int h = 0; h < 2; ++h) { const int raw = *(const LAS int*)(lds + GROWS + (2 * h + i) * 2048 + tz * 4); off[h][i] = (unsigned)(raw >> 1) * (unsigned)(K * 2) + (unsigned)Cc * 2u; } }
    }
};
__device__ __forceinline__ void moe_table(const Params& p, const Ctx& C, int layer, LAS int* tab) {
    if (C.tid < 16) { const GAS unsigned* cnt = (const GAS unsigned*)(p.ws + WS_CTL) + CW_CNT + layer * 16;
        tab[17 + C.tid] = (int)__hip_atomic_load(cnt + C.tid, __ATOMIC_RELAXED, __HIP_MEMORY_SCOPE_AGENT); }
    __syncthreads();
    if (C.tid == 0) { int acc = 0;
        for (int e = 0; e < 16; ++e) { const int n = tab[17 + e]; tab[e] = acc; acc += (n + 255) >> 8; }
        tab[16] = acc; }
    __syncthreads();
    for (int t = C.tid; t < tab[16]; t += 512) { int e = 0;
#pragma unroll
        for (int q = 1; q < 16; ++q) e += (tab[q] <= t) ? 1 : 0;
        tab[34 + t] = e; }
    __syncthreads();
}
constexpr size_t MX_BASE = WS_H;
constexpr size_t MX_AVAIL = WS_END - WS_H;
constexpr size_t M64 = (size_t)64 * 64;
constexpr size_t RW_PT = 0, RW_QT = RW_PT + 4096 * M64 * 2, RW_RH = RW_QT + 4096 * M64 * 2, RW_MH = RW_RH + 4096 * M64 * 2, RW_S = RW_MH + 4096 * M64 * 2, RW_BON = RW_S + 4096 * M64 * 2;
constexpr size_t GX_D_E = RW_BON + 4096 * 64 * 4;
constexpr size_t GX_S_E = GX_D_E + (size_t)2048 * 128 * 64 * 2;
constexpr size_t GX_DEC_E = GX_S_E + (size_t)2048 * 128 * 64 * 2;
constexpr size_t MX_END_E = GX_DEC_E + (size_t)2048 * 64 * 4;
constexpr size_t GX_D_O = 0, GX_S_O = GX_D_O + (size_t)2048 * 128 * 64 * 2, GX_DEC_O = GX_S_O + (size_t)2048 * 128 * 64 * 2;
constexpr size_t SX_ST = GX_DEC_O + (size_t)2048 * 64 * 4;
constexpr size_t SX_S = SX_ST + 4096 * M64 * 2;
constexpr size_t SX_DEC = SX_S + 4096 * M64 * 2;
constexpr size_t MX_END_O = SX_DEC + 4096 * 4;
static_assert(MX_END_E <= WS_XB - WS_H && MX_END_O <= WS_PGU - WS_H, "mixer scratch overflow");

template <int NC, bool LDSB = false>
__device__ __forceinline__ void lds_cumsum64(LAS float* tile, int stride, LAS float* seg, int tid) {
    const int n = tid % NC, s = tid / NC; const bool act = tid < 8 * NC;
    float v[8];
    if (act) {
#pragma unroll
        for (int i = 0; i < 8; ++i) v[i] = tile[(8 * s + i) * stride + n];
#pragma unroll
        for (int i = 1; i < 8; ++i) v[i] += v[i - 1];
        seg[s * NC + n] = v[7];
    }
    if constexpr (LDSB) LDS_BARRIER(); else __syncthreads();
    if (act) { float off = 0.f;
#pragma unroll
        for (int q = 0; q < 8; ++q) off += (q < s) ? seg[q * NC + n] : 0.f;
#pragma unroll
        for (int i = 0; i < 8; ++i) tile[(8 * s + i) * stride + n] = v[i] + off; }
    if constexpr (LDSB) LDS_BARRIER(); else __syncthreads();
}

constexpr int GL_GT = 0, GL_SEG = 17408, GL_AUP = 19456, GL_KD = 24576, GL_KM = 24576, GL_QM = 33792, GL_Q2 = 43008, GL_VT = 52224, GL_ST = 69632, GL_PL = 88064, GL_RS = 97280;

template <bool HGRN>
__device__ __forceinline__ void gla_stage_g(const Params& p, const Ctx& C, int layer, int h, const u32x4 a0, const u32x4 a1, const u32x4 kk, float (&kreg)[8]) {
    const int j = C.tid >> 3, cg = C.tid & 7, jl = layer >> 1;
    LAS float* Gt = (LAS float*)(C.lds + GL_GT);
    float g[8];
    if constexpr (HGRN) {
        float fr[8]; unpack8(a0, fr);
        const GAS float* lb = (const GAS float*)(p.ws + WS_LB) + layer * 256 + 64 * h + 8 * cg;
#pragma unroll
        for (int q = 0; q < 8; ++q) { const float l = lb[q]; const float f = l + (1.f - l) * sigmoidf_(fr[q]); g[q] = __logf(f); kreg[q] = 1.f - f; }
    } else {
        LAS float* AUP = (LAS float*)(C.lds + GL_AUP);
        float ad[16]; { float t0[8], t1[8]; unpack8(a0, t0); unpack8(a1, t1);
#pragma unroll
            for (int q = 0; q < 8; ++q) { ad[q] = t0[q]; ad[8 + q] = t1[q]; } }
#pragma unroll
        for (int q = 0; q < 8; ++q) { float x = AUP[16 * 64 + 8 * cg + q];
#pragma unroll
            for (int r = 0; r < 16; ++r) x += ad[r] * AUP[r * 64 + 8 * cg + q];
            g[q] = logsigmoidf_(x) * (1.f / 16.f); }
        unpack8(kk, kreg);
    }
    *(LAS f32x4*)(Gt + j * FS + 8 * cg) = (f32x4){g[0], g[1], g[2], g[3]};
    *(LAS f32x4*)(Gt + j * FS + 8 * cg + 4) = (f32x4){g[4], g[5], g[6], g[7]};
    (void)jl;
}
template <bool HGRN>
__device__ __forceinline__ void gla_stage_aup(const Params& p, const Ctx& C, int layer, int h) {
    if constexpr (!HGRN) { const int jl = layer >> 1; LAS float* AUP = (LAS float*)(C.lds + GL_AUP);
        for (int i = C.tid; i < 16 * 64; i += 512) AUP[i] = p.b_alpha_up[(size_t)jl * 16 * 256 + (i >> 6) * 256 + 64 * h + (i & 63)];
        if (C.tid < 64) AUP[16 * 64 + C.tid] = p.b_alpha_bias[jl * 256 + 64 * h + C.tid]; }
}
__device__ __forceinline__ void gla_stage_v(const Ctx& C, const GAS bf16_t* urow0, int vcol) {
    const int j = C.tid >> 3, cg = C.tid & 7;
    const GAS u32x4* src = (const GAS u32x4*)(urow0 + (size_t)j * UPITCH + vcol + 16 * cg);
    LAS u32x4* dst = (LAS u32x4*)(C.lds + GL_VT + j * TS2 + 32 * cg);
    dst[0] = src[0]; dst[1] = src[1];
}

struct GlPre { u32x4 a0, a1, k, v0, v1; };
template <bool HGRN>
__device__ __forceinline__ void gla_prefetch1(const Params& p, int tid, int item, GlPre& pre) {
    const int h = item & 3, bc = item >> 2, j = tid >> 3, cg = tid & 7;
    const GAS bf16_t* ur = (const GAS bf16_t*)(p.ws + WS_U) + ((size_t)bc * 64 + j) * UPITCH;
    if constexpr (HGRN) { pre.a0 = *(const GAS u32x4*)(ur + HG_F + 64 * h + 8 * cg); pre.a1 = pre.a0; pre.k = pre.a0; }
    else { pre.a0 = *(const GAS u32x4*)(ur + GL_AD); pre.a1 = *(const GAS u32x4*)(ur + GL_AD + 8); pre.k = *(const GAS u32x4*)(ur + GL_K + 64 * h + 8 * cg); }
    const GAS u32x4* vs = (const GAS u32x4*)(ur + (HGRN ? HG_I : GL_V) + 128 * h + 16 * cg); pre.v0 = vs[0]; pre.v1 = vs[1];
}
template <bool HGRN>
__device__ __forceinline__ void gla_pass1_item(const Params& p, const Ctx& C0, int layer, int item, int next_item, GlPre& pre) {
    Ctx C = C0; asm volatile("" : "+s"(C.wave)); asm volatile("" : "+v"(C.tid)); C.lane = C.tid & 63;
    const int h = item & 3, bc = item >> 2;
    const GAS bf16_t* urow0 = (const GAS bf16_t*)(p.ws + WS_U) + (size_t)bc * 64 * UPITCH;
    LAS float* Gt = (LAS float*)(C.lds + GL_GT);
    const int j = C.tid >> 3, cg = C.tid & 7;
    GAS unsigned char* mx = p.ws + MX_BASE;
    GAS bf16_t* Dg = (GAS bf16_t*)(mx + (HGRN ? GX_D_O : GX_D_E)) + (size_t)item * 128 * 64;
    GAS float* DECg = (GAS float*)(mx + (HGRN ? GX_DEC_O : GX_DEC_E)) + (size_t)item * 64;
    float kreg[8];
    gla_stage_g<HGRN>(p, C, layer, h, pre.a0, pre.a1, pre.k, kreg);
    { LAS u32x4* dst = (LAS u32x4*)(C.lds + GL_VT + j * TS2 + 32 * cg); dst[0] = pre.v0; dst[1] = pre.v1; }
    gla_prefetch1<HGRN>(p, C.tid, next_item, pre);
    LDS_BARRIER();
    lds_cumsum64<64, true>(Gt, FS, (LAS float*)(C.lds + GL_SEG), C.tid);
    { float kd[8]; float bjv[8];
#pragma unroll
      for (int q = 0; q < 8; ++q) { const float bj = Gt[j * FS + 8 * cg + q], bl = Gt[63 * FS + 8 * cg + q]; bjv[q] = bj; kd[q] = kreg[q] * __expf(bl - bj); if (j == 63) DECg[8 * cg + q] = __expf(bl); }
      *(LAS u32x4*)(C.lds + GL_KD + j * TS + 16 * cg) = pack8(kd);
      GAS float* Gg = (GAS float*)((GAS bf16_t*)(p.ws + WS_Y) + ((size_t)bc * 64 + j) * D + (HGRN ? 0 : 512) + 128 * h) + 8 * cg;
      *(GAS f32x4*)Gg = (f32x4){bjv[0], bjv[1], bjv[2], bjv[3]}; *(GAS f32x4*)(Gg + 4) = (f32x4){bjv[4], bjv[5], bjv[6], bjv[7]}; }
    LDS_BARRIER();
    { const int e0 = 16 * C.wave; const LAS unsigned char* Vt = C.lds + GL_VT; const LAS unsigned char* Kd = C.lds + GL_KD;
      bf16x8 bv[2], ak[2][4]; tf_2x1<TS2>(Vt, 0, e0, C.lane, bv); tf_2x4<TS>(Kd, 0, 0, C.lane, ak);
      f32x4 acc4[4];
#pragma unroll
      for (int bt = 0; bt < 4; ++bt) acc4[bt] = (f32x4){0.f, 0.f, 0.f, 0.f};
#pragma unroll
      for (int ks = 0; ks < 2; ++ks)
#pragma unroll
          for (int bt = 0; bt < 4; ++bt) acc4[bt] = MFMA16(ak[ks][bt], bv[ks], acc4[bt]);
      SETTLE4(acc4[0], acc4[1], acc4[2], acc4[3]);
#pragma unroll
      for (int bt = 0; bt < 4; ++bt) { const f32x4 acc = acc4[bt];
          { u32x2 o; o.x = pk2(acc[0], acc[1]); o.y = pk2(acc[2], acc[3]); *(GAS u32x2*)(Dg + (size_t)(e0 + (C.lane & 15)) * 64 + 16 * bt + 4 * (C.lane >> 4)) = o; } } }
    LDS_BARRIER();
}

template <bool HGRN>
__device__ __forceinline__ void gla_pass2_job(const Params& p, int job, int lane) {
    GAS unsigned char* mx = p.ws + MX_BASE;
    const int bh = job >> 5, slab = job & 31, b = bh >> 2, h = bh & 3;
    const int el = slab * 256 + lane * 4;
    const int d0 = el & 63;
    f32x4 S = {0.f, 0.f, 0.f, 0.f};
    const GAS bf16_t* Dp = (const GAS bf16_t*)(mx + (HGRN ? GX_D_O : GX_D_E)); const GAS float* Cp = (const GAS float*)(mx + (HGRN ? GX_DEC_O : GX_DEC_E)); GAS bf16_t* Sp = (GAS bf16_t*)(mx + (HGRN ? GX_S_O : GX_S_E));
#pragma unroll 1
    for (int c0 = 0; c0 < 64; c0 += 8) {
        f32x4 Dv[8], dc[8];
#pragma unroll
        for (int q = 0; q < 8; ++q) { const size_t item = ((size_t)(b * 64 + c0 + q) * 4 + h); { const u32x2 d2 = __builtin_nontemporal_load((const GAS u32x2*)(Dp + item * 8192 + el)); Dv[q] = (f32x4){bflo(d2.x), bfhi(d2.x), bflo(d2.y), bfhi(d2.y)}; } dc[q] = *(const GAS f32x4*)(Cp + item * 64 + d0); }
#pragma unroll
        for (int q = 0; q < 8; ++q) { const size_t item = ((size_t)(b * 64 + c0 + q) * 4 + h);
            u32x2 o; o.x = pk2(S[0], S[1]); o.y = pk2(S[2], S[3]);
            *(GAS u32x2*)(Sp + item * 8192 + el) = o;
            S = S * dc[q] + Dv[q]; }
    }
}

struct Gl3Pre { f32x4 gb0, gb1, gr0, gr1; u32x4 kf, q, v0, v1, s0, s1; };
template <bool HGRN>
__device__ __forceinline__ void gla_prefetch3(const Params& p, int tid, int item, Gl3Pre& pre) {
    const int h = item & 3, bc = item >> 2, j = tid >> 3, cg = tid & 7;
    const GAS bf16_t* Y = (const GAS bf16_t*)(p.ws + WS_Y);
    const GAS float* Gg = (const GAS float*)(Y + ((size_t)bc * 64 + j) * D + (HGRN ? 0 : 512) + 128 * h) + 8 * cg;
    const GAS float* Gr = (const GAS float*)(Y + ((size_t)bc * 64 + 31) * D + (HGRN ? 0 : 512) + 128 * h) + 8 * cg;
    pre.gb0 = *(const GAS f32x4*)Gg; pre.gb1 = *(const GAS f32x4*)(Gg + 4); pre.gr0 = *(const GAS f32x4*)Gr; pre.gr1 = *(const GAS f32x4*)(Gr + 4);
    const GAS bf16_t* ur = (const GAS bf16_t*)(p.ws + WS_U) + ((size_t)bc * 64 + j) * UPITCH;
    pre.kf = *(const GAS u32x4*)(ur + (HGRN ? HG_F : GL_K) + 64 * h + 8 * cg);
    pre.q = *(const GAS u32x4*)(ur + (HGRN ? HG_Q : GL_Q) + 64 * h + 8 * cg);
    const GAS u32x4* vs = (const GAS u32x4*)(ur + (HGRN ? HG_I : GL_V) + 128 * h + 16 * cg); pre.v0 = vs[0]; pre.v1 = vs[1];
    const GAS bf16_t* Sg = (const GAS bf16_t*)(p.ws + MX_BASE + (HGRN ? GX_S_O : GX_S_E)) + (size_t)item * 8192;
    pre.s0 = __builtin_nontemporal_load((const GAS u32x4*)(Sg + (size_t)(tid >> 3) * 64 + 8 * (tid & 7)));
    pre.s1 = __builtin_nontemporal_load((const GAS u32x4*)(Sg + (size_t)((tid + 512) >> 3) * 64 + 8 * (tid & 7)));
}
template <bool HGRN>
__device__ __forceinline__ void gla_pass3_item(const Params& p, const Ctx& C0, int layer, int item, int next_item, Gl3Pre& pre) {
    Ctx C = C0; asm volatile("" : "+s"(C.wave)); asm volatile("" : "+v"(C.tid)); C.lane = C.tid & 63;
    const int h = item & 3, bc = item >> 2, jl = layer >> 1;
    const GAS bf16_t* urow0 = (const GAS bf16_t*)(p.ws + WS_U) + (size_t)bc * 64 * UPITCH;
    GAS bf16_t* Y = (GAS bf16_t*)(p.ws + WS_Y);
    LAS float* Gt = (LAS float*)(C.lds + GL_GT);
    const int j = C.tid >> 3, cg = C.tid & 7;
    GAS unsigned char* mx = p.ws + MX_BASE;
    const GAS bf16_t* Sg = (const GAS bf16_t*)(mx + (HGRN ? GX_S_O : GX_S_E)) + (size_t)item * 8192;
    u32x2 gvv[4];
    { const int at_ = C.wave & 3, eh_ = C.wave >> 2; const size_t tk_ = (size_t)bc * 64 + 16 * at_ + (C.lane & 15);
      const GAS bf16_t* gp_ = (const GAS bf16_t*)(p.ws + WS_U) + tk_ * UPITCH + (HGRN ? HG_G : GL_G) + 128 * h + 64 * eh_ + 4 * (C.lane >> 4);
#pragma unroll
      for (int et = 0; et < 4; ++et) gvv[et] = *(const GAS u32x2*)(gp_ + 16 * et); }
    f32x4 gnv[4];
    { const GAS float* gain_ = (HGRN ? p.c_norm_gain : p.b_norm_gain) + (layer >> 1) * 128 + 64 * (C.wave >> 2) + 4 * (C.lane >> 4);
#pragma unroll
      for (int et = 0; et < 4; ++et) gnv[et] = *(const GAS f32x4*)(gain_ + 16 * et); }
    float kreg[8];
    if constexpr (HGRN) {
        float fr[8]; unpack8(pre.kf, fr);
        const GAS float* lb = (const GAS float*)(p.ws + WS_LB) + layer * 256 + 64 * h + 8 * cg;
#pragma unroll
        for (int q = 0; q < 8; ++q) { const float l = lb[q]; kreg[q] = (1.f - l) * (1.f - sigmoidf_(fr[q])); }
    } else unpack8(pre.kf, kreg);
    { LAS u32x4* dst = (LAS u32x4*)(C.lds + GL_VT + j * TS2 + 32 * cg); dst[0] = pre.v0; dst[1] = pre.v1; }
    *(LAS u32x4*)(C.lds + GL_ST + (C.tid >> 3) * TS + 16 * (C.tid & 7)) = pre.s0;
    *(LAS u32x4*)(C.lds + GL_ST + ((C.tid + 512) >> 3) * TS + 16 * (C.tid & 7)) = pre.s1;
    { float qv[8]; unpack8(pre.q, qv);
      const float qs = HGRN ? 1.f : 0.125f;
      float qm[8], q2[8], km[8];
#pragma unroll
      for (int q = 0; q < 8; ++q) { const float bj = q < 4 ? pre.gb0[q & 3] : pre.gb1[q & 3], br = q < 4 ? pre.gr0[q & 3] : pre.gr1[q & 3]; const float qq = qv[q] * qs;
          qm[q] = qq * __expf(bj - br); q2[q] = qq * __expf(bj); km[q] = kreg[q] * __expf(br - bj); }
      *(LAS u32x4*)(C.lds + GL_QM + j * TS + 16 * cg) = pack8(qm);
      *(LAS u32x4*)(C.lds + GL_Q2 + j * TS + 16 * cg) = pack8(q2);
      *(LAS u32x4*)(C.lds + GL_KM + j * TS + 16 * cg) = pack8(km); }
    gla_prefetch3<HGRN>(p, C.tid, next_item, pre);
    LDS_BARRIER();
    {
      const LAS unsigned char* Qm = C.lds + GL_QM; const LAS unsigned char* Km = C.lds + GL_KM; LAS unsigned char* Pl = C.lds + GL_PL;
#pragma unroll
      for (int q = 0; q < 2; ++q) { const int id = 2 * C.wave + q, at = id >> 2, bt = id & 3; f32x4 acc = {0.f, 0.f, 0.f, 0.f};
          if (bt <= at) {
#pragma unroll
              for (int ks = 0; ks < 2; ++ks) acc = MFMA16(rf_lds(Km, TS, 16 * bt, 32 * ks, C.lane), rf_lds(Qm, TS, 16 * at, 32 * ks, C.lane), acc);
          SETTLE(acc);
              const int i = 16 * at + (C.lane & 15), j0 = 16 * bt + 4 * (C.lane >> 4);
#pragma unroll
              for (int r = 0; r < 4; ++r) acc[r] = (j0 + r <= i) ? acc[r] : 0.f; }
          st4_lds(Pl, TS, 16 * at + (C.lane & 15), 16 * bt + 4 * (C.lane >> 4), acc); } }
    LDS_BARRIER();
    { const int at = C.wave & 3, eh = C.wave >> 2, i = 16 * at + (C.lane & 15), g4 = 4 * (C.lane >> 4);
      const LAS unsigned char* Vt = C.lds + GL_VT; const LAS unsigned char* St = C.lds + GL_ST; const LAS unsigned char* Pl = C.lds + GL_PL; const LAS unsigned char* Q2 = C.lds + GL_Q2;
      LAS float* RS = (LAS float*)(C.lds + GL_RS);
      bf16x8 bp[2], bq[2];
#pragma unroll
      for (int ks = 0; ks < 2; ++ks) { bp[ks] = rf_lds(Pl, TS, 16 * at, 32 * ks, C.lane); bq[ks] = rf_lds(Q2, TS, 16 * at, 32 * ks, C.lane); }
      bf16x8 av[2][4]; tf_2x4<TS2>(Vt, 0, 64 * eh, C.lane, av);
      f32x4 acc[4]; float ss = 0.f;
      bf16x8 sf[2][4];
#pragma unroll
      for (int et = 0; et < 4; ++et) { sf[0][et] = rf_lds(St, TS, 64 * eh + 16 * et, 0, C.lane); sf[1][et] = rf_lds(St, TS, 64 * eh + 16 * et, 32, C.lane); acc[et] = (f32x4){0.f, 0.f, 0.f, 0.f}; }
#pragma unroll
      for (int ks = 0; ks < 2; ++ks) {
#pragma unroll
          for (int et = 0; et < 4; ++et) acc[et] = MFMA16(av[ks][et], bp[ks], acc[et]);
#pragma unroll
          for (int et = 0; et < 4; ++et) acc[et] = MFMA16(sf[ks][et], bq[ks], acc[et]); }
      SETTLE4(acc[0], acc[1], acc[2], acc[3]);
#pragma unroll
      for (int et = 0; et < 4; ++et) { const f32x4 a = acc[et]; ss += (a[0] * a[0] + a[1] * a[1]) + (a[2] * a[2] + a[3] * a[3]); }
      ss += __shfl_xor(ss, 16); ss += __shfl_xor(ss, 32);
      if (C.lane < 16) RS[eh * 64 + i] = ss;
      LDS_BARRIER();
      const float rstd = rsqrtf((RS[i] + RS[64 + i]) * (1.f / 128.f) + NORM_EPS);
      const GAS float* gain = (HGRN ? p.c_norm_gain : p.b_norm_gain) + jl * 128;
      const size_t tk = (size_t)bc * 64 + i;
      const GAS bf16_t* gp = (const GAS bf16_t*)(p.ws + WS_U) + tk * UPITCH + (HGRN ? HG_G : GL_G) + 128 * h;
      GAS bf16_t* yp = Y + tk * D + (HGRN ? 0 : 512) + 128 * h;
#pragma unroll
      for (int et = 0; et < 4; ++et) { const int e = 64 * eh + 16 * et + g4; const u32x2 gv = gvv[et]; const f32x4 gn = gnv[et];
          const float g0 = siluf_(bflo(gv.x)), g1 = siluf_(bfhi(gv.x)), g2 = siluf_(bflo(gv.y)), g3 = siluf_(bfhi(gv.y));
          u32x2 o; o.x = pk2(acc[et][0] * rstd * gn[0] * g0, acc[et][1] * rstd * gn[1] * g1); o.y = pk2(acc[et][2] * rstd * gn[2] * g2, acc[et][3] * rstd * gn[3] * g3);
          *(GAS u32x2*)(yp + e) = o; } }
    LDS_BARRIER();
}
constexpr int SD_BMT = 0, SD_CMT = 9216, SD_X = 18432  , SD_HS = 55296  , SD_PL = 92160  , SD_DTL = 129024  , SD_CUM = 130048  , SD_SEG = 131072  , SD_RS = 131328  ;

constexpr int SD_CW = 132096;
constexpr int SD_GN = SD_CW + 5 * 384 * 4;
constexpr int SD_HK = SD_GN + 1024;
constexpr int SD_END = SD_HK + 64;
__device__ __forceinline__ float ssd_dt_load(const Ctx& C, int grp, const GAS bf16_t* urow0) {
    const int j = (C.tid & 255) >> 2, hh = C.tid & 3, head = 4 * grp + hh;
    return bf2f(urow0[(size_t)j * UPITCH + SD_DT + head]);
}
__device__ __forceinline__ void ssd_stage_dt(const Ctx& C, float raw_in) {
    LAS float* DTL = (LAS float*)(C.lds + SD_DTL); LAS float* CUM = (LAS float*)(C.lds + SD_CUM); const LAS float* HK = (const LAS float*)(C.lds + SD_HK);
    if (C.tid < 256) { const int j = C.tid >> 2, hh = C.tid & 3;
        const float raw = raw_in + HK[hh];
        const float dt = softplusf_(raw); DTL[j * 4 + hh] = dt; CUM[j * 4 + hh] = -dt * HK[4 + hh]; }
    LDS_BARRIER();
    lds_cumsum64<4, true>(CUM, 4, (LAS float*)(C.lds + SD_SEG), C.tid);
}
__device__ __forceinline__ void ssd_load_cw(const Params& p, const Ctx& C, int layer, int grp) {
    const int jl = layer >> 1; LAS float* cwl = (LAS float*)(C.lds + SD_CW);
    for (int i = C.tid; i < 5 * 384; i += 512) { const int tap = i / 384, lc = i % 384;
        const int ch = lc < 256 ? 256 * grp + lc : (lc < 320 ? 512 + 64 * grp + (lc - 256) : 640 + 64 * grp + (lc - 320));
        cwl[i] = tap < 4 ? p.d_conv_w[(size_t)jl * 4 * 768 + tap * 768 + ch] : p.d_conv_b[jl * 768 + ch]; }
    if (C.tid < 256) ((LAS float*)(C.lds + SD_GN))[C.tid] = p.d_norm_gain[jl * 512 + 256 * grp + C.tid];
    if (C.tid < 12) { const int k = C.tid >> 2, head = 4 * grp + (C.tid & 3);
        ((LAS float*)(C.lds + SD_HK))[C.tid] = k == 0 ? p.d_dt_bias[jl * 8 + head] : k == 1 ? __expf(p.d_a_log[jl * 8 + head]) : p.d_skip[jl * 8 + head]; }
}
struct Conv4 { u32x4 r[4]; };
__device__ __forceinline__ void ssd_conv_load(const GAS bf16_t* useq, int pos, int ch, Conv4& cv) {
#pragma unroll
    for (int i = 0; i < 4; ++i) { const int pp = pos - 3 + i; cv.r[i] = *(const GAS u32x4*)(useq + (size_t)(pp >= 0 ? pp : 0) * UPITCH + SD_XBC + ch); }
}
__device__ __forceinline__ void ssd_conv_apply(const LAS float* cwl, int lc, int pos, const Conv4& cv, float (&o)[8]) {
    { const f32x4 b0 = *(const LAS f32x4*)(cwl + 4 * 384 + lc), b1 = *(const LAS f32x4*)(cwl + 4 * 384 + lc + 4);
      o[0] = b0[0]; o[1] = b0[1]; o[2] = b0[2]; o[3] = b0[3]; o[4] = b1[0]; o[5] = b1[1]; o[6] = b1[2]; o[7] = b1[3]; }
#pragma unroll
    for (int i = 0; i < 4; ++i) { const int pp = pos - 3 + i;
        u32x4 raw = cv.r[i]; if (pp < 0) raw = (u32x4){0u, 0u, 0u, 0u};
        float xv[8]; unpack8(raw, xv);
        const f32x4 w0 = *(const LAS f32x4*)(cwl + i * 384 + lc), w1 = *(const LAS f32x4*)(cwl + i * 384 + lc + 4);
        o[0] += w0[0] * xv[0]; o[1] += w0[1] * xv[1]; o[2] += w0[2] * xv[2]; o[3] += w0[3] * xv[3]; o[4] += w1[0] * xv[4]; o[5] += w1[1] * xv[5]; o[6] += w1[2] * xv[6]; o[7] += w1[3] * xv[7]; }
#pragma unroll
    for (int q = 0; q < 8; ++q) o[q] = siluf_(o[q]);
}
__device__ __forceinline__ void ssd_pass1_item(const Params& p, const Ctx& C0, int layer, int item) {
    Ctx C = C0; asm volatile("" : "+s"(C.wave)); asm volatile("" : "+v"(C.tid)); C.lane = C.tid & 63;
    const int grp = item & 1, bc = item >> 1, c = bc & 63, jl = layer >> 1;
    const GAS bf16_t* U = (const GAS bf16_t*)(p.ws + WS_U);
    const GAS bf16_t* urow0 = U + (size_t)bc * 64 * UPITCH; const GAS bf16_t* useq = U + (size_t)(bc >> 6) * SEQ * UPITCH;
    LAS float* DTL = (LAS float*)(C.lds + SD_DTL); LAS float* CUM = (LAS float*)(C.lds + SD_CUM); const LAS float* cwl = (const LAS float*)(C.lds + SD_CW);
    GAS unsigned char* mx = p.ws + MX_BASE;
    const float dtraw = ssd_dt_load(C, grp, urow0);
    const int j = C.tid >> 3, cg = C.tid & 7;
    Conv4 cv[5];
#pragma unroll
    for (int blk = 0; blk < 5; ++blk) ssd_conv_load(useq, c * 64 + j, blk < 4 ? 256 * grp + 64 * blk + 8 * cg : 512 + 64 * grp + 8 * cg, cv[blk]);
    ssd_stage_dt(C, dtraw);
#pragma unroll
    for (int blk = 0; blk < 5; ++blk) { float o[8];
        if (blk < 4) { ssd_conv_apply(cwl, 64 * blk + 8 * cg, c * 64 + j, cv[blk], o);
            const float s = DTL[j * 4 + blk] * __expf(CUM[63 * 4 + blk] - CUM[j * 4 + blk]);
#pragma unroll
            for (int q = 0; q < 8; ++q) o[q] *= s;
            *(LAS u32x4*)(C.lds + SD_X + blk * TILE64 + j * TS + 16 * cg) = pack8(o);
        } else { ssd_conv_apply(cwl, 256 + 8 * cg, c * 64 + j, cv[blk], o); *(LAS u32x4*)(C.lds + SD_BMT + j * TS + 16 * cg) = pack8(o); } }
    LDS_BARRIER();
    { const int hh = C.wave >> 1; const LAS unsigned char* Xt = C.lds + SD_X + hh * TILE64; const LAS unsigned char* Bt = C.lds + SD_BMT;
      const size_t ih = (size_t)bc * 8 + 4 * grp + hh;
      GAS bf16_t* STg = (GAS bf16_t*)(mx + SX_ST) + ih * 4096;
      if ((C.wave & 1) == 0 && C.lane == 0) ((GAS float*)(mx + SX_DEC))[ih] = __expf(CUM[63 * 4 + hh]);
      bf16x8 ab[2][4]; tf_2x4<TS>(Bt, 0, 0, C.lane, ab);
#pragma unroll
      for (int q = 0; q < 2; ++q) { const int at = 2 * (C.wave & 1) + q;
          bf16x8 bx[2]; tf_2x1<TS>(Xt, 0, 16 * at, C.lane, bx);
          f32x4 acc4[4];
#pragma unroll
          for (int bt = 0; bt < 4; ++bt) acc4[bt] = (f32x4){0.f, 0.f, 0.f, 0.f};
#pragma unroll
          for (int ks = 0; ks < 2; ++ks)
#pragma unroll
              for (int bt = 0; bt < 4; ++bt) acc4[bt] = MFMA16(ab[ks][bt], bx[ks], acc4[bt]);
          SETTLE4(acc4[0], acc4[1], acc4[2], acc4[3]);
#pragma unroll
          for (int bt = 0; bt < 4; ++bt) { const f32x4 acc = acc4[bt];
              { u32x2 o; o.x = pk2(acc[0], acc[1]); o.y = pk2(acc[2], acc[3]); *(GAS u32x2*)(STg + (size_t)(16 * at + (C.lane & 15)) * 64 + 16 * bt + 4 * (C.lane >> 4)) = o; } } } }
    LDS_BARRIER();
}
__device__ __forceinline__ void ssd_pass2_job(const Params& p, int job, int lane) {
    GAS unsigned char* mx = p.ws + MX_BASE;
    const int bh = job >> 4, slab = job & 15, b = bh >> 3, head = bh & 7;
    const int el = slab * 256 + lane * 4;
    f32x4 S = {0.f, 0.f, 0.f, 0.f};
#pragma unroll 1
    for (int c0 = 0; c0 < 64; c0 += 8) {
        f32x4 Dv[8]; float dc[8];
#pragma unroll
        for (int q = 0; q < 8; ++q) { const size_t ih = (size_t)(b * 64 + c0 + q) * 8 + head; { const u32x2 d2 = __builtin_nontemporal_load((const GAS u32x2*)((const GAS bf16_t*)(mx + SX_ST) + ih * 4096 + el)); Dv[q] = (f32x4){bflo(d2.x), bfhi(d2.x), bflo(d2.y), bfhi(d2.y)}; } dc[q] = ((const GAS float*)(mx + SX_DEC))[ih]; }
#pragma unroll
        for (int q = 0; q < 8; ++q) { const size_t ih = (size_t)(b * 64 + c0 + q) * 8 + head;
            u32x2 o; o.x = pk2(S[0], S[1]); o.y = pk2(S[2], S[3]);
            *(GAS u32x2*)((GAS bf16_t*)(mx + SX_S) + ih * 4096 + el) = o;
            S = S * dc[q] + Dv[q]; }
    }
}
__device__ __forceinline__ void ssd_pass3_item(const Params& p, const Ctx& C0, int layer, int item) {
    Ctx C = C0; asm volatile("" : "+s"(C.wave)); asm volatile("" : "+v"(C.tid)); C.lane = C.tid & 63;
    const int grp = item & 1, bc = item >> 1, c = bc & 63, jl = layer >> 1;
    const GAS bf16_t* U = (const GAS bf16_t*)(p.ws + WS_U);
    const GAS bf16_t* urow0 = U + (size_t)bc * 64 * UPITCH; const GAS bf16_t* useq = U + (size_t)(bc >> 6) * SEQ * UPITCH;
    LAS float* DTL = (LAS float*)(C.lds + SD_DTL); LAS float* CUM = (LAS float*)(C.lds + SD_CUM); LAS float* RS = (LAS float*)(C.lds + SD_RS); const LAS float* cwl = (const LAS float*)(C.lds + SD_CW);
    GAS unsigned char* mx = p.ws + MX_BASE;
    GAS bf16_t* Y = (GAS bf16_t*)(p.ws + WS_Y);
    const float dtraw = ssd_dt_load(C, grp, urow0);
    const int j = C.tid >> 3, cg = C.tid & 7;
    Conv4 cv[6];
#pragma unroll
    for (int blk = 0; blk < 6; ++blk) ssd_conv_load(useq, c * 64 + j, blk < 4 ? 256 * grp + 64 * blk + 8 * cg : (blk == 4 ? 512 : 640) + 64 * grp + 8 * cg, cv[blk]);
    u32x4 sreg[4];
#pragma unroll
    for (int k4 = 0; k4 < 4; ++k4) { const GAS bf16_t* Sg = (const GAS bf16_t*)(mx + SX_S) + ((size_t)bc * 8 + 4 * grp + k4) * 4096;
        sreg[k4] = __builtin_nontemporal_load((const GAS u32x4*)(Sg + (size_t)j * 64 + 8 * cg)); }
    ssd_stage_dt(C, dtraw);
#pragma unroll
    for (int blk = 0; blk < 6; ++blk) { float o[8];
        if (blk < 4) { ssd_conv_apply(cwl, 64 * blk + 8 * cg, c * 64 + j, cv[blk], o);
            const float s = DTL[j * 4 + blk];
#pragma unroll
            for (int q = 0; q < 8; ++q) o[q] *= s;
            *(LAS u32x4*)(C.lds + SD_X + blk * TILE64 + j * TS + 16 * cg) = pack8(o);
        } else if (blk == 4) { ssd_conv_apply(cwl, 256 + 8 * cg, c * 64 + j, cv[blk], o); *(LAS u32x4*)(C.lds + SD_BMT + j * TS + 16 * cg) = pack8(o);
        } else { ssd_conv_apply(cwl, 320 + 8 * cg, c * 64 + j, cv[blk], o); *(LAS u32x4*)(C.lds + SD_CMT + j * TS + 16 * cg) = pack8(o); } }
#pragma unroll
    for (int k4 = 0; k4 < 4; ++k4) *(LAS u32x4*)(C.lds + SD_HS + k4 * TILE64 + j * TS + 16 * cg) = sreg[k4];
    LDS_BARRIER();
    {
      const LAS unsigned char* Cm = C.lds + SD_CMT; const LAS unsigned char* Bm = C.lds + SD_BMT;
#pragma unroll
      for (int q = 0; q < 2; ++q) { const int id = 2 * C.wave + q, at = id >> 2, bt = id & 3; f32x4 acc = {0.f, 0.f, 0.f, 0.f};
          const int tt = 16 * at + (C.lane & 15), s0 = 16 * bt + 4 * (C.lane >> 4);
          if (bt <= at) {
#pragma unroll
              for (int ks = 0; ks < 2; ++ks) acc = MFMA16(rf_lds(Bm, TS, 16 * bt, 32 * ks, C.lane), rf_lds(Cm, TS, 16 * at, 32 * ks, C.lane), acc); }
          SETTLE(acc);
#pragma unroll
          for (int hh = 0; hh < 4; ++hh) { f32x4 v; const float ct = CUM[tt * 4 + hh];
#pragma unroll
              for (int r = 0; r < 4; ++r) { const float e = __expf(ct - CUM[(s0 + r) * 4 + hh]); v[r] = (bt <= at && s0 + r <= tt) ? acc[r] * e : 0.f; }
              st4_lds(C.lds + SD_PL + hh * TILE64, TS, tt, s0, v); } } }
    LDS_BARRIER();
    { const int at = C.wave & 3, hp = C.wave >> 2, tt = 16 * at + (C.lane & 15), g4 = 4 * (C.lane >> 4);
      const LAS unsigned char* Cm = C.lds + SD_CMT;
      bf16x8 bc_[2]; bc_[0] = rf_lds(Cm, TS, 16 * at, 0, C.lane); bc_[1] = rf_lds(Cm, TS, 16 * at, 32, C.lane);
      const size_t tk = (size_t)bc * 64 + tt;
      f32x4 yv[2][4]; float ss = 0.f;
#pragma unroll
      for (int q = 0; q < 2; ++q) { const int hh = 2 * hp + q, head = 4 * grp + hh;
          const LAS unsigned char* Hs = C.lds + SD_HS + hh * TILE64; const LAS unsigned char* Xt = C.lds + SD_X + hh * TILE64; const LAS unsigned char* Pl = C.lds + SD_PL + hh * TILE64;
          bf16x8 bp[2]; bp[0] = rf_lds(Pl, TS, 16 * at, 0, C.lane); bp[1] = rf_lds(Pl, TS, 16 * at, 32, C.lane);
          bf16x8 ax[2][4]; tf_2x4<TS>(Xt, 0, 0, C.lane, ax);
          const float ec = __expf(CUM[tt * 4 + hh]), rdt = rcpf_(DTL[tt * 4 + hh]), skip = ((const LAS float*)(C.lds + SD_HK))[8 + hh];
          const GAS bf16_t* zp = U + tk * UPITCH + SD_Z + 64 * head;
          bf16x8 hf[2][4]; f32x4 a4[4];
#pragma unroll
          for (int pt = 0; pt < 4; ++pt) { hf[0][pt] = rf_lds(Hs, TS, 16 * pt, 0, C.lane); hf[1][pt] = rf_lds(Hs, TS, 16 * pt, 32, C.lane); a4[pt] = (f32x4){0.f, 0.f, 0.f, 0.f}; }
#pragma unroll
          for (int ks = 0; ks < 2; ++ks)
#pragma unroll
              for (int pt = 0; pt < 4; ++pt) a4[pt] = MFMA16(hf[ks][pt], bc_[ks], a4[pt]);
          SETTLE4(a4[0], a4[1], a4[2], a4[3]);
#pragma unroll
          for (int pt = 0; pt < 4; ++pt) a4[pt] = a4[pt] * ec;
#pragma unroll
          for (int ks = 0; ks < 2; ++ks)
#pragma unroll
              for (int pt = 0; pt < 4; ++pt) a4[pt] = MFMA16(ax[ks][pt], bp[ks], a4[pt]);
          SETTLE4(a4[0], a4[1], a4[2], a4[3]);
#pragma unroll
          for (int pt = 0; pt < 4; ++pt) { f32x4 a = a4[pt];
              const f32x4 xh = ld4_lds(Xt, TS, tt, 16 * pt + g4) * rdt;
              const u32x2 zv = *(const GAS u32x2*)(zp + 16 * pt + g4);
              a[0] = (a[0] + skip * xh[0]) * siluf_(bflo(zv.x)); a[1] = (a[1] + skip * xh[1]) * siluf_(bfhi(zv.x)); a[2] = (a[2] + skip * xh[2]) * siluf_(bflo(zv.y)); a[3] = (a[3] + skip * xh[3]) * siluf_(bfhi(zv.y));
              yv[q][pt] = a; ss += (a[0] * a[0] + a[1] * a[1]) + (a[2] * a[2] + a[3] * a[3]); } }
      ss += __shfl_xor(ss, 16); ss += __shfl_xor(ss, 32);
      if (C.lane < 16) RS[hp * 64 + tt] = ss;
      LDS_BARRIER();
      const float rstd = rsqrtf((RS[tt] + RS[64 + tt]) * (1.f / 256.f) + NORM_EPS);
#pragma unroll
      for (int q = 0; q < 2; ++q) { const int hh = 2 * hp + q, head = 4 * grp + hh;
          const LAS float* gn = (const LAS float*)(C.lds + SD_GN) + 64 * hh; GAS bf16_t* yp = Y + tk * D + 512 + 64 * head;
#pragma unroll
          for (int pt = 0; pt < 4; ++pt) { const f32x4 g = *(const LAS f32x4*)(gn + 16 * pt + g4); const f32x4 a = yv[q][pt] * rstd * g;
              u32x2 o; o.x = pk2(a[0], a[1]); o.y = pk2(a[2], a[3]); *(GAS u32x2*)(yp + 16 * pt + g4) = o; } } }
    LDS_BARRIER();
}
constexpr int RK_LW = 0, RK_AA = 17408, RK_NA = 0, RK_NB = 9216, RK_TA = 18432, RK_TB = 27648, RK_SEG = 40960, RK_ECL = 43008, RK_TW = 43520, RK_AD = 52736, RK_WZ = 43520,
              RK_KKG = 61952, RK_BI = 71168, RK_KTI = 80384, RK_RG = 89600, RK_V = 98816, RK_MBR = 108032, RK_MKR = 117248, RK_N0 = 126464, RK_AK = 135680, RK_KH = RK_BI, RK_END = 144896;

__device__ __forceinline__ void rk_shift8(const GAS bf16_t* cur, const GAS bf16_t* prv, bool has_prev, const LAS float* mu, float (&o)[8]) {
    const u32x4 cr = *(const GAS u32x4*)cur, pr = *(const GAS u32x4*)(has_prev ? prv : cur);
    float c[8], q[8]; unpack8(cr, c); unpack8(pr, q);
    const f32x4 m0 = *(const LAS f32x4*)mu, m1 = *(const LAS f32x4*)(mu + 4);
#pragma unroll
    for (int i = 0; i < 8; ++i) { const float m = i < 4 ? m0[i & 3] : m1[i & 3]; const float qq = has_prev ? q[i] : 0.f; o[i] = c[i] + m * (qq - c[i]); }
}
__device__ __forceinline__ float tanhf_(float x) { const float e = __expf(-2.f * fabsf(x)); const float t = (1.f - e) * rcpf_(1.f + e); return x < 0.f ? -t : t; }

#ifdef DBG_RW
#define RWCHK(cond, bit) do { if (layer == 0 && __any((int)(cond))) { GAS unsigned* f_ = (GAS unsigned*)(p.ws + WS_CTL) + 8192; if (C.lane == 0 && !(__hip_atomic_load(f_, __ATOMIC_RELAXED, __HIP_MEMORY_SCOPE_AGENT) & (bit))) atomicOr(f_, (bit)); } } while (0)
#else
#define RWCHK(cond, bit) do { } while (0)
#endif
#ifdef DBG_DUMP
#define RWDUMP(ldsoff, nbytes, gofs) do { if (layer == 0 && item < 1024) { const int rs_ = ((nbytes) == 64 * TS2) ? TS2 : TS; const int vb_ = rs_ - 16; for (int i_ = C.tid * 16; i_ < 64 * vb_; i_ += 512 * 16) { const int r_ = i_ / vb_, c_ = i_ % vb_; *(GAS u32x4*)(p.ws + WS_Y + (gofs) + (size_t)item * (nbytes) + r_ * rs_ + c_) = *(const LAS u32x4*)(L + (ldsoff) + r_ * rs_ + c_); } } } while (0)
#else
#define RWDUMP(ldsoff, nbytes, gofs) do { } while (0)
#endif

constexpr int RK_CONST = RK_END;
struct RkPre { u32x4 cur[5], prv[5]; };
__device__ __forceinline__ void rk_prefetch(const Params& p, int tid, int h, int item, RkPre& pre) {
    const int bc = item >> 3, j = tid >> 3, cg = tid & 7;
    const GAS bf16_t* cur = (const GAS bf16_t*)(p.ws + WS_U) + ((size_t)bc * 64 + j) * UPITCH; const bool hp = ((bc & 63) * 64 + j) != 0;
    const GAS bf16_t* prv = hp ? cur - UPITCH : cur;
    const int col[5] = {RW_R + 64 * h + 8 * cg, RW_K + 64 * h + 8 * cg, RW_V + 64 * h + 8 * cg, RW_WD + 8 * cg, RW_AD + 8 * cg};
#pragma unroll
    for (int q = 0; q < 5; ++q) { pre.cur[q] = *(const GAS u32x4*)(cur + col[q]); pre.prv[q] = *(const GAS u32x4*)(prv + col[q]); }
}
__device__ __forceinline__ void rk_shift8r(const u32x4 cur, const u32x4 prv, bool has_prev, const LAS float* mu, float (&o)[8]) {
    float c[8], q[8]; unpack8(cur, c); unpack8(prv, q);
    const f32x4 m0 = *(const LAS f32x4*)mu, m1 = *(const LAS f32x4*)(mu + 4);
#pragma unroll
    for (int i = 0; i < 8; ++i) { const float m = i < 4 ? m0[i & 3] : m1[i & 3]; const float qq = has_prev ? q[i] : 0.f; o[i] = c[i] + m * (qq - c[i]); }
}
__device__ __forceinline__ void rk_load_const(const Params& p, const Ctx& C, int layer, int h) {
    const int jl = layer >> 1; LAS float* K = (LAS float*)(C.lds + RK_CONST);
    for (int i = C.tid; i < 640; i += 512) { float v;
        if (i < 320) { const int g = i >> 6, n = i & 63; const int col = g == 0 ? RW_R + 64 * h + n : g == 1 ? RW_K + 64 * h + n : g == 2 ? RW_V + 64 * h + n : g == 3 ? RW_WD + n : RW_AD + n; v = p.a_mu[(size_t)jl * RWKV_IN + col]; }
        else { const int g = (i - 320) >> 6, n = i & 63; const GAS float* src = g == 0 ? p.a_k_k : g == 1 ? p.a_k_a : g == 2 ? p.a_r_k : g == 3 ? p.a_w0 : p.a_a0; v = src[jl * 512 + 64 * h + n]; }
        K[i] = v; }
}
__device__ __forceinline__ void rwkv_pass1_item(const Params& p, const Ctx& C0, int layer, int item, int next_item, RkPre& pre, const bf16x8 (&wf)[4][2]) {
    Ctx C = C0; asm volatile("" : "+s"(C.wave)); asm volatile("" : "+v"(C.tid)); C.lane = C.tid & 63;
    const int h = item & 7, bc = item >> 3, c = bc & 63, jl = layer >> 1;
    const GAS bf16_t* urow0 = (const GAS bf16_t*)(p.ws + WS_U) + (size_t)bc * 64 * UPITCH;
    GAS unsigned char* mx = p.ws + MX_BASE;
    LAS unsigned char* L = C.lds;
    LAS float* LW = (LAS float*)(L + RK_LW); LAS float* AA = (LAS float*)(L + RK_AA); LAS float* ECL = (LAS float*)(L + RK_ECL);
    const int j = C.tid >> 3, cg = C.tid & 7, lane = C.lane, w = C.wave;
    const int g4 = 4 * (lane >> 4), l15 = lane & 15;
    float rr[8], kk[8], vv[8];
    const LAS float* KC = (const LAS float*)(L + RK_CONST);
    { const bool hp = (c * 64 + j) != 0;
      rk_shift8r(pre.cur[0], pre.prv[0], hp, KC + 0 * 64 + 8 * cg, rr);
      rk_shift8r(pre.cur[1], pre.prv[1], hp, KC + 1 * 64 + 8 * cg, kk);
      rk_shift8r(pre.cur[2], pre.prv[2], hp, KC + 2 * 64 + 8 * cg, vv);
      float t[8];
      rk_shift8r(pre.cur[3], pre.prv[3], hp, KC + 3 * 64 + 8 * cg, t);
#pragma unroll
      for (int q = 0; q < 8; ++q) t[q] = tanhf_(t[q]);
      *(LAS u32x4*)(L + RK_TW + j * TS + 16 * cg) = pack8(t);
      rk_shift8r(pre.cur[4], pre.prv[4], hp, KC + 4 * 64 + 8 * cg, t);
      *(LAS u32x4*)(L + RK_AD + j * TS + 16 * cg) = pack8(t);
      rk_prefetch(p, C.tid, h, next_item, pre); }
    LDS_BARRIER();
    { const int prod = w >> 2, at = w & 3;
      const LAS unsigned char* src = L + (prod ? RK_AD : RK_TW);
      const LAS float* bias = KC + (prod ? 576 : 512);
      LAS float* dst = prod ? AA : LW;
      bf16x8 bj[2]; bj[0] = rf_lds(src, TS, 16 * at, 0, lane); bj[1] = rf_lds(src, TS, 16 * at, 32, lane);
      f32x4 acc4[4];
#pragma unroll
      for (int bt = 0; bt < 4; ++bt) acc4[bt] = *(const LAS f32x4*)(bias + 16 * bt + g4);
#pragma unroll
      for (int ks = 0; ks < 2; ++ks)
#pragma unroll
          for (int bt = 0; bt < 4; ++bt) acc4[bt] = MFMA16(wf[bt][ks], bj[ks], acc4[bt]);
      SETTLE4(acc4[0], acc4[1], acc4[2], acc4[3]);
#pragma unroll
      for (int bt = 0; bt < 4; ++bt) { f32x4 acc = acc4[bt];
#pragma unroll
          for (int r = 0; r < 4; ++r) acc[r] = prod ? sigmoidf_(acc[r]) : -0.6065306597f * sigmoidf_(acc[r]);
          *(LAS f32x4*)(dst + (16 * at + l15) * FS + 16 * bt + g4) = acc; } }
    LDS_BARRIER();
    float lw[8];
#pragma unroll
    for (int q = 0; q < 8; ++q) lw[q] = LW[j * FS + 8 * cg + q];
    LDS_BARRIER();
    lds_cumsum64<64, true>(LW, FS, (LAS float*)(L + RK_SEG), C.tid);
    { const LAS float* k_k = KC + 320 + 8 * cg; const LAS float* k_a = KC + 384 + 8 * cg; const LAS float* r_k = KC + 448 + 8 * cg;
      float kn[8], ss = 0.f, bon = 0.f, kt[8], bb[8], cs[8];
#pragma unroll
      for (int q = 0; q < 8; ++q) { kn[q] = kk[q] * k_k[q]; ss += kn[q] * kn[q]; }
      ss += __shfl_xor(ss, 1); ss += __shfl_xor(ss, 2); ss += __shfl_xor(ss, 4);
      const float rn = rsqrtf(ss + 1e-12f);
#pragma unroll
      for (int q = 0; q < 8; ++q) { const float a = AA[j * FS + 8 * cg + q]; kn[q] *= rn; kt[q] = kk[q] * (1.f + (a - 1.f) * k_a[q]); bb[q] = a * kn[q]; bon += rr[q] * kt[q] * r_k[q]; cs[q] = LW[j * FS + 8 * cg + q]; }
#pragma unroll
      for (int q = 0; q < 1; ++q) { }
      bon += __shfl_xor(bon, 1); bon += __shfl_xor(bon, 2); bon += __shfl_xor(bon, 4);
      if (cg == 0) ((GAS float*)(mx + RW_BON))[(size_t)item * 64 + j] = bon;
      float o[8];
#pragma unroll
      for (int q = 0; q < 8; ++q) o[q] = kn[q] * __expf(cs[q] - lw[q]);
      *(LAS u32x4*)(L + RK_KKG + j * TS + 16 * cg) = pack8(o);
#pragma unroll
      for (int q = 0; q < 8; ++q) o[q] = bb[q] * __expf(-cs[q]);
      *(LAS u32x4*)(L + RK_BI + j * TS + 16 * cg) = pack8(o);
#pragma unroll
      for (int q = 0; q < 8; ++q) o[q] = kt[q] * __expf(-cs[q]);
      *(LAS u32x4*)(L + RK_KTI + j * TS + 16 * cg) = pack8(o);
#pragma unroll
      for (int q = 0; q < 8; ++q) o[q] = rr[q] * __expf(cs[q]);
      *(LAS u32x4*)(L + RK_RG + j * TS + 16 * cg) = pack8(o);
      *(LAS u32x4*)(L + RK_V + j * TS + 16 * cg) = pack8(vv);
      if (j == 63) {
#pragma unroll
          for (int q = 0; q < 8; ++q) ECL[8 * cg + q] = __expf(cs[q]); } }
    LDS_BARRIER();
    { const int prod = w >> 1;
      const LAS unsigned char* bsrc = L + (prod <= 1 ? RK_KKG : (prod == 2 ? RK_BI : RK_RG));
      const LAS unsigned char* asrc = L + (prod == 0 ? RK_BI : (prod == 1 ? RK_KTI : (prod == 2 ? RK_RG : RK_KTI)));
      LAS unsigned char* dst = L + (prod == 0 ? RK_N0 : (prod == 1 ? RK_AK : (prod == 2 ? RK_MBR : RK_MKR)));
#pragma unroll
      for (int q = 0; q < 2; ++q) { const int at = 2 * (w & 1) + q;
          bf16x8 bj[2]; bj[0] = rf_lds(bsrc, TS, 16 * at, 0, lane); bj[1] = rf_lds(bsrc, TS, 16 * at, 32, lane);
          bf16x8 af[2][4]; f32x4 acc4[4];
#pragma unroll
          for (int bt = 0; bt < 4; ++bt) { af[0][bt] = rf_lds(asrc, TS, 16 * bt, 0, lane); af[1][bt] = rf_lds(asrc, TS, 16 * bt, 32, lane); acc4[bt] = (f32x4){0.f, 0.f, 0.f, 0.f}; }
#pragma unroll
          for (int ks = 0; ks < 2; ++ks)
#pragma unroll
              for (int bt = 0; bt < 4; ++bt) acc4[bt] = MFMA16(af[ks][bt], bj[ks], acc4[bt]);
          SETTLE4(acc4[0], acc4[1], acc4[2], acc4[3]);
#pragma unroll
          for (int bt = 0; bt < 4; ++bt) { f32x4 acc = acc4[bt];
              const int a = 16 * at + l15, b0 = 16 * bt + g4;
#pragma unroll
              for (int r = 0; r < 4; ++r) { const int b = b0 + r; const bool keep = prod <= 1 ? (b < a) : (prod == 2 ? (a <= b) : (b <= a)); acc[r] = keep ? acc[r] : 0.f; }
#pragma unroll
              for (int r = 0; r < 4; ++r) RWCHK(!(fabsf(acc[r]) < (prod == 0 ? 1.5f : 1e3f)), prod == 0 ? 1u : 2u);
              st4_lds(dst, TS, a, b0, acc);
              if (prod == 0) { f32x4 t0;
#pragma unroll
                  for (int r = 0; r < 4; ++r) t0[r] = ((b0 + r) == a ? 1.f : 0.f) - acc[r];
                  st4_lds(L + RK_TA, TS, a, b0, t0);
                  if (at < 2 && bt >= 2) { u32x2 zz; asm volatile("v_mov_b32 %0, 0\n\tv_mov_b32 %1, 0" : "=v"(zz.x), "=v"(zz.y)); *(LAS u32x2*)(L + RK_TB + a * TS + b0 * 2) = zz; } } } } }
    LDS_BARRIER();
    {
        int nsrc = RK_N0, ndst = RK_NA, tsrc = RK_TA, tdst = RK_TB;
        for (int st = 0; st < 6; ++st) {
            const int jb = w & 3, prod = w >> 2;
            const bool doN = (st < 5), doT = (st > 0);
            if ((prod == 0 && doN) || (prod == 1 && doT)) {
                const LAS unsigned char* bs = L + (prod == 0 ? nsrc : tsrc); const LAS unsigned char* as = L + nsrc; LAS unsigned char* dst = L + (prod == 0 ? ndst : tdst);
                if (jb < 2) { const int q2 = 2 * jb;
                    bf16x8 bj[2]; bj[0] = rf_lds(bs, TS, 16 * q2, 32 * jb, lane); bj[1] = rf_lds(bs, TS, 16 * (q2 + 1), 32 * jb, lane);
                    bf16x8 aa[2]; tf_1x2<TS>(as, 32 * jb, 16 * q2, lane, aa);
                    f32x4 acc4[4];
#pragma unroll
                    for (int i = 0; i < 2; ++i)
#pragma unroll
                        for (int jj = 0; jj < 2; ++jj) { acc4[2 * i + jj] = (f32x4){0.f, 0.f, 0.f, 0.f}; if (prod == 1) acc4[2 * i + jj] = ld4_lds(bs, TS, 16 * (q2 + i) + l15, 16 * (q2 + jj) + g4); }
#pragma unroll
                    for (int i = 0; i < 2; ++i)
#pragma unroll
                        for (int jj = 0; jj < 2; ++jj) acc4[2 * i + jj] = MFMA16(aa[jj], bj[i], acc4[2 * i + jj]);
                    SETTLE4(acc4[0], acc4[1], acc4[2], acc4[3]);
#pragma unroll
                    for (int i = 0; i < 2; ++i)
#pragma unroll
                        for (int jj = 0; jj < 2; ++jj) st4_lds(dst, TS, 16 * (q2 + i) + l15, 16 * (q2 + jj) + g4, acc4[2 * i + jj]);
                } else { const int at = jb;
                    bf16x8 bj[2]; bj[0] = rf_lds(bs, TS, 16 * at, 0, lane); bj[1] = rf_lds(bs, TS, 16 * at, 32, lane);
                    bf16x8 a0[2], a1[2]; tf_1x2<TS>(as, 0, 0, lane, a0); tf_1x2<TS>(as, 32, 0, lane, a1);
                    f32x4 acc2[2];
#pragma unroll
                    for (int jj = 0; jj < 2; ++jj) { acc2[jj] = (f32x4){0.f, 0.f, 0.f, 0.f}; if (prod == 1) acc2[jj] = ld4_lds(bs, TS, 16 * at + l15, 16 * jj + g4); }
#pragma unroll
                    for (int jj = 0; jj < 2; ++jj) acc2[jj] = MFMA16(a0[jj], bj[0], acc2[jj]);
#pragma unroll
                    for (int jj = 0; jj < 2; ++jj) acc2[jj] = MFMA16(a1[jj], bj[1], acc2[jj]);
                    SETTLE(acc2[0]); SETTLE(acc2[1]);
#pragma unroll
                    for (int jj = 0; jj < 2; ++jj) st4_lds(dst, TS, 16 * at + l15, 16 * jj + g4, acc2[jj]);
                }
            }
            LDS_BARRIER();
            if (doT) { const int t = tsrc; tsrc = tdst; tdst = t; }
            if (doN) { nsrc = ndst; ndst = (ndst == RK_NA) ? RK_NB : RK_NA; }
        }
        { const int at = w & 3, half = w >> 2; const LAS unsigned char* Tt = L + tsrc;
          bf16x8 bj[2]; tf_2x1<TS>(Tt, 0, 16 * at, lane, bj);
          const LAS unsigned char* as = L + (half ? RK_MBR : RK_BI);
          bf16x8 aa[2][4]; tf_2x4<TS>(as, 0, 0, lane, aa);
          f32x4 acc4[4];
#pragma unroll
          for (int bt = 0; bt < 4; ++bt) acc4[bt] = (f32x4){0.f, 0.f, 0.f, 0.f};
#pragma unroll
          for (int ks = 0; ks < 2; ++ks)
#pragma unroll
              for (int bt = 0; bt < 4; ++bt) acc4[bt] = MFMA16(aa[ks][bt], bj[ks], acc4[bt]);
          SETTLE4(acc4[0], acc4[1], acc4[2], acc4[3]);
#pragma unroll
          for (int bt = 0; bt < 4; ++bt) { f32x4 acc = acc4[bt];
              if (!half) { const f32x4 e = *(const LAS f32x4*)(ECL + 16 * bt + g4); acc = acc * e; }
#pragma unroll
              for (int r = 0; r < 4; ++r) RWCHK(!(fabsf(acc[r]) < 1e4f), 8u);
              st4_lds(L + RK_WZ, TS2, 16 * at + l15, 64 * half + 16 * bt + g4, acc); } }
    }
    LDS_BARRIER();
    { const int prod = w >> 1; const size_t io = (size_t)item * 4096;
      GAS bf16_t* Pt = (GAS bf16_t*)(mx + RW_PT) + io; GAS bf16_t* Rh = (GAS bf16_t*)(mx + RW_RH) + io; GAS bf16_t* Mh = (GAS bf16_t*)(mx + RW_MH) + io;
      bf16x8 ax[2][4];
      if (prod == 2) tf_2x4<TS2>(L + RK_WZ, 0, 0, lane, ax); else tf_2x4<TS>(L + (prod == 3 ? RK_AK : RK_KKG), 0, 0, lane, ax);
#pragma unroll
      for (int q = 0; q < 2; ++q) { const int at = 2 * (w & 1) + q; const int a = 16 * at + l15;
          bf16x8 bj[2];
          if (prod == 0) tf_2x1<TS2>(L + RK_WZ, 0, 16 * at, lane, bj);
          else if (prod == 2) tf_2x1<TS>(L + RK_AK, 0, 16 * at, lane, bj);
          else tf_2x1<TS2>(L + RK_WZ, 0, 64 + 16 * at, lane, bj);
          f32x4 acc4[4];
#pragma unroll
          for (int bt = 0; bt < 4; ++bt) acc4[bt] = (f32x4){0.f, 0.f, 0.f, 0.f};
#pragma unroll
          for (int ks = 0; ks < 2; ++ks)
#pragma unroll
              for (int bt = 0; bt < 4; ++bt) acc4[bt] = MFMA16(ax[ks][bt], bj[ks], acc4[bt]);
          SETTLE4(acc4[0], acc4[1], acc4[2], acc4[3]);
#pragma unroll
          for (int bt = 0; bt < 4; ++bt) { f32x4 acc = acc4[bt]; const int b0 = 16 * bt + g4;
              f32x4 o;
#pragma unroll
              for (int r = 0; r < 4; ++r) RWCHK(!(fabsf(acc[r]) < 1e4f), 16u);
              if (prod == 0) { const float e = ECL[a];
#pragma unroll
                  for (int r = 0; r < 4; ++r) o[r] = ((b0 + r) == a ? e : 0.f) - acc[r];
                  RWCHK(!(fabsf(o[0]) < 1e4f) || !(fabsf(o[1]) < 1e4f) || !(fabsf(o[2]) < 1e4f) || !(fabsf(o[3]) < 1e4f), 1u);
                  u32x2 pk; pk.x = pk2(o[0], o[1]); pk.y = pk2(o[2], o[3]); *(GAS u32x2*)(Pt + (size_t)a * 64 + b0) = pk;
              } else if (prod == 1) { o = ld4_lds(L + RK_RG, TS, a, b0) - acc;
                  RWCHK(!(fabsf(o[0]) < 1e4f) || !(fabsf(o[1]) < 1e4f) || !(fabsf(o[2]) < 1e4f) || !(fabsf(o[3]) < 1e4f), 2u);
                  u32x2 pk; pk.x = pk2(o[0], o[1]); pk.y = pk2(o[2], o[3]); *(GAS u32x2*)(Rh + (size_t)a * 64 + b0) = pk;
              } else if (prod == 2) { const f32x4 e = *(const LAS f32x4*)(ECL + b0); o = ld4_lds(L + RK_KTI, TS, a, b0) * e - acc;
                  st4_lds(L + RK_KH, TS, a, b0, o);
              } else { o = ld4_lds(L + RK_MKR, TS, a, b0) - acc;
                  u32x2 pk; pk.x = pk2(o[0], o[1]); pk.y = pk2(o[2], o[3]); *(GAS u32x2*)(Mh + (size_t)a * 64 + b0) = pk; } } } }
    LDS_BARRIER();
    { GAS bf16_t* Qt = (GAS bf16_t*)(mx + RW_QT) + (size_t)item * 4096;
      bf16x8 bk[2]; tf_2x1<TS>(L + RK_KH, 0, 16 * (w >> 1), lane, bk);
#pragma unroll
      for (int q = 0; q < 2; ++q) { const int id = 2 * w + q, at = id >> 2, bt = id & 3; f32x4 acc = {0.f, 0.f, 0.f, 0.f};
          bf16x8 avq[2]; tf_2x1<TS>(L + RK_V, 0, 16 * bt, lane, avq);
#pragma unroll
          for (int ks = 0; ks < 2; ++ks) acc = MFMA16(avq[ks], bk[ks], acc);
          SETTLE(acc);
#pragma unroll
          for (int r = 0; r < 4; ++r) RWCHK(true, 32u);
          u32x2 pk; pk.x = pk2(acc[0], acc[1]); pk.y = pk2(acc[2], acc[3]); *(GAS u32x2*)(Qt + (size_t)(16 * at + l15) * 64 + 16 * bt + g4) = pk; } }
    LDS_BARRIER();
    RWDUMP(RK_MBR, TILE64, 0); RWDUMP(RK_MKR, TILE64, (size_t)10 << 20); RWDUMP(RK_WZ, 64 * TS2, (size_t)20 << 20); RWDUMP(RK_RG, TILE64, (size_t)40 << 20); RWDUMP(RK_AK, TILE64, (size_t)50 << 20);
    LDS_BARRIER();
}

__device__ __forceinline__ void rwkv_pass2_job(const Params& p, LAS unsigned char* scr  , int job, int lane) {
    GAS unsigned char* mx = p.ws + MX_BASE;
    const int bh = job >> 2, vq = job & 3, b = bh >> 3, h = bh & 7, g4 = 4 * (lane >> 4), l15 = lane & 15;
    f32x4 S[4];
#pragma unroll
    for (int nt = 0; nt < 4; ++nt) S[nt] = (f32x4){0.f, 0.f, 0.f, 0.f};
    bf16x8 bp[4][2]; u32x2 qv[4];
    { const size_t io = ((size_t)(b * 64) * 8 + h) * 4096; const GAS bf16_t* Pt = (const GAS bf16_t*)(mx + RW_PT) + io; const GAS bf16_t* Qt = (const GAS bf16_t*)(mx + RW_QT) + io;
#pragma unroll
      for (int nt = 0; nt < 4; ++nt) { bp[nt][0] = rf_glb(Pt, 64, 16 * nt, 0, lane); bp[nt][1] = rf_glb(Pt, 64, 16 * nt, 32, lane); qv[nt] = *(const GAS u32x2*)(Qt + (size_t)(16 * nt + l15) * 64 + 16 * vq + g4); } }
#pragma unroll 1
    for (int c = 0; c < 64; ++c) {
        const size_t io = ((size_t)(b * 64 + c) * 8 + h) * 4096;
        GAS bf16_t* Sg = (GAS bf16_t*)(mx + RW_S) + io;
        bf16x8 bpn[4][2]; u32x2 qvn[4];
        { const int cn = c < 63 ? c + 1 : 63; const size_t ion = ((size_t)(b * 64 + cn) * 8 + h) * 4096;
          const GAS bf16_t* Pt = (const GAS bf16_t*)(mx + RW_PT) + ion; const GAS bf16_t* Qt = (const GAS bf16_t*)(mx + RW_QT) + ion;
#pragma unroll
          for (int nt = 0; nt < 4; ++nt) { bpn[nt][0] = rf_glb(Pt, 64, 16 * nt, 0, lane); bpn[nt][1] = rf_glb(Pt, 64, 16 * nt, 32, lane); qvn[nt] = *(const GAS u32x2*)(Qt + (size_t)(16 * nt + l15) * 64 + 16 * vq + g4); } }
#pragma unroll
        for (int nt = 0; nt < 4; ++nt)
#pragma unroll
            for (int r = 0; r < 4; ++r) *(LAS bf16_t*)(scr + (g4 + r) * TS + (16 * nt + l15) * 2) = (bf16_t)(pk2(S[nt][r], 0.f) & 0xffffu);
        asm volatile("s_waitcnt lgkmcnt(0)" ::: "memory");
        bf16x8 af[2]; af[0] = rf_lds(scr, TS, 0, 0, lane); af[1] = rf_lds(scr, TS, 0, 32, lane);
        asm volatile("s_waitcnt lgkmcnt(0)" ::: "memory");
        *(GAS bf16x8*)(Sg + (size_t)(16 * vq + l15) * 64 + 8 * (lane >> 4)) = af[0];
        *(GAS bf16x8*)(Sg + (size_t)(16 * vq + l15) * 64 + 32 + 8 * (lane >> 4)) = af[1];
#pragma unroll
        for (int nt = 0; nt < 4; ++nt) { f32x4 acc = {bflo(qv[nt].x), bfhi(qv[nt].x), bflo(qv[nt].y), bfhi(qv[nt].y)};
            acc = MFMA16(af[0], bp[nt][0], acc); acc = MFMA16(af[1], bp[nt][1], acc); S[nt] = acc; }
        SETTLE(S[0]); SETTLE(S[1]); SETTLE(S[2]); SETTLE(S[3]);
#pragma unroll
        for (int nt = 0; nt < 4; ++nt) { bp[nt][0] = bpn[nt][0]; bp[nt][1] = bpn[nt][1]; qv[nt] = qvn[nt]; }
    }
}

constexpr int R3_S0 = 0, R3_RH = 9216, R3_MH = 18432, R3_V = 27648, R3_SG = 36864, R3_HALF = 54272;
constexpr int R3_GT = 2 * R3_HALF, R3_GT_SZ = 64 * TS2, R3_KC = R3_GT + 2 * R3_GT_SZ, R3_KC_SZ = 320 * 4, R3_END = R3_KC + 2 * R3_KC_SZ;
__device__ __forceinline__ void rwkv_p3_load_const(const Params& p, const Ctx& C, int layer) {
    const int half = C.wave >> 2, th = C.tid & 255, h = (2 * C.bid + half) & 7, jl = layer >> 1;
    const GAS bf16_t* Gt = (const GAS bf16_t*)(p.ws + WS_GUPT) + ((size_t)jl * 512 + 64 * h) * 128;
#pragma unroll
    for (int q = 0; q < 4; ++q) { const int idx = th + 256 * q, r = idx >> 4, ch = idx & 15;
        *(LAS u32x4*)(C.lds + R3_GT + half * R3_GT_SZ + r * TS2 + 16 * ch) = *(const GAS u32x4*)(Gt + (size_t)r * 128 + 8 * ch); }
    LAS float* K = (LAS float*)(C.lds + R3_KC + half * R3_KC_SZ); const GAS float* mu = p.a_mu + (size_t)jl * RWKV_IN;
    for (int i = th; i < 320; i += 256)
        K[i] = i < 64 ? mu[RW_V + 64 * h + i] : i < 192 ? mu[RW_GD + (i - 64)] : i < 256 ? p.a_ln_gain[jl * 512 + 64 * h + (i - 192)] : p.a_ln_bias[jl * 512 + 64 * h + (i - 256)];
}
struct R3Pre { u32x4 cur[6], prv[6], s[2], rh[2], mh[2]; };
__device__ __forceinline__ void rwkv_p3_prefetch(const Params& p, int tid, int wave, int pair, R3Pre& pre) {
    const int half = wave >> 2, item = 2 * pair + half, h = item & 7, bc = item >> 3, c = bc & 63, th = tid & 255, j = th >> 2, cq = th & 3;
    const GAS bf16_t* cur = (const GAS bf16_t*)(p.ws + WS_U) + ((size_t)bc * 64 + j) * UPITCH; const bool hp = (c * 64 + j) != 0; const GAS bf16_t* prv = hp ? cur - UPITCH : cur;
#pragma unroll
    for (int q = 0; q < 6; ++q) { const int col = q < 2 ? RW_V + 64 * h + 16 * cq + 8 * q : RW_GD + 32 * cq + 8 * (q - 2); pre.cur[q] = *(const GAS u32x4*)(cur + col); pre.prv[q] = *(const GAS u32x4*)(prv + col); }
    GAS unsigned char* mx = p.ws + MX_BASE; const size_t io = (size_t)item * 4096;
    const GAS bf16_t* Sg = (const GAS bf16_t*)(mx + RW_S) + io; const GAS bf16_t* Rh = (const GAS bf16_t*)(mx + RW_RH) + io; const GAS bf16_t* Mh = (const GAS bf16_t*)(mx + RW_MH) + io;
#pragma unroll
    for (int q = 0; q < 2; ++q) { const int idx = th + 256 * q, r = idx >> 3, ch = idx & 7;
        pre.s[q] = __builtin_nontemporal_load((const GAS u32x4*)(Sg + (size_t)r * 64 + 8 * ch));
        pre.rh[q] = __builtin_nontemporal_load((const GAS u32x4*)(Rh + (size_t)r * 64 + 8 * ch));
        pre.mh[q] = __builtin_nontemporal_load((const GAS u32x4*)(Mh + (size_t)r * 64 + 8 * ch)); }
}
__device__ __forceinline__ void rwkv_pass3_pair(const Params& p, const Ctx& C0, int layer, int pair, int next_pair, R3Pre& pre) {
    Ctx C = C0; asm volatile("" : "+s"(C.wave)); asm volatile("" : "+v"(C.tid)); C.lane = C.tid & 63;
    const int half = C.wave >> 2, item = 2 * pair + half, h = item & 7, bc = item >> 3, c = bc & 63, jl = layer >> 1;
    GAS unsigned char* mx = p.ws + MX_BASE;
    LAS unsigned char* L = C.lds + half * R3_HALF;
    GAS bf16_t* Y = (GAS bf16_t*)(p.ws + WS_Y);
    const int th = C.tid & 255, lane = C.lane, g4 = 4 * (lane >> 4), l15 = lane & 15;
    const LAS float* KC = (const LAS float*)(C.lds + R3_KC + half * R3_KC_SZ); const LAS unsigned char* GtL = C.lds + R3_GT + half * R3_GT_SZ;
    const float bon = ((const GAS float*)(mx + RW_BON))[(size_t)item * 64 + 16 * (C.wave & 3) + l15];
    { const int j = th >> 2, cq = th & 3; const bool hp = (c * 64 + j) != 0;
      float t[8];
#pragma unroll
      for (int q = 0; q < 2; ++q) { rk_shift8r(pre.cur[q], pre.prv[q], hp, KC + 16 * cq + 8 * q, t); *(LAS u32x4*)(L + R3_V + j * TS + 32 * cq + 16 * q) = pack8(t); }
#pragma unroll
      for (int q = 0; q < 4; ++q) { rk_shift8r(pre.cur[2 + q], pre.prv[2 + q], hp, KC + 64 + 32 * cq + 8 * q, t);
#pragma unroll
          for (int i = 0; i < 8; ++i) t[i] = sigmoidf_(t[i]);
          *(LAS u32x4*)(L + R3_SG + j * TS2 + 64 * cq + 16 * q) = pack8(t); }
#pragma unroll
      for (int q = 0; q < 2; ++q) { const int idx = th + 256 * q, r = idx >> 3, ch = idx & 7;
          *(LAS u32x4*)(L + R3_S0 + r * TS + 16 * ch) = pre.s[q];
          *(LAS u32x4*)(L + R3_RH + r * TS + 16 * ch) = pre.rh[q];
          *(LAS u32x4*)(L + R3_MH + r * TS + 16 * ch) = pre.mh[q]; } }
    rwkv_p3_prefetch(p, C.tid, C.wave, next_pair, pre);
    LDS_BARRIER();
    { const int tb = C.wave & 3, t = 16 * tb + l15; const size_t tk = (size_t)bc * 64 + t;
      bf16x8 br[2], bm[2], bg[4];
#pragma unroll
      for (int ks = 0; ks < 2; ++ks) { br[ks] = rf_lds(L + R3_RH, TS, 16 * tb, 32 * ks, lane); bm[ks] = rf_lds(L + R3_MH, TS, 16 * tb, 32 * ks, lane); }
#pragma unroll
      for (int ks = 0; ks < 4; ++ks) bg[ks] = rf_lds(L + R3_SG, TS2, 16 * tb, 32 * ks, lane);
      bf16x8 av[2][4]; tf_2x4<TS>(L + R3_V, 0, 0, lane, av);
      f32x4 y[4], gt[4]; float s = 0.f;
      bf16x8 s0f[2][4];
#pragma unroll
      for (int mt = 0; mt < 4; ++mt) { s0f[0][mt] = rf_lds(L + R3_S0, TS, 16 * mt, 0, lane); s0f[1][mt] = rf_lds(L + R3_S0, TS, 16 * mt, 32, lane); y[mt] = (f32x4){0.f, 0.f, 0.f, 0.f}; gt[mt] = (f32x4){0.f, 0.f, 0.f, 0.f}; }
#pragma unroll
      for (int ks = 0; ks < 2; ++ks) {
#pragma unroll
          for (int mt = 0; mt < 4; ++mt) y[mt] = MFMA16(s0f[ks][mt], br[ks], y[mt]);
#pragma unroll
          for (int mt = 0; mt < 4; ++mt) y[mt] = MFMA16(av[ks][mt], bm[ks], y[mt]); }
#pragma unroll
      for (int ks = 0; ks < 4; ++ks)
#pragma unroll
          for (int mt = 0; mt < 4; ++mt) gt[mt] = MFMA16(rf_lds(GtL, TS2, 16 * mt, 32 * ks, lane), bg[ks], gt[mt]);
      SETTLE4(y[0], y[1], y[2], y[3]); SETTLE4(gt[0], gt[1], gt[2], gt[3]);
#pragma unroll
      for (int mt = 0; mt < 4; ++mt) s += (y[mt][0] + y[mt][1]) + (y[mt][2] + y[mt][3]);
      s += __shfl_xor(s, 16); s += __shfl_xor(s, 32);
      const float mean = s * (1.f / 64.f); float s2 = 0.f;
#pragma unroll
      for (int mt = 0; mt < 4; ++mt)
#pragma unroll
          for (int r = 0; r < 4; ++r) { const float d = y[mt][r] - mean; s2 += d * d; }
      s2 += __shfl_xor(s2, 16); s2 += __shfl_xor(s2, 32);
      const float rstd = rsqrtf(s2 * (1.f / 64.f) + 64e-5f);
      const LAS float* lg = KC + 192; const LAS float* lb = KC + 256;
      GAS bf16_t* yp = Y + tk * D + 64 * h;
#pragma unroll
      for (int mt = 0; mt < 4; ++mt) { const int v0 = 16 * mt + g4; const f32x4 G = *(const LAS f32x4*)(lg + v0), Bv = *(const LAS f32x4*)(lb + v0); const f32x4 vv = ld4_lds(L + R3_V, TS, t, v0);
          f32x4 o;
#pragma unroll
          for (int r = 0; r < 4; ++r) o[r] = ((y[mt][r] - mean) * rstd * G[r] + Bv[r] + bon * vv[r]) * gt[mt][r];
          u32x2 pk; pk.x = pk2(o[0], o[1]); pk.y = pk2(o[2], o[3]); *(GAS u32x2*)(yp + v0) = pk; } }
    LDS_BARRIER();
}
constexpr int LDS_BYTES = 150528;
constexpr int LDS_TAB = 131072;
constexpr int LDS_P2SCR = 135168;
constexpr int LDS_BARW = LDS_BYTES - 16;
constexpr int N_PHASES = 2 + 9 * DEPTH;
static_assert(SD_END <= LDS_BARW && RK_CONST + 2560 <= LDS_BARW && SD_RS + 512 <= LDS_BARW && R3_END <= LDS_BARW, "LDS map");

typedef const __attribute__((address_space(4))) Params* KParams;
__global__ void __launch_bounds__(512, 2) mk_fwd(Params p_arg) {
    extern __shared__ __attribute__((aligned(16))) unsigned char lds_raw[];
    KParams kp0 = (KParams)__builtin_amdgcn_kernarg_segment_ptr();
    Params p;
    Ctx C; C.lds = (LAS unsigned char*)lds_raw; C.G = gridDim.x; C.bid = blockIdx.x;
    const int wave0 = __builtin_amdgcn_readfirstlane(threadIdx.x >> 6);
    C.wave = wave0; C.lane = __builtin_amdgcn_mbcnt_hi(~0u, __builtin_amdgcn_mbcnt_lo(~0u, 0u)); C.tid = wave0 * 64 + C.lane;
    const int lo = (int)kp0->ph_lo, hi = (int)kp0->ph_hi;
    GAS unsigned char* const ws0 = kp0->ws;
    if (C.tid == 0) *(LAS u32x4*)(C.lds + LDS_BARW) = (u32x4){0u, 0u, 0u, 0u};
    __syncthreads();
    XcdBarrier bar; bar.bar = (GAS unsigned*)(ws0 + WS_CTL) + CW_BAR; bar.x = 0; bar.st = (volatile LAS unsigned*)(C.lds + LDS_BARW);
    if (hi - lo > 1) bar = xcd_barrier_post((GAS unsigned*)(ws0 + WS_CTL) + CW_BAR, (volatile LAS unsigned*)(C.lds + LDS_BARW), C.tid);
#define FRESH() do { KParams kq_ = kp0; asm volatile("" : "+s"(kq_)); { const __attribute__((address_space(4))) unsigned long long* kw_ = (const __attribute__((address_space(4))) unsigned long long*)kq_; unsigned long long* pw_ = (unsigned long long*)&p; _Pragma("unroll") for (int i_ = 0; i_ < (int)(sizeof(Params) / 8); ++i_) pw_[i_] = kw_[i_]; } int wv_ = wave0; asm volatile("" : "+s"(wv_)); \
        unsigned mk_ = ~0u; asm volatile("" : "+s"(mk_)); int ln_ = __builtin_amdgcn_mbcnt_hi(mk_, __builtin_amdgcn_mbcnt_lo(mk_, 0u)); asm volatile("" : "+v"(ln_)); C.wave = wv_; C.lane = ln_; C.tid = wv_ * 64 + ln_; } while (0)
#ifndef PH_MASK
#define PH_MASK 0xFFFF
#endif
#define PM(b) ((PH_MASK >> (b)) & 1)
#ifndef REP_MASK
#define REP_MASK 0
#endif
#define RP(b) for (int rep_ = 0; rep_ < 1 + ((REP_MASK >> (b)) & 1); ++rep_)
#ifdef DBG_TIME
#define STAMP(k) do { if (blockIdx.x == 0 && C.tid == 0) ((GAS unsigned long long*)(ws0 + WS_END - 32768))[(k)] = wall_clock64(); } while (0)
#else
#define STAMP(k) do { } while (0)
#endif
#define IN(k) (lo <= (k) && (k) < hi)
#define SEAM(k) do { if (IN(k) && IN((k) + 1)) { FRESH(); xcd_barrier(bar, C.tid); if ((REP_MASK >> 15) & 1) { xcd_barrier(bar, C.tid); xcd_barrier(bar, C.tid); } STAMP((k) + 1); } } while (0)
    STAMP(0);
    if (PM(0) && IN(0)) RP(0) { FRESH(); p0_prologue(p, C); __syncthreads(); }
    SEAM(0);
#pragma nounroll
    for (int l = 0; l < DEPTH; ++l) {
        const int P = 1 + 9 * l; const bool odd = (l & 1) != 0;
        if (PM(1) && IN(P)) { if ((REP_MASK >> 1) & 1) { FRESH(); norm_phase<false, true>(p, C, l); __syncthreads(); } FRESH(); norm_phase<false>(p, C, l); }
        SEAM(P);
        if (PM(2) && IN(P + 1)) RP(2) { FRESH();
            const GAS bf16_t* W = odd ? (const GAS bf16_t*)(p.ws + WS_WINO) + (size_t)(l >> 1) * NPO * D : (const GAS bf16_t*)(p.ws + WS_WINE) + (size_t)(l >> 1) * NPE * D;
            pg8::StaticOrder S; S.init(p.ws + WS_H, W, T, odd ? NPO : NPE, D, C.G, C.bid);
            EpiU E{(GAS bf16_t*)(p.ws + WS_U)};
            pg8::gemm_phase<EpiU, pg8::StaticOrder, false>(C.lds, C.tid, D, S, E);
        }
        SEAM(P + 1);
        if (IN(P + 2)) { FRESH();
            if (!odd) { if (PM(3)) RP(3) { const int h = C.bid & 7; rk_load_const(p, C, l, h); RkPre pre; rk_prefetch(p, C.tid, h, C.bid, pre);
                            bf16x8 wf[4][2]; { const int prod = C.wave >> 2; const GAS bf16_t* Wt = (const GAS bf16_t*)(p.ws + (prod ? WS_AUPT : WS_WUPT)) + ((size_t)(l >> 1) * 512 + 64 * h) * 64;
#pragma unroll
                              for (int bt = 0; bt < 4; ++bt) { wf[bt][0] = rf_glb(Wt, 64, 16 * bt, 0, C.lane); wf[bt][1] = rf_glb(Wt, 64, 16 * bt, 32, C.lane); } }
                            __syncthreads();
                            for (int it = C.bid; it < 4096; it += C.G) rwkv_pass1_item(p, C, l, it, (it + C.G < 4096) ? it + C.G : it, pre, wf); }
                        if (PM(4)) RP(4) { gla_stage_aup<false>(p, C, l, C.bid & 3); GlPre pre1; gla_prefetch1<false>(p, C.tid, C.bid, pre1); __syncthreads(); for (int it = C.bid; it < 2048; it += C.G) gla_pass1_item<false>(p, C, l, it, (it + C.G < 2048) ? it + C.G : it, pre1); } }
            else      { if (PM(4)) RP(4) { GlPre pre1; gla_prefetch1<true>(p, C.tid, C.bid, pre1); for (int it = C.bid; it < 2048; it += C.G) gla_pass1_item<true>(p, C, l, it, (it + C.G < 2048) ? it + C.G : it, pre1); }
                        if (PM(5)) RP(5) { ssd_load_cw(p, C, l, C.bid & 1); __syncthreads(); for (int it = C.bid; it < 1024; it += C.G) ssd_pass1_item(p, C, l, it); } }
        }
        SEAM(P + 2);
        if (PM(6) && IN(P + 3)) RP(6) { FRESH();
            if (!odd) { if (C.wave == 0) { for (int job = C.bid; job < 256; job += C.G) rwkv_pass2_job(p, C.lds + LDS_P2SCR, job, C.lane); }
                        else if (C.wave <= 4) { for (int job = C.bid * 4 + C.wave - 1; job < 1024; job += C.G * 4) gla_pass2_job<false>(p, job, C.lane); } }
            else      { if (C.wave < 4) { for (int job = C.bid * 4 + C.wave; job < 1024; job += C.G * 4) gla_pass2_job<true>(p, job, C.lane); }
                        else { for (int job = C.bid * 4 + C.wave - 4; job < 1024; job += C.G * 4) ssd_pass2_job(p, job, C.lane); } }
        }
        SEAM(P + 3);
        if (IN(P + 4)) { FRESH();
            if (!odd) { if (PM(7)) RP(7) { rwkv_p3_load_const(p, C, l); R3Pre pre3; rwkv_p3_prefetch(p, C.tid, C.wave, C.bid, pre3); __syncthreads(); for (int it = C.bid; it < 2048; it += C.G) rwkv_pass3_pair(p, C, l, it, (it + C.G < 2048) ? it + C.G : it, pre3); __syncthreads(); }
                        if (PM(8)) RP(8) { Gl3Pre pre3; gla_prefetch3<false>(p, C.tid, C.bid, pre3); for (int it = C.bid; it < 2048; it += C.G) gla_pass3_item<false>(p, C, l, it, (it + C.G < 2048) ? it + C.G : it, pre3); } }
            else      { if (PM(8)) RP(8) { Gl3Pre pre3; gla_prefetch3<true>(p, C.tid, C.bid, pre3); for (int it = C.bid; it < 2048; it += C.G) gla_pass3_item<true>(p, C, l, it, (it + C.G < 2048) ? it + C.G : it, pre3); }
                        if (PM(9)) RP(9) { ssd_load_cw(p, C, l, C.bid & 1); __syncthreads(); for (int it = C.bid; it < 1024; it += C.G) ssd_pass3_item(p, C, l, it); } }
        }
        SEAM(P + 4);
        if (PM(10) && IN(P + 5)) { FRESH();
            pg8::StaticOrder S; S.init(p.ws + WS_Y, (const GAS bf16_t*)(p.ws + WS_WOUT) + (size_t)l * D * D, T, D, D, C.G, C.bid);
            EpiOut E{(GAS bf16_t*)(p.ws + WS_XB), (const GAS float*)(p.ws + WS_MOD) + (size_t)l * NB * 6 * D + 2 * D};
            pg8::gemm_phase<EpiOut, pg8::StaticOrder, false>(C.lds, C.tid, D, S, E);
        }
        SEAM(P + 5);
        if (PM(11) && IN(P + 6)) { if ((REP_MASK >> 11) & 1) { FRESH(); route_phase<true>(p, C, l); __syncthreads(); } FRESH(); route_phase<false>(p, C, l); }
        SEAM(P + 6);
        if (PM(12) && IN(P + 7)) RP(12) { FRESH();
            LAS int* tab = (LAS int*)(C.lds + LDS_TAB); moe_table(p, C, l, tab);
            MoeOrder S{(const GAS char*)(p.ws + WS_H), (const GAS char*)(p.ws + moe_wgu(l)), D, (size_t)1024 * D * 2, tab, (const GAS int*)(p.ws + WS_LISTA), C.G, C.bid, false};
            EpiUp E{(GAS bf16_t*)(p.ws + WS_ACT)};
            pg8::gemm_phase<EpiUp, MoeOrder, true>(C.lds, C.tid, D, S, E);
            FRESH(); moe_convert_tail(p, C, l, (const LAS int*)(C.lds + LDS_TAB), 0);
        }
        SEAM(P + 7);
        if (PM(13) && IN(P + 8)) RP(13) { FRESH();
            LAS int* tab = (LAS int*)(C.lds + LDS_TAB); moe_table(p, C, l, tab);
            MoeOrder S{(const GAS char*)(p.ws + WS_ACT), (const GAS char*)(p.ws + moe_wdn(l)), DEXP, (size_t)D * DEXP * 2, tab, (const GAS int*)(p.ws + WS_LISTA), C.G, C.bid, true};
            EpiDown E{(GAS bf16_t*)(p.ws + WS_YB), (const GAS int*)(p.ws + WS_LISTA), (const GAS float*)(p.ws + WS_LISTW)};
            pg8::gemm_phase<EpiDown, MoeOrder, false>(C.lds, C.tid, DEXP, S, E);
            FRESH(); moe_convert_tail(p, C, l, (const LAS int*)(C.lds + LDS_TAB), 1);
        }
        SEAM(P + 8);
    }
    if (PM(14) && IN(N_PHASES - 1)) { FRESH(); norm_phase<true>(p, C, DEPTH - 1); }
    __syncthreads(); STAMP(N_PHASES);
#undef IN
#undef PM
#undef SEAM
}


#ifdef DBG
constexpr int CW_DBG = 8192;
__global__ void dbg_scan(const void* base, int rows, int cols, int pitch, int is_f32, unsigned* flags, unsigned bit, float thr = 1e30f) {
    bool bad = false;
    for (size_t i = (size_t)blockIdx.x * blockDim.x + threadIdx.x; i < (size_t)rows * cols; i += (size_t)gridDim.x * blockDim.x) {
        const size_t r = i / cols, c = i % cols;
        float v = is_f32 ? ((const float*)base)[r * pitch + c] : bf2f(((const bf16_t*)base)[r * pitch + c]);
        if (!(fabsf(v) < thr)) bad = true;
    }
    if (bad) atomicOr(flags, bit);
}

__global__ void dbg_count(const void* base, size_t n, int is_f32, unsigned long long* cnt) {
    unsigned long long c = 0;
    for (size_t i = (size_t)blockIdx.x * blockDim.x + threadIdx.x; i < n; i += (size_t)gridDim.x * blockDim.x) {
        float v = is_f32 ? ((const float*)base)[i] : bf2f(((const bf16_t*)base)[i]);
        if (!(fabsf(v) < 1e30f)) ++c;
    }
    if (c) atomicAdd(cnt, c);
}
__global__ void dbg_log2(const unsigned long long* cnt, unsigned* flags) { unsigned long long c = *cnt; unsigned k = 0; while (c) { ++k; c >>= 1; } *flags = k; }

__global__ void dbg_sum(const void* base, int rows, int cols, int pitch, int esz, unsigned long long* slot) {
    unsigned long long c = 0;
    for (size_t i = (size_t)blockIdx.x * blockDim.x + threadIdx.x; i < (size_t)rows * cols; i += (size_t)gridDim.x * blockDim.x) {
        const size_t r = i / cols, cc = i % cols;
        const unsigned v = esz == 4 ? ((const unsigned*)base)[r * pitch + cc] : (unsigned)((const unsigned short*)base)[r * pitch + cc];
        c += (unsigned long long)v * (unsigned long long)(1 + (i & 1023));
    }
    atomicAdd(slot, c);
}
__global__ void dbg_cmpmask(const unsigned long long* s1, const unsigned long long* s2, int n, unsigned* flags) { unsigned f = 0; for (int i = 0; i < n; ++i) if (s1[i] != s2[i]) f |= 1u << i; *flags = f; }
__global__ void dbg_cmp(const unsigned long long* s1, const unsigned long long* s2, int n, unsigned* flags) { unsigned f = 0; for (int i = n - 1; i >= 0; --i) if (s1[i] != s2[i]) f = (unsigned)i; *flags = f; }
__global__ void dbg_emit(float* out, const unsigned* flags) {
    const size_t i = (size_t)blockIdx.x * blockDim.x + threadIdx.x;
    if (i < (size_t)T * D) out[i] = (i == 0) ? sqrtf((float)(flags[0] + flags[1]) * (float)T * (float)D) : 0.f;
}
#endif

#ifdef DBG_TIME
__global__ void dbg_time_emit(float* out, const unsigned long long* st) {
    const size_t i = (size_t)blockIdx.x * blockDim.x + threadIdx.x;
    const float da = (float)(st[DBG_TA1] - st[DBG_TA0]) * 0.01f, db = (float)(st[DBG_TB1] - st[DBG_TB0]) * 0.01f;
    if (i < (size_t)T * D) out[i] = (i == 0) ? db : sqrtf(da);
}
#endif
extern "C" void kernel_launch(void* const* d_in, const int* in_sizes, int n_in, void* d_out, int out_size, void* d_ws, size_t ws_size, hipStream_t stream) {
    static int grid = 0;
    if (grid == 0) {
        if (n_in != 36 || out_size != T * D || ws_size < WS_END) { fprintf(stderr, "kernel_launch: unexpected shapes (n_in %d out %d ws %zu need %zu)\n", n_in, out_size, ws_size, (size_t)WS_END); grid = -1; return; }
        int dev = 0, cus = 0, per_cu = 0;
        if (hipGetDevice(&dev) != hipSuccess || hipDeviceGetAttribute(&cus, hipDeviceAttributeMultiprocessorCount, dev) != hipSuccess) { grid = -1; return; }
        if (hipFuncSetAttribute((const void*)mk_fwd, hipFuncAttributeMaxDynamicSharedMemorySize, LDS_BYTES) != hipSuccess) { fprintf(stderr, "kernel_launch: hipFuncSetAttribute failed\n"); grid = -1; return; }
        if (hipOccupancyMaxActiveBlocksPerMultiprocessor(&per_cu, (const void*)mk_fwd, 512, LDS_BYTES) != hipSuccess || per_cu < 1) { fprintf(stderr, "kernel_launch: occupancy query says %d\n", per_cu); (void)hipGetLastError(); grid = -1; return; }
        grid = cus; if (grid % 8) { fprintf(stderr, "kernel_launch: grid %d is not a multiple of 8\n", grid); grid = -1; return; }
    }
    if (grid < 0) return;
#ifdef DBG_MEMSET_ALL
    (void)hipMemsetAsync((char*)d_ws, 0, WS_END, stream);
#else
    (void)hipMemsetAsync((char*)d_ws + WS_CTL, 0, CTL_BYTES, stream);
#endif
    Params p{};
    const float** pp = (const float**)&p;
    for (int i = 0; i < 36; ++i) pp[i] = (const float*)d_in[i];
    p.out = (GAS float*)d_out; p.ws = (GAS unsigned char*)d_ws;
#if MK_LAUNCHES == 1
    p.ph_lo = 0; p.ph_hi = N_PHASES;
    hipLaunchKernelGGL(mk_fwd, dim3(grid), dim3(512), LDS_BYTES, stream, p);
#ifdef DBG_TIME
    hipLaunchKernelGGL(dbg_time_emit, dim3(T * D / 256), dim3(256), 0, stream, (float*)d_out, (const unsigned long long*)((unsigned char*)d_ws + WS_END - 32768));
#endif
#else
#ifdef DBG_TWICE
    (void)hipMemsetAsync((char*)d_ws + WS_END - 65536, 0, 65536, stream);
    for (int rep = 0; rep < 2; ++rep) { if (rep) (void)hipMemsetAsync((char*)d_ws + WS_CTL, 0, CTL_BYTES, stream);
#else
    { const int rep = 0; (void)rep;
#endif
    for (int ph = 0; ph < N_PHASES; ++ph) { p.ph_lo = ph; p.ph_hi = ph + 1; hipLaunchKernelGGL(mk_fwd, dim3(grid), dim3(512), LDS_BYTES, stream, p);
#ifdef DBG
        unsigned char* ws = (unsigned char*)d_ws; unsigned* fl = (unsigned*)(ws + WS_CTL) + CW_DBG;
        DBG_HOOKS
#endif
    }
    }
#ifdef DBG
    { unsigned* fl = (unsigned*)((unsigned char*)d_ws + WS_CTL) + CW_DBG;
      hipLaunchKernelGGL(dbg_scan, dim3(1024), dim3(256), 0, stream, (const void*)d_out, T, D, D, 1, fl, DBG_FINAL_BIT);
      hipLaunchKernelGGL(dbg_emit, dim3(T * D / 256), dim3(256), 0, stream, (float*)d_out, (const unsigned*)fl); }
#endif
#endif
}
```
